# Optimizing an MI355X kernel written in HIP

```python
import math
import jax, jax.numpy as jnp
from jax import lax
import numpy as np

D_MODEL = 1024
BATCH = 8
SEQ = 4096
DEPTH = 2

CHUNK = 64
Q_BLOCK = 128
RMS_EPS = 1e-6

N_BUCKETS = 32
MAX_DISTANCE = 128

A_HEADS = 4
A_HEAD_DIM = 64
A_V_DIM = 2 * A_HEAD_DIM
A_WIDTH = A_HEADS * A_V_DIM

B_HEADS = 8
B_HEAD_DIM = 64
B_WIDTH = B_HEADS * B_HEAD_DIM
IDX_HEADS = 8
IDX_DIM = 64
TOPK_MAX = 256

BIAS_HEADS = A_HEADS + B_HEADS
L0_WIDTH = A_WIDTH + B_WIDTH
L0_SIZES = (A_HEADS * 2 * A_HEAD_DIM, A_HEADS * 2 * A_HEAD_DIM, A_WIDTH,
            B_WIDTH, B_HEAD_DIM, B_HEAD_DIM,
            IDX_HEADS * IDX_DIM, IDX_DIM, IDX_HEADS,
            L0_WIDTH)
L0_COLS = sum(L0_SIZES)

C_HEADS = 16
C_NOPE = 64
C_ROPE = 32
C_V = 64
Q_LORA = 384
KV_LORA = 256
C_WIDTH = C_HEADS * C_V
ROPE_THETA = 10000.0
L1_SIZES = (Q_LORA, KV_LORA, C_ROPE, C_WIDTH)
L1_COLS = sum(L1_SIZES)

N_EVEN = (DEPTH + 1) // 2
N_ODD = DEPTH // 2

kernel_name = 'hybrid_diff_dsa_mla_stream_encoder'


def rms_norm(x, g):
    xf = x.astype(jnp.float32)
    y = xf * lax.rsqrt(jnp.mean(xf * xf, axis=-1, keepdims=True) + RMS_EPS)
    return (y * g.astype(jnp.float32)).astype(x.dtype)


def split_cols(t, sizes):
    return jnp.split(t, np.cumsum(sizes)[:-1].tolist(), axis=-1)


def to_blocks(t):
    b, s = t.shape[:2]
    return t.reshape((b, s // Q_BLOCK, Q_BLOCK) + t.shape[2:]).swapaxes(0, 1)


def from_blocks(o):
    nb, b, q = o.shape[:3]
    return o.swapaxes(0, 1).reshape((b, nb * q) + o.shape[3:])


def chunk_mask(qpos, kpos):
    return (kpos[None, :] // CHUNK) <= (qpos[:, None] // CHUNK)


def t5_bucket(rel):
    nb = N_BUCKETS // 2
    ret = jnp.where(rel > 0, nb, 0)
    n = jnp.abs(rel)
    max_exact = nb // 2
    n_f = jnp.maximum(n, 1).astype(jnp.float32)
    large = max_exact + (jnp.log(n_f / max_exact) / math.log(MAX_DISTANCE / max_exact)
                         * (nb - max_exact)).astype(jnp.int32)
    large = jnp.minimum(large, nb - 1)
    return ret + jnp.where(n < max_exact, n, large)


def rope_tables(s):
    inv = ROPE_THETA ** (-jnp.arange(0, C_ROPE, 2, dtype=jnp.float32) / C_ROPE)
    ang = jnp.arange(s, dtype=jnp.float32)[:, None] * inv[None, :]
    return jnp.cos(ang), jnp.sin(ang)


def apply_rope(x, cos, sin):
    x1, x2 = jnp.split(x, 2, axis=-1)
    c = cos.astype(x.dtype)
    s = sin.astype(x.dtype)
    return jnp.concatenate([x1 * c - x2 * s, x1 * s + x2 * c], axis=-1)


def diff_attention(q, k, v, lam, bias_tab):
    s_len = q.shape[1]
    nb = s_len // Q_BLOCK
    kpos = jnp.arange(s_len)
    scale = A_HEAD_DIM ** -0.5

    def block(args):
        q_blk, bi = args
        qpos = bi * Q_BLOCK + jnp.arange(Q_BLOCK)
        s = jnp.einsum('bqhmd,bkhmd->bhmqk', q_blk, k).astype(jnp.float32) * scale
        bias = bias_tab[t5_bucket(kpos[None, :] - qpos[:, None])].astype(jnp.float32)
        s = s + jnp.transpose(bias, (2, 0, 1))[None, :, None]
        s = jnp.where(chunk_mask(qpos, kpos), s, -jnp.inf)
        p = jax.nn.softmax(s, axis=-1)
        p = p[:, :, 0] - lam * p[:, :, 1]
        return jnp.einsum('bhqk,bkhe->bqhe', p.astype(v.dtype), v)

    return from_blocks(lax.map(block, (to_blocks(q), jnp.arange(nb))))


def dsa_attention(q, k, v, q_idx, k_idx, w_idx, bias_tab, top_k):
    b, s_len = q.shape[:2]
    nb = s_len // Q_BLOCK
    kpos = jnp.arange(s_len)
    scale = B_HEAD_DIM ** -0.5

    def block(args):
        q_blk, qi_blk, w_blk, bi = args
        qpos = bi * Q_BLOCK + jnp.arange(Q_BLOCK)
        logits = jnp.einsum('bqhd,bkd->bqhk', qi_blk, k_idx).astype(jnp.float32)
        score = jnp.einsum('bqh,bqhk->bqk', w_blk.astype(jnp.float32), jax.nn.relu(logits))
        score = jnp.where(chunk_mask(qpos, kpos)[None], score, -jnp.inf)
        _, sel = lax.top_k(score, top_k)
        valid = (sel // CHUNK) <= (qpos // CHUNK)[None, :, None]
        flat = sel.reshape(b, -1, 1)
        k_sel = jnp.take_along_axis(k, flat, axis=1).reshape(b, Q_BLOCK, top_k, B_HEAD_DIM)
        v_sel = jnp.take_along_axis(v, flat, axis=1).reshape(b, Q_BLOCK, top_k, B_HEAD_DIM)
        s = jnp.einsum('bqhd,bqkd->bhqk', q_blk, k_sel).astype(jnp.float32) * scale
        bias = bias_tab[t5_bucket(sel - qpos[None, :, None])].astype(jnp.float32)
        s = s + jnp.transpose(bias, (0, 3, 1, 2))
        s = jnp.where(valid[:, None], s, -jnp.inf)
        p = jax.nn.softmax(s, axis=-1)
        return jnp.einsum('bhqk,bqkd->bqhd', p.astype(v.dtype), v_sel)

    xs = (to_blocks(q), to_blocks(q_idx), to_blocks(w_idx), jnp.arange(nb))
    return from_blocks(lax.map(block, xs))


def mla_attention(q_nope, q_rope, k_nope, k_rope, v):
    s_len = q_nope.shape[1]
    nb = s_len // Q_BLOCK
    kpos = jnp.arange(s_len)
    scale = (C_NOPE + C_ROPE) ** -0.5

    def block(args):
        qn, qr, bi = args
        qpos = bi * Q_BLOCK + jnp.arange(Q_BLOCK)
        s = (jnp.einsum('bqhd,bkhd->bhqk', qn, k_nope)
             + jnp.einsum('bqhr,bkr->bhqk', qr, k_rope)).astype(jnp.float32) * scale
        s = jnp.where(chunk_mask(qpos, kpos), s, -jnp.inf)
        p = jax.nn.softmax(s, axis=-1)
        return jnp.einsum('bhqk,bkhd->bqhd', p.astype(v.dtype), v)

    xs = (to_blocks(q_nope), to_blocks(q_rope), jnp.arange(nb))
    return from_blocks(lax.map(block, xs))


def diff_dsa_layer(x, norm_g, w_in, lq1, lk1, lq2, lk2, subln_g, w_o, rel_bias, layer, top_k):
    b, s_len, _ = x.shape
    h = rms_norm(x, norm_g)
    proj = h @ w_in
    qa, ka, va, qb, kb, vb, qi, ki, wi, gate = split_cols(proj, L0_SIZES)
    lam_init = 0.8 - 0.6 * math.exp(-0.3 * layer)
    f32 = jnp.float32
    lam = (jnp.exp(jnp.sum(lq1.astype(f32) * lk1.astype(f32)))
           - jnp.exp(jnp.sum(lq2.astype(f32) * lk2.astype(f32))) + lam_init)
    o_a = diff_attention(qa.reshape(b, s_len, A_HEADS, 2, A_HEAD_DIM),
                         ka.reshape(b, s_len, A_HEADS, 2, A_HEAD_DIM),
                         va.reshape(b, s_len, A_HEADS, A_V_DIM),
                         lam, rel_bias[:, :A_HEADS])
    o_a = rms_norm(o_a, subln_g) * (1.0 - lam_init)
    o_b = dsa_attention(qb.reshape(b, s_len, B_HEADS, B_HEAD_DIM), kb, vb,
                        qi.reshape(b, s_len, IDX_HEADS, IDX_DIM), ki, wi,
                        rel_bias[:, A_HEADS:], top_k)
    mix = jnp.concatenate([o_a.reshape(b, s_len, A_WIDTH), o_b.reshape(b, s_len, B_WIDTH)], axis=-1)
    return x + (mix * jax.nn.silu(gate)) @ w_o


def mla_layer(x, norm_g, w_in, q_norm, w_uq, kv_norm, w_ukv, w_o, cos, sin):
    b, s_len, _ = x.shape
    h = rms_norm(x, norm_g)
    proj = h @ w_in
    q_lat, kv_lat, k_rope, gate = split_cols(proj, L1_SIZES)
    q = (rms_norm(q_lat, q_norm) @ w_uq).reshape(b, s_len, C_HEADS, C_NOPE + C_ROPE)
    kv = (rms_norm(kv_lat, kv_norm) @ w_ukv).reshape(b, s_len, C_HEADS, C_NOPE + C_V)
    q_nope, q_rope = q[..., :C_NOPE], q[..., C_NOPE:]
    k_nope, v = kv[..., :C_NOPE], kv[..., C_NOPE:]
    q_rope = apply_rope(q_rope, cos[:, None, :], sin[:, None, :])
    k_rope = apply_rope(k_rope, cos, sin)
    o = mla_attention(q_nope, q_rope, k_nope, k_rope, v).reshape(b, s_len, C_WIDTH)
    return x + (o * jax.nn.silu(gate)) @ w_o


def setup_inputs(seed: int = 0) -> dict:
    key = jax.random.key(seed)
    ks = jax.random.split(key, 20)
    f32 = jnp.float32

    def dense(k, shape, fan_in):
        return jax.random.normal(k, shape, f32) * (fan_in ** -0.5)

    def gain(k, shape):
        return 1.0 + 0.02 * jax.random.normal(k, shape, f32)

    return {
        'x': jax.random.normal(ks[0], (BATCH, SEQ, D_MODEL), f32),
        'rel_bias': 0.2 * jax.random.normal(ks[1], (N_BUCKETS, BIAS_HEADS), f32),
        'e_norm': gain(ks[2], (N_EVEN, D_MODEL)),
        'e_w_in': dense(ks[3], (N_EVEN, D_MODEL, L0_COLS), D_MODEL),
        'e_lam_q1': 0.1 * jax.random.normal(ks[4], (N_EVEN, A_HEAD_DIM), f32),
        'e_lam_k1': 0.1 * jax.random.normal(ks[5], (N_EVEN, A_HEAD_DIM), f32),
        'e_lam_q2': 0.1 * jax.random.normal(ks[6], (N_EVEN, A_HEAD_DIM), f32),
        'e_lam_k2': 0.1 * jax.random.normal(ks[7], (N_EVEN, A_HEAD_DIM), f32),
        'e_subln': gain(ks[8], (N_EVEN, A_V_DIM)),
        'e_w_o': dense(ks[9], (N_EVEN, L0_WIDTH, D_MODEL), L0_WIDTH),
        'o_norm': gain(ks[10], (N_ODD, D_MODEL)),
        'o_w_in': dense(ks[11], (N_ODD, D_MODEL, L1_COLS), D_MODEL),
        'o_q_norm': gain(ks[12], (N_ODD, Q_LORA)),
        'o_w_uq': dense(ks[13], (N_ODD, Q_LORA, C_HEADS * (C_NOPE + C_ROPE)), Q_LORA),
        'o_kv_norm': gain(ks[14], (N_ODD, KV_LORA)),
        'o_w_ukv': dense(ks[15], (N_ODD, KV_LORA, C_HEADS * (C_NOPE + C_V)), KV_LORA),
        'o_w_o': dense(ks[16], (N_ODD, C_WIDTH, D_MODEL), C_WIDTH),
        'final_norm': gain(ks[17], (D_MODEL,)),
    }


def reference(x, rel_bias, e_norm, e_w_in, e_lam_q1, e_lam_k1, e_lam_q2, e_lam_k2, e_subln, e_w_o,
              o_norm, o_w_in, o_q_norm, o_w_uq, o_kv_norm, o_w_ukv, o_w_o, final_norm):
    s_len = x.shape[1]
    top_k = min(TOPK_MAX, s_len // 4)
    cos, sin = rope_tables(s_len)
    h = x
    for layer in range(DEPTH):
        i = layer // 2
        if layer % 2 == 0:
            h = diff_dsa_layer(h, e_norm[i], e_w_in[i], e_lam_q1[i], e_lam_k1[i], e_lam_q2[i],
                               e_lam_k2[i], e_subln[i], e_w_o[i], rel_bias, layer, top_k)
        else:
            h = mla_layer(h, o_norm[i], o_w_in[i], o_q_norm[i], o_w_uq[i], o_kv_norm[i],
                          o_w_ukv[i], o_w_o[i], cos, sin)
    return rms_norm(h, final_norm)
```

```cpp
#include <hip/hip_runtime.h>
#include <cstdio>
#include <cstdint>

#ifndef DEBUG_CHECK
#define DEBUG_CHECK 0
#endif
#define TAPB 3
#define TAPH 5
#define TAPQB 7
#ifndef MK_N_LAUNCHES
#define MK_N_LAUNCHES 1
#endif

#define LAS __attribute__((address_space(3)))
#define GAS __attribute__((address_space(1)))
typedef unsigned short u16;
typedef unsigned long long u64;
typedef _Float16 h8 __attribute__((ext_vector_type(8)));
typedef _Float16 h2 __attribute__((ext_vector_type(2)));
typedef _Float16 h4 __attribute__((ext_vector_type(4)));
typedef short s16x4 __attribute__((ext_vector_type(4)));
typedef short s16x8 __attribute__((ext_vector_type(8)));
typedef float f32x2 __attribute__((ext_vector_type(2)));
typedef float f32x4 __attribute__((ext_vector_type(4)));
typedef float f32x16 __attribute__((ext_vector_type(16)));
typedef unsigned u32x2 __attribute__((ext_vector_type(2)));
typedef unsigned u32x4 __attribute__((ext_vector_type(4)));

constexpr int SEQ = 4096, NB = 8, T = NB * SEQ, DM = 1024;
constexpr int P0W = 3840;
constexpr int C_QA = 0, C_KA = 512, C_VA = 1024, C_QB = 1536, C_KB = 2048, C_VB = 2112, C_QI = 2176, C_KI = 2688, C_WI = 2752, C_G0 = 2816;
constexpr int L0_SRC = 3784;
constexpr int P1W = 1792;
constexpr int L1_SRC = 1696;
constexpr int LATW = 640;
constexpr int TOPK = 256;
constexpr float LOG2E = 1.4426950408889634f;
constexpr float QS_AB = 0.125f * LOG2E;
constexpr float QS_C = 0.10206207261596575f * LOG2E;
constexpr float RMS_EPS = 1e-6f;
constexpr float FXS = 1048576.0f;

constexpr size_t MiB = 1u << 20;
constexpr size_t WS_CTL = 0, CTL_ZERO_BYTES = 2 * MiB;
constexpr size_t WS_SSQ1 = 1 * MiB, WS_SSQKV = WS_SSQ1 + 256 * 1024, WS_SSQQ = WS_SSQKV + 256 * 1024;
constexpr size_t WS_ROPEC = 2 * MiB, WS_ROPES = WS_ROPEC + 256 * 1024, WS_BTG = WS_ROPES + 256 * 1024, WS_LAM = WS_BTG + 16 * 1024;
constexpr size_t WS_W0T = 4 * MiB;
constexpr size_t WS_WO0T = 12 * MiB;
constexpr size_t WS_W1T = 14 * MiB;
constexpr size_t WS_WUQT = 18 * MiB;
constexpr size_t WS_WUKVT = 20 * MiB;
constexpr size_t WS_WO1T = 22 * MiB;
constexpr size_t WS_XN0 = 32 * MiB;
constexpr size_t WS_PROJ0 = 96 * MiB;
constexpr size_t WS_MG0 = 336 * MiB;
constexpr size_t WS_LAT = 96 * MiB;
constexpr size_t WS_KROPE = 136 * MiB;
constexpr size_t WS_G1 = 140 * MiB;
constexpr size_t WS_Q1 = 204 * MiB;
constexpr size_t WS_KV1 = 300 * MiB;
constexpr size_t WS_MG1 = 428 * MiB;
constexpr size_t WS_END = 492 * MiB;
constexpr size_t WS_DBGBUF = 3 * MiB + 4096;
constexpr int CW_TMO = 0, CW_CODE = 1, CW_Q0 = 64, CW_Q1 = 128, CW_BAR = 4096;

constexpr int RING_BYTES = 131072;
constexpr int MISC_OFF = RING_BYTES + 320;
constexpr int LDS_BYTES = 147456;
constexpr int NWAVES = 8;

__device__ __forceinline__ unsigned pkh(float lo, float hi) { f32x2 v = {lo, hi}; h2 h = __builtin_convertvector(v, h2); return __builtin_bit_cast(unsigned, h); }
__device__ __forceinline__ float h2f(u16 b) { return (float)__builtin_bit_cast(_Float16, b); }
__device__ __forceinline__ float silu_f(float x) { return x * __builtin_amdgcn_rcpf(1.0f + __builtin_amdgcn_exp2f(-x * LOG2E)); }
__device__ __forceinline__ float swap_max(float m) { auto rr = __builtin_amdgcn_permlane32_swap(__float_as_uint(m), __float_as_uint(m), false, false); return fmaxf(__uint_as_float(rr[0]), __uint_as_float(rr[1])); }
__device__ __forceinline__ float swap_sum(float m) { auto rr = __builtin_amdgcn_permlane32_swap(__float_as_uint(m), __float_as_uint(m), false, false); return __uint_as_float(rr[0]) + __uint_as_float(rr[1]); }
__device__ __forceinline__ float wave_sum(float v) {
#pragma unroll
    for (int o = 1; o < 64; o <<= 1) v += __shfl_xor(v, o);
    return v;
}
#define LDS_WAIT() asm volatile("s_waitcnt lgkmcnt(0)" ::: "memory")
#define VM_WAIT() asm volatile("s_waitcnt vmcnt(0)" ::: "memory")

namespace pg8 {
constexpr int BM = 256, BK = 64, HALF = 128, HTB = HALF * BK * 2, STAGE_BYTES = 8 * HTB, NXCD = 8, WGM = 8;
__host__ __device__ __forceinline__ int lds_byte(int r, int c) { const int st = (r >> 4) * 2 + (c >> 5), rr = r & 15, cc = c & 31, ob = rr * 64 + cc * 2; return st * 1024 + (ob ^ (((ob >> 9) & 1) << 5)); }
__host__ __device__ __forceinline__ void stage_rc(int b, int& R, int& C) { const int st = b / 1024, sb = b % 1024, swz = sb ^ (((sb >> 9) & 1) << 5); R = (st >> 1) * 16 + swz / 64; C = (st & 1) * 32 + (swz % 64) / 2; }
__host__ __device__ __forceinline__ int perm32(int rho) { const int n = rho >> 4, i = rho & 15; return 8 * (i >> 2) + 4 * n + (i & 3); }
struct Unit { int pm, pn; };
struct Gemm { const u16* A; const u16* Bt; int M, N, K, lda; };
struct StaticOrder {
    int nM, nN, nwg, G, c;
    __device__ void init(int M, int N, int G_, int c_) { nM = M / BM; nN = N / BM; nwg = nM * nN; G = G_; c = c_; }
    __device__ bool next(int i, Unit& u) const {
        const long L = (long)i * G + c; if (L >= nwg) return false;
        int wgid = (int)L; { const int q = nwg / NXCD, r = nwg % NXCD, xcd = wgid % NXCD, off = wgid / NXCD; wgid = (xcd < r ? xcd * (q + 1) : r * (q + 1) + (xcd - r) * q) + off; }
        const int nig = WGM * nN, gid = wgid / nig, fm = gid * WGM, gsz = (nM - fm) < WGM ? (nM - fm) : WGM;
        u.pm = fm + ((wgid % nig) % gsz); u.pn = (wgid % nig) / gsz; return true;
    }
};
template <class Epi>
__device__ __forceinline__ void gemm_phase(LAS unsigned char* lds, const Gemm g, const StaticOrder& S, const Epi& E) {
    const int tid = threadIdx.x, wid = __builtin_amdgcn_readfirstlane(tid >> 6), lane = tid & 63, wr = wid >> 2, wc = wid & 3, fr = lane & 15, fq = lane >> 4;
    const int K = g.K, nt = K / BK, lda = g.lda;
    unsigned voffA[2], voffB[2];
#pragma unroll
    for (int i = 0; i < 2; ++i) { int R, C; stage_rc(tid * 16 + i * 8192, R, C); const int Rb = Epi::PERM ? ((R & ~31) + perm32(R & 31)) : R;
        voffA[i] = (unsigned)(R * lda + C) * 2u; voffB[i] = (unsigned)(Rb * K + C) * 2u; }
    const size_t kstep = (size_t)(BK * 2);
    const size_t hstepA = (size_t)HALF * lda * 2, tstepA = 2 * hstepA;
    const size_t hstepB = (size_t)HALF * K * 2, tstepB = 2 * hstepB;
    const unsigned ldsw = (unsigned)wid * 1024u;
    const int aoff = lds_byte(wr * 64 + fr, fq * 8), boff = lds_byte(wc * 32 + fr, fq * 8);
#define PG8_SA(b, h) (((b) * 2 + (h)) * HTB)
#define PG8_SB(b, h) ((4 + (b) * 2 + (h)) * HTB)
#define PG8_STAGE(bufoff, gbase, voff) do { _Pragma("unroll") for (int _i = 0; _i < 2; ++_i) \
        __builtin_amdgcn_global_load_lds((const unsigned*)((const char*)(gbase) + (voff)[_i]), (LAS unsigned*)(lds + (bufoff) + ldsw + _i * 8192), 16, 0, 0); } while (0)
#define PG8_LDA(dst, b, h) do { _Pragma("unroll") for (int m = 0; m < 4; ++m) _Pragma("unroll") for (int k = 0; k < 2; ++k) dst[m][k] = *(const LAS h8*)(lds + PG8_SA(b, h) + aoff + m * 2048 + k * 1024); } while (0)
#define PG8_LDB(dst, b, h) do { _Pragma("unroll") for (int n = 0; n < 2; ++n) _Pragma("unroll") for (int k = 0; k < 2; ++k) dst[n][k] = *(const LAS h8*)(lds + PG8_SB(b, h) + boff + n * 2048 + k * 1024); } while (0)
#define PG8_MMA(ai, bj, At, Bt) do { __builtin_amdgcn_s_setprio(1); _Pragma("unroll") for (int m = 0; m < 4; ++m) _Pragma("unroll") for (int n = 0; n < 2; ++n) _Pragma("unroll") for (int k = 0; k < 2; ++k) \
        acc[ai][bj][m][n] = __builtin_amdgcn_mfma_f32_16x16x32_f16(Bt[n][k], At[m][k], acc[ai][bj][m][n], 0, 0, 0); __builtin_amdgcn_s_setprio(0); } while (0)
#define PG8_WAIT_V(n) asm volatile("s_waitcnt vmcnt(" #n ")" ::: "memory")
#define PG8_WAIT_L(n) asm volatile("s_waitcnt lgkmcnt(" #n ")" ::: "memory")
#define PG8_BAR __builtin_amdgcn_s_barrier()
#define PG8_SCHED __builtin_amdgcn_sched_barrier(0)
    Unit cur, nxt; int ui = 0;
    if (!S.next(0, cur)) return;
    f32x4 acc[2][2][4][2];
#pragma unroll
    for (int a = 0; a < 2; ++a)
#pragma unroll
        for (int b = 0; b < 2; ++b)
#pragma unroll
            for (int m = 0; m < 4; ++m)
#pragma unroll
                for (int n = 0; n < 2; ++n) acc[a][b][m][n] = (f32x4){0.f, 0.f, 0.f, 0.f};
    h8 At[4][2], B0[2][2], B1[2][2];
    const char* cA = (const char*)g.A + (size_t)cur.pm * tstepA; const char* cB = (const char*)g.Bt + (size_t)cur.pn * tstepB;
    PG8_STAGE(PG8_SB(0, 0), cB, voffB); PG8_STAGE(PG8_SB(0, 1), cB + hstepB, voffB); PG8_STAGE(PG8_SA(0, 0), cA, voffA); PG8_STAGE(PG8_SA(0, 1), cA + hstepA, voffA);
    if (wr == 1) PG8_BAR;
    PG8_WAIT_V(2); PG8_BAR;
    PG8_STAGE(PG8_SB(1, 0), cB + kstep, voffB); PG8_STAGE(PG8_SA(1, 0), cA + kstep, voffA); PG8_STAGE(PG8_SB(1, 1), cB + hstepB + kstep, voffB);
    PG8_WAIT_V(6); PG8_BAR;
    for (;;) {
        const bool has_next = S.next(ui + 1, nxt);
        const char* nA = has_next ? (const char*)g.A + (size_t)nxt.pm * tstepA : cA; const char* nB = has_next ? (const char*)g.Bt + (size_t)nxt.pn * tstepB : cB;
#pragma unroll 1
        for (int t = 0; t < nt; t += 2) {
            const bool last = (t == nt - 2);
            const char* a1 = cA + (size_t)(t + 1) * kstep;
            const char* a2 = last ? nA : cA + (size_t)(t + 2) * kstep; const char* b2 = last ? nB : cB + (size_t)(t + 2) * kstep;
            const char* a3 = a2 + kstep; const char* b3 = b2 + kstep;
            PG8_LDB(B0, 0, 0); PG8_LDB(B1, 0, 1); PG8_SCHED; PG8_LDA(At, 0, 0); PG8_STAGE(PG8_SA(1, 1), a1 + hstepA, voffA);
            PG8_WAIT_V(8); PG8_WAIT_L(0); PG8_BAR; PG8_MMA(0, 0, At, B0); PG8_MMA(0, 1, At, B1); PG8_BAR; PG8_SCHED;
            PG8_LDA(At, 0, 1); PG8_STAGE(PG8_SB(0, 0), b2, voffB); PG8_STAGE(PG8_SB(0, 1), b2 + hstepB, voffB); PG8_STAGE(PG8_SA(0, 0), a2, voffA);
            PG8_WAIT_V(8); PG8_WAIT_L(0); PG8_BAR; PG8_MMA(1, 0, At, B0); PG8_MMA(1, 1, At, B1); PG8_BAR; PG8_SCHED;
            PG8_LDB(B0, 1, 0); PG8_LDB(B1, 1, 1); PG8_SCHED; PG8_LDA(At, 1, 0); PG8_STAGE(PG8_SA(0, 1), a2 + hstepA, voffA);
            PG8_WAIT_V(8); PG8_WAIT_L(0); PG8_BAR; PG8_MMA(0, 0, At, B0); PG8_MMA(0, 1, At, B1); PG8_BAR; PG8_SCHED;
            PG8_LDA(At, 1, 1); PG8_STAGE(PG8_SB(1, 0), b3, voffB); PG8_STAGE(PG8_SB(1, 1), b3 + hstepB, voffB); PG8_STAGE(PG8_SA(1, 0), a3, voffA);
            PG8_WAIT_V(8); PG8_WAIT_L(0); PG8_BAR; PG8_MMA(1, 0, At, B0); PG8_MMA(1, 1, At, B1); PG8_BAR; PG8_SCHED;
        }
        if (wr == 0) PG8_BAR;
        E(acc, cur, wr, wc, fr, fq);
        if (!has_next) break;
#pragma unroll
        for (int a = 0; a < 2; ++a)
#pragma unroll
            for (int b = 0; b < 2; ++b)
#pragma unroll
                for (int m = 0; m < 4; ++m)
#pragma unroll
                    for (int n = 0; n < 2; ++n) acc[a][b][m][n] = (f32x4){0.f, 0.f, 0.f, 0.f};
        cur = nxt; cA = nA; cB = nB; ++ui;
        if (wr == 1) PG8_BAR;
    }
    PG8_WAIT_V(0);
    PG8_BAR;
#undef PG8_SA
#undef PG8_SB
#undef PG8_STAGE
#undef PG8_LDA
#undef PG8_LDB
#undef PG8_MMA
#undef PG8_WAIT_V
#undef PG8_WAIT_L
#undef PG8_BAR
#undef PG8_SCHED
}

typedef f32x4 Acc[2][2][4][2];
__device__ __forceinline__ float rstd_from(const u64* ssq, int row, float inv_n) { return __builtin_amdgcn_rsqf((float)ssq[row] * (1.0f / FXS) * inv_n + RMS_EPS); }
__device__ __forceinline__ void ssq_add(u64* ssq, int row, float ss, int fq) {
    ss += __shfl_xor(ss, 16); ss += __shfl_xor(ss, 32);
    if (fq == 0) atomicAdd((unsigned long long*)(ssq + row), (unsigned long long)(ss * FXS + 0.5f));
}
struct EpiProj0 {
    static constexpr bool PERM = true;
    u16* O;
    __device__ __forceinline__ void operator()(const Acc& acc, const Unit& u, int wr, int wc, int fr, int fq) const {
        const int row0 = u.pm * BM + wr * 64 + fr, col0 = u.pn * BM + wc * 32 + 8 * fq; const bool gate = u.pn >= 11;
#pragma unroll
        for (int ai = 0; ai < 2; ++ai)
#pragma unroll
            for (int m = 0; m < 4; ++m) { u16* rowp = O + (size_t)(row0 + ai * HALF + m * 16) * P0W + col0;
#pragma unroll
                for (int bj = 0; bj < 2; ++bj) { f32x4 v0 = acc[ai][bj][m][0], v1 = acc[ai][bj][m][1];
                    if (gate) {
#pragma unroll
                        for (int e = 0; e < 4; ++e) { v0[e] = silu_f(v0[e]); v1[e] = silu_f(v1[e]); } }
                    u32x4 w; w.x = pkh(v0[0], v0[1]); w.y = pkh(v0[2], v0[3]); w.z = pkh(v1[0], v1[1]); w.w = pkh(v1[2], v1[3]);
                    *(u32x4*)(rowp + bj * HALF) = w; } }
    }
};
struct EpiRes {
    static constexpr bool PERM = false;
    const float* base; float* out; u16* outh; u64* ssq;
    __device__ __forceinline__ void operator()(const Acc& acc, const Unit& u, int wr, int wc, int fr, int fq) const {
        const int row0 = u.pm * BM + wr * 64 + fr, col0 = u.pn * BM + wc * 32 + 4 * fq;
#pragma unroll
        for (int ai = 0; ai < 2; ++ai)
#pragma unroll
            for (int m = 0; m < 4; ++m) { const int row = row0 + ai * HALF + m * 16; const size_t off = (size_t)row * DM + col0; float ss = 0.f;
#pragma unroll
                for (int bj = 0; bj < 2; ++bj)
#pragma unroll
                    for (int n = 0; n < 2; ++n) { const f32x4 bs = *(const f32x4*)(base + off + bj * HALF + n * 16); const f32x4 o = bs + acc[ai][bj][m][n];
                        *(f32x4*)(out + off + bj * HALF + n * 16) = o;
                        if (outh) { u32x2 w; w.x = pkh(o[0], o[1]); w.y = pkh(o[2], o[3]); *(u32x2*)(outh + off + bj * HALF + n * 16) = w; }
                        ss += (o[0] * o[0] + o[1] * o[1]) + (o[2] * o[2] + o[3] * o[3]); }
                if (ssq) ssq_add(ssq, row, ss, fq); }
    }
};
struct EpiProj1 {
    static constexpr bool PERM = false;
    const u64* ssq1; u16* lat; u16* krope; u16* g1; u64* ssqkv; u64* ssqq; const float* ropec; const float* ropes;
    __device__ __forceinline__ void operator()(const Acc& acc, const Unit& u, int wr, int wc, int fr, int fq) const {
        const int row0 = u.pm * BM + wr * 64 + fr, pn = u.pn;
#pragma unroll
        for (int ai = 0; ai < 2; ++ai)
#pragma unroll
            for (int m = 0; m < 4; ++m) { const int row = row0 + ai * HALF + m * 16; const float rs = rstd_from(ssq1, row, 1.0f / 1024.0f); float ss = 0.f;
#pragma unroll
                for (int bj = 0; bj < 2; ++bj) { f32x4 v0 = acc[ai][bj][m][0] * rs, v1 = acc[ai][bj][m][1] * rs;
                    const int tc = bj * HALF + wc * 32 + 4 * fq;
                    if (pn >= 3) {
#pragma unroll
                        for (int e = 0; e < 4; ++e) { v0[e] = silu_f(v0[e]); v1[e] = silu_f(v1[e]); }
                        u16* p = g1 + (size_t)row * DM + (pn - 3) * BM + tc;
                        u32x2 w0, w1; w0.x = pkh(v0[0], v0[1]); w0.y = pkh(v0[2], v0[3]); w1.x = pkh(v1[0], v1[1]); w1.y = pkh(v1[2], v1[3]);
                        *(u32x2*)p = w0; *(u32x2*)(p + 16) = w1;
                    } else if (pn < 2 || bj == 0) {
                        u16* p = lat + (size_t)row * LATW + pn * BM + tc;
                        u32x2 w0, w1; w0.x = pkh(v0[0], v0[1]); w0.y = pkh(v0[2], v0[3]); w1.x = pkh(v1[0], v1[1]); w1.y = pkh(v1[2], v1[3]);
                        *(u32x2*)p = w0; *(u32x2*)(p + 16) = w1;
                        ss += (v0[0] * v0[0] + v0[1] * v0[1]) + (v0[2] * v0[2] + v0[3] * v0[3]) + (v1[0] * v1[0] + v1[1] * v1[1]) + (v1[2] * v1[2] + v1[3] * v1[3]);
                    } else if (wc == 0) {
                        const int pos = row & (SEQ - 1); const f32x4 cs = *(const f32x4*)(ropec + pos * 16 + 4 * fq), sn = *(const f32x4*)(ropes + pos * 16 + 4 * fq);
                        const f32x4 o0 = v0 * cs - v1 * sn, o1 = v0 * sn + v1 * cs;
                        u16* p = krope + (size_t)row * 32 + 4 * fq;
                        u32x2 w0, w1; w0.x = pkh(o0[0], o0[1]); w0.y = pkh(o0[2], o0[3]); w1.x = pkh(o1[0], o1[1]); w1.y = pkh(o1[2], o1[3]);
                        *(u32x2*)p = w0; *(u32x2*)(p + 16) = w1;
                    } }
                if (pn == 0) ssq_add(ssqkv, row, ss, fq); else if (pn <= 2) ssq_add(ssqq, row, ss, fq);
                asm volatile("" ::: "memory"); }
    }
};
struct EpiQ1 {
    static constexpr bool PERM = false;
    const u64* ssqq; u16* q1; const float* ropec; const float* ropes;
    __device__ __forceinline__ void operator()(const Acc& acc, const Unit& u, int wr, int wc, int fr, int fq) const {
        const int row0 = u.pm * BM + wr * 64 + fr;
#pragma unroll
        for (int ai = 0; ai < 2; ++ai)
#pragma unroll
            for (int m = 0; m < 4; ++m) { const int row = row0 + ai * HALF + m * 16; const float rs = rstd_from(ssqq, row, 1.0f / 384.0f);
#pragma unroll
                for (int bj = 0; bj < 2; ++bj) { f32x4 v0 = acc[ai][bj][m][0] * rs, v1 = acc[ai][bj][m][1] * rs;
                    const int g0 = u.pn * BM + bj * HALF + wc * 32;
                    if ((g0 % 96) == 64) { const int pos = row & (SEQ - 1); const f32x4 cs = *(const f32x4*)(ropec + pos * 16 + 4 * fq), sn = *(const f32x4*)(ropes + pos * 16 + 4 * fq);
                        const f32x4 o0 = v0 * cs - v1 * sn, o1 = v0 * sn + v1 * cs; v0 = o0; v1 = o1; }
                    u16* p = q1 + (size_t)row * 1536 + g0 + 4 * fq;
                    u32x2 w0, w1; w0.x = pkh(v0[0], v0[1]); w0.y = pkh(v0[2], v0[3]); w1.x = pkh(v1[0], v1[1]); w1.y = pkh(v1[2], v1[3]);
                    *(u32x2*)p = w0; *(u32x2*)(p + 16) = w1; }
                asm volatile("" ::: "memory"); }
    }
};
struct EpiKV1 {
    static constexpr bool PERM = true;
    const u64* ssqkv; u16* kv1;
    __device__ __forceinline__ void operator()(const Acc& acc, const Unit& u, int wr, int wc, int fr, int fq) const {
        const int row0 = u.pm * BM + wr * 64 + fr, col0 = u.pn * BM + wc * 32 + 8 * fq;
#pragma unroll
        for (int ai = 0; ai < 2; ++ai)
#pragma unroll
            for (int m = 0; m < 4; ++m) { const int row = row0 + ai * HALF + m * 16; const float rs = rstd_from(ssqkv, row, 1.0f / 256.0f); u16* rowp = kv1 + (size_t)row * 2048 + col0;
#pragma unroll
                for (int bj = 0; bj < 2; ++bj) { const f32x4 v0 = acc[ai][bj][m][0] * rs, v1 = acc[ai][bj][m][1] * rs;
                    u32x4 w; w.x = pkh(v0[0], v0[1]); w.y = pkh(v0[2], v0[3]); w.z = pkh(v1[0], v1[1]); w.w = pkh(v1[2], v1[3]);
                    *(u32x4*)(rowp + bj * HALF) = w; }
                if (m & 1) asm volatile("" ::: "memory"); }
    }
};
}

#define XB_TMO      128
#define XB_XCNT(j)  (256  + 64 * (j))
#define XB_XSUB(j)  (1280 + 64 * (j))
#define XB_XGEN(j)  (2304 + 64 * (j))
#define XB_TOP      3328
#define XB_TOPGEN   3392
#define XCD_BAR_WORDS 3456
#define XB_SPIN_CAP (1u << 20)
__device__ __forceinline__ unsigned xb_ld(unsigned* p)              { return __hip_atomic_load(p, __ATOMIC_RELAXED, __HIP_MEMORY_SCOPE_AGENT); }
__device__ __forceinline__ unsigned xb_add(unsigned* p, unsigned v) { return __hip_atomic_fetch_add(p, v, __ATOMIC_RELAXED, __HIP_MEMORY_SCOPE_AGENT); }
__device__ __forceinline__ unsigned xb_xcc_id() { return (unsigned)__builtin_amdgcn_s_getreg((3 << 11) | 20) & 0xFu; }
#define XB_SPIN(cond, bar) do { unsigned _sp = 0; while (cond) { __builtin_amdgcn_s_sleep(1); \
    if ((++_sp & 255u) == 0u) { if (xb_ld(&(bar)[XB_TMO])) break; if (_sp > XB_SPIN_CAP) { atomicAdd(&(bar)[XB_TMO], 1u); break; } } } } while (0)
struct XcdBarrier { unsigned* bar; unsigned x; volatile LAS unsigned* st; };
__device__ __forceinline__ XcdBarrier xcd_barrier_post(unsigned* bar, volatile LAS unsigned* st) {
    XcdBarrier b; b.bar = bar; b.x = xb_xcc_id(); b.st = st;
    if (threadIdx.x == 0) (void)xb_add(&bar[XB_XCNT(b.x)], 1u);
    return b;
}
__device__ __forceinline__ void xcd_barrier_complete(unsigned* bar, unsigned x, unsigned& nloc, unsigned& nx) {
    const unsigned G = gridDim.x * gridDim.y * gridDim.z;
    unsigned sum, cnt, mine, sp = 0u;
    for (;;) {
        sum = 0u; cnt = 0u; mine = 0u;
#pragma unroll
        for (unsigned j = 0; j < 16; ++j) { const unsigned c = xb_ld(&bar[XB_XCNT(j)]); sum += c; cnt += (c > 0u) ? 1u : 0u; mine = (j == x) ? c : mine; }
        if (sum == G) break;
        __builtin_amdgcn_s_sleep(1);
        if ((++sp & 255u) == 0u) { if (xb_ld(&bar[XB_TMO])) break; if (sp > XB_SPIN_CAP) { atomicAdd(&bar[XB_TMO], 1u); break; } }
    }
    nloc = mine > 0u ? mine : 1u; nx = cnt > 0u ? cnt : 1u;
}
__device__ __forceinline__ void xcd_barrier(const XcdBarrier& b) {
    asm volatile("s_waitcnt vmcnt(0)" ::: "memory");
    __syncthreads();
    if (threadIdx.x == 0) {
        unsigned* bar = b.bar;
        __builtin_amdgcn_s_waitcnt(0);
        unsigned nloc = b.st[0], nx = b.st[1];
        if (nloc == 0u) { xcd_barrier_complete(bar, b.x, nloc, nx); b.st[0] = nloc; b.st[1] = nx; }
        const unsigned old = xb_add(&bar[XB_XSUB(b.x)], 1u);
        const unsigned gen = old / nloc;
        if (old + 1u == (gen + 1u) * nloc) {
            __builtin_amdgcn_fence(__ATOMIC_RELEASE, "agent");
            asm volatile("s_waitcnt vmcnt(0)" ::: "memory");
            const unsigned og = xb_add(&bar[XB_TOP], 1u);
            const unsigned tg = og / nx;
            if (og + 1u == (tg + 1u) * nx) xb_add(&bar[XB_TOPGEN], 1u);
            else XB_SPIN(xb_ld(&bar[XB_TOPGEN]) == tg, bar);
            __builtin_amdgcn_fence(__ATOMIC_ACQUIRE, "agent");
            xb_add(&bar[XB_XGEN(b.x)], 1u);
            asm volatile("s_waitcnt vmcnt(0)" ::: "memory");
        } else {
            XB_SPIN(xb_ld(&bar[XB_XGEN(b.x)]) == gen, bar);
            __builtin_amdgcn_fence(__ATOMIC_ACQUIRE, "agent");
            asm volatile("s_waitcnt vmcnt(0)" ::: "memory");
        }
    }
    __syncthreads();
}

struct Args { const float* in[18]; float* out; unsigned char* ws; int ph_lo, ph_hi; };
struct Frame {
    LAS unsigned char* lds;
    volatile LAS unsigned* MISC;
    unsigned* ctl;
    int tid, lane, wave, G;
    float* out;
    unsigned char* ws;
};
enum { I_X = 0, I_RELB, I_ENORM, I_EWIN, I_LQ1, I_LK1, I_LQ2, I_LK2, I_SUBLN, I_EWO, I_ONORM, I_OWIN, I_OQNORM, I_OWUQ, I_OKVNORM, I_OWUKV, I_OWO, I_FNORM };

__device__ __forceinline__ int t5_bucket(int rel) {
    const int n = rel < 0 ? -rel : rel;
    const int v = n < 8 ? n : n < 12 ? 8 : n < 16 ? 9 : n < 23 ? 10 : n < 32 ? 11 : n < 46 ? 12 : n < 64 ? 13 : n < 91 ? 14 : 15;
    return (rel > 0 ? 16 : 0) + v;
}

__device__ __forceinline__ int wsrc_col(int mat, int n) {
    switch (mat) {
        case 0: return n < 2760 ? n : (n < C_G0 ? -1 : n - 56);
        case 2: return n < 256 ? 384 + n : (n < 640 ? n - 256 : (n < 672 ? n : (n < 768 ? -1 : n - 96)));
        default: return n;
    }
}
__device__ __forceinline__ float wcol_scale(int mat, int n) {
    if (mat == 0) return (n < 512 || (n >= C_QB && n < C_QB + 512)) ? QS_AB : 1.0f;
    if (mat == 3) return QS_C;
    return 1.0f;
}
__device__ __forceinline__ void p0_transpose_item(const float* W, int K, int Nsrc, int Npad, const float* gain, int mat, u16* WT, LAS float* scr, int item, int lane) {
    const int nblk = Npad / 32, kb = item / nblk, nb = item % nblk, k0 = 64 * kb, n0 = 32 * nb;
    const int n = n0 + (lane & 31); const int sc = wsrc_col(mat, n); const float cs = wcol_scale(mat, n);
#pragma unroll 8
    for (int i = 0; i < 32; ++i) { const int kk = 2 * i + (lane >> 5); float v = 0.f;
        if (sc >= 0) { v = W[(size_t)(k0 + kk) * Nsrc + sc] * cs; if (gain) v *= gain[k0 + kk]; }
        scr[kk * 33 + (lane & 31)] = v; }
    LDS_WAIT(); asm volatile("" ::: "memory");
    const int c = lane & 7;
#pragma unroll
    for (int j = 0; j < 4; ++j) { const int nn = (lane >> 3) + 8 * j; const LAS float* s = scr + (8 * c) * 33 + nn;
        u32x4 o; o.x = pkh(s[0 * 33], s[1 * 33]); o.y = pkh(s[2 * 33], s[3 * 33]); o.z = pkh(s[4 * 33], s[5 * 33]); o.w = pkh(s[6 * 33], s[7 * 33]);
        *(u32x4*)(WT + (size_t)(n0 + nn) * K + k0 + 8 * c) = o; }
    LDS_WAIT(); asm volatile("" ::: "memory");
}
__device__ __forceinline__ void p0_prologue(Frame& F, const Args& AR) {
    LAS float* scr = (LAS float*)(F.lds + F.wave * 16384);
    const int gw = blockIdx.x * NWAVES + F.wave, NGW = F.G * NWAVES;
    unsigned char* ws = F.ws;
    constexpr int I0 = (1024 / 64) * (P0W / 32), I1 = (1024 / 64) * (1024 / 32), I2 = (1024 / 64) * (P1W / 32), I3 = (384 / 64) * (1536 / 32), I4 = (256 / 64) * (2048 / 32), I5 = I1;
    constexpr int NITEMS = I0 + I1 + I2 + I3 + I4 + I5;
    for (int it = gw; it < NITEMS; it += NGW) {
        int r = it;
        if (r < I0) { p0_transpose_item(AR.in[I_EWIN], 1024, L0_SRC, P0W, nullptr, 0, (u16*)(ws + WS_W0T), scr, r, F.lane); continue; } r -= I0;
        if (r < I1) { p0_transpose_item(AR.in[I_EWO], 1024, 1024, 1024, nullptr, 1, (u16*)(ws + WS_WO0T), scr, r, F.lane); continue; } r -= I1;
        if (r < I2) { p0_transpose_item(AR.in[I_OWIN], 1024, L1_SRC, P1W, AR.in[I_ONORM], 2, (u16*)(ws + WS_W1T), scr, r, F.lane); continue; } r -= I2;
        if (r < I3) { p0_transpose_item(AR.in[I_OWUQ], 384, 1536, 1536, AR.in[I_OQNORM], 3, (u16*)(ws + WS_WUQT), scr, r, F.lane); continue; } r -= I3;
        if (r < I4) { p0_transpose_item(AR.in[I_OWUKV], 256, 2048, 2048, AR.in[I_OKVNORM], 4, (u16*)(ws + WS_WUKVT), scr, r, F.lane); continue; } r -= I4;
        p0_transpose_item(AR.in[I_OWO], 1024, 1024, 1024, nullptr, 5, (u16*)(ws + WS_WO1T), scr, r, F.lane);
    }
    {
        const float* gn = AR.in[I_ENORM]; f32x4 gv[4];
#pragma unroll
        for (int j = 0; j < 4; ++j) gv[j] = *(const f32x4*)(gn + 4 * F.lane + 256 * j);
        u16* XN = (u16*)(ws + WS_XN0);
        for (int mrow = gw; mrow < T; mrow += NGW) {
            const f32x4* xr = (const f32x4*)(AR.in[I_X] + (size_t)mrow * DM) + F.lane;
            f32x4 v[4]; float s = 0.f;
#pragma unroll
            for (int j = 0; j < 4; ++j) { v[j] = xr[64 * j]; s += (v[j].x * v[j].x + v[j].y * v[j].y) + (v[j].z * v[j].z + v[j].w * v[j].w); }
            const float rstd = __builtin_amdgcn_rsqf(wave_sum(s) * (1.f / DM) + RMS_EPS);
            u32x2* o8 = (u32x2*)(XN + (size_t)mrow * DM) + F.lane;
#pragma unroll
            for (int j = 0; j < 4; ++j) { const f32x4 t = v[j] * rstd * gv[j]; u32x2 w; w.x = pkh(t.x, t.y); w.y = pkh(t.z, t.w); o8[64 * j] = w; }
        }
    }
    {
        float* rc = (float*)(ws + WS_ROPEC); float* rs = (float*)(ws + WS_ROPES);
        const int gt = blockIdx.x * 512 + F.tid, NGT = F.G * 512;
        for (int e = gt; e < SEQ * 16; e += NGT) { const int pos = e >> 4, i = e & 15;
            const float inv = (float)pow(10000.0, -(double)i / 16.0); const float ang = (float)pos * inv;
            rc[e] = (float)cos((double)ang); rs[e] = (float)sin((double)ang); }
        float* bt = (float*)(ws + WS_BTG);
        for (int e = gt; e < 12 * 192; e += NGT) { const int hd = e / 192, idx = e % 192; const int rel = idx - 128;
            bt[e] = AR.in[I_RELB][t5_bucket(rel) * 12 + hd] * LOG2E; }
        if (blockIdx.x == 0 && F.wave == 0) {
            const float a = wave_sum(AR.in[I_LQ1][F.lane] * AR.in[I_LK1][F.lane]), b = wave_sum(AR.in[I_LQ2][F.lane] * AR.in[I_LK2][F.lane]);
            if (F.lane == 0) *(float*)(ws + WS_LAM) = expf(a) - expf(b) + 0.2f;
        }
    }
}

__device__ __forceinline__ h8 tr2(LAS const unsigned char* p0, LAS const unsigned char* p1) {
    const s16x4 lo = __builtin_amdgcn_ds_read_tr16_b64_v4i16((LAS s16x4*)p0), hi = __builtin_amdgcn_ds_read_tr16_b64_v4i16((LAS s16x4*)p1);
    const s16x8 v = __builtin_shufflevector(lo, hi, 0, 1, 2, 3, 4, 5, 6, 7); return __builtin_bit_cast(h8, v);
}
template <int ND>
__device__ __forceinline__ void softmax_step(f32x16& p0, f32x16& p1, float& mrun, float& lrun, f32x16 (&o)[ND], h8 (&pf)[4]) {
    float mx = fmaxf(p0[0], p1[0]);
#pragma unroll
    for (int r = 1; r < 16; ++r) mx = fmaxf(mx, fmaxf(p0[r], p1[r]));
    mx = swap_max(mx);
    const float mnew = fmaxf(mrun, mx), alpha = __builtin_amdgcn_exp2f(mrun - mnew);
    mrun = mnew;
    float s = 0.f;
#pragma unroll
    for (int r = 0; r < 16; ++r) { p0[r] = __builtin_amdgcn_exp2f(p0[r] - mnew); p1[r] = __builtin_amdgcn_exp2f(p1[r] - mnew); s += p0[r] + p1[r]; }
    lrun = lrun * alpha + s;
#pragma unroll
    for (int d = 0; d < ND; ++d)
#pragma unroll
        for (int r = 0; r < 16; ++r) o[d][r] *= alpha;
#pragma unroll
    for (int ks = 0; ks < 4; ++ks) {
        u32x4 w;
        if (ks < 2) { w.x = pkh(p0[8 * ks + 0], p0[8 * ks + 1]); w.y = pkh(p0[8 * ks + 2], p0[8 * ks + 3]); w.z = pkh(p0[8 * ks + 4], p0[8 * ks + 5]); w.w = pkh(p0[8 * ks + 6], p0[8 * ks + 7]); }
        else { const int k2 = ks - 2; w.x = pkh(p1[8 * k2 + 0], p1[8 * k2 + 1]); w.y = pkh(p1[8 * k2 + 2], p1[8 * k2 + 3]); w.z = pkh(p1[8 * k2 + 4], p1[8 * k2 + 5]); w.w = pkh(p1[8 * k2 + 6], p1[8 * k2 + 7]); }
        pf[ks] = __builtin_bit_cast(h8, w);
    }
}
__device__ __forceinline__ void add_bias(f32x16& p0, f32x16& p1, const LAS float* bt, int idx0) {
#pragma unroll
    for (int r = 0; r < 16; ++r) { const int c = (r & 3) + 8 * (r >> 2);
        const int i0 = idx0 + c, i1 = idx0 + 32 + c;
        p0[r] += bt[i0 < 0 ? 0 : i0]; p1[r] += bt[i1 < 0 ? 0 : i1]; }
}
__device__ __forceinline__ int next_unit(Frame& F, int cw) {
    volatile LAS unsigned* slot = F.MISC + 16;
    __syncthreads();
    if (F.tid == 0) slot[0] = __hip_atomic_fetch_add(F.ctl + cw, 1u, __ATOMIC_RELAXED, __HIP_MEMORY_SCOPE_AGENT);
    __syncthreads();
    return (int)slot[0];
}

__device__ __forceinline__ void attnA_unit(Frame& F, const Args& AR, int b, int h, int qb) {
    LAS unsigned char* lds = F.lds;
    int tid = F.tid; asm volatile("" : "+v"(tid)); int wid = F.wave; asm volatile("" : "+s"(wid));
    const int lane = tid & 63, r32 = lane & 31, hi = lane >> 5;
    const int m = wid & 1, qsub = wid >> 1, q0 = 128 * qb + 32 * qsub, cw = q0 >> 6, nt = 2 * qb + 2;
    const size_t rowb = (size_t)b * SEQ;
    const u16* P0 = (const u16*)(F.ws + WS_PROJ0);
    LAS float* bt = (LAS float*)(lds + 65536);
    if (tid < 192) bt[tid] = ((const float*)(F.ws + WS_BTG))[h * 192 + tid];
    h8 qf[4];
    { const u16* qp = P0 + (rowb + q0 + r32) * P0W + C_QA + h * 128 + m * 64 + hi * 8;
#pragma unroll
      for (int d0 = 0; d0 < 4; ++d0) qf[d0] = *(const h8*)(qp + d0 * 16); }
    f32x16 o[4];
#pragma unroll
    for (int d = 0; d < 4; ++d)
#pragma unroll
        for (int r = 0; r < 16; ++r) o[d][r] = 0.f;
    float mrun = -1e30f, lrun = 0.f;
    const int krow = tid >> 3, kch = tid & 7, vrow = tid >> 4, vch = tid & 15;
    const u16* ksrc = P0 + (rowb + krow) * P0W + C_KA + h * 128 + kch * 8;
    const u16* vsrc = P0 + (rowb + vrow) * P0W + C_VA + h * 128 + vch * 8;
    const int kdst = krow * 128 + ((kch ^ ((krow >> 1) & 7)) << 4);
    const int vdst = 16384 + vrow * 256 + ((vch ^ ((vrow & 3) << 2)) << 4);
    u32x4 st0, st1, st2, st3;
#define A_LOAD(t) do { const size_t to = (size_t)(t) * 64 * P0W; st0 = *(const u32x4*)(ksrc + to); st1 = *(const u32x4*)(ksrc + to + 64); st2 = *(const u32x4*)(vsrc + to); st3 = *(const u32x4*)(vsrc + to + (size_t)32 * P0W); } while (0)
#define A_WRITE(s) do { LAS unsigned char* sb = lds + (s) * 32768; *(LAS u32x4*)(sb + kdst) = st0; *(LAS u32x4*)(sb + 8192 + kdst) = st1; *(LAS u32x4*)(sb + vdst) = st2; *(LAS u32x4*)(sb + vdst + 32 * 256) = st3; } while (0)
    const int kfo = r32 * 128, ksw = (r32 >> 1) & 7;
    const int i16 = lane & 15, qrow = i16 >> 2, pp = i16 & 3, g16 = (lane >> 4) & 1;
    const int vlane = (4 * hi + qrow) * 256 + ((2 * g16 + (pp >> 1)) << 4) + 8 * (pp & 1);
    const int qglob = q0 + r32;
    A_LOAD(0); A_WRITE(0); __syncthreads();
    for (int t = 0; t < nt; ++t) {
        if (t + 1 < nt) A_LOAD(t + 1);
        if (t <= cw) {
            LAS const unsigned char* sb = lds + (t & 1) * 32768; LAS const unsigned char* kb = sb + m * 8192 + kfo; LAS const unsigned char* vb = sb + 16384 + vlane;
            const bool nearb = (64 * t + 63 - q0) > -128;
            const float c0 = nearb ? 0.f : bt[0];
            f32x16 p0, p1;
#pragma unroll
            for (int r = 0; r < 16; ++r) { p0[r] = c0; p1[r] = c0; }
#pragma unroll
            for (int d0 = 0; d0 < 4; ++d0) { const int co = ((2 * d0 + hi) ^ ksw) << 4;
                const h8 ka = *(LAS const h8*)(kb + co), kc = *(LAS const h8*)(kb + 4096 + co);
                p0 = __builtin_amdgcn_mfma_f32_32x32x16_f16(ka, qf[d0], p0, 0, 0, 0); p1 = __builtin_amdgcn_mfma_f32_32x32x16_f16(kc, qf[d0], p1, 0, 0, 0); }
            if (nearb) add_bias(p0, p1, bt, 64 * t + 4 * hi - qglob + 128);
            h8 pf[4];
            softmax_step<4>(p0, p1, mrun, lrun, o, pf);
#pragma unroll
            for (int d0 = 0; d0 < 4; ++d0) { const int dx = (d0 ^ qrow) << 6;
#pragma unroll
                for (int ks = 0; ks < 4; ++ks) { const h8 vf = tr2(vb + ks * 4096 + dx, vb + ks * 4096 + 2048 + dx);
                    o[d0] = __builtin_amdgcn_mfma_f32_32x32x16_f16(vf, pf[ks], o[d0], 0, 0, 0); } }
        }
        if (t + 1 < nt) A_WRITE((t + 1) & 1);
        __syncthreads();
    }
#undef A_LOAD
#undef A_WRITE
    const float linv = 1.0f / swap_sum(lrun);
    LAS f32x4* xb = (LAS f32x4*)(lds + qsub * 16384);
    if (m == 1) {
#pragma unroll
        for (int d0 = 0; d0 < 4; ++d0)
#pragma unroll
            for (int g = 0; g < 4; ++g) { f32x4 v = {o[d0][4 * g] * linv, o[d0][4 * g + 1] * linv, o[d0][4 * g + 2] * linv, o[d0][4 * g + 3] * linv};
                xb[(8 * d0 + 2 * g + hi) * 32 + r32] = v; }
    }
    __syncthreads();
    if (m == 0) {
        const float lam = *(const float*)(F.ws + WS_LAM);
        float ss = 0.f;
#pragma unroll
        for (int d0 = 0; d0 < 4; ++d0)
#pragma unroll
            for (int g = 0; g < 4; ++g) { const f32x4 v1 = xb[(8 * d0 + 2 * g + hi) * 32 + r32];
#pragma unroll
                for (int e = 0; e < 4; ++e) { const float v = o[d0][4 * g + e] * linv - lam * v1[e]; o[d0][4 * g + e] = v; ss += v * v; } }
        ss = swap_sum(ss);
        const float rs = __builtin_amdgcn_rsqf(ss * (1.0f / 128.0f) + RMS_EPS) * 0.8f;
        const size_t row = rowb + qglob;
        const u16* gp = P0 + row * P0W + C_G0 + h * 128;
        u16* op = (u16*)(F.ws + WS_MG0) + row * DM + h * 128;
        const float* sg = AR.in[I_SUBLN];
#pragma unroll
        for (int d0 = 0; d0 < 4; ++d0)
#pragma unroll
            for (int g = 0; g < 4; ++g) { const int d = 32 * d0 + 8 * g + 4 * hi;
                const h4 gv = *(const h4*)(gp + d); const f32x4 sv = *(const f32x4*)(sg + d);
                u32x2 w; w.x = pkh(o[d0][4 * g] * rs * sv[0] * (float)gv[0], o[d0][4 * g + 1] * rs * sv[1] * (float)gv[1]);
                w.y = pkh(o[d0][4 * g + 2] * rs * sv[2] * (float)gv[2], o[d0][4 * g + 3] * rs * sv[3] * (float)gv[3]);
                *(u32x2*)(op + d) = w; }
    }
}

constexpr int B_MASK = 32768, B_QF = 49152, B_BT = 65536, B_RED = 71680;
__device__ __forceinline__ float next_up(float x) { if (x == 0.f) return __uint_as_float(1u); const unsigned u = __float_as_uint(x); return __uint_as_float(x > 0.f ? u + 1u : u - 1u); }
__device__ __forceinline__ void selB_16(Frame& F, int b, int c, int q0, int mrow0) {
    LAS unsigned char* lds = F.lds;
    int tid = F.tid; asm volatile("" : "+v"(tid)); int wid = F.wave; asm volatile("" : "+s"(wid));
    const int lane = tid & 63, ql = lane & 15, g = lane >> 4;
    const size_t rowb = (size_t)b * SEQ;
    const u16* P0 = (const u16*)(F.ws + WS_PROJ0);
    LAS u16* m16 = (LAS u16*)(lds + B_MASK);
    const int NT16 = 4 * (c + 1), N = 64 * (c + 1);
    if (c < 4) {
        for (int e = tid; e < 16 * (c + 1); e += 512) { const int q = e / (c + 1), t = e % (c + 1); *(LAS u64*)(lds + B_MASK + ((mrow0 + q) * 64 + t) * 8) = ~0ull; }
        return;
    }
    LAS h8* qfl = (LAS h8*)(lds + B_QF);
#pragma unroll
    for (int i = 0; i < 2; ++i) { const int idx = tid + 512 * i, fg = idx >> 6, ln = idx & 63, hh = fg >> 1, ks = fg & 1;
        qfl[idx] = *(const h8*)(P0 + (rowb + q0 + (ln & 15)) * P0W + C_QI + hh * 64 + 32 * ks + 8 * (ln >> 4)); }
    float wq[8];
    { const h8 wv = *(const h8*)(P0 + (rowb + q0 + ql) * P0W + C_WI);
#pragma unroll
      for (int i = 0; i < 8; ++i) wq[i] = (float)wv[i]; }
    __syncthreads();
    float sc[32][4];
    const u16* kp = P0 + (rowb + ql) * P0W + C_KI + 8 * g;
    h8 a0n = *(const h8*)(kp + (size_t)(16 * wid) * P0W), a1n = *(const h8*)(kp + (size_t)(16 * wid) * P0W + 32);
#pragma unroll
    for (int jj = 0; jj < 32; ++jj) {
        const int j = wid + 8 * jj;
        if (j < NT16) {
            const h8 a0 = a0n, a1 = a1n;
            if (j + 8 < NT16) { a0n = *(const h8*)(kp + (size_t)(16 * (j + 8)) * P0W); a1n = *(const h8*)(kp + (size_t)(16 * (j + 8)) * P0W + 32); }
            f32x4 s4 = {0.f, 0.f, 0.f, 0.f};
#pragma unroll
            for (int hh = 0; hh < 8; ++hh) {
                f32x4 acc = {0.f, 0.f, 0.f, 0.f};
                acc = __builtin_amdgcn_mfma_f32_16x16x32_f16(a0, qfl[(hh * 2 + 0) * 64 + lane], acc, 0, 0, 0);
                acc = __builtin_amdgcn_mfma_f32_16x16x32_f16(a1, qfl[(hh * 2 + 1) * 64 + lane], acc, 0, 0, 0);
#pragma unroll
                for (int r = 0; r < 4; ++r) s4[r] += wq[hh] * fmaxf(acc[r], 0.f);
            }
#pragma unroll
            for (int r = 0; r < 4; ++r) sc[jj][r] = s4[r];
        } else {
#pragma unroll
            for (int r = 0; r < 4; ++r) sc[jj][r] = -INFINITY;
        }
    }
    LAS unsigned* red = (LAS unsigned*)(lds + B_RED);
    LAS float* redf = (LAS float*)(lds + B_RED + 1024);
    float mn = INFINITY, mxv = -INFINITY;
#pragma unroll
    for (int jj = 0; jj < 32; ++jj)
#pragma unroll
        for (int r = 0; r < 4; ++r) { const float s = sc[jj][r]; mn = fminf(mn, s > -INFINITY ? s : INFINITY); mxv = fmaxf(mxv, s); }
    mn = fminf(mn, __shfl_xor(mn, 16)); mn = fminf(mn, __shfl_xor(mn, 32)); mxv = fmaxf(mxv, __shfl_xor(mxv, 16)); mxv = fmaxf(mxv, __shfl_xor(mxv, 32));
    redf[wid * 16 + ql] = mn; redf[128 + wid * 16 + ql] = mxv;
    __syncthreads();
    float lo = INFINITY, hi = -INFINITY;
#pragma unroll
    for (int w = 0; w < 8; ++w) { lo = fminf(lo, redf[w * 16 + ql]); hi = fmaxf(hi, redf[128 + w * 16 + ql]); }
    hi = next_up(hi);
#define SEL_LTBITS(W, P) do { _Pragma("unroll") for (int w_ = 0; w_ < 4; ++w_) { unsigned a_ = 0u; _Pragma("unroll") for (int k_ = 0; k_ < 32; ++k_) \
        a_ = __builtin_amdgcn_alignbit(a_, __float_as_uint(sc[8 * w_ + (k_ >> 2)][k_ & 3] - (P)), 31); W[w_] = a_; } } while (0)
    bool done = false, tie = false; float Tv = 0.f; unsigned chi = 0u;
    for (int it = 0; it < 96; ++it) {
        const float mid = lo + (hi - lo) * 0.5f;
        if (!done && !(mid > lo && mid < hi)) { done = true; tie = true; Tv = lo; }
        const float pv = done ? Tv : mid;
        unsigned ltw[4]; SEL_LTBITS(ltw, pv);
        unsigned cnt = 128u - (unsigned)(__builtin_popcount(ltw[0]) + __builtin_popcount(ltw[1]) + __builtin_popcount(ltw[2]) + __builtin_popcount(ltw[3]));
        cnt += __shfl_xor(cnt, 16); cnt += __shfl_xor(cnt, 32);
        LAS unsigned* rb = red + (it & 1) * 128;
        rb[wid * 16 + ql] = cnt;
        __syncthreads();
        unsigned tot = 0u;
#pragma unroll
        for (int w = 0; w < 8; ++w) tot += rb[w * 16 + ql];
        if (!done) { if (tot == (unsigned)TOPK) { done = true; Tv = mid; } else if (tot > (unsigned)TOPK) lo = mid; else { hi = mid; chi = tot; } }
        if (__all(done)) break;
    }
    unsigned selw[4];
    { unsigned ltw[4]; SEL_LTBITS(ltw, Tv);
#pragma unroll
      for (int w = 0; w < 4; ++w) selw[w] = __builtin_bitreverse32(~ltw[w]); }
    if (__any(tie)) {
        unsigned eqw[4];
        { unsigned lew[4]; const float tn = next_up(Tv); SEL_LTBITS(lew, tn);
#pragma unroll
          for (int w = 0; w < 4; ++w) eqw[w] = __builtin_bitreverse32(lew[w]) & selw[w]; }
        const unsigned rneed = (unsigned)TOPK - chi;
        const int kb = 16 * wid + 4 * g;
        int ilo = -1, ihi = N - 1, icut = N; bool tdone = !tie;
        for (int it = 0; it < 40; ++it) {
            const int imid = (ilo + ihi) >> 1;
            if (!tdone && (ihi - ilo) <= 1) { tdone = true; icut = ihi; }
            const int iv = (tdone ? icut : imid) - kb;
            const int nle = iv < 0 ? 0 : min(128, 4 * (iv >> 7) + min(iv & 127, 3) + 1);
            unsigned cnt = 0u;
#pragma unroll
            for (int w = 0; w < 4; ++w) { const int nw = min(max(nle - 32 * w, 0), 32); const unsigned mk = nw >= 32 ? 0xffffffffu : ((1u << nw) - 1u); cnt += (unsigned)__builtin_popcount(eqw[w] & mk); }
            cnt += __shfl_xor(cnt, 16); cnt += __shfl_xor(cnt, 32);
            LAS unsigned* rb = red + (it & 1) * 128;
            rb[wid * 16 + ql] = cnt;
            __syncthreads();
            unsigned tot = 0u;
#pragma unroll
            for (int w = 0; w < 8; ++w) tot += rb[w * 16 + ql];
            if (!tdone) { if (tot == rneed) { tdone = true; icut = imid; } else if (tot < rneed) ilo = imid; else ihi = imid; }
            if (__all(tdone)) break;
        }
        if (tie) {
            const int iv = icut - kb; const int nle = iv < 0 ? 0 : min(128, 4 * (iv >> 7) + min(iv & 127, 3) + 1);
#pragma unroll
            for (int w = 0; w < 4; ++w) { const int nw = min(max(nle - 32 * w, 0), 32); const unsigned mk = nw >= 32 ? 0xffffffffu : ((1u << nw) - 1u); selw[w] = (selw[w] & ~eqw[w]) | (eqw[w] & mk); }
        }
    }
#undef SEL_LTBITS
    LAS u16* mrowp = m16 + ((mrow0 + ql) * 64 + (wid >> 2)) * 4 + (wid & 3);
#pragma unroll
    for (int jj = 0; jj < 32; ++jj) { const int j = wid + 8 * jj;
        if (j < NT16) { unsigned v = ((selw[jj >> 3] >> (4 * (jj & 7))) & 0xFu) << (4 * g);
            v |= __shfl_xor(v, 16); v |= __shfl_xor(v, 32);
            mrowp[8 * jj] = (u16)v; } }
}
__device__ __forceinline__ void attnB_unit(Frame& F, int b, int qb32) {
    LAS unsigned char* lds = F.lds;
    int tid = F.tid; asm volatile("" : "+v"(tid)); int wid = F.wave; asm volatile("" : "+s"(wid));
    const int lane = tid & 63, r32 = lane & 31, hi = lane >> 5;
    const int q0 = 32 * qb32, c = q0 >> 6, nt = c + 1;
    const size_t rowb = (size_t)b * SEQ;
    const u16* P0 = (const u16*)(F.ws + WS_PROJ0);
    selB_16(F, b, c, q0, 0);
    __syncthreads();
    selB_16(F, b, c, q0 + 16, 16);
    LAS float* bt = (LAS float*)(lds + B_BT) + wid * 192;
    for (int e = tid; e < 8 * 192; e += 512) ((LAS float*)(lds + B_BT))[e] = ((const float*)(F.ws + WS_BTG))[4 * 192 + e];
    h8 qf[4];
    { const u16* qp = P0 + (rowb + q0 + r32) * P0W + C_QB + wid * 64 + hi * 8;
#pragma unroll
      for (int d0 = 0; d0 < 4; ++d0) qf[d0] = *(const h8*)(qp + d0 * 16); }
    f32x16 o[2];
#pragma unroll
    for (int d = 0; d < 2; ++d)
#pragma unroll
        for (int r = 0; r < 16; ++r) o[d][r] = 0.f;
    float mrun = -1e30f, lrun = 0.f;
    const int krow = tid >> 3, kch = tid & 7;
    const u16* ksrc = P0 + (rowb + krow) * P0W + C_KB + kch * 8;
    const int kdst = krow * 128 + ((kch ^ ((krow >> 1) & 7)) << 4);
    const int vdst = 8192 + krow * 128 + ((kch ^ (((krow >> 1) & 1) << 2)) << 4);
    u32x4 st0, st1;
#define B_LOAD(t) do { const size_t to = (size_t)(t) * 64 * P0W; st0 = *(const u32x4*)(ksrc + to); st1 = *(const u32x4*)(ksrc + to + 64); } while (0)
#define B_WRITE(s) do { LAS unsigned char* sb = lds + (s) * 16384; *(LAS u32x4*)(sb + kdst) = st0; *(LAS u32x4*)(sb + vdst) = st1; } while (0)
    const int kfo = r32 * 128, ksw = (r32 >> 1) & 7;
    const int i16 = lane & 15, qrow = i16 >> 2, pp = i16 & 3, g16 = (lane >> 4) & 1;
    const int vlane = (4 * hi + qrow) * 128 + ((2 * g16 + (pp >> 1)) << 4) + 8 * (pp & 1);
    const int qglob = q0 + r32;
    B_LOAD(0); B_WRITE(0); __syncthreads();
    for (int t = 0; t < nt; ++t) {
        if (t + 1 < nt) B_LOAD(t + 1);
        {
            LAS const unsigned char* sb = lds + (t & 1) * 16384; LAS const unsigned char* kb = sb + kfo; LAS const unsigned char* vb = sb + 8192 + vlane;
            const bool nearb = (64 * t + 63 - q0) > -128;
            const float c0 = nearb ? 0.f : bt[0];
            f32x16 p0, p1;
#pragma unroll
            for (int r = 0; r < 16; ++r) { p0[r] = c0; p1[r] = c0; }
#pragma unroll
            for (int d0 = 0; d0 < 4; ++d0) { const int co = ((2 * d0 + hi) ^ ksw) << 4;
                const h8 ka = *(LAS const h8*)(kb + co), kc = *(LAS const h8*)(kb + 4096 + co);
                p0 = __builtin_amdgcn_mfma_f32_32x32x16_f16(ka, qf[d0], p0, 0, 0, 0); p1 = __builtin_amdgcn_mfma_f32_32x32x16_f16(kc, qf[d0], p1, 0, 0, 0); }
            if (nearb) add_bias(p0, p1, bt, 64 * t + 4 * hi - qglob + 128);
            const u64 mw = *(LAS const u64*)(lds + B_MASK + (r32 * 64 + t) * 8);
            const unsigned mlo = (unsigned)mw >> (4 * hi), mhi = (unsigned)(mw >> 32) >> (4 * hi);
#pragma unroll
            for (int r = 0; r < 16; ++r) { const int cb = (r & 3) + 8 * (r >> 2);
                if (!((mlo >> cb) & 1u)) p0[r] = -1e30f; if (!((mhi >> cb) & 1u)) p1[r] = -1e30f; }
            h8 pf[4];
            softmax_step<2>(p0, p1, mrun, lrun, o, pf);
#pragma unroll
            for (int d0 = 0; d0 < 2; ++d0) { const int dx = (d0 ^ (qrow >> 1)) << 6;
#pragma unroll
                for (int ks = 0; ks < 4; ++ks) { const h8 vf = tr2(vb + ks * 2048 + dx, vb + ks * 2048 + 1024 + dx);
                    o[d0] = __builtin_amdgcn_mfma_f32_32x32x16_f16(vf, pf[ks], o[d0], 0, 0, 0); } }
        }
        if (t + 1 < nt) B_WRITE((t + 1) & 1);
        __syncthreads();
    }
#undef B_LOAD
#undef B_WRITE
    const float linv = 1.0f / swap_sum(lrun);
    const size_t row = rowb + qglob;
    const u16* gp = P0 + row * P0W + C_G0 + 512 + wid * 64;
    u16* op = (u16*)(F.ws + WS_MG0) + row * DM + 512 + wid * 64;
#pragma unroll
    for (int d0 = 0; d0 < 2; ++d0)
#pragma unroll
        for (int g = 0; g < 4; ++g) { const int d = 32 * d0 + 8 * g + 4 * hi;
            const h4 gv = *(const h4*)(gp + d);
            u32x2 w; w.x = pkh(o[d0][4 * g] * linv * (float)gv[0], o[d0][4 * g + 1] * linv * (float)gv[1]);
            w.y = pkh(o[d0][4 * g + 2] * linv * (float)gv[2], o[d0][4 * g + 3] * linv * (float)gv[3]);
            *(u32x2*)(op + d) = w; }
}

__device__ __forceinline__ void attnC_unit(Frame& F, int b, int h, int qb) {
    LAS unsigned char* lds = F.lds;
    int tid = F.tid; asm volatile("" : "+v"(tid)); int wid = F.wave; asm volatile("" : "+s"(wid));
    const int lane = tid & 63, r32 = lane & 31, hi = lane >> 5;
    const int q0 = 256 * qb + 32 * wid, cw = q0 >> 6, nt = 4 * qb + 4;
    const size_t rowb = (size_t)b * SEQ;
    const u16* Q1 = (const u16*)(F.ws + WS_Q1); const u16* KV = (const u16*)(F.ws + WS_KV1); const u16* KR = (const u16*)(F.ws + WS_KROPE);
    h8 qf[6];
    { const u16* qp = Q1 + (rowb + q0 + r32) * 1536 + h * 96 + hi * 8;
#pragma unroll
      for (int d0 = 0; d0 < 6; ++d0) qf[d0] = *(const h8*)(qp + d0 * 16); }
    f32x16 o[2];
#pragma unroll
    for (int d = 0; d < 2; ++d)
#pragma unroll
        for (int r = 0; r < 16; ++r) o[d][r] = 0.f;
    float mrun = -1e30f, lrun = 0.f;
    const int krow = tid >> 3, kch = tid & 7;
    const u16* ksrc = KV + (rowb + krow) * 2048 + h * 128 + kch * 8;
    const int kdst = krow * 128 + ((kch ^ ((krow >> 1) & 7)) << 4);
    const int vdst = 12288 + krow * 128 + ((kch ^ (((krow >> 1) & 1) << 2)) << 4);
    const int rrow = (tid & 255) >> 2, rch = tid & 3;
    const u16* rsrc = KR + (rowb + rrow) * 32 + rch * 8;
    const int rdst = 8192 + rrow * 64 + ((rch ^ ((rrow >> 2) & 3)) << 4);
    u32x4 st0, st1, st2;
#define C_LOAD(t) do { const size_t tr = (size_t)(t) * 64; st0 = *(const u32x4*)(ksrc + tr * 2048); st1 = *(const u32x4*)(ksrc + tr * 2048 + 64); if (tid < 256) st2 = *(const u32x4*)(rsrc + tr * 32); } while (0)
#define C_WRITE(s) do { LAS unsigned char* sb = lds + (s) * 20480; *(LAS u32x4*)(sb + kdst) = st0; *(LAS u32x4*)(sb + vdst) = st1; if (tid < 256) *(LAS u32x4*)(sb + rdst) = st2; } while (0)
    const int kfo = r32 * 128, ksw = (r32 >> 1) & 7;
    const int rfo = 8192 + r32 * 64, rsw = (r32 >> 2) & 3;
    const int i16 = lane & 15, qrow = i16 >> 2, pp = i16 & 3, g16 = (lane >> 4) & 1;
    const int vlane = (4 * hi + qrow) * 128 + ((2 * g16 + (pp >> 1)) << 4) + 8 * (pp & 1);
    C_LOAD(0); C_WRITE(0); __syncthreads();
    for (int t = 0; t < nt; ++t) {
        if (t + 1 < nt) C_LOAD(t + 1);
        if (t <= cw) {
            LAS const unsigned char* sb = lds + (t & 1) * 20480; LAS const unsigned char* kb = sb + kfo; LAS const unsigned char* rb = sb + rfo; LAS const unsigned char* vb = sb + 12288 + vlane;
            f32x16 p0, p1;
#pragma unroll
            for (int r = 0; r < 16; ++r) { p0[r] = 0.f; p1[r] = 0.f; }
#pragma unroll
            for (int d0 = 0; d0 < 4; ++d0) { const int co = ((2 * d0 + hi) ^ ksw) << 4;
                const h8 ka = *(LAS const h8*)(kb + co), kc = *(LAS const h8*)(kb + 4096 + co);
                p0 = __builtin_amdgcn_mfma_f32_32x32x16_f16(ka, qf[d0], p0, 0, 0, 0); p1 = __builtin_amdgcn_mfma_f32_32x32x16_f16(kc, qf[d0], p1, 0, 0, 0); }
#pragma unroll
            for (int d0 = 0; d0 < 2; ++d0) { const int co = ((2 * d0 + hi) ^ rsw) << 4;
                const h8 ka = *(LAS const h8*)(rb + co), kc = *(LAS const h8*)(rb + 2048 + co);
                p0 = __builtin_amdgcn_mfma_f32_32x32x16_f16(ka, qf[4 + d0], p0, 0, 0, 0); p1 = __builtin_amdgcn_mfma_f32_32x32x16_f16(kc, qf[4 + d0], p1, 0, 0, 0); }
#if DEBUG_CHECK
            if (b == TAPB && h == TAPH && qb == TAPQB && wid == 0 && t == 0) { float* db = (float*)(F.ws + WS_DBGBUF);
#pragma unroll
                for (int r = 0; r < 16; ++r) { const int key = (r & 3) + 8 * (r >> 2) + 4 * hi; db[r32 * 64 + key] = p0[r]; db[r32 * 64 + 32 + key] = p1[r]; } }
#endif
            h8 pf[4];
            softmax_step<2>(p0, p1, mrun, lrun, o, pf);
#pragma unroll
            for (int d0 = 0; d0 < 2; ++d0) { const int dx = (d0 ^ (qrow >> 1)) << 6;
#pragma unroll
                for (int ks = 0; ks < 4; ++ks) { const h8 vf = tr2(vb + ks * 2048 + dx, vb + ks * 2048 + 1024 + dx);
                    o[d0] = __builtin_amdgcn_mfma_f32_32x32x16_f16(vf, pf[ks], o[d0], 0, 0, 0); } }
        }
        if (t + 1 < nt) C_WRITE((t + 1) & 1);
        __syncthreads();
    }
#undef C_LOAD
#undef C_WRITE
    const float linv = 1.0f / swap_sum(lrun);
    const size_t row = rowb + q0 + r32;
#if DEBUG_CHECK
    if (b == TAPB && h == TAPH && qb == TAPQB) { float* db = (float*)(F.ws + WS_DBGBUF) + 4096;
#pragma unroll
        for (int d0 = 0; d0 < 2; ++d0)
#pragma unroll
            for (int r = 0; r < 16; ++r) db[(32 * wid + r32) * 64 + 32 * d0 + (r & 3) + 8 * (r >> 2) + 4 * hi] = o[d0][r] * linv; }
#endif
    const u16* gp = (const u16*)(F.ws + WS_G1) + row * DM + h * 64;
    u16* op = (u16*)(F.ws + WS_MG1) + row * DM + h * 64;
#pragma unroll
    for (int d0 = 0; d0 < 2; ++d0)
#pragma unroll
        for (int g = 0; g < 4; ++g) { const int d = 32 * d0 + 8 * g + 4 * hi;
            const h4 gv = *(const h4*)(gp + d);
            u32x2 w; w.x = pkh(o[d0][4 * g] * linv * (float)gv[0], o[d0][4 * g + 1] * linv * (float)gv[1]);
            w.y = pkh(o[d0][4 * g + 2] * linv * (float)gv[2], o[d0][4 * g + 3] * linv * (float)gv[3]);
            *(u32x2*)(op + d) = w; }
}

__device__ __forceinline__ void p8_final(Frame& F, const Args& AR) {
    const int gw = blockIdx.x * NWAVES + F.wave, NGW = F.G * NWAVES;
    const float* gn = AR.in[I_FNORM]; f32x4 gv[4];
#pragma unroll
    for (int j = 0; j < 4; ++j) gv[j] = *(const f32x4*)(gn + 4 * F.lane + 256 * j);
    for (int mrow = gw; mrow < T; mrow += NGW) {
        f32x4* xr = (f32x4*)(F.out + (size_t)mrow * DM) + F.lane;
        f32x4 v[4]; float s = 0.f;
#pragma unroll
        for (int j = 0; j < 4; ++j) { v[j] = xr[64 * j]; s += (v[j].x * v[j].x + v[j].y * v[j].y) + (v[j].z * v[j].z + v[j].w * v[j].w); }
        const float rstd = __builtin_amdgcn_rsqf(wave_sum(s) * (1.f / DM) + RMS_EPS);
#pragma unroll
        for (int j = 0; j < 4; ++j) xr[64 * j] = v[j] * rstd * gv[j];
    }
}


#ifndef NAIVE_ATTN
#define NAIVE_ATTN 0
#endif
struct NaiveSh { float sh[4096]; float red[256]; unsigned char sel[4096]; };
__device__ __forceinline__ float blk_max(NaiveSh& S, float v, int tid) { S.red[tid] = v; __syncthreads(); for (int o2 = 128; o2 > 0; o2 >>= 1) { if (tid < o2) S.red[tid] = fmaxf(S.red[tid], S.red[tid + o2]); __syncthreads(); } const float r = S.red[0]; __syncthreads(); return r; }
__device__ __forceinline__ float blk_sum(NaiveSh& S, float v, int tid) { S.red[tid] = v; __syncthreads(); for (int o2 = 128; o2 > 0; o2 >>= 1) { if (tid < o2) S.red[tid] += S.red[tid + o2]; __syncthreads(); } const float r = S.red[0]; __syncthreads(); return r; }
__device__ __forceinline__ float blk_softmax(NaiveSh& S, int nk, int tid) {
    float mx = -1e30f; for (int k = tid; k < nk; k += 256) mx = fmaxf(mx, S.sh[k]); mx = blk_max(S, mx, tid);
    float ls = 0.f; for (int k = tid; k < nk; k += 256) { const float p = S.sh[k] > -1e29f ? exp2f(S.sh[k] - mx) : 0.f; S.sh[k] = p; ls += p; }
    return blk_sum(S, ls, tid);
}
__device__ __forceinline__ float naiveA(NaiveSh& S, const Args& args, int b, int q, int hd, int tid) {
    unsigned char* ws = args.ws; const u16* P0 = (const u16*)(ws + WS_PROJ0); const float* BT = (const float*)(ws + WS_BTG);
    const size_t row = (size_t)b * SEQ + q; const int nk = 64 * (q / 64 + 1); float outv[2] = {0.f, 0.f};
    for (int m = 0; m < 2; ++m) {
        for (int k = tid; k < nk; k += 256) { float sacc = 0.f; const u16* qp = P0 + row * P0W + C_QA + hd * 128 + m * 64; const u16* kp = P0 + ((size_t)b * SEQ + k) * P0W + C_KA + hd * 128 + m * 64;
            for (int d = 0; d < 64; ++d) sacc += h2f(qp[d]) * h2f(kp[d]);
            int rel = k - q; rel = rel < -128 ? -128 : rel; S.sh[k] = sacc + BT[hd * 192 + rel + 128]; }
        __syncthreads();
        const float ls = blk_softmax(S, nk, tid);
        if (tid < 128) { float a = 0.f; for (int k = 0; k < nk; ++k) a += S.sh[k] * h2f(P0[((size_t)b * SEQ + k) * P0W + C_VA + hd * 128 + tid]); outv[m] = a / ls; }
        __syncthreads();
    }
    const float lam = *(const float*)(ws + WS_LAM); const float v = tid < 128 ? outv[0] - lam * outv[1] : 0.f;
    const float ss = blk_sum(S, v * v, tid);
    const float rs = rsqrtf(ss / 128.f + RMS_EPS) * 0.8f;
    return tid < 128 ? v * rs * args.in[I_SUBLN][tid] * h2f(P0[row * P0W + C_G0 + hd * 128 + tid]) : 0.f;
}
__device__ __forceinline__ void naiveB_select(NaiveSh& S, const Args& args, int b, int q, int tid) {
    const u16* P0 = (const u16*)(args.ws + WS_PROJ0); const size_t row = (size_t)b * SEQ + q; const int nk = 64 * (q / 64 + 1);
    for (int k = tid; k < nk; k += 256) { float sc = 0.f;
        for (int hh = 0; hh < 8; ++hh) { float l = 0.f; const u16* qp = P0 + row * P0W + C_QI + hh * 64; const u16* kp = P0 + ((size_t)b * SEQ + k) * P0W + C_KI;
            for (int d = 0; d < 64; ++d) l += h2f(qp[d]) * h2f(kp[d]);
            sc += h2f(P0[row * P0W + C_WI + hh]) * fmaxf(l, 0.f); }
        S.sh[k] = sc; }
    __syncthreads();
    for (int k = tid; k < nk; k += 256) { const float sk = S.sh[k]; int rank = 0; for (int k2 = 0; k2 < nk; ++k2) { const float s2 = S.sh[k2]; rank += (s2 > sk || (s2 == sk && k2 < k)) ? 1 : 0; } S.sel[k] = rank < TOPK ? 1 : 0; }
    __syncthreads();
}
__device__ __forceinline__ float naiveB_head(NaiveSh& S, const Args& args, int b, int q, int hd, int tid) {
    const u16* P0 = (const u16*)(args.ws + WS_PROJ0); const float* BT = (const float*)(args.ws + WS_BTG); const size_t row = (size_t)b * SEQ + q; const int nk = 64 * (q / 64 + 1);
    for (int k = tid; k < nk; k += 256) { float sacc = -1e30f;
        if (S.sel[k]) { sacc = 0.f; const u16* qp = P0 + row * P0W + C_QB + hd * 64; const u16* kp = P0 + ((size_t)b * SEQ + k) * P0W + C_KB;
            for (int d = 0; d < 64; ++d) sacc += h2f(qp[d]) * h2f(kp[d]);
            int rel = k - q; rel = rel < -128 ? -128 : rel; sacc += BT[(4 + hd) * 192 + rel + 128]; }
        S.sh[k] = sacc; }
    __syncthreads();
    const float ls = blk_softmax(S, nk, tid);
    float r = 0.f;
    if (tid < 64) { float a = 0.f; for (int k = 0; k < nk; ++k) a += S.sh[k] * h2f(P0[((size_t)b * SEQ + k) * P0W + C_VB + tid]); r = a / ls * h2f(P0[row * P0W + C_G0 + 512 + hd * 64 + tid]); }
    __syncthreads();
    return r;
}
__device__ __forceinline__ float naiveC(NaiveSh& S, const Args& args, int b, int q, int hd, int tid) {
    unsigned char* ws = args.ws; const size_t row = (size_t)b * SEQ + q; const int nk = 64 * (q / 64 + 1);
    const u16* Q1 = (const u16*)(ws + WS_Q1); const u16* KV = (const u16*)(ws + WS_KV1); const u16* KR = (const u16*)(ws + WS_KROPE);
    for (int k = tid; k < nk; k += 256) { float sacc = 0.f; const u16* qp = Q1 + row * 1536 + hd * 96; const size_t kr = (size_t)b * SEQ + k;
        for (int d = 0; d < 64; ++d) sacc += h2f(qp[d]) * h2f(KV[kr * 2048 + hd * 128 + d]);
        for (int d = 0; d < 32; ++d) sacc += h2f(qp[64 + d]) * h2f(KR[kr * 32 + d]);
        S.sh[k] = sacc; }
    __syncthreads();
    const float ls = blk_softmax(S, nk, tid);
    float r = 0.f;
    if (tid < 64) { float a = 0.f; for (int k = 0; k < nk; ++k) a += S.sh[k] * h2f(KV[((size_t)b * SEQ + k) * 2048 + hd * 128 + 64 + tid]); r = a / ls * h2f(((const u16*)(ws + WS_G1))[row * DM + hd * 64 + tid]); }
    __syncthreads();
    return r;
}
#if NAIVE_ATTN
__global__ void __launch_bounds__(256) naive_attn(Args args, int which) {
    __shared__ NaiveSh S; const int tid = threadIdx.x; unsigned char* ws = args.ws;
    if (which == 0) {
        for (int it = blockIdx.x; it < T * 5; it += gridDim.x) {
            const int row = it / 5, sub = it % 5, b = row / SEQ, q = row % SEQ;
            if (sub < 4) { const float v = naiveA(S, args, b, q, sub, tid); if (tid < 128) ((u16*)(ws + WS_MG0))[(size_t)row * DM + sub * 128 + tid] = (u16)(pkh(v, 0.f) & 0xffffu); }
            else { naiveB_select(S, args, b, q, tid);
                for (int hd = 0; hd < 8; ++hd) { const float v = naiveB_head(S, args, b, q, hd, tid); if (tid < 64) ((u16*)(ws + WS_MG0))[(size_t)row * DM + 512 + hd * 64 + tid] = (u16)(pkh(v, 0.f) & 0xffffu); } }
        }
    } else {
        for (int it = blockIdx.x; it < T * 16; it += gridDim.x) {
            const int row = it >> 4, hd = it & 15, b = row / SEQ, q = row % SEQ;
            const float v = naiveC(S, args, b, q, hd, tid); if (tid < 64) ((u16*)(ws + WS_MG1))[(size_t)row * DM + hd * 64 + tid] = (u16)(pkh(v, 0.f) & 0xffffu);
        }
    }
}
#endif

#if DEBUG_CHECK
constexpr size_t WS_DBG = 3 * MiB;
#ifndef DBG_BITS_MODE
#define DBG_BITS_MODE 1
#define DBG_BITS_IDS 14, 4, 5, 21, 22, 23
#endif
#ifndef DBG_SKIP_MASK
#define DBG_SKIP_MASK 0x10
#endif
#ifndef DBG_REPORT_ID
#define DBG_REPORT_ID 0
#endif
__device__ __forceinline__ unsigned dhash(unsigned x) { x ^= x >> 16; x *= 0x7feb352du; x ^= x >> 15; x *= 0x846ca68bu; x ^= x >> 16; return x; }
__device__ __forceinline__ void dbg_rec(unsigned char* ws, int id, float got, float ref, float scale) {
    float e = fabsf(got - ref) / (fabsf(ref) + scale); if (!(e == e)) e = 1e6f;
    atomicMax((unsigned*)(ws + WS_DBG) + id, __float_as_uint(e));
}
__device__ __forceinline__ float dh(const u16* p, size_t i) { return h2f(p[i]); }
__global__ void __launch_bounds__(256) dbg_check(Args args, int stage) {
    unsigned char* ws = args.ws; const int tid = threadIdx.x, bid = blockIdx.x, gid = bid * 256 + tid;
    if (stage == 0) { if (gid < 64) ((unsigned*)(ws + WS_DBG))[gid] = (gid == 44) ? 0xffffu : 0u; return; }
    if (stage == 1) {
        const unsigned h = dhash(gid * 7919u + 13u);
        { const int n = h % P0W, k = (h >> 12) % 1024; const int sc = wsrc_col(0, n); const float ref = sc < 0 ? 0.f : args.in[I_EWIN][(size_t)k * L0_SRC + sc] * wcol_scale(0, n);
          dbg_rec(ws, 1, dh((const u16*)(ws + WS_W0T), (size_t)n * 1024 + k), ref, 1e-3f); }
        { const int n = h % P1W, k = (h >> 12) % 1024; const int sc = wsrc_col(2, n); const float ref = sc < 0 ? 0.f : args.in[I_OWIN][(size_t)k * L1_SRC + sc] * args.in[I_ONORM][k];
          dbg_rec(ws, 1, dh((const u16*)(ws + WS_W1T), (size_t)n * 1024 + k), ref, 1e-3f); }
        { const int n = h % 1536, k = (h >> 12) % 384; const float ref = args.in[I_OWUQ][(size_t)k * 1536 + n] * args.in[I_OQNORM][k] * QS_C;
          dbg_rec(ws, 1, dh((const u16*)(ws + WS_WUQT), (size_t)n * 384 + k), ref, 1e-3f); }
        { const int n = h % 2048, k = (h >> 12) % 256; const float ref = args.in[I_OWUKV][(size_t)k * 2048 + n] * args.in[I_OKVNORM][k];
          dbg_rec(ws, 1, dh((const u16*)(ws + WS_WUKVT), (size_t)n * 256 + k), ref, 1e-3f); }
        { const int n = h % 1024, k = (h >> 12) % 1024; dbg_rec(ws, 1, dh((const u16*)(ws + WS_WO0T), (size_t)n * 1024 + k), args.in[I_EWO][(size_t)k * 1024 + n], 1e-3f);
          dbg_rec(ws, 1, dh((const u16*)(ws + WS_WO1T), (size_t)n * 1024 + k), args.in[I_OWO][(size_t)k * 1024 + n], 1e-3f); }
        { const int row = h % T, col = (h >> 15) % 1024; const float* xr = args.in[I_X] + (size_t)row * DM; float ss = 0.f; for (int k = 0; k < DM; ++k) ss += xr[k] * xr[k];
          const float ref = xr[col] * rsqrtf(ss / DM + RMS_EPS) * args.in[I_ENORM][col]; dbg_rec(ws, 2, dh((const u16*)(ws + WS_XN0), (size_t)row * DM + col), ref, 1e-2f); }
        return;
    }
    if (stage == 2) {
        const unsigned h = dhash(gid * 104729u + 7u); const int row = h % T; int col = (h >> 15) % P0W; if (gid & 1) col = C_G0 + (col & 1023); if ((gid & 7) == 2) col = C_KI + (col & 63);
        const u16* a = (const u16*)(ws + WS_XN0) + (size_t)row * DM; const u16* b = (const u16*)(ws + WS_W0T) + (size_t)col * 1024; float acc = 0.f;
        for (int k = 0; k < 1024; ++k) acc += h2f(a[k]) * h2f(b[k]);
        if (col >= C_G0) acc = acc / (1.f + expf(-acc));
        dbg_rec(ws, 3, dh((const u16*)(ws + WS_PROJ0), (size_t)row * P0W + col), acc, 2e-2f);
        return;
    }
    if (stage == 3) {
        __shared__ NaiveSh NS;
        const unsigned h = dhash(bid * 2654435761u + 99u);
        int q = h % SEQ; const int b = (h >> 12) % NB; if (bid % 5 == 0) q = q % 320;
        const size_t row = (size_t)b * SEQ + q;
        if (bid < 48) { const int hd = (h >> 20) % 4; const float ref = naiveA(NS, args, b, q, hd, tid);
            if (tid < 128) dbg_rec(ws, 4, dh((const u16*)(ws + WS_MG0), row * DM + hd * 128 + tid), ref, 2e-2f); }
        else { const int hd = (h >> 20) % 8; naiveB_select(NS, args, b, q, tid); const float ref = naiveB_head(NS, args, b, q, hd, tid);
            if (tid < 64) dbg_rec(ws, 5, dh((const u16*)(ws + WS_MG0), row * DM + 512 + hd * 64 + tid), ref, 2e-2f); }
        return;
    }
    if (stage == 4) {
        const unsigned h = dhash(gid * 15485863u + 3u); const int row = h % T, col = (h >> 15) % 1024;
        const u16* a = (const u16*)(ws + WS_MG0) + (size_t)row * DM; const u16* b = (const u16*)(ws + WS_WO0T) + (size_t)col * 1024; float acc = 0.f;
        for (int k = 0; k < 1024; ++k) acc += h2f(a[k]) * h2f(b[k]);
        const float ref = args.in[I_X][(size_t)row * DM + col] + acc;
        dbg_rec(ws, 6, args.out[(size_t)row * DM + col], ref, 1e-2f); dbg_rec(ws, 6, dh((const u16*)(ws + WS_XN0), (size_t)row * DM + col), ref, 1e-2f);
        if (gid < 2048) { float ss = 0.f; for (int k = 0; k < DM; ++k) { const float v = args.out[(size_t)row * DM + k]; ss += v * v; }
            dbg_rec(ws, 7, (float)((const u64*)(ws + WS_SSQ1))[row] / FXS, ss, 1e-3f); }
        return;
    }
    if (stage == 5) {
        const unsigned h = dhash(gid * 32452843u + 5u); const int row = h % T; int col = (h >> 15) % P1W; if ((gid & 3) == 1) col = 640 + (col & 31);
        if (col >= 672 && col < 768) col -= 200;
        const u16* a = (const u16*)(ws + WS_XN0) + (size_t)row * DM; float ss = 0.f; for (int k = 0; k < DM; ++k) { const float v = args.out[(size_t)row * DM + k]; ss += v * v; }
        const float rs = rsqrtf(ss / DM + RMS_EPS);
        auto dotc = [&](int c) { const u16* b = (const u16*)(ws + WS_W1T) + (size_t)c * 1024; float acc = 0.f; for (int k = 0; k < 1024; ++k) acc += h2f(a[k]) * h2f(b[k]); return acc * rs; };
        const float v = dotc(col);
        if (col < 640) dbg_rec(ws, 8, dh((const u16*)(ws + WS_LAT), (size_t)row * LATW + col), v, 2e-2f);
        else if (col < 672) { const int j = col - 640, pos = row & (SEQ - 1), i = j & 15; const float inv = (float)pow(10000.0, -(double)i / 16.0), ang = (float)pos * inv; const float cs = cosf(ang), sn = sinf(ang);
            const float other = dotc(j < 16 ? col + 16 : col - 16); const float ref = j < 16 ? v * cs - other * sn : other * sn + v * cs;
            dbg_rec(ws, 9, dh((const u16*)(ws + WS_KROPE), (size_t)row * 32 + j), ref, 2e-2f); }
        else dbg_rec(ws, 10, dh((const u16*)(ws + WS_G1), (size_t)row * DM + col - 768), v / (1.f + expf(-v)), 2e-2f);
        if (gid < 1024) { const u16* lat = (const u16*)(ws + WS_LAT) + (size_t)row * LATW; float s1 = 0.f, s2 = 0.f; for (int k = 0; k < 256; ++k) s1 += h2f(lat[k]) * h2f(lat[k]); for (int k = 256; k < 640; ++k) s2 += h2f(lat[k]) * h2f(lat[k]);
            dbg_rec(ws, 11, (float)((const u64*)(ws + WS_SSQKV))[row] / FXS, s1, 1e-2f); dbg_rec(ws, 11, (float)((const u64*)(ws + WS_SSQQ))[row] / FXS, s2, 1e-2f); }
        return;
    }
    if (stage == 6) {
        const unsigned h = dhash(gid * 49979687u + 11u); const int row = h % T; const u16* lat = (const u16*)(ws + WS_LAT) + (size_t)row * LATW;
        { const int col = (h >> 15) % 2048; float s1 = 0.f; for (int k = 0; k < 256; ++k) s1 += h2f(lat[k]) * h2f(lat[k]); const float rs = rsqrtf(s1 / 256.f + RMS_EPS);
          const u16* b = (const u16*)(ws + WS_WUKVT) + (size_t)col * 256; float acc = 0.f; for (int k = 0; k < 256; ++k) acc += h2f(lat[k]) * h2f(b[k]);
          dbg_rec(ws, 13, dh((const u16*)(ws + WS_KV1), (size_t)row * 2048 + col), acc * rs, 2e-2f); }
        { int col = (h >> 15) % 1536; if (gid & 1) col = (col / 96) * 96 + 64 + (col & 31);
          float s2 = 0.f; for (int k = 256; k < 640; ++k) s2 += h2f(lat[k]) * h2f(lat[k]); const float rs = rsqrtf(s2 / 384.f + RMS_EPS);
          auto dotc = [&](int c) { const u16* b = (const u16*)(ws + WS_WUQT) + (size_t)c * 384; float acc = 0.f; for (int k = 0; k < 384; ++k) acc += h2f(lat[256 + k]) * h2f(b[k]); return acc * rs; };
          float v = dotc(col); const int jj = col % 96;
          if (jj >= 64) { const int j = jj - 64, pos = row & (SEQ - 1), i = j & 15; const float inv = (float)pow(10000.0, -(double)i / 16.0), ang = (float)pos * inv; const float cs = cosf(ang), sn = sinf(ang);
              const float other = dotc(j < 16 ? col + 16 : col - 16); v = j < 16 ? v * cs - other * sn : other * sn + v * cs; }
          dbg_rec(ws, 12, dh((const u16*)(ws + WS_Q1), (size_t)row * 1536 + col), v, 2e-2f); }
        return;
    }
    if (stage == 7) {
        __shared__ NaiveSh NS;
        const unsigned h = dhash(bid * 2654435761u + 777u); int q = h % SEQ; const int b = (h >> 12) % NB, hd = (h >> 20) % 16; if (bid % 5 == 0) q = q % 320;
        const size_t row = (size_t)b * SEQ + q; const float ref = naiveC(NS, args, b, q, hd, tid);
        if (tid < 64) dbg_rec(ws, 14, dh((const u16*)(ws + WS_MG1), row * DM + hd * 64 + tid), ref, 2e-2f);
        { const float got = tid < 64 ? dh((const u16*)(ws + WS_MG1), row * DM + hd * 64 + tid) : 0.f; const bool bad = tid < 64 && fabsf(got - ref) / (fabsf(ref) + 2e-2f) > 0.05f;
          if (__syncthreads_or(bad ? 1 : 0) && tid == 0) { atomicAdd((unsigned*)(ws + WS_DBG) + 43, 1u); atomicMin((unsigned*)(ws + WS_DBG) + 44, (unsigned)(q / 64)); atomicMax((unsigned*)(ws + WS_DBG) + 45, (unsigned)(q / 64)); } }
        {
            const u16* Q1 = (const u16*)(ws + WS_Q1); const u16* KV = (const u16*)(ws + WS_KV1); const u16* KR = (const u16*)(ws + WS_KROPE); const float* db = (const float*)(ws + WS_DBGBUF) + 4096;
            for (int e = gid; e < 256 * 64; e += gridDim.x * 256) { const int qq = e >> 6, d = e & 63, qpos = 256 * TAPQB + qq, nkk = 64 * (qpos / 64 + 1); float mx = -1e30f, ls = 0.f, a = 0.f;
                const size_t rb = (size_t)TAPB * SEQ; const u16* qp = Q1 + (rb + qpos) * 1536 + TAPH * 96;
                for (int pass = 0; pass < 2; ++pass)
                for (int k = 0; k < nkk; ++k) { float sacc = 0.f; for (int dd = 0; dd < 64; ++dd) sacc += h2f(qp[dd]) * h2f(KV[(rb + k) * 2048 + TAPH * 128 + dd]);
                    for (int dd = 0; dd < 32; ++dd) sacc += h2f(qp[64 + dd]) * h2f(KR[(rb + k) * 32 + dd]);
                    if (pass == 0) mx = fmaxf(mx, sacc); else { const float p = exp2f(sacc - mx); ls += p; a += p * h2f(KV[(rb + k) * 2048 + TAPH * 128 + 64 + d]); } }
                dbg_rec(ws, 21 + (qq >> 6), db[e], a / ls, 2e-2f); }
        }
        if (bid == 0) {
            const u16* Q1 = (const u16*)(ws + WS_Q1); const u16* KV = (const u16*)(ws + WS_KV1); const u16* KR = (const u16*)(ws + WS_KROPE); const float* db = (const float*)(ws + WS_DBGBUF);
            for (int e = tid; e < 32 * 64; e += 256) { const int qq = e >> 6, k = e & 63; float sacc = 0.f;
                for (int d = 0; d < 64; ++d) sacc += h2f(Q1[(size_t)qq * 1536 + d]) * h2f(KV[(size_t)k * 2048 + d]);
                for (int d = 0; d < 32; ++d) sacc += h2f(Q1[(size_t)qq * 1536 + 64 + d]) * h2f(KR[(size_t)k * 32 + d]);
                dbg_rec(ws, 20, db[e], sacc, 2e-2f); dbg_rec(ws, 41, db[e], 0.f, 1.0f); dbg_rec(ws, 42, sacc, 0.f, 1.0f); }
            (void)0;
        }
        return;
    }
    if (stage == 9) {
        if (gid == 0) { const unsigned* e = (const unsigned*)(ws + WS_DBG);
            if (DBG_REPORT_ID >= 43 && DBG_REPORT_ID <= 45) { args.out[0] = 100.0f * (float)e[DBG_REPORT_ID] + 50.f; }
            else if (DBG_REPORT_ID == 40) { args.out[0] = 100.0f * (float)(e[40] / 32u) + 50.f; }
            else if (DBG_REPORT_ID > 0) { args.out[0] = 1000.0f * __uint_as_float(e[DBG_REPORT_ID]); }
            else if (DBG_BITS_MODE) { const int ids[6] = {DBG_BITS_IDS}; int v = 0; for (int i = 0; i < 6; ++i) if (ids[i] > 0 && __uint_as_float(e[ids[i]]) > 0.05f) v |= 1 << i; if (v) args.out[0] = 100.0f * v; }
            else { int first = 0; for (int id = 1; id < 32 && !first; ++id) if (!((DBG_SKIP_MASK >> id) & 1) && __uint_as_float(e[id]) > 0.05f) first = id; if (first) args.out[0] = 100.0f * first; } }
        return;
    }
}
#endif

constexpr int N_PHASES = 9;
__global__ void __launch_bounds__(NWAVES * 64) hybrid_fwd(Args args) {
    extern __shared__ __attribute__((aligned(16))) unsigned char lds_raw[];
    Frame F;
    F.lds = (LAS unsigned char*)lds_raw;
    F.MISC = (volatile LAS unsigned*)(F.lds + MISC_OFF);
    F.tid = threadIdx.x; F.lane = F.tid & 63; F.wave = __builtin_amdgcn_readfirstlane(F.tid >> 6);
    F.G = gridDim.x;
    F.out = args.out; F.ws = args.ws; F.ctl = (unsigned*)(args.ws + WS_CTL);
    for (int u = F.tid; u < (LDS_BYTES - RING_BYTES) / 4; u += NWAVES * 64) ((LAS unsigned*)(F.lds + RING_BYTES))[u] = 0u;
    __syncthreads();
    const int lo = args.ph_lo, hi = args.ph_hi;
    const bool multi = (hi - lo) > 1;
    XcdBarrier bar; bar.bar = F.ctl + CW_BAR; bar.x = 0; bar.st = nullptr;
    if (multi) bar = xcd_barrier_post(F.ctl + CW_BAR, F.MISC + 8);
#ifndef PH_MASK
#define PH_MASK 0x1FF
#endif
#define IN(k) (((PH_MASK >> (k)) & 1) && lo <= (k) && (k) < hi)
#define SEAM(k) do { if (IN(k) && IN((k) + 1)) xcd_barrier(bar); } while (0)
    unsigned char* ws = args.ws;
    LAS unsigned char* ring = F.lds;

    if (IN(0)) { p0_prologue(F, args); } SEAM(0);
    if (IN(1)) {
        pg8::Gemm g{(const u16*)(ws + WS_XN0), (const u16*)(ws + WS_W0T), T, P0W, 1024, 1024}; pg8::StaticOrder S; S.init(T, P0W, F.G, (int)blockIdx.x);
        pg8::EpiProj0 E{(u16*)(ws + WS_PROJ0)};
        pg8::gemm_phase<pg8::EpiProj0>(ring, g, S, E);
    } SEAM(1);
    if (IN(2) && !NAIVE_ATTN) {
        for (;;) {
            const int u = next_unit(F, CW_Q0);
            if (u >= 2048) break;
            const int lvl = 31 - (u >> 6), r = u & 63;
#ifndef NO_B
            if (r < 32) { const int c = 2 * lvl + 1 - (r >> 4), rr = r & 15; attnB_unit(F, rr >> 1, 2 * c + (rr & 1)); }
#endif
#ifndef NO_A
            if (r >= 32) { const int idx = r - 32; attnA_unit(F, args, idx >> 2, idx & 3, lvl); }
#endif
        }
        __syncthreads();
    } SEAM(2);
    if (IN(3)) {
        pg8::Gemm g{(const u16*)(ws + WS_MG0), (const u16*)(ws + WS_WO0T), T, 1024, 1024, 1024}; pg8::StaticOrder S; S.init(T, 1024, F.G, (int)blockIdx.x);
        pg8::EpiRes E{args.in[I_X], F.out, (u16*)(ws + WS_XN0), (u64*)(ws + WS_SSQ1)};
        pg8::gemm_phase<pg8::EpiRes>(ring, g, S, E);
    } SEAM(3);
    if (IN(4)) {
        pg8::Gemm g{(const u16*)(ws + WS_XN0), (const u16*)(ws + WS_W1T), T, P1W, 1024, 1024}; pg8::StaticOrder S; S.init(T, P1W, F.G, (int)blockIdx.x);
        pg8::EpiProj1 E{(const u64*)(ws + WS_SSQ1), (u16*)(ws + WS_LAT), (u16*)(ws + WS_KROPE), (u16*)(ws + WS_G1), (u64*)(ws + WS_SSQKV), (u64*)(ws + WS_SSQQ), (const float*)(ws + WS_ROPEC), (const float*)(ws + WS_ROPES)};
        pg8::gemm_phase<pg8::EpiProj1>(ring, g, S, E);
    } SEAM(4);
    if (IN(5)) {
#ifndef NO_4A
        { pg8::Gemm g{(const u16*)(ws + WS_LAT) + 256, (const u16*)(ws + WS_WUQT), T, 1536, 384, LATW}; pg8::StaticOrder S; S.init(T, 1536, F.G, (int)blockIdx.x);
          pg8::EpiQ1 E{(const u64*)(ws + WS_SSQQ), (u16*)(ws + WS_Q1), (const float*)(ws + WS_ROPEC), (const float*)(ws + WS_ROPES)};
          pg8::gemm_phase<pg8::EpiQ1>(ring, g, S, E); }
#endif
#ifndef NO_4B
        { pg8::Gemm g{(const u16*)(ws + WS_LAT), (const u16*)(ws + WS_WUKVT), T, 2048, 256, LATW}; pg8::StaticOrder S; S.init(T, 2048, F.G, (int)blockIdx.x);
          pg8::EpiKV1 E{(const u64*)(ws + WS_SSQKV), (u16*)(ws + WS_KV1)};
          pg8::gemm_phase<pg8::EpiKV1>(ring, g, S, E); }
#endif
    } SEAM(5);
    if (IN(6) && !NAIVE_ATTN) {
        for (;;) {
            const int u = next_unit(F, CW_Q1);
            if (u >= 2048) break;
            const int qb = 15 - (u >> 7), r = u & 127;
#if DEBUG_CHECK
            if (F.tid == 0) atomicAdd((unsigned*)(ws + WS_DBG) + 40, 1u);
#endif
            attnC_unit(F, r >> 4, r & 15, qb);
        }
        __syncthreads();
    } SEAM(6);
    if (IN(7)) {
        pg8::Gemm g{(const u16*)(ws + WS_MG1), (const u16*)(ws + WS_WO1T), T, 1024, 1024, 1024}; pg8::StaticOrder S; S.init(T, 1024, F.G, (int)blockIdx.x);
        pg8::EpiRes E{F.out, F.out, nullptr, nullptr};
        pg8::gemm_phase<pg8::EpiRes>(ring, g, S, E);
    } SEAM(7);
    if (IN(8)) { p8_final(F, args); }
#undef IN
#undef SEAM
}

extern "C" void kernel_launch(void* const* d_in, const int* in_sizes, int n_in, void* d_out, int out_size, void* d_ws, size_t ws_size, hipStream_t stream) {
    static int grid = 0;
    if (grid == 0) {
        if (n_in != 18 || in_sizes[0] != T * DM || out_size != T * DM || ws_size < WS_END) {
            fprintf(stderr, "kernel_launch: unexpected shapes (n_in %d, in0 %d, out %d, ws %zu, need %zu); nothing launched\n", n_in, n_in > 0 ? in_sizes[0] : -1, out_size, ws_size, (size_t)WS_END); grid = -1; return; }
        int dev = 0, cus = 0, per_cu = 0;
        if (hipGetDevice(&dev) != hipSuccess || hipDeviceGetAttribute(&cus, hipDeviceAttributeMultiprocessorCount, dev) != hipSuccess) { fprintf(stderr, "kernel_launch: device query failed\n"); grid = -1; return; }
        if (hipFuncSetAttribute((const void*)hybrid_fwd, hipFuncAttributeMaxDynamicSharedMemorySize, LDS_BYTES) != hipSuccess) { fprintf(stderr, "kernel_launch: hipFuncSetAttribute failed\n"); grid = -1; return; }
        if (hipOccupancyMaxActiveBlocksPerMultiprocessor(&per_cu, (const void*)hybrid_fwd, NWAVES * 64, LDS_BYTES) != hipSuccess || per_cu < 1)
            fprintf(stderr, "kernel_launch: note: occupancy query reports %d workgroups per CU\n", per_cu);
        (void)hipGetLastError();
        grid = cus;
        if (grid % 8 != 0) grid -= grid % 8;
    }
    if (grid <= 0) return;
    (void)hipMemsetAsync((char*)d_ws + WS_CTL, 0, CTL_ZERO_BYTES, stream);
    Args a{};
    for (int i = 0; i < 18; ++i) a.in[i] = (const float*)d_in[i];
    a.out = (float*)d_out; a.ws = (unsigned char*)d_ws;
#if MK_N_LAUNCHES == 1
    a.ph_lo = 0; a.ph_hi = N_PHASES;
    hipLaunchKernelGGL(hybrid_fwd, dim3(grid), dim3(NWAVES * 64), LDS_BYTES, stream, a);
#else
#if DEBUG_CHECK
    hipLaunchKernelGGL(dbg_check, dim3(1), dim3(256), 0, stream, a, 0);
#endif
    for (int p = 0; p < N_PHASES; ++p) { a.ph_lo = p; a.ph_hi = p + 1;
#if NAIVE_ATTN
        if (p == 2) { hipLaunchKernelGGL(naive_attn, dim3(8192), dim3(256), 0, stream, a, 0); continue; }
        if (p == 6) { hipLaunchKernelGGL(naive_attn, dim3(8192), dim3(256), 0, stream, a, 1); continue; }
#endif
        hipLaunchKernelGGL(hybrid_fwd, dim3(grid), dim3(NWAVES * 64), LDS_BYTES, stream, a);
#if DEBUG_CHECK
        if (p <= 6) hipLaunchKernelGGL(dbg_check, dim3((p == 2 || p == 6) ? 96 : 64), dim3(256), 0, stream, a, p + 1);
#endif
    }
#if DEBUG_CHECK
    hipLaunchKernelGGL(dbg_check, dim3(1), dim3(256), 0, stream, a, 9);
#endif
#endif
    const hipError_t le = hipPeekAtLastError();
    if (le != hipSuccess) fprintf(stderr, "kernel_launch: launch failed: %s\n", hipGetErrorName(le));
}
```

```cpp
#include <hip/hip_runtime.h>
#include <cstdio>
#include <cstdint>

#ifndef DEBUG_CHECK
#define DEBUG_CHECK 0
#endif
#define TAPB 3
#define TAPH 5
#define TAPQB 7
#ifndef REPEAT_PHASE
#define REPEAT_PHASE -1
#define REPEAT_SUB 0
#endif
#ifndef MK_N_LAUNCHES
#define MK_N_LAUNCHES 1
#endif

#define LAS __attribute__((address_space(3)))
#define GAS __attribute__((address_space(1)))
typedef unsigned short u16;
typedef unsigned long long u64;
typedef _Float16 h8 __attribute__((ext_vector_type(8)));
typedef _Float16 h2 __attribute__((ext_vector_type(2)));
typedef _Float16 h4 __attribute__((ext_vector_type(4)));
typedef short s16x4 __attribute__((ext_vector_type(4)));
typedef short s16x8 __attribute__((ext_vector_type(8)));
typedef float f32x2 __attribute__((ext_vector_type(2)));
typedef float f32x4 __attribute__((ext_vector_type(4)));
typedef float f32x16 __attribute__((ext_vector_type(16)));
typedef unsigned u32x2 __attribute__((ext_vector_type(2)));
typedef unsigned u32x4 __attribute__((ext_vector_type(4)));

constexpr int SEQ = 4096, NB = 8, T = NB * SEQ, DM = 1024;
constexpr int P0W = 3840;
constexpr int C_QA = 0, C_KA = 512, C_VA = 1024, C_QB = 1536, C_KB = 2048, C_VB = 2112, C_QI = 2176, C_KI = 2688, C_WI = 2752, C_G0 = 2816;
constexpr int L0_SRC = 3784;
constexpr int P1W = 1792;
constexpr int L1_SRC = 1696;
constexpr int LATW = 640;
constexpr int TOPK = 256;
constexpr float LOG2E = 1.4426950408889634f;
constexpr float QS_AB = 0.125f * LOG2E;
constexpr float QS_C = 0.10206207261596575f * LOG2E;
constexpr float RMS_EPS = 1e-6f;
constexpr float FXS = 1048576.0f;

constexpr size_t MiB = 1u << 20;
constexpr size_t WS_CTL = 0, CTL_ZERO_BYTES = 2 * MiB;
constexpr size_t WS_SSQ1 = 1 * MiB, WS_SSQKV = WS_SSQ1 + 256 * 1024, WS_SSQQ = WS_SSQKV + 256 * 1024;
constexpr size_t WS_ROPEC = 2 * MiB, WS_ROPES = WS_ROPEC + 256 * 1024, WS_BTG = WS_ROPES + 256 * 1024, WS_LAM = WS_BTG + 16 * 1024;
constexpr size_t WS_W0T = 4 * MiB;
constexpr size_t WS_WO0T = 12 * MiB;
constexpr size_t WS_W1T = 14 * MiB;
constexpr size_t WS_WUQT = 18 * MiB;
constexpr size_t WS_WUKVT = 20 * MiB;
constexpr size_t WS_WO1T = 22 * MiB;
constexpr size_t WS_XN0 = 32 * MiB;
constexpr size_t WS_PROJ0 = 96 * MiB;
constexpr size_t WS_MG0 = 336 * MiB;
constexpr size_t WS_LAT = 96 * MiB;
constexpr size_t WS_KROPE = 136 * MiB;
constexpr size_t WS_G1 = 140 * MiB;
constexpr size_t WS_Q1 = 204 * MiB;
constexpr size_t WS_KV1 = 300 * MiB;
constexpr size_t WS_MG1 = 428 * MiB;
constexpr size_t WS_END = 492 * MiB;
constexpr size_t WS_DBGBUF = 3 * MiB + 4096;
constexpr int CW_TMO = 0, CW_CODE = 1, CW_Q0 = 64, CW_Q1 = 128, CW_BAR = 4096;

constexpr int RING_BYTES = 131072;
constexpr int MISC_OFF = RING_BYTES + 320;
constexpr int LDS_BYTES = 147456;
constexpr int NWAVES = 8;

__device__ __forceinline__ unsigned pkh(float lo, float hi) { f32x2 v = {lo, hi}; h2 h = __builtin_convertvector(v, h2); return __builtin_bit_cast(unsigned, h); }
__device__ __forceinline__ float h2f(u16 b) { return (float)__builtin_bit_cast(_Float16, b); }
__device__ __forceinline__ float silu_f(float x) { return x * __builtin_amdgcn_rcpf(1.0f + __builtin_amdgcn_exp2f(-x * LOG2E)); }
__device__ __forceinline__ float swap_max(float m) { auto rr = __builtin_amdgcn_permlane32_swap(__float_as_uint(m), __float_as_uint(m), false, false); return fmaxf(__uint_as_float(rr[0]), __uint_as_float(rr[1])); }
__device__ __forceinline__ float swap_sum(float m) { auto rr = __builtin_amdgcn_permlane32_swap(__float_as_uint(m), __float_as_uint(m), false, false); return __uint_as_float(rr[0]) + __uint_as_float(rr[1]); }
__device__ __forceinline__ float wave_sum(float v) {
#pragma unroll
    for (int o = 1; o < 64; o <<= 1) v += __shfl_xor(v, o);
    return v;
}
#define LDS_WAIT() asm volatile("s_waitcnt lgkmcnt(0)" ::: "memory")
#define VM_WAIT() asm volatile("s_waitcnt vmcnt(0)" ::: "memory")

namespace pg8 {
constexpr int BM = 256, BK = 64, HALF = 128, HTB = HALF * BK * 2, STAGE_BYTES = 8 * HTB, NXCD = 8, WGM = 8;
__host__ __device__ __forceinline__ int lds_byte(int r, int c) { const int st = (r >> 4) * 2 + (c >> 5), rr = r & 15, cc = c & 31, ob = rr * 64 + cc * 2; return st * 1024 + (ob ^ (((ob >> 9) & 1) << 5)); }
__host__ __device__ __forceinline__ void stage_rc(int b, int& R, int& C) { const int st = b / 1024, sb = b % 1024, swz = sb ^ (((sb >> 9) & 1) << 5); R = (st >> 1) * 16 + swz / 64; C = (st & 1) * 32 + (swz % 64) / 2; }
__host__ __device__ __forceinline__ int perm32(int rho) { const int n = rho >> 4, i = rho & 15; return 8 * (i >> 2) + 4 * n + (i & 3); }
struct Unit { int pm, pn; };
struct Gemm { const u16* A; const u16* Bt; int M, N, K, lda; };
struct StaticOrder {
    int nM, nN, nwg, G, c;
    __device__ void init(int M, int N, int G_, int c_) { nM = M / BM; nN = N / BM; nwg = nM * nN; G = G_; c = c_; }
    __device__ bool next(int i, Unit& u) const {
        const long L = (long)i * G + c; if (L >= nwg) return false;
        int wgid = (int)L; { const int q = nwg / NXCD, r = nwg % NXCD, xcd = wgid % NXCD, off = wgid / NXCD; wgid = (xcd < r ? xcd * (q + 1) : r * (q + 1) + (xcd - r) * q) + off; }
        const int nig = WGM * nN, gid = wgid / nig, fm = gid * WGM, gsz = (nM - fm) < WGM ? (nM - fm) : WGM;
        u.pm = fm + ((wgid % nig) % gsz); u.pn = (wgid % nig) / gsz; return true;
    }
};
template <class Epi>
__device__ __forceinline__ void gemm_phase(LAS unsigned char* lds, const Gemm g, const StaticOrder& S, const Epi& E) {
    const int tid = threadIdx.x, wid = __builtin_amdgcn_readfirstlane(tid >> 6), lane = tid & 63, wr = wid >> 2, wc = wid & 3, fr = lane & 15, fq = lane >> 4;
    const int K = g.K, nt = K / BK, lda = g.lda;
    unsigned voffA[2], voffB[2];
#pragma unroll
    for (int i = 0; i < 2; ++i) { int R, C; stage_rc(tid * 16 + i * 8192, R, C); const int Rb = Epi::PERM ? ((R & ~31) + perm32(R & 31)) : R;
        voffA[i] = (unsigned)(R * lda + C) * 2u; voffB[i] = (unsigned)(Rb * K + C) * 2u; }
    const size_t kstep = (size_t)(BK * 2);
    const size_t hstepA = (size_t)HALF * lda * 2, tstepA = 2 * hstepA;
    const size_t hstepB = (size_t)HALF * K * 2, tstepB = 2 * hstepB;
    const unsigned ldsw = (unsigned)wid * 1024u;
    const int aoff = lds_byte(wr * 64 + fr, fq * 8), boff = lds_byte(wc * 32 + fr, fq * 8);
#define PG8_SA(b, h) (((b) * 2 + (h)) * HTB)
#define PG8_SB(b, h) ((4 + (b) * 2 + (h)) * HTB)
#define PG8_STAGE(bufoff, gbase, voff) do { _Pragma("unroll") for (int _i = 0; _i < 2; ++_i) \
        __builtin_amdgcn_global_load_lds((const unsigned*)((const char*)(gbase) + (voff)[_i]), (LAS unsigned*)(lds + (bufoff) + ldsw + _i * 8192), 16, 0, 0); } while (0)
#define PG8_LDA(dst, b, h) do { _Pragma("unroll") for (int m = 0; m < 4; ++m) _Pragma("unroll") for (int k = 0; k < 2; ++k) dst[m][k] = *(const LAS h8*)(lds + PG8_SA(b, h) + aoff + m * 2048 + k * 1024); } while (0)
#define PG8_LDB(dst, b, h) do { _Pragma("unroll") for (int n = 0; n < 2; ++n) _Pragma("unroll") for (int k = 0; k < 2; ++k) dst[n][k] = *(const LAS h8*)(lds + PG8_SB(b, h) + boff + n * 2048 + k * 1024); } while (0)
#define PG8_MMA(ai, bj, At, Bt) do { __builtin_amdgcn_s_setprio(1); _Pragma("unroll") for (int m = 0; m < 4; ++m) _Pragma("unroll") for (int n = 0; n < 2; ++n) _Pragma("unroll") for (int k = 0; k < 2; ++k) \
        acc[ai][bj][m][n] = __builtin_amdgcn_mfma_f32_16x16x32_f16(Bt[n][k], At[m][k], acc[ai][bj][m][n], 0, 0, 0); __builtin_amdgcn_s_setprio(0); } while (0)
#define PG8_WAIT_V(n) asm volatile("s_waitcnt vmcnt(" #n ")" ::: "memory")
#define PG8_WAIT_L(n) asm volatile("s_waitcnt lgkmcnt(" #n ")" ::: "memory")
#define PG8_BAR __builtin_amdgcn_s_barrier()
#define PG8_SCHED __builtin_amdgcn_sched_barrier(0)
    Unit cur, nxt; int ui = 0;
    if (!S.next(0, cur)) return;
    f32x4 acc[2][2][4][2];
#pragma unroll
    for (int a = 0; a < 2; ++a)
#pragma unroll
        for (int b = 0; b < 2; ++b)
#pragma unroll
            for (int m = 0; m < 4; ++m)
#pragma unroll
                for (int n = 0; n < 2; ++n) acc[a][b][m][n] = (f32x4){0.f, 0.f, 0.f, 0.f};
    h8 At[4][2], B0[2][2], B1[2][2];
    const char* cA = (const char*)g.A + (size_t)cur.pm * tstepA; const char* cB = (const char*)g.Bt + (size_t)cur.pn * tstepB;
    PG8_STAGE(PG8_SB(0, 0), cB, voffB); PG8_STAGE(PG8_SB(0, 1), cB + hstepB, voffB); PG8_STAGE(PG8_SA(0, 0), cA, voffA); PG8_STAGE(PG8_SA(0, 1), cA + hstepA, voffA);
    if (wr == 1) PG8_BAR;
    PG8_WAIT_V(2); PG8_BAR;
    PG8_STAGE(PG8_SB(1, 0), cB + kstep, voffB); PG8_STAGE(PG8_SA(1, 0), cA + kstep, voffA); PG8_STAGE(PG8_SB(1, 1), cB + hstepB + kstep, voffB);
    PG8_WAIT_V(6); PG8_BAR;
    for (;;) {
        const bool has_next = S.next(ui + 1, nxt);
        const char* nA = has_next ? (const char*)g.A + (size_t)nxt.pm * tstepA : cA; const char* nB = has_next ? (const char*)g.Bt + (size_t)nxt.pn * tstepB : cB;
#pragma unroll 1
        for (int t = 0; t < nt; t += 2) {
            const bool last = (t == nt - 2);
            const char* a1 = cA + (size_t)(t + 1) * kstep;
            const char* a2 = last ? nA : cA + (size_t)(t + 2) * kstep; const char* b2 = last ? nB : cB + (size_t)(t + 2) * kstep;
            const char* a3 = a2 + kstep; const char* b3 = b2 + kstep;
            PG8_LDB(B0, 0, 0); PG8_LDB(B1, 0, 1); PG8_SCHED; PG8_LDA(At, 0, 0); PG8_STAGE(PG8_SA(1, 1), a1 + hstepA, voffA);
            PG8_WAIT_V(8); PG8_WAIT_L(0); PG8_BAR; PG8_MMA(0, 0, At, B0); PG8_MMA(0, 1, At, B1); PG8_BAR; PG8_SCHED;
            PG8_LDA(At, 0, 1); PG8_STAGE(PG8_SB(0, 0), b2, voffB); PG8_STAGE(PG8_SB(0, 1), b2 + hstepB, voffB); PG8_STAGE(PG8_SA(0, 0), a2, voffA);
            PG8_WAIT_V(8); PG8_WAIT_L(0); PG8_BAR; PG8_MMA(1, 0, At, B0); PG8_MMA(1, 1, At, B1); PG8_BAR; PG8_SCHED;
            PG8_LDB(B0, 1, 0); PG8_LDB(B1, 1, 1); PG8_SCHED; PG8_LDA(At, 1, 0); PG8_STAGE(PG8_SA(0, 1), a2 + hstepA, voffA);
            PG8_WAIT_V(8); PG8_WAIT_L(0); PG8_BAR; PG8_MMA(0, 0, At, B0); PG8_MMA(0, 1, At, B1); PG8_BAR; PG8_SCHED;
            PG8_LDA(At, 1, 1); PG8_STAGE(PG8_SB(1, 0), b3, voffB); PG8_STAGE(PG8_SB(1, 1), b3 + hstepB, voffB); PG8_STAGE(PG8_SA(1, 0), a3, voffA);
            PG8_WAIT_V(8); PG8_WAIT_L(0); PG8_BAR; PG8_MMA(1, 0, At, B0); PG8_MMA(1, 1, At, B1); PG8_BAR; PG8_SCHED;
        }
        if (wr == 0) PG8_BAR;
        E(acc, cur, wr, wc, fr, fq);
        if (!has_next) break;
#pragma unroll
        for (int a = 0; a < 2; ++a)
#pragma unroll
            for (int b = 0; b < 2; ++b)
#pragma unroll
                for (int m = 0; m < 4; ++m)
#pragma unroll
                    for (int n = 0; n < 2; ++n) acc[a][b][m][n] = (f32x4){0.f, 0.f, 0.f, 0.f};
        cur = nxt; cA = nA; cB = nB; ++ui;
        if (wr == 1) PG8_BAR;
    }
    PG8_WAIT_V(0);
    PG8_BAR;
#undef PG8_SA
#undef PG8_SB
#undef PG8_STAGE
#undef PG8_LDA
#undef PG8_LDB
#undef PG8_MMA
#undef PG8_WAIT_V
#undef PG8_WAIT_L
#undef PG8_BAR
#undef PG8_SCHED
}

typedef f32x4 Acc[2][2][4][2];
__device__ __forceinline__ float rstd_from(const u64* ssq, int row, float inv_n) { return __builtin_amdgcn_rsqf((float)ssq[row] * (1.0f / FXS) * inv_n + RMS_EPS); }
__device__ __forceinline__ void ssq_add(u64* ssq, int row, float ss, int fq) {
    ss += __shfl_xor(ss, 16); ss += __shfl_xor(ss, 32);
    if (fq == 0) atomicAdd((unsigned long long*)(ssq + row), (unsigned long long)(ss * FXS + 0.5f));
}
struct EpiProj0 {
    static constexpr bool PERM = true;
    u16* O;
    __device__ __forceinline__ void operator()(const Acc& acc, const Unit& u, int wr, int wc, int fr, int fq) const {
        const int row0 = u.pm * BM + wr * 64 + fr, col0 = u.pn * BM + wc * 32 + 8 * fq; const bool gate = u.pn >= 11;
#pragma unroll
        for (int ai = 0; ai < 2; ++ai)
#pragma unroll
            for (int m = 0; m < 4; ++m) { u16* rowp = O + (size_t)(row0 + ai * HALF + m * 16) * P0W + col0;
#pragma unroll
                for (int bj = 0; bj < 2; ++bj) { f32x4 v0 = acc[ai][bj][m][0], v1 = acc[ai][bj][m][1];
                    if (gate) {
#pragma unroll
                        for (int e = 0; e < 4; ++e) { v0[e] = silu_f(v0[e]); v1[e] = silu_f(v1[e]); } }
                    u32x4 w; w.x = pkh(v0[0], v0[1]); w.y = pkh(v0[2], v0[3]); w.z = pkh(v1[0], v1[1]); w.w = pkh(v1[2], v1[3]);
                    *(u32x4*)(rowp + bj * HALF) = w; } }
    }
};
struct EpiRes0 {
    static constexpr bool PERM = false;
    const float* base; u16* outh; u64* ssq;
    __device__ __forceinline__ void operator()(const Acc& acc, const Unit& u, int wr, int wc, int fr, int fq) const {
        const int row0 = u.pm * BM + wr * 64 + fr, col0 = u.pn * BM + wc * 32 + 4 * fq;
#pragma unroll
        for (int ai = 0; ai < 2; ++ai)
#pragma unroll
            for (int m = 0; m < 4; ++m) { const int row = row0 + ai * HALF + m * 16; const size_t off = (size_t)row * DM + col0; float ss = 0.f;
#pragma unroll
                for (int bj = 0; bj < 2; ++bj)
#pragma unroll
                    for (int n = 0; n < 2; ++n) { const f32x4 bs = *(const f32x4*)(base + off + bj * HALF + n * 16); const f32x4 o = bs + acc[ai][bj][m][n];
                        u32x2 w; w.x = pkh(o[0], o[1]); w.y = pkh(o[2], o[3]); *(u32x2*)(outh + off + bj * HALF + n * 16) = w;
                        ss += (o[0] * o[0] + o[1] * o[1]) + (o[2] * o[2] + o[3] * o[3]); }
                if (ssq) ssq_add(ssq, row, ss, fq); }
    }
};
struct EpiRes1 {
    static constexpr bool PERM = false;
    const u16* baseh; float* out;
    __device__ __forceinline__ void operator()(const Acc& acc, const Unit& u, int wr, int wc, int fr, int fq) const {
        const int row0 = u.pm * BM + wr * 64 + fr, col0 = u.pn * BM + wc * 32 + 4 * fq;
#pragma unroll
        for (int ai = 0; ai < 2; ++ai)
#pragma unroll
            for (int m = 0; m < 4; ++m) { const int row = row0 + ai * HALF + m * 16; const size_t off = (size_t)row * DM + col0;
#pragma unroll
                for (int bj = 0; bj < 2; ++bj)
#pragma unroll
                    for (int n = 0; n < 2; ++n) { const h4 bh = *(const h4*)(baseh + off + bj * HALF + n * 16);
                        f32x4 o = acc[ai][bj][m][n]; o[0] += (float)bh[0]; o[1] += (float)bh[1]; o[2] += (float)bh[2]; o[3] += (float)bh[3];
                        *(f32x4*)(out + off + bj * HALF + n * 16) = o; } }
    }
};
struct EpiProj1 {
    static constexpr bool PERM = false;
    const u64* ssq1; u16* lat; u16* krope; u16* g1; u64* ssqkv; u64* ssqq; const float* ropec; const float* ropes;
    __device__ __forceinline__ void operator()(const Acc& acc, const Unit& u, int wr, int wc, int fr, int fq) const {
        const int row0 = u.pm * BM + wr * 64 + fr, pn = u.pn;
#pragma unroll
        for (int ai = 0; ai < 2; ++ai)
#pragma unroll
            for (int m = 0; m < 4; ++m) { const int row = row0 + ai * HALF + m * 16; const float rs = rstd_from(ssq1, row, 1.0f / 1024.0f); float ss = 0.f;
#pragma unroll
                for (int bj = 0; bj < 2; ++bj) { f32x4 v0 = acc[ai][bj][m][0] * rs, v1 = acc[ai][bj][m][1] * rs;
                    const int tc = bj * HALF + wc * 32 + 4 * fq;
                    if (pn >= 3) {
#pragma unroll
                        for (int e = 0; e < 4; ++e) { v0[e] = silu_f(v0[e]); v1[e] = silu_f(v1[e]); }
                        u16* p = g1 + (size_t)row * DM + (pn - 3) * BM + tc;
                        u32x2 w0, w1; w0.x = pkh(v0[0], v0[1]); w0.y = pkh(v0[2], v0[3]); w1.x = pkh(v1[0], v1[1]); w1.y = pkh(v1[2], v1[3]);
                        *(u32x2*)p = w0; *(u32x2*)(p + 16) = w1;
                    } else if (pn < 2 || bj == 0) {
                        u16* p = lat + (size_t)row * LATW + pn * BM + tc;
                        u32x2 w0, w1; w0.x = pkh(v0[0], v0[1]); w0.y = pkh(v0[2], v0[3]); w1.x = pkh(v1[0], v1[1]); w1.y = pkh(v1[2], v1[3]);
                        *(u32x2*)p = w0; *(u32x2*)(p + 16) = w1;
                        ss += (v0[0] * v0[0] + v0[1] * v0[1]) + (v0[2] * v0[2] + v0[3] * v0[3]) + (v1[0] * v1[0] + v1[1] * v1[1]) + (v1[2] * v1[2] + v1[3] * v1[3]);
                    } else if (wc == 0) {
                        const int pos = row & (SEQ - 1); const f32x4 cs = *(const f32x4*)(ropec + pos * 16 + 4 * fq), sn = *(const f32x4*)(ropes + pos * 16 + 4 * fq);
                        const f32x4 o0 = v0 * cs - v1 * sn, o1 = v0 * sn + v1 * cs;
                        u16* p = krope + (size_t)row * 32 + 4 * fq;
                        u32x2 w0, w1; w0.x = pkh(o0[0], o0[1]); w0.y = pkh(o0[2], o0[3]); w1.x = pkh(o1[0], o1[1]); w1.y = pkh(o1[2], o1[3]);
                        *(u32x2*)p = w0; *(u32x2*)(p + 16) = w1;
                    } }
                if (pn == 0) { if (ssqkv) ssq_add(ssqkv, row, ss, fq); } else if (pn <= 2) { if (ssqq) ssq_add(ssqq, row, ss, fq); }
                asm volatile("" ::: "memory"); }
    }
};
struct EpiQ1 {
    static constexpr bool PERM = false;
    const u64* ssqq; u16* q1; const float* ropec; const float* ropes;
    __device__ __forceinline__ void operator()(const Acc& acc, const Unit& u, int wr, int wc, int fr, int fq) const {
        const int row0 = u.pm * BM + wr * 64 + fr;
#pragma unroll
        for (int ai = 0; ai < 2; ++ai)
#pragma unroll
            for (int m = 0; m < 4; ++m) { const int row = row0 + ai * HALF + m * 16; const float rs = rstd_from(ssqq, row, 1.0f / 384.0f);
#pragma unroll
                for (int bj = 0; bj < 2; ++bj) { f32x4 v0 = acc[ai][bj][m][0] * rs, v1 = acc[ai][bj][m][1] * rs;
                    const int g0 = u.pn * BM + bj * HALF + wc * 32;
                    if ((g0 % 96) == 64) { const int pos = row & (SEQ - 1); const f32x4 cs = *(const f32x4*)(ropec + pos * 16 + 4 * fq), sn = *(const f32x4*)(ropes + pos * 16 + 4 * fq);
                        const f32x4 o0 = v0 * cs - v1 * sn, o1 = v0 * sn + v1 * cs; v0 = o0; v1 = o1; }
                    u16* p = q1 + (size_t)row * 1536 + g0 + 4 * fq;
                    u32x2 w0, w1; w0.x = pkh(v0[0], v0[1]); w0.y = pkh(v0[2], v0[3]); w1.x = pkh(v1[0], v1[1]); w1.y = pkh(v1[2], v1[3]);
                    *(u32x2*)p = w0; *(u32x2*)(p + 16) = w1; }
                asm volatile("" ::: "memory"); }
    }
};
struct EpiKV1 {
    static constexpr bool PERM = true;
    const u64* ssqkv; u16* kv1;
    __device__ __forceinline__ void operator()(const Acc& acc, const Unit& u, int wr, int wc, int fr, int fq) const {
        const int row0 = u.pm * BM + wr * 64 + fr, col0 = u.pn * BM + wc * 32 + 8 * fq;
#pragma unroll
        for (int ai = 0; ai < 2; ++ai)
#pragma unroll
            for (int m = 0; m < 4; ++m) { const int row = row0 + ai * HALF + m * 16; const float rs = rstd_from(ssqkv, row, 1.0f / 256.0f); u16* rowp = kv1 + (size_t)row * 2048 + col0;
#pragma unroll
                for (int bj = 0; bj < 2; ++bj) { const f32x4 v0 = acc[ai][bj][m][0] * rs, v1 = acc[ai][bj][m][1] * rs;
                    u32x4 w; w.x = pkh(v0[0], v0[1]); w.y = pkh(v0[2], v0[3]); w.z = pkh(v1[0], v1[1]); w.w = pkh(v1[2], v1[3]);
                    *(u32x4*)(rowp + bj * HALF) = w; }
                if (m & 1) asm volatile("" ::: "memory"); }
    }
};
}

#define XB_TMO      128
#define XB_XCNT(j)  (256  + 64 * (j))
#define XB_XSUB(j)  (1280 + 64 * (j))
#define XB_XGEN(j)  (2304 + 64 * (j))
#define XB_TOP      3328
#define XB_TOPGEN   3392
#define XCD_BAR_WORDS 3456
#define XB_SPIN_CAP (1u << 20)
__device__ __forceinline__ unsigned xb_ld(unsigned* p)              { return __hip_atomic_load(p, __ATOMIC_RELAXED, __HIP_MEMORY_SCOPE_AGENT); }
__device__ __forceinline__ unsigned xb_add(unsigned* p, unsigned v) { return __hip_atomic_fetch_add(p, v, __ATOMIC_RELAXED, __HIP_MEMORY_SCOPE_AGENT); }
__device__ __forceinline__ unsigned xb_xcc_id() { return (unsigned)__builtin_amdgcn_s_getreg((3 << 11) | 20) & 0xFu; }
#define XB_SPIN(cond, bar) do { unsigned _sp = 0; while (cond) { __builtin_amdgcn_s_sleep(1); \
    if ((++_sp & 255u) == 0u) { if (xb_ld(&(bar)[XB_TMO])) break; if (_sp > XB_SPIN_CAP) { atomicAdd(&(bar)[XB_TMO], 1u); break; } } } } while (0)
struct XcdBarrier { unsigned* bar; unsigned x; volatile LAS unsigned* st; };
__device__ __forceinline__ XcdBarrier xcd_barrier_post(unsigned* bar, volatile LAS unsigned* st) {
    XcdBarrier b; b.bar = bar; b.x = xb_xcc_id(); b.st = st;
    if (threadIdx.x == 0) (void)xb_add(&bar[XB_XCNT(b.x)], 1u);
    return b;
}
__device__ __forceinline__ void xcd_barrier_complete(unsigned* bar, unsigned x, unsigned& nloc, unsigned& nx) {
    const unsigned G = gridDim.x * gridDim.y * gridDim.z;
    unsigned sum, cnt, mine, sp = 0u;
    for (;;) {
        sum = 0u; cnt = 0u; mine = 0u;
#pragma unroll
        for (unsigned j = 0; j < 16; ++j) { const unsigned c = xb_ld(&bar[XB_XCNT(j)]); sum += c; cnt += (c > 0u) ? 1u : 0u; mine = (j == x) ? c : mine; }
        if (sum == G) break;
        __builtin_amdgcn_s_sleep(1);
        if ((++sp & 255u) == 0u) { if (xb_ld(&bar[XB_TMO])) break; if (sp > XB_SPIN_CAP) { atomicAdd(&bar[XB_TMO], 1u); break; } }
    }
    nloc = mine > 0u ? mine : 1u; nx = cnt > 0u ? cnt : 1u;
}
__device__ __forceinline__ void xcd_barrier(const XcdBarrier& b) {
    asm volatile("s_waitcnt vmcnt(0)" ::: "memory");
    __syncthreads();
    if (threadIdx.x == 0) {
        unsigned* bar = b.bar;
        __builtin_amdgcn_s_waitcnt(0);
        unsigned nloc = b.st[0], nx = b.st[1];
        if (nloc == 0u) { xcd_barrier_complete(bar, b.x, nloc, nx); b.st[0] = nloc; b.st[1] = nx; }
        const unsigned old = xb_add(&bar[XB_XSUB(b.x)], 1u);
        const unsigned gen = old / nloc;
        if (old + 1u == (gen + 1u) * nloc) {
            __builtin_amdgcn_fence(__ATOMIC_RELEASE, "agent");
            asm volatile("s_waitcnt vmcnt(0)" ::: "memory");
            const unsigned og = xb_add(&bar[XB_TOP], 1u);
            const unsigned tg = og / nx;
            if (og + 1u == (tg + 1u) * nx) xb_add(&bar[XB_TOPGEN], 1u);
            else XB_SPIN(xb_ld(&bar[XB_TOPGEN]) == tg, bar);
            __builtin_amdgcn_fence(__ATOMIC_ACQUIRE, "agent");
            xb_add(&bar[XB_XGEN(b.x)], 1u);
            asm volatile("s_waitcnt vmcnt(0)" ::: "memory");
        } else {
            XB_SPIN(xb_ld(&bar[XB_XGEN(b.x)]) == gen, bar);
            __builtin_amdgcn_fence(__ATOMIC_ACQUIRE, "agent");
            asm volatile("s_waitcnt vmcnt(0)" ::: "memory");
        }
    }
    __syncthreads();
}

struct Args { const float* in[18]; float* out; unsigned char* ws; int ph_lo, ph_hi; };
struct Frame {
    LAS unsigned char* lds;
    volatile LAS unsigned* MISC;
    unsigned* ctl;
    int tid, lane, wave, G;
    float* out;
    unsigned char* ws;
};
enum { I_X = 0, I_RELB, I_ENORM, I_EWIN, I_LQ1, I_LK1, I_LQ2, I_LK2, I_SUBLN, I_EWO, I_ONORM, I_OWIN, I_OQNORM, I_OWUQ, I_OKVNORM, I_OWUKV, I_OWO, I_FNORM };

__device__ __forceinline__ int t5_bucket(int rel) {
    const int n = rel < 0 ? -rel : rel;
    const int v = n < 8 ? n : n < 12 ? 8 : n < 16 ? 9 : n < 23 ? 10 : n < 32 ? 11 : n < 46 ? 12 : n < 64 ? 13 : n < 91 ? 14 : 15;
    return (rel > 0 ? 16 : 0) + v;
}

__device__ __forceinline__ int wsrc_col(int mat, int n) {
    switch (mat) {
        case 0: return n < 2760 ? n : (n < C_G0 ? -1 : n - 56);
        case 2: return n < 256 ? 384 + n : (n < 640 ? n - 256 : (n < 672 ? n : (n < 768 ? -1 : n - 96)));
        default: return n;
    }
}
__device__ __forceinline__ float wcol_scale(int mat, int n) {
    if (mat == 0) return (n < 512 || (n >= C_QB && n < C_QB + 512)) ? QS_AB : 1.0f;
    if (mat == 3) return QS_C;
    return 1.0f;
}
__device__ __forceinline__ void p0_transpose_item(const float* W, int K, int Nsrc, int Npad, const float* gain, int mat, u16* WT, LAS float* scr, int item, int lane) {
    const int nblk = Npad / 32, kb = item / nblk, nb = item % nblk, k0 = 64 * kb, n0 = 32 * nb;
    const int n = n0 + (lane & 31); const int sc = wsrc_col(mat, n); const float cs = wcol_scale(mat, n);
#pragma unroll 8
    for (int i = 0; i < 32; ++i) { const int kk = 2 * i + (lane >> 5); float v = 0.f;
        if (sc >= 0) { v = W[(size_t)(k0 + kk) * Nsrc + sc] * cs; if (gain) v *= gain[k0 + kk]; }
        scr[kk * 33 + (lane & 31)] = v; }
    LDS_WAIT(); asm volatile("" ::: "memory");
    const int c = lane & 7;
#pragma unroll
    for (int j = 0; j < 4; ++j) { const int nn = (lane >> 3) + 8 * j; const LAS float* s = scr + (8 * c) * 33 + nn;
        u32x4 o; o.x = pkh(s[0 * 33], s[1 * 33]); o.y = pkh(s[2 * 33], s[3 * 33]); o.z = pkh(s[4 * 33], s[5 * 33]); o.w = pkh(s[6 * 33], s[7 * 33]);
        *(u32x4*)(WT + (size_t)(n0 + nn) * K + k0 + 8 * c) = o; }
    LDS_WAIT(); asm volatile("" ::: "memory");
}
__device__ __forceinline__ void p0_prologue(Frame& F, const Args& AR) {
    LAS float* scr = (LAS float*)(F.lds + F.wave * 16384);
    const int gw = blockIdx.x * NWAVES + F.wave, NGW = F.G * NWAVES;
    unsigned char* ws = F.ws;
    constexpr int I0 = (1024 / 64) * (P0W / 32), I1 = (1024 / 64) * (1024 / 32), I2 = (1024 / 64) * (P1W / 32), I3 = (384 / 64) * (1536 / 32), I4 = (256 / 64) * (2048 / 32), I5 = I1;
    constexpr int NITEMS = I0 + I1 + I2 + I3 + I4 + I5;
    for (int it = gw; it < NITEMS; it += NGW) {
        int r = it;
        if (r < I0) { p0_transpose_item(AR.in[I_EWIN], 1024, L0_SRC, P0W, nullptr, 0, (u16*)(ws + WS_W0T), scr, r, F.lane); continue; } r -= I0;
        if (r < I1) { p0_transpose_item(AR.in[I_EWO], 1024, 1024, 1024, nullptr, 1, (u16*)(ws + WS_WO0T), scr, r, F.lane); continue; } r -= I1;
        if (r < I2) { p0_transpose_item(AR.in[I_OWIN], 1024, L1_SRC, P1W, AR.in[I_ONORM], 2, (u16*)(ws + WS_W1T), scr, r, F.lane); continue; } r -= I2;
        if (r < I3) { p0_transpose_item(AR.in[I_OWUQ], 384, 1536, 1536, AR.in[I_OQNORM], 3, (u16*)(ws + WS_WUQT), scr, r, F.lane); continue; } r -= I3;
        if (r < I4) { p0_transpose_item(AR.in[I_OWUKV], 256, 2048, 2048, AR.in[I_OKVNORM], 4, (u16*)(ws + WS_WUKVT), scr, r, F.lane); continue; } r -= I4;
        p0_transpose_item(AR.in[I_OWO], 1024, 1024, 1024, nullptr, 5, (u16*)(ws + WS_WO1T), scr, r, F.lane);
    }
    {
        const float* gn = AR.in[I_ENORM]; f32x4 gv[4];
#pragma unroll
        for (int j = 0; j < 4; ++j) gv[j] = *(const f32x4*)(gn + 4 * F.lane + 256 * j);
        u16* XN = (u16*)(ws + WS_XN0);
        for (int mrow = gw; mrow < T; mrow += NGW) {
            const f32x4* xr = (const f32x4*)(AR.in[I_X] + (size_t)mrow * DM) + F.lane;
            f32x4 v[4]; float s = 0.f;
#pragma unroll
            for (int j = 0; j < 4; ++j) { v[j] = xr[64 * j]; s += (v[j].x * v[j].x + v[j].y * v[j].y) + (v[j].z * v[j].z + v[j].w * v[j].w); }
            const float rstd = __builtin_amdgcn_rsqf(wave_sum(s) * (1.f / DM) + RMS_EPS);
            u32x2* o8 = (u32x2*)(XN + (size_t)mrow * DM) + F.lane;
#pragma unroll
            for (int j = 0; j < 4; ++j) { const f32x4 t = v[j] * rstd * gv[j]; u32x2 w; w.x = pkh(t.x, t.y); w.y = pkh(t.z, t.w); o8[64 * j] = w; }
        }
    }
    {
        float* rc = (float*)(ws + WS_ROPEC); float* rs = (float*)(ws + WS_ROPES);
        const int gt = blockIdx.x * 512 + F.tid, NGT = F.G * 512;
        for (int e = gt; e < SEQ * 16; e += NGT) { const int pos = e >> 4, i = e & 15;
            const float inv = (float)pow(10000.0, -(double)i / 16.0); const float ang = (float)pos * inv;
            rc[e] = (float)cos((double)ang); rs[e] = (float)sin((double)ang); }
        float* bt = (float*)(ws + WS_BTG);
        for (int e = gt; e < 12 * 192; e += NGT) { const int hd = e / 192, idx = e % 192; const int rel = idx - 128;
            bt[e] = AR.in[I_RELB][t5_bucket(rel) * 12 + hd] * LOG2E; }
        if (blockIdx.x == 0 && F.wave == 0) {
            const float a = wave_sum(AR.in[I_LQ1][F.lane] * AR.in[I_LK1][F.lane]), b = wave_sum(AR.in[I_LQ2][F.lane] * AR.in[I_LK2][F.lane]);
            if (F.lane == 0) *(float*)(ws + WS_LAM) = expf(a) - expf(b) + 0.2f;
        }
    }
}

__device__ __forceinline__ h8 tr2(LAS const unsigned char* p0, LAS const unsigned char* p1) {
    const s16x4 lo = __builtin_amdgcn_ds_read_tr16_b64_v4i16((LAS s16x4*)p0), hi = __builtin_amdgcn_ds_read_tr16_b64_v4i16((LAS s16x4*)p1);
    const s16x8 v = __builtin_shufflevector(lo, hi, 0, 1, 2, 3, 4, 5, 6, 7); return __builtin_bit_cast(h8, v);
}
constexpr float SM_THR = 8.0f;
template <int ND, bool MASKED>
__device__ __forceinline__ void softmax_step(f32x16& p0, f32x16& p1, float& mref, float& lrun, bool& have, f32x16 (&o)[ND], h8 (&pf)[4]) {
    float mx = fmaxf(fmaxf(p0[0], p1[0]), fmaxf(p0[1], p1[1]));
#pragma unroll
    for (int r = 2; r < 16; r += 2) mx = fmaxf(mx, fmaxf(fmaxf(p0[r], p1[r]), fmaxf(p0[r + 1], p1[r + 1])));
    mx = swap_max(mx);
    const bool valid = MASKED ? (mx > -1e29f) : true;
    const bool trig = valid && (!have || mx > SM_THR);
    if (__any(trig)) {
        const float dl = valid ? (have ? fmaxf(mx, 0.f) : mx) : 0.f;
        have = have || valid;
        mref += dl;
        const float alpha = __builtin_amdgcn_exp2f(-dl);
        lrun *= alpha;
#pragma unroll
        for (int r = 0; r < 16; ++r) { p0[r] -= dl; p1[r] -= dl; }
#pragma unroll
        for (int d = 0; d < ND; ++d)
#pragma unroll
            for (int r = 0; r < 16; ++r) o[d][r] *= alpha;
    }
    float s0 = 0.f, s1 = 0.f;
#pragma unroll
    for (int r = 0; r < 16; ++r) { p0[r] = __builtin_amdgcn_exp2f(p0[r]); p1[r] = __builtin_amdgcn_exp2f(p1[r]); s0 += p0[r]; s1 += p1[r]; }
    lrun += s0 + s1;
#pragma unroll
    for (int ks = 0; ks < 4; ++ks) {
        u32x4 w;
        if (ks < 2) { w.x = pkh(p0[8 * ks + 0], p0[8 * ks + 1]); w.y = pkh(p0[8 * ks + 2], p0[8 * ks + 3]); w.z = pkh(p0[8 * ks + 4], p0[8 * ks + 5]); w.w = pkh(p0[8 * ks + 6], p0[8 * ks + 7]); }
        else { const int k2 = ks - 2; w.x = pkh(p1[8 * k2 + 0], p1[8 * k2 + 1]); w.y = pkh(p1[8 * k2 + 2], p1[8 * k2 + 3]); w.z = pkh(p1[8 * k2 + 4], p1[8 * k2 + 5]); w.w = pkh(p1[8 * k2 + 6], p1[8 * k2 + 7]); }
        pf[ks] = __builtin_bit_cast(h8, w);
    }
}
__device__ __forceinline__ void add_bias(f32x16& p0, f32x16& p1, const LAS float* bt, int idx0) {
#pragma unroll
    for (int r = 0; r < 16; ++r) { const int c = (r & 3) + 8 * (r >> 2);
        const int i0 = idx0 + c, i1 = idx0 + 32 + c;
        p0[r] += bt[i0 < 0 ? 0 : i0]; p1[r] += bt[i1 < 0 ? 0 : i1]; }
}
__device__ __forceinline__ int next_unit(Frame& F, int cw) {
    volatile LAS unsigned* slot = F.MISC + 16;
    __syncthreads();
    if (F.tid == 0) slot[0] = __hip_atomic_fetch_add(F.ctl + cw, 1u, __ATOMIC_RELAXED, __HIP_MEMORY_SCOPE_AGENT);
    __syncthreads();
    return (int)slot[0];
}

__device__ __forceinline__ void attnA_unit(Frame& F, const Args& AR, int b, int h, int qb) {
    LAS unsigned char* lds = F.lds;
    int tid = F.tid; asm volatile("" : "+v"(tid)); int wid = F.wave; asm volatile("" : "+s"(wid));
    const int lane = tid & 63, r32 = lane & 31, hi = lane >> 5;
    const int m = wid & 1, qsub = wid >> 1, q0 = 128 * qb + 32 * qsub, cw = q0 >> 6, nt = 2 * qb + 2;
    const size_t rowb = (size_t)b * SEQ;
    const u16* P0 = (const u16*)(F.ws + WS_PROJ0);
    LAS float* bt = (LAS float*)(lds + 65536);
    if (tid < 192) bt[tid] = ((const float*)(F.ws + WS_BTG))[h * 192 + tid];
    h8 qf[4];
    { const u16* qp = P0 + (rowb + q0 + r32) * P0W + C_QA + h * 128 + m * 64 + hi * 8;
#pragma unroll
      for (int d0 = 0; d0 < 4; ++d0) qf[d0] = *(const h8*)(qp + d0 * 16); }
    f32x16 o[4];
#pragma unroll
    for (int d = 0; d < 4; ++d)
#pragma unroll
        for (int r = 0; r < 16; ++r) o[d][r] = 0.f;
    float mrun = 0.f, lrun = 0.f; bool have = false;
    const int krow = tid >> 3, kch = tid & 7, vrow = tid >> 4, vch = tid & 15;
    const u16* ksrc = P0 + (rowb + krow) * P0W + C_KA + h * 128 + kch * 8;
    const u16* vsrc = P0 + (rowb + vrow) * P0W + C_VA + h * 128 + vch * 8;
    const int kdst = krow * 128 + ((kch ^ ((krow >> 1) & 7)) << 4);
    const int vdst = 16384 + vrow * 256 + ((vch ^ ((vrow & 3) << 2)) << 4);
    u32x4 st0, st1, st2, st3;
#define A_LOAD(t) do { const size_t to = (size_t)(t) * 64 * P0W; st0 = *(const u32x4*)(ksrc + to); st1 = *(const u32x4*)(ksrc + to + 64); st2 = *(const u32x4*)(vsrc + to); st3 = *(const u32x4*)(vsrc + to + (size_t)32 * P0W); } while (0)
#define A_WRITE(s) do { LAS unsigned char* sb = lds + (s) * 32768; *(LAS u32x4*)(sb + kdst) = st0; *(LAS u32x4*)(sb + 8192 + kdst) = st1; *(LAS u32x4*)(sb + vdst) = st2; *(LAS u32x4*)(sb + vdst + 32 * 256) = st3; } while (0)
    const int kfo = r32 * 128, ksw = (r32 >> 1) & 7;
    const int i16 = lane & 15, qrow = i16 >> 2, pp = i16 & 3, g16 = (lane >> 4) & 1;
    const int vlane = (4 * hi + qrow) * 256 + ((2 * g16 + (pp >> 1)) << 4) + 8 * (pp & 1);
    const int qglob = q0 + r32;
    A_LOAD(0); A_WRITE(0); __syncthreads();
    for (int t = 0; t < nt; ++t) {
        if (t + 1 < nt) A_LOAD(t + 1);
        if (t <= cw) {
            LAS const unsigned char* sb = lds + (t & 1) * 32768; LAS const unsigned char* kb = sb + m * 8192 + kfo; LAS const unsigned char* vb = sb + 16384 + vlane;
            const bool nearb = (64 * t + 63 - q0) > -128;
            const float c0 = (nearb ? 0.f : bt[0]) - mrun;
            f32x16 p0, p1;
#pragma unroll
            for (int r = 0; r < 16; ++r) { p0[r] = c0; p1[r] = c0; }
#pragma unroll
            for (int d0 = 0; d0 < 4; ++d0) { const int co = ((2 * d0 + hi) ^ ksw) << 4;
                const h8 ka = *(LAS const h8*)(kb + co), kc = *(LAS const h8*)(kb + 4096 + co);
                p0 = __builtin_amdgcn_mfma_f32_32x32x16_f16(ka, qf[d0], p0, 0, 0, 0); p1 = __builtin_amdgcn_mfma_f32_32x32x16_f16(kc, qf[d0], p1, 0, 0, 0); }
            if (nearb) add_bias(p0, p1, bt, 64 * t + 4 * hi - qglob + 128);
            h8 pf[4];
            softmax_step<4, false>(p0, p1, mrun, lrun, have, o, pf);
#pragma unroll
            for (int d0 = 0; d0 < 4; ++d0) { const int dx = (d0 ^ qrow) << 6;
#pragma unroll
                for (int ks = 0; ks < 4; ++ks) { const h8 vf = tr2(vb + ks * 4096 + dx, vb + ks * 4096 + 2048 + dx);
                    o[d0] = __builtin_amdgcn_mfma_f32_32x32x16_f16(vf, pf[ks], o[d0], 0, 0, 0); } }
        }
        if (t + 1 < nt) A_WRITE((t + 1) & 1);
        __syncthreads();
    }
#undef A_LOAD
#undef A_WRITE
    const float linv = 1.0f / swap_sum(lrun);
    LAS f32x4* xb = (LAS f32x4*)(lds + qsub * 16384);
    if (m == 1) {
#pragma unroll
        for (int d0 = 0; d0 < 4; ++d0)
#pragma unroll
            for (int g = 0; g < 4; ++g) { f32x4 v = {o[d0][4 * g] * linv, o[d0][4 * g + 1] * linv, o[d0][4 * g + 2] * linv, o[d0][4 * g + 3] * linv};
                xb[(8 * d0 + 2 * g + hi) * 32 + r32] = v; }
    }
    __syncthreads();
    if (m == 0) {
        const float lam = *(const float*)(F.ws + WS_LAM);
        float ss = 0.f;
#pragma unroll
        for (int d0 = 0; d0 < 4; ++d0)
#pragma unroll
            for (int g = 0; g < 4; ++g) { const f32x4 v1 = xb[(8 * d0 + 2 * g + hi) * 32 + r32];
#pragma unroll
                for (int e = 0; e < 4; ++e) { const float v = o[d0][4 * g + e] * linv - lam * v1[e]; o[d0][4 * g + e] = v; ss += v * v; } }
        ss = swap_sum(ss);
        const float rs = __builtin_amdgcn_rsqf(ss * (1.0f / 128.0f) + RMS_EPS) * 0.8f;
        const size_t row = rowb + qglob;
        const u16* gp = P0 + row * P0W + C_G0 + h * 128;
        u16* op = (u16*)(F.ws + WS_MG0) + row * DM + h * 128;
        const float* sg = AR.in[I_SUBLN];
#pragma unroll
        for (int d0 = 0; d0 < 4; ++d0)
#pragma unroll
            for (int g = 0; g < 4; ++g) { const int d = 32 * d0 + 8 * g + 4 * hi;
                const h4 gv = *(const h4*)(gp + d); const f32x4 sv = *(const f32x4*)(sg + d);
                u32x2 w; w.x = pkh(o[d0][4 * g] * rs * sv[0] * (float)gv[0], o[d0][4 * g + 1] * rs * sv[1] * (float)gv[1]);
                w.y = pkh(o[d0][4 * g + 2] * rs * sv[2] * (float)gv[2], o[d0][4 * g + 3] * rs * sv[3] * (float)gv[3]);
                *(u32x2*)(op + d) = w; }
    }
}

constexpr int B_MASK = 32768, B_QF = 49152, B_BT = 65536, B_RED = 71680;
__device__ __forceinline__ float next_up(float x) { if (x == 0.f) return __uint_as_float(1u); const unsigned u = __float_as_uint(x); return __uint_as_float(x > 0.f ? u + 1u : u - 1u); }
__device__ __forceinline__ void selB_16(Frame& F, int b, int c, int q0, int mrow0) {
    LAS unsigned char* lds = F.lds;
    int tid = F.tid; asm volatile("" : "+v"(tid)); int wid = F.wave; asm volatile("" : "+s"(wid));
    const int lane = tid & 63, ql = lane & 15, g = lane >> 4;
    const size_t rowb = (size_t)b * SEQ;
    const u16* P0 = (const u16*)(F.ws + WS_PROJ0);
    LAS u16* m16 = (LAS u16*)(lds + B_MASK);
    const int NT16 = 4 * (c + 1), N = 64 * (c + 1);
    if (c < 4) {
        for (int e = tid; e < 16 * (c + 1); e += 512) { const int q = e / (c + 1), t = e % (c + 1); *(LAS u64*)(lds + B_MASK + ((mrow0 + q) * 64 + t) * 8) = ~0ull; }
        return;
    }
    LAS h8* qfl = (LAS h8*)(lds + B_QF);
#pragma unroll
    for (int i = 0; i < 2; ++i) { const int idx = tid + 512 * i, fg = idx >> 6, ln = idx & 63, hh = fg >> 1, ks = fg & 1;
        qfl[idx] = *(const h8*)(P0 + (rowb + q0 + (ln & 15)) * P0W + C_QI + hh * 64 + 32 * ks + 8 * (ln >> 4)); }
    float wq[8];
    { const h8 wv = *(const h8*)(P0 + (rowb + q0 + ql) * P0W + C_WI);
#pragma unroll
      for (int i = 0; i < 8; ++i) wq[i] = (float)wv[i]; }
    __syncthreads();
    float sc[32][4];
    const u16* kp = P0 + (rowb + ql) * P0W + C_KI + 8 * g;
    h8 a0n = *(const h8*)(kp + (size_t)(16 * wid) * P0W), a1n = *(const h8*)(kp + (size_t)(16 * wid) * P0W + 32);
#pragma unroll
    for (int jj = 0; jj < 32; ++jj) {
        const int j = wid + 8 * jj;
        if (j < NT16) {
            const h8 a0 = a0n, a1 = a1n;
            if (j + 8 < NT16) { a0n = *(const h8*)(kp + (size_t)(16 * (j + 8)) * P0W); a1n = *(const h8*)(kp + (size_t)(16 * (j + 8)) * P0W + 32); }
            f32x4 s4 = {0.f, 0.f, 0.f, 0.f};
#pragma unroll
            for (int hh = 0; hh < 8; ++hh) {
                f32x4 acc = {0.f, 0.f, 0.f, 0.f};
                acc = __builtin_amdgcn_mfma_f32_16x16x32_f16(a0, qfl[(hh * 2 + 0) * 64 + lane], acc, 0, 0, 0);
                acc = __builtin_amdgcn_mfma_f32_16x16x32_f16(a1, qfl[(hh * 2 + 1) * 64 + lane], acc, 0, 0, 0);
#pragma unroll
                for (int r = 0; r < 4; ++r) s4[r] += wq[hh] * fmaxf(acc[r], 0.f);
            }
#pragma unroll
            for (int r = 0; r < 4; ++r) sc[jj][r] = s4[r];
        } else {
#pragma unroll
            for (int r = 0; r < 4; ++r) sc[jj][r] = -INFINITY;
        }
    }
    LAS unsigned* red = (LAS unsigned*)(lds + B_RED);
    LAS float* redf = (LAS float*)(lds + B_RED + 1024);
    float mn = INFINITY, mxv = -INFINITY;
#pragma unroll
    for (int jj = 0; jj < 32; ++jj)
#pragma unroll
        for (int r = 0; r < 4; ++r) { const float s = sc[jj][r]; mn = fminf(mn, s > -INFINITY ? s : INFINITY); mxv = fmaxf(mxv, s); }
    mn = fminf(mn, __shfl_xor(mn, 16)); mn = fminf(mn, __shfl_xor(mn, 32)); mxv = fmaxf(mxv, __shfl_xor(mxv, 16)); mxv = fmaxf(mxv, __shfl_xor(mxv, 32));
    redf[wid * 16 + ql] = mn; redf[128 + wid * 16 + ql] = mxv;
    __syncthreads();
    float lo = INFINITY, hi = -INFINITY;
#pragma unroll
    for (int w = 0; w < 8; ++w) { lo = fminf(lo, redf[w * 16 + ql]); hi = fmaxf(hi, redf[128 + w * 16 + ql]); }
    hi = next_up(hi);
#define SEL_LTBITS(W, P) do { _Pragma("unroll") for (int w_ = 0; w_ < 4; ++w_) { unsigned a_ = 0u; _Pragma("unroll") for (int k_ = 0; k_ < 32; ++k_) \
        a_ = __builtin_amdgcn_alignbit(a_, __float_as_uint(sc[8 * w_ + (k_ >> 2)][k_ & 3] - (P)), 31); W[w_] = a_; } } while (0)
    bool done = false, tie = false; float Tv = 0.f; unsigned chi = 0u;
    for (int it = 0; it < 96; ++it) {
        const float mid = lo + (hi - lo) * 0.5f;
        if (!done && !(mid > lo && mid < hi)) { done = true; tie = true; Tv = lo; }
        const float pv = done ? Tv : mid;
        unsigned ltw[4]; SEL_LTBITS(ltw, pv);
        unsigned cnt = 128u - (unsigned)(__builtin_popcount(ltw[0]) + __builtin_popcount(ltw[1]) + __builtin_popcount(ltw[2]) + __builtin_popcount(ltw[3]));
        cnt += __shfl_xor(cnt, 16); cnt += __shfl_xor(cnt, 32);
        LAS unsigned* rb = red + (it & 1) * 128;
        rb[wid * 16 + ql] = cnt;
        __syncthreads();
        unsigned tot = 0u;
#pragma unroll
        for (int w = 0; w < 8; ++w) tot += rb[w * 16 + ql];
        if (!done) { if (tot == (unsigned)TOPK) { done = true; Tv = mid; } else if (tot > (unsigned)TOPK) lo = mid; else { hi = mid; chi = tot; } }
        if (__all(done)) break;
    }
    unsigned selw[4];
    { unsigned ltw[4]; SEL_LTBITS(ltw, Tv);
#pragma unroll
      for (int w = 0; w < 4; ++w) selw[w] = __builtin_bitreverse32(~ltw[w]); }
    if (__any(tie)) {
        unsigned eqw[4];
        { unsigned lew[4]; const float tn = next_up(Tv); SEL_LTBITS(lew, tn);
#pragma unroll
          for (int w = 0; w < 4; ++w) eqw[w] = __builtin_bitreverse32(lew[w]) & selw[w]; }
        const unsigned rneed = (unsigned)TOPK - chi;
        const int kb = 16 * wid + 4 * g;
        int ilo = -1, ihi = N - 1, icut = N; bool tdone = !tie;
        for (int it = 0; it < 40; ++it) {
            const int imid = (ilo + ihi) >> 1;
            if (!tdone && (ihi - ilo) <= 1) { tdone = true; icut = ihi; }
            const int iv = (tdone ? icut : imid) - kb;
            const int nle = iv < 0 ? 0 : min(128, 4 * (iv >> 7) + min(iv & 127, 3) + 1);
            unsigned cnt = 0u;
#pragma unroll
            for (int w = 0; w < 4; ++w) { const int nw = min(max(nle - 32 * w, 0), 32); const unsigned mk = nw >= 32 ? 0xffffffffu : ((1u << nw) - 1u); cnt += (unsigned)__builtin_popcount(eqw[w] & mk); }
            cnt += __shfl_xor(cnt, 16); cnt += __shfl_xor(cnt, 32);
            LAS unsigned* rb = red + (it & 1) * 128;
            rb[wid * 16 + ql] = cnt;
            __syncthreads();
            unsigned tot = 0u;
#pragma unroll
            for (int w = 0; w < 8; ++w) tot += rb[w * 16 + ql];
            if (!tdone) { if (tot == rneed) { tdone = true; icut = imid; } else if (tot < rneed) ilo = imid; else ihi = imid; }
            if (__all(tdone)) break;
        }
        if (tie) {
            const int iv = icut - kb; const int nle = iv < 0 ? 0 : min(128, 4 * (iv >> 7) + min(iv & 127, 3) + 1);
#pragma unroll
            for (int w = 0; w < 4; ++w) { const int nw = min(max(nle - 32 * w, 0), 32); const unsigned mk = nw >= 32 ? 0xffffffffu : ((1u << nw) - 1u); selw[w] = (selw[w] & ~eqw[w]) | (eqw[w] & mk); }
        }
    }
#undef SEL_LTBITS
    LAS u16* mrowp = m16 + ((mrow0 + ql) * 64 + (wid >> 2)) * 4 + (wid & 3);
#pragma unroll
    for (int jj = 0; jj < 32; ++jj) { const int j = wid + 8 * jj;
        if (j < NT16) { unsigned v = ((selw[jj >> 3] >> (4 * (jj & 7))) & 0xFu) << (4 * g);
            v |= __shfl_xor(v, 16); v |= __shfl_xor(v, 32);
            mrowp[8 * jj] = (u16)v; } }
}
__device__ __forceinline__ void attnB_unit(Frame& F, int b, int qb32, int mode = 0) {
    LAS unsigned char* lds = F.lds;
    int tid = F.tid; asm volatile("" : "+v"(tid)); int wid = F.wave; asm volatile("" : "+s"(wid));
    const int lane = tid & 63, r32 = lane & 31, hi = lane >> 5;
    const int q0 = 32 * qb32, c = q0 >> 6, nt = c + 1;
    const size_t rowb = (size_t)b * SEQ;
    const u16* P0 = (const u16*)(F.ws + WS_PROJ0);
    if (mode != 3) { selB_16(F, b, c, q0, 0);
    __syncthreads();
    selB_16(F, b, c, q0 + 16, 16); }
    if (mode == 4) return;
    LAS float* bt = (LAS float*)(lds + B_BT) + wid * 192;
    for (int e = tid; e < 8 * 192; e += 512) ((LAS float*)(lds + B_BT))[e] = ((const float*)(F.ws + WS_BTG))[4 * 192 + e];
    h8 qf[4];
    { const u16* qp = P0 + (rowb + q0 + r32) * P0W + C_QB + wid * 64 + hi * 8;
#pragma unroll
      for (int d0 = 0; d0 < 4; ++d0) qf[d0] = *(const h8*)(qp + d0 * 16); }
    f32x16 o[2];
#pragma unroll
    for (int d = 0; d < 2; ++d)
#pragma unroll
        for (int r = 0; r < 16; ++r) o[d][r] = 0.f;
    float mrun = 0.f, lrun = 0.f; bool have = false;
    const int krow = tid >> 3, kch = tid & 7;
    const u16* ksrc = P0 + (rowb + krow) * P0W + C_KB + kch * 8;
    const int kdst = krow * 128 + ((kch ^ ((krow >> 1) & 7)) << 4);
    const int vdst = 8192 + krow * 128 + ((kch ^ (((krow >> 1) & 1) << 2)) << 4);
    u32x4 st0, st1;
#define B_LOAD(t) do { const size_t to = (size_t)(t) * 64 * P0W; st0 = *(const u32x4*)(ksrc + to); st1 = *(const u32x4*)(ksrc + to + 64); } while (0)
#define B_WRITE(s) do { LAS unsigned char* sb = lds + (s) * 16384; *(LAS u32x4*)(sb + kdst) = st0; *(LAS u32x4*)(sb + vdst) = st1; } while (0)
    const int kfo = r32 * 128, ksw = (r32 >> 1) & 7;
    const int i16 = lane & 15, qrow = i16 >> 2, pp = i16 & 3, g16 = (lane >> 4) & 1;
    const int vlane = (4 * hi + qrow) * 128 + ((2 * g16 + (pp >> 1)) << 4) + 8 * (pp & 1);
    const int qglob = q0 + r32;
    B_LOAD(0); B_WRITE(0); __syncthreads();
    for (int t = 0; t < nt; ++t) {
        if (t + 1 < nt) B_LOAD(t + 1);
        {
            LAS const unsigned char* sb = lds + (t & 1) * 16384; LAS const unsigned char* kb = sb + kfo; LAS const unsigned char* vb = sb + 8192 + vlane;
            const bool nearb = (64 * t + 63 - q0) > -128;
            const float c0 = (nearb ? 0.f : bt[0]) - mrun;
            f32x16 p0, p1;
#pragma unroll
            for (int r = 0; r < 16; ++r) { p0[r] = c0; p1[r] = c0; }
#pragma unroll
            for (int d0 = 0; d0 < 4; ++d0) { const int co = ((2 * d0 + hi) ^ ksw) << 4;
                const h8 ka = *(LAS const h8*)(kb + co), kc = *(LAS const h8*)(kb + 4096 + co);
                p0 = __builtin_amdgcn_mfma_f32_32x32x16_f16(ka, qf[d0], p0, 0, 0, 0); p1 = __builtin_amdgcn_mfma_f32_32x32x16_f16(kc, qf[d0], p1, 0, 0, 0); }
            if (nearb) add_bias(p0, p1, bt, 64 * t + 4 * hi - qglob + 128);
            const u64 mw = *(LAS const u64*)(lds + B_MASK + (r32 * 64 + t) * 8);
            const unsigned mlo = (unsigned)mw >> (4 * hi), mhi = (unsigned)(mw >> 32) >> (4 * hi);
#pragma unroll
            for (int r = 0; r < 16; ++r) { const int cb = (r & 3) + 8 * (r >> 2);
                if (!((mlo >> cb) & 1u)) p0[r] = -1e30f; if (!((mhi >> cb) & 1u)) p1[r] = -1e30f; }
            h8 pf[4];
            softmax_step<2, true>(p0, p1, mrun, lrun, have, o, pf);
#pragma unroll
            for (int d0 = 0; d0 < 2; ++d0) { const int dx = (d0 ^ (qrow >> 1)) << 6;
#pragma unroll
                for (int ks = 0; ks < 4; ++ks) { const h8 vf = tr2(vb + ks * 2048 + dx, vb + ks * 2048 + 1024 + dx);
                    o[d0] = __builtin_amdgcn_mfma_f32_32x32x16_f16(vf, pf[ks], o[d0], 0, 0, 0); } }
        }
        if (t + 1 < nt) B_WRITE((t + 1) & 1);
        __syncthreads();
    }
#undef B_LOAD
#undef B_WRITE
    const float linv = 1.0f / swap_sum(lrun);
    const size_t row = rowb + qglob;
    const u16* gp = P0 + row * P0W + C_G0 + 512 + wid * 64;
    u16* op = (u16*)(F.ws + WS_MG0) + row * DM + 512 + wid * 64;
#pragma unroll
    for (int d0 = 0; d0 < 2; ++d0)
#pragma unroll
        for (int g = 0; g < 4; ++g) { const int d = 32 * d0 + 8 * g + 4 * hi;
            const h4 gv = *(const h4*)(gp + d);
            u32x2 w; w.x = pkh(o[d0][4 * g] * linv * (float)gv[0], o[d0][4 * g + 1] * linv * (float)gv[1]);
            w.y = pkh(o[d0][4 * g + 2] * linv * (float)gv[2], o[d0][4 * g + 3] * linv * (float)gv[3]);
            *(u32x2*)(op + d) = w; }
}

__device__ __forceinline__ void attnC_unit(Frame& F, int b, int h, int qb) {
    LAS unsigned char* lds = F.lds;
    int tid = F.tid; asm volatile("" : "+v"(tid)); int wid = F.wave; asm volatile("" : "+s"(wid));
    const int lane = tid & 63, r32 = lane & 31, hi = lane >> 5;
    const int q0 = 256 * qb + 32 * wid, cw = q0 >> 6, nt = 4 * qb + 4;
    const size_t rowb = (size_t)b * SEQ;
    const u16* Q1 = (const u16*)(F.ws + WS_Q1); const u16* KV = (const u16*)(F.ws + WS_KV1); const u16* KR = (const u16*)(F.ws + WS_KROPE);
    h8 qf[6];
    { const u16* qp = Q1 + (rowb + q0 + r32) * 1536 + h * 96 + hi * 8;
#pragma unroll
      for (int d0 = 0; d0 < 6; ++d0) qf[d0] = *(const h8*)(qp + d0 * 16); }
    f32x16 o[2];
#pragma unroll
    for (int d = 0; d < 2; ++d)
#pragma unroll
        for (int r = 0; r < 16; ++r) o[d][r] = 0.f;
    float mrun = 0.f, lrun = 0.f; bool have = false;
    const int krow = tid >> 3, kch = tid & 7;
    const u16* ksrc = KV + (rowb + krow) * 2048 + h * 128 + kch * 8;
    const int kdst = krow * 128 + ((kch ^ ((krow >> 1) & 7)) << 4);
    const int vdst = 12288 + krow * 128 + ((kch ^ (((krow >> 1) & 1) << 2)) << 4);
    const int rrow = (tid & 255) >> 2, rch = tid & 3;
    const u16* rsrc = KR + (rowb + rrow) * 32 + rch * 8;
    const int rdst = 8192 + rrow * 64 + ((rch ^ ((rrow >> 2) & 3)) << 4);
    u32x4 st0, st1, st2;
#define C_LOAD(t) do { const size_t tr = (size_t)(t) * 64; st0 = *(const u32x4*)(ksrc + tr * 2048); st1 = *(const u32x4*)(ksrc + tr * 2048 + 64); if (tid < 256) st2 = *(const u32x4*)(rsrc + tr * 32); } while (0)
#define C_WRITE(s) do { LAS unsigned char* sb = lds + (s) * 20480; *(LAS u32x4*)(sb + kdst) = st0; *(LAS u32x4*)(sb + vdst) = st1; if (tid < 256) *(LAS u32x4*)(sb + rdst) = st2; } while (0)
    const int kfo = r32 * 128, ksw = (r32 >> 1) & 7;
    const int rfo = 8192 + r32 * 64, rsw = (r32 >> 2) & 3;
    const int i16 = lane & 15, qrow = i16 >> 2, pp = i16 & 3, g16 = (lane >> 4) & 1;
    const int vlane = (4 * hi + qrow) * 128 + ((2 * g16 + (pp >> 1)) << 4) + 8 * (pp & 1);
    C_LOAD(0); C_WRITE(0); __syncthreads();
    for (int t = 0; t < nt; ++t) {
        if (t + 1 < nt) C_LOAD(t + 1);
        if (t <= cw) {
            LAS const unsigned char* sb = lds + (t & 1) * 20480; LAS const unsigned char* kb = sb + kfo; LAS const unsigned char* rb = sb + rfo; LAS const unsigned char* vb = sb + 12288 + vlane;
            f32x16 p0, p1;
#pragma unroll
            for (int r = 0; r < 16; ++r) { p0[r] = -mrun; p1[r] = -mrun; }
#pragma unroll
            for (int d0 = 0; d0 < 4; ++d0) { const int co = ((2 * d0 + hi) ^ ksw) << 4;
                const h8 ka = *(LAS const h8*)(kb + co), kc = *(LAS const h8*)(kb + 4096 + co);
                p0 = __builtin_amdgcn_mfma_f32_32x32x16_f16(ka, qf[d0], p0, 0, 0, 0); p1 = __builtin_amdgcn_mfma_f32_32x32x16_f16(kc, qf[d0], p1, 0, 0, 0); }
#pragma unroll
            for (int d0 = 0; d0 < 2; ++d0) { const int co = ((2 * d0 + hi) ^ rsw) << 4;
                const h8 ka = *(LAS const h8*)(rb + co), kc = *(LAS const h8*)(rb + 2048 + co);
                p0 = __builtin_amdgcn_mfma_f32_32x32x16_f16(ka, qf[4 + d0], p0, 0, 0, 0); p1 = __builtin_amdgcn_mfma_f32_32x32x16_f16(kc, qf[4 + d0], p1, 0, 0, 0); }
#if DEBUG_CHECK
            if (b == TAPB && h == TAPH && qb == TAPQB && wid == 0 && t == 0) { float* db = (float*)(F.ws + WS_DBGBUF);
#pragma unroll
                for (int r = 0; r < 16; ++r) { const int key = (r & 3) + 8 * (r >> 2) + 4 * hi; db[r32 * 64 + key] = p0[r]; db[r32 * 64 + 32 + key] = p1[r]; } }
#endif
            h8 pf[4];
            softmax_step<2, false>(p0, p1, mrun, lrun, have, o, pf);
#pragma unroll
            for (int d0 = 0; d0 < 2; ++d0) { const int dx = (d0 ^ (qrow >> 1)) << 6;
#pragma unroll
                for (int ks = 0; ks < 4; ++ks) { const h8 vf = tr2(vb + ks * 2048 + dx, vb + ks * 2048 + 1024 + dx);
                    o[d0] = __builtin_amdgcn_mfma_f32_32x32x16_f16(vf, pf[ks], o[d0], 0, 0, 0); } }
        }
        if (t + 1 < nt) C_WRITE((t + 1) & 1);
        __syncthreads();
    }
#undef C_LOAD
#undef C_WRITE
    const float linv = 1.0f / swap_sum(lrun);
    const size_t row = rowb + q0 + r32;
#if DEBUG_CHECK
    if (b == TAPB && h == TAPH && qb == TAPQB) { float* db = (float*)(F.ws + WS_DBGBUF) + 4096;
#pragma unroll
        for (int d0 = 0; d0 < 2; ++d0)
#pragma unroll
            for (int r = 0; r < 16; ++r) db[(32 * wid + r32) * 64 + 32 * d0 + (r & 3) + 8 * (r >> 2) + 4 * hi] = o[d0][r] * linv; }
#endif
    const u16* gp = (const u16*)(F.ws + WS_G1) + row * DM + h * 64;
    u16* op = (u16*)(F.ws + WS_MG1) + row * DM + h * 64;
#pragma unroll
    for (int d0 = 0; d0 < 2; ++d0)
#pragma unroll
        for (int g = 0; g < 4; ++g) { const int d = 32 * d0 + 8 * g + 4 * hi;
            const h4 gv = *(const h4*)(gp + d);
            u32x2 w; w.x = pkh(o[d0][4 * g] * linv * (float)gv[0], o[d0][4 * g + 1] * linv * (float)gv[1]);
            w.y = pkh(o[d0][4 * g + 2] * linv * (float)gv[2], o[d0][4 * g + 3] * linv * (float)gv[3]);
            *(u32x2*)(op + d) = w; }
}

__device__ __forceinline__ void p8_final(Frame& F, const Args& AR) {
    const int gw = blockIdx.x * NWAVES + F.wave, NGW = F.G * NWAVES;
    const float* gn = AR.in[I_FNORM]; f32x4 gv[4];
#pragma unroll
    for (int j = 0; j < 4; ++j) gv[j] = *(const f32x4*)(gn + 4 * F.lane + 256 * j);
    for (int mrow = gw; mrow < T; mrow += NGW) {
        f32x4* xr = (f32x4*)(F.out + (size_t)mrow * DM) + F.lane;
        f32x4 v[4]; float s = 0.f;
#pragma unroll
        for (int j = 0; j < 4; ++j) { v[j] = xr[64 * j]; s += (v[j].x * v[j].x + v[j].y * v[j].y) + (v[j].z * v[j].z + v[j].w * v[j].w); }
        const float rstd = __builtin_amdgcn_rsqf(wave_sum(s) * (1.f / DM) + RMS_EPS);
#pragma unroll
        for (int j = 0; j < 4; ++j) xr[64 * j] = v[j] * rstd * gv[j];
    }
}


#ifndef NAIVE_ATTN
#define NAIVE_ATTN 0
#endif
struct NaiveSh { float sh[4096]; float red[256]; unsigned char sel[4096]; };
__device__ __forceinline__ float blk_max(NaiveSh& S, float v, int tid) { S.red[tid] = v; __syncthreads(); for (int o2 = 128; o2 > 0; o2 >>= 1) { if (tid < o2) S.red[tid] = fmaxf(S.red[tid], S.red[tid + o2]); __syncthreads(); } const float r = S.red[0]; __syncthreads(); return r; }
__device__ __forceinline__ float blk_sum(NaiveSh& S, float v, int tid) { S.red[tid] = v; __syncthreads(); for (int o2 = 128; o2 > 0; o2 >>= 1) { if (tid < o2) S.red[tid] += S.red[tid + o2]; __syncthreads(); } const float r = S.red[0]; __syncthreads(); return r; }
__device__ __forceinline__ float blk_softmax(NaiveSh& S, int nk, int tid) {
    float mx = -1e30f; for (int k = tid; k < nk; k += 256) mx = fmaxf(mx, S.sh[k]); mx = blk_max(S, mx, tid);
    float ls = 0.f; for (int k = tid; k < nk; k += 256) { const float p = S.sh[k] > -1e29f ? exp2f(S.sh[k] - mx) : 0.f; S.sh[k] = p; ls += p; }
    return blk_sum(S, ls, tid);
}
__device__ __forceinline__ float naiveA(NaiveSh& S, const Args& args, int b, int q, int hd, int tid) {
    unsigned char* ws = args.ws; const u16* P0 = (const u16*)(ws + WS_PROJ0); const float* BT = (const float*)(ws + WS_BTG);
    const size_t row = (size_t)b * SEQ + q; const int nk = 64 * (q / 64 + 1); float outv[2] = {0.f, 0.f};
    for (int m = 0; m < 2; ++m) {
        for (int k = tid; k < nk; k += 256) { float sacc = 0.f; const u16* qp = P0 + row * P0W + C_QA + hd * 128 + m * 64; const u16* kp = P0 + ((size_t)b * SEQ + k) * P0W + C_KA + hd * 128 + m * 64;
            for (int d = 0; d < 64; ++d) sacc += h2f(qp[d]) * h2f(kp[d]);
            int rel = k - q; rel = rel < -128 ? -128 : rel; S.sh[k] = sacc + BT[hd * 192 + rel + 128]; }
        __syncthreads();
        const float ls = blk_softmax(S, nk, tid);
        if (tid < 128) { float a = 0.f; for (int k = 0; k < nk; ++k) a += S.sh[k] * h2f(P0[((size_t)b * SEQ + k) * P0W + C_VA + hd * 128 + tid]); outv[m] = a / ls; }
        __syncthreads();
    }
    const float lam = *(const float*)(ws + WS_LAM); const float v = tid < 128 ? outv[0] - lam * outv[1] : 0.f;
    const float ss = blk_sum(S, v * v, tid);
    const float rs = rsqrtf(ss / 128.f + RMS_EPS) * 0.8f;
    return tid < 128 ? v * rs * args.in[I_SUBLN][tid] * h2f(P0[row * P0W + C_G0 + hd * 128 + tid]) : 0.f;
}
__device__ __forceinline__ void naiveB_select(NaiveSh& S, const Args& args, int b, int q, int tid) {
    const u16* P0 = (const u16*)(args.ws + WS_PROJ0); const size_t row = (size_t)b * SEQ + q; const int nk = 64 * (q / 64 + 1);
    for (int k = tid; k < nk; k += 256) { float sc = 0.f;
        for (int hh = 0; hh < 8; ++hh) { float l = 0.f; const u16* qp = P0 + row * P0W + C_QI + hh * 64; const u16* kp = P0 + ((size_t)b * SEQ + k) * P0W + C_KI;
            for (int d = 0; d < 64; ++d) l += h2f(qp[d]) * h2f(kp[d]);
            sc += h2f(P0[row * P0W + C_WI + hh]) * fmaxf(l, 0.f); }
        S.sh[k] = sc; }
    __syncthreads();
    for (int k = tid; k < nk; k += 256) { const float sk = S.sh[k]; int rank = 0; for (int k2 = 0; k2 < nk; ++k2) { const float s2 = S.sh[k2]; rank += (s2 > sk || (s2 == sk && k2 < k)) ? 1 : 0; } S.sel[k] = rank < TOPK ? 1 : 0; }
    __syncthreads();
}
__device__ __forceinline__ float naiveB_head(NaiveSh& S, const Args& args, int b, int q, int hd, int tid) {
    const u16* P0 = (const u16*)(args.ws + WS_PROJ0); const float* BT = (const float*)(args.ws + WS_BTG); const size_t row = (size_t)b * SEQ + q; const int nk = 64 * (q / 64 + 1);
    for (int k = tid; k < nk; k += 256) { float sacc = -1e30f;
        if (S.sel[k]) { sacc = 0.f; const u16* qp = P0 + row * P0W + C_QB + hd * 64; const u16* kp = P0 + ((size_t)b * SEQ + k) * P0W + C_KB;
            for (int d = 0; d < 64; ++d) sacc += h2f(qp[d]) * h2f(kp[d]);
            int rel = k - q; rel = rel < -128 ? -128 : rel; sacc += BT[(4 + hd) * 192 + rel + 128]; }
        S.sh[k] = sacc; }
    __syncthreads();
    const float ls = blk_softmax(S, nk, tid);
    float r = 0.f;
    if (tid < 64) { float a = 0.f; for (int k = 0; k < nk; ++k) a += S.sh[k] * h2f(P0[((size_t)b * SEQ + k) * P0W + C_VB + tid]); r = a / ls * h2f(P0[row * P0W + C_G0 + 512 + hd * 64 + tid]); }
    __syncthreads();
    return r;
}
__device__ __forceinline__ float naiveC(NaiveSh& S, const Args& args, int b, int q, int hd, int tid) {
    unsigned char* ws = args.ws; const size_t row = (size_t)b * SEQ + q; const int nk = 64 * (q / 64 + 1);
    const u16* Q1 = (const u16*)(ws + WS_Q1); const u16* KV = (const u16*)(ws + WS_KV1); const u16* KR = (const u16*)(ws + WS_KROPE);
    for (int k = tid; k < nk; k += 256) { float sacc = 0.f; const u16* qp = Q1 + row * 1536 + hd * 96; const size_t kr = (size_t)b * SEQ + k;
        for (int d = 0; d < 64; ++d) sacc += h2f(qp[d]) * h2f(KV[kr * 2048 + hd * 128 + d]);
        for (int d = 0; d < 32; ++d) sacc += h2f(qp[64 + d]) * h2f(KR[kr * 32 + d]);
        S.sh[k] = sacc; }
    __syncthreads();
    const float ls = blk_softmax(S, nk, tid);
    float r = 0.f;
    if (tid < 64) { float a = 0.f; for (int k = 0; k < nk; ++k) a += S.sh[k] * h2f(KV[((size_t)b * SEQ + k) * 2048 + hd * 128 + 64 + tid]); r = a / ls * h2f(((const u16*)(ws + WS_G1))[row * DM + hd * 64 + tid]); }
    __syncthreads();
    return r;
}
#if NAIVE_ATTN
__global__ void __launch_bounds__(256) naive_attn(Args args, int which) {
    __shared__ NaiveSh S; const int tid = threadIdx.x; unsigned char* ws = args.ws;
    if (which == 0) {
        for (int it = blockIdx.x; it < T * 5; it += gridDim.x) {
            const int row = it / 5, sub = it % 5, b = row / SEQ, q = row % SEQ;
            if (sub < 4) { const float v = naiveA(S, args, b, q, sub, tid); if (tid < 128) ((u16*)(ws + WS_MG0))[(size_t)row * DM + sub * 128 + tid] = (u16)(pkh(v, 0.f) & 0xffffu); }
            else { naiveB_select(S, args, b, q, tid);
                for (int hd = 0; hd < 8; ++hd) { const float v = naiveB_head(S, args, b, q, hd, tid); if (tid < 64) ((u16*)(ws + WS_MG0))[(size_t)row * DM + 512 + hd * 64 + tid] = (u16)(pkh(v, 0.f) & 0xffffu); } }
        }
    } else {
        for (int it = blockIdx.x; it < T * 16; it += gridDim.x) {
            const int row = it >> 4, hd = it & 15, b = row / SEQ, q = row % SEQ;
            const float v = naiveC(S, args, b, q, hd, tid); if (tid < 64) ((u16*)(ws + WS_MG1))[(size_t)row * DM + hd * 64 + tid] = (u16)(pkh(v, 0.f) & 0xffffu);
        }
    }
}
#endif

#if DEBUG_CHECK
constexpr size_t WS_DBG = 3 * MiB;
#ifndef DBG_BITS_MODE
#define DBG_BITS_MODE 1
#define DBG_BITS_IDS 14, 4, 5, 21, 22, 23
#endif
#ifndef DBG_SKIP_MASK
#define DBG_SKIP_MASK 0x10
#endif
#ifndef DBG_REPORT_ID
#define DBG_REPORT_ID 0
#endif
__device__ __forceinline__ unsigned dhash(unsigned x) { x ^= x >> 16; x *= 0x7feb352du; x ^= x >> 15; x *= 0x846ca68bu; x ^= x >> 16; return x; }
__device__ __forceinline__ void dbg_rec(unsigned char* ws, int id, float got, float ref, float scale) {
    float e = fabsf(got - ref) / (fabsf(ref) + scale); if (!(e == e)) e = 1e6f;
    atomicMax((unsigned*)(ws + WS_DBG) + id, __float_as_uint(e));
}
__device__ __forceinline__ float dh(const u16* p, size_t i) { return h2f(p[i]); }
__global__ void __launch_bounds__(256) dbg_check(Args args, int stage) {
    unsigned char* ws = args.ws; const int tid = threadIdx.x, bid = blockIdx.x, gid = bid * 256 + tid;
    if (stage == 0) { if (gid < 64) ((unsigned*)(ws + WS_DBG))[gid] = (gid == 44) ? 0xffffu : 0u; return; }
    if (stage == 1) {
        const unsigned h = dhash(gid * 7919u + 13u);
        { const int n = h % P0W, k = (h >> 12) % 1024; const int sc = wsrc_col(0, n); const float ref = sc < 0 ? 0.f : args.in[I_EWIN][(size_t)k * L0_SRC + sc] * wcol_scale(0, n);
          dbg_rec(ws, 1, dh((const u16*)(ws + WS_W0T), (size_t)n * 1024 + k), ref, 1e-3f); }
        { const int n = h % P1W, k = (h >> 12) % 1024; const int sc = wsrc_col(2, n); const float ref = sc < 0 ? 0.f : args.in[I_OWIN][(size_t)k * L1_SRC + sc] * args.in[I_ONORM][k];
          dbg_rec(ws, 1, dh((const u16*)(ws + WS_W1T), (size_t)n * 1024 + k), ref, 1e-3f); }
        { const int n = h % 1536, k = (h >> 12) % 384; const float ref = args.in[I_OWUQ][(size_t)k * 1536 + n] * args.in[I_OQNORM][k] * QS_C;
          dbg_rec(ws, 1, dh((const u16*)(ws + WS_WUQT), (size_t)n * 384 + k), ref, 1e-3f); }
        { const int n = h % 2048, k = (h >> 12) % 256; const float ref = args.in[I_OWUKV][(size_t)k * 2048 + n] * args.in[I_OKVNORM][k];
          dbg_rec(ws, 1, dh((const u16*)(ws + WS_WUKVT), (size_t)n * 256 + k), ref, 1e-3f); }
        { const int n = h % 1024, k = (h >> 12) % 1024; dbg_rec(ws, 1, dh((const u16*)(ws + WS_WO0T), (size_t)n * 1024 + k), args.in[I_EWO][(size_t)k * 1024 + n], 1e-3f);
          dbg_rec(ws, 1, dh((const u16*)(ws + WS_WO1T), (size_t)n * 1024 + k), args.in[I_OWO][(size_t)k * 1024 + n], 1e-3f); }
        { const int row = h % T, col = (h >> 15) % 1024; const float* xr = args.in[I_X] + (size_t)row * DM; float ss = 0.f; for (int k = 0; k < DM; ++k) ss += xr[k] * xr[k];
          const float ref = xr[col] * rsqrtf(ss / DM + RMS_EPS) * args.in[I_ENORM][col]; dbg_rec(ws, 2, dh((const u16*)(ws + WS_XN0), (size_t)row * DM + col), ref, 1e-2f); }
        return;
    }
    if (stage == 2) {
        const unsigned h = dhash(gid * 104729u + 7u); const int row = h % T; int col = (h >> 15) % P0W; if (gid & 1) col = C_G0 + (col & 1023); if ((gid & 7) == 2) col = C_KI + (col & 63);
        const u16* a = (const u16*)(ws + WS_XN0) + (size_t)row * DM; const u16* b = (const u16*)(ws + WS_W0T) + (size_t)col * 1024; float acc = 0.f;
        for (int k = 0; k < 1024; ++k) acc += h2f(a[k]) * h2f(b[k]);
        if (col >= C_G0) acc = acc / (1.f + expf(-acc));
        dbg_rec(ws, 3, dh((const u16*)(ws + WS_PROJ0), (size_t)row * P0W + col), acc, 2e-2f);
        return;
    }
    if (stage == 3) {
        __shared__ NaiveSh NS;
        const unsigned h = dhash(bid * 2654435761u + 99u);
        int q = h % SEQ; const int b = (h >> 12) % NB; if (bid % 5 == 0) q = q % 320;
        const size_t row = (size_t)b * SEQ + q;
        if (bid < 48) { const int hd = (h >> 20) % 4; const float ref = naiveA(NS, args, b, q, hd, tid);
            if (tid < 128) dbg_rec(ws, 4, dh((const u16*)(ws + WS_MG0), row * DM + hd * 128 + tid), ref, 2e-2f); }
        else { const int hd = (h >> 20) % 8; naiveB_select(NS, args, b, q, tid); const float ref = naiveB_head(NS, args, b, q, hd, tid);
            if (tid < 64) dbg_rec(ws, 5, dh((const u16*)(ws + WS_MG0), row * DM + 512 + hd * 64 + tid), ref, 2e-2f); }
        return;
    }
    if (stage == 4) {
        const unsigned h = dhash(gid * 15485863u + 3u); const int row = h % T, col = (h >> 15) % 1024;
        const u16* a = (const u16*)(ws + WS_MG0) + (size_t)row * DM; const u16* b = (const u16*)(ws + WS_WO0T) + (size_t)col * 1024; float acc = 0.f;
        for (int k = 0; k < 1024; ++k) acc += h2f(a[k]) * h2f(b[k]);
        const float ref = args.in[I_X][(size_t)row * DM + col] + acc;
        dbg_rec(ws, 6, args.out[(size_t)row * DM + col], ref, 1e-2f); dbg_rec(ws, 6, dh((const u16*)(ws + WS_XN0), (size_t)row * DM + col), ref, 1e-2f);
        if (gid < 2048) { float ss = 0.f; for (int k = 0; k < DM; ++k) { const float v = args.out[(size_t)row * DM + k]; ss += v * v; }
            dbg_rec(ws, 7, (float)((const u64*)(ws + WS_SSQ1))[row] / FXS, ss, 1e-3f); }
        return;
    }
    if (stage == 5) {
        const unsigned h = dhash(gid * 32452843u + 5u); const int row = h % T; int col = (h >> 15) % P1W; if ((gid & 3) == 1) col = 640 + (col & 31);
        if (col >= 672 && col < 768) col -= 200;
        const u16* a = (const u16*)(ws + WS_XN0) + (size_t)row * DM; float ss = 0.f; for (int k = 0; k < DM; ++k) { const float v = args.out[(size_t)row * DM + k]; ss += v * v; }
        const float rs = rsqrtf(ss / DM + RMS_EPS);
        auto dotc = [&](int c) { const u16* b = (const u16*)(ws + WS_W1T) + (size_t)c * 1024; float acc = 0.f; for (int k = 0; k < 1024; ++k) acc += h2f(a[k]) * h2f(b[k]); return acc * rs; };
        const float v = dotc(col);
        if (col < 640) dbg_rec(ws, 8, dh((const u16*)(ws + WS_LAT), (size_t)row * LATW + col), v, 2e-2f);
        else if (col < 672) { const int j = col - 640, pos = row & (SEQ - 1), i = j & 15; const float inv = (float)pow(10000.0, -(double)i / 16.0), ang = (float)pos * inv; const float cs = cosf(ang), sn = sinf(ang);
            const float other = dotc(j < 16 ? col + 16 : col - 16); const float ref = j < 16 ? v * cs - other * sn : other * sn + v * cs;
            dbg_rec(ws, 9, dh((const u16*)(ws + WS_KROPE), (size_t)row * 32 + j), ref, 2e-2f); }
        else dbg_rec(ws, 10, dh((const u16*)(ws + WS_G1), (size_t)row * DM + col - 768), v / (1.f + expf(-v)), 2e-2f);
        if (gid < 1024) { const u16* lat = (const u16*)(ws + WS_LAT) + (size_t)row * LATW; float s1 = 0.f, s2 = 0.f; for (int k = 0; k < 256; ++k) s1 += h2f(lat[k]) * h2f(lat[k]); for (int k = 256; k < 640; ++k) s2 += h2f(lat[k]) * h2f(lat[k]);
            dbg_rec(ws, 11, (float)((const u64*)(ws + WS_SSQKV))[row] / FXS, s1, 1e-2f); dbg_rec(ws, 11, (float)((const u64*)(ws + WS_SSQQ))[row] / FXS, s2, 1e-2f); }
        return;
    }
    if (stage == 6) {
        const unsigned h = dhash(gid * 49979687u + 11u); const int row = h % T; const u16* lat = (const u16*)(ws + WS_LAT) + (size_t)row * LATW;
        { const int col = (h >> 15) % 2048; float s1 = 0.f; for (int k = 0; k < 256; ++k) s1 += h2f(lat[k]) * h2f(lat[k]); const float rs = rsqrtf(s1 / 256.f + RMS_EPS);
          const u16* b = (const u16*)(ws + WS_WUKVT) + (size_t)col * 256; float acc = 0.f; for (int k = 0; k < 256; ++k) acc += h2f(lat[k]) * h2f(b[k]);
          dbg_rec(ws, 13, dh((const u16*)(ws + WS_KV1), (size_t)row * 2048 + col), acc * rs, 2e-2f); }
        { int col = (h >> 15) % 1536; if (gid & 1) col = (col / 96) * 96 + 64 + (col & 31);
          float s2 = 0.f; for (int k = 256; k < 640; ++k) s2 += h2f(lat[k]) * h2f(lat[k]); const float rs = rsqrtf(s2 / 384.f + RMS_EPS);
          auto dotc = [&](int c) { const u16* b = (const u16*)(ws + WS_WUQT) + (size_t)c * 384; float acc = 0.f; for (int k = 0; k < 384; ++k) acc += h2f(lat[256 + k]) * h2f(b[k]); return acc * rs; };
          float v = dotc(col); const int jj = col % 96;
          if (jj >= 64) { const int j = jj - 64, pos = row & (SEQ - 1), i = j & 15; const float inv = (float)pow(10000.0, -(double)i / 16.0), ang = (float)pos * inv; const float cs = cosf(ang), sn = sinf(ang);
              const float other = dotc(j < 16 ? col + 16 : col - 16); v = j < 16 ? v * cs - other * sn : other * sn + v * cs; }
          dbg_rec(ws, 12, dh((const u16*)(ws + WS_Q1), (size_t)row * 1536 + col), v, 2e-2f); }
        return;
    }
    if (stage == 7) {
        __shared__ NaiveSh NS;
        const unsigned h = dhash(bid * 2654435761u + 777u); int q = h % SEQ; const int b = (h >> 12) % NB, hd = (h >> 20) % 16; if (bid % 5 == 0) q = q % 320;
        const size_t row = (size_t)b * SEQ + q; const float ref = naiveC(NS, args, b, q, hd, tid);
        if (tid < 64) dbg_rec(ws, 14, dh((const u16*)(ws + WS_MG1), row * DM + hd * 64 + tid), ref, 2e-2f);
        { const float got = tid < 64 ? dh((const u16*)(ws + WS_MG1), row * DM + hd * 64 + tid) : 0.f; const bool bad = tid < 64 && fabsf(got - ref) / (fabsf(ref) + 2e-2f) > 0.05f;
          if (__syncthreads_or(bad ? 1 : 0) && tid == 0) { atomicAdd((unsigned*)(ws + WS_DBG) + 43, 1u); atomicMin((unsigned*)(ws + WS_DBG) + 44, (unsigned)(q / 64)); atomicMax((unsigned*)(ws + WS_DBG) + 45, (unsigned)(q / 64)); } }
        {
            const u16* Q1 = (const u16*)(ws + WS_Q1); const u16* KV = (const u16*)(ws + WS_KV1); const u16* KR = (const u16*)(ws + WS_KROPE); const float* db = (const float*)(ws + WS_DBGBUF) + 4096;
            for (int e = gid; e < 256 * 64; e += gridDim.x * 256) { const int qq = e >> 6, d = e & 63, qpos = 256 * TAPQB + qq, nkk = 64 * (qpos / 64 + 1); float mx = -1e30f, ls = 0.f, a = 0.f;
                const size_t rb = (size_t)TAPB * SEQ; const u16* qp = Q1 + (rb + qpos) * 1536 + TAPH * 96;
                for (int pass = 0; pass < 2; ++pass)
                for (int k = 0; k < nkk; ++k) { float sacc = 0.f; for (int dd = 0; dd < 64; ++dd) sacc += h2f(qp[dd]) * h2f(KV[(rb + k) * 2048 + TAPH * 128 + dd]);
                    for (int dd = 0; dd < 32; ++dd) sacc += h2f(qp[64 + dd]) * h2f(KR[(rb + k) * 32 + dd]);
                    if (pass == 0) mx = fmaxf(mx, sacc); else { const float p = exp2f(sacc - mx); ls += p; a += p * h2f(KV[(rb + k) * 2048 + TAPH * 128 + 64 + d]); } }
                dbg_rec(ws, 21 + (qq >> 6), db[e], a / ls, 2e-2f); }
        }
        if (bid == 0) {
            const u16* Q1 = (const u16*)(ws + WS_Q1); const u16* KV = (const u16*)(ws + WS_KV1); const u16* KR = (const u16*)(ws + WS_KROPE); const float* db = (const float*)(ws + WS_DBGBUF);
            for (int e = tid; e < 32 * 64; e += 256) { const int qq = e >> 6, k = e & 63; float sacc = 0.f;
                for (int d = 0; d < 64; ++d) sacc += h2f(Q1[(size_t)qq * 1536 + d]) * h2f(KV[(size_t)k * 2048 + d]);
                for (int d = 0; d < 32; ++d) sacc += h2f(Q1[(size_t)qq * 1536 + 64 + d]) * h2f(KR[(size_t)k * 32 + d]);
                dbg_rec(ws, 20, db[e], sacc, 2e-2f); dbg_rec(ws, 41, db[e], 0.f, 1.0f); dbg_rec(ws, 42, sacc, 0.f, 1.0f); }
            (void)0;
        }
        return;
    }
    if (stage == 9) {
        if (gid == 0) { const unsigned* e = (const unsigned*)(ws + WS_DBG);
            if (DBG_REPORT_ID >= 43 && DBG_REPORT_ID <= 45) { args.out[0] = 100.0f * (float)e[DBG_REPORT_ID] + 50.f; }
            else if (DBG_REPORT_ID == 40) { args.out[0] = 100.0f * (float)(e[40] / 32u) + 50.f; }
            else if (DBG_REPORT_ID > 0) { args.out[0] = 1000.0f * __uint_as_float(e[DBG_REPORT_ID]); }
            else if (DBG_BITS_MODE) { const int ids[6] = {DBG_BITS_IDS}; int v = 0; for (int i = 0; i < 6; ++i) if (ids[i] > 0 && __uint_as_float(e[ids[i]]) > 0.05f) v |= 1 << i; if (v) args.out[0] = 100.0f * v; }
            else { int first = 0; for (int id = 1; id < 32 && !first; ++id) if (!((DBG_SKIP_MASK >> id) & 1) && __uint_as_float(e[id]) > 0.05f) first = id; if (first) args.out[0] = 100.0f * first; } }
        return;
    }
}
#endif

constexpr int N_PHASES = 9;
__global__ void __launch_bounds__(NWAVES * 64) hybrid_fwd(Args args) {
    extern __shared__ __attribute__((aligned(16))) unsigned char lds_raw[];
    Frame F;
    F.lds = (LAS unsigned char*)lds_raw;
    F.MISC = (volatile LAS unsigned*)(F.lds + MISC_OFF);
    F.tid = threadIdx.x; F.lane = F.tid & 63; F.wave = __builtin_amdgcn_readfirstlane(F.tid >> 6);
    F.G = gridDim.x;
    F.out = args.out; F.ws = args.ws; F.ctl = (unsigned*)(args.ws + WS_CTL);
    for (int u = F.tid; u < (LDS_BYTES - RING_BYTES) / 4; u += NWAVES * 64) ((LAS unsigned*)(F.lds + RING_BYTES))[u] = 0u;
    __syncthreads();
    const int lo = args.ph_lo, hi = args.ph_hi;
    const bool multi = (hi - lo) > 1;
    XcdBarrier bar; bar.bar = F.ctl + CW_BAR; bar.x = 0; bar.st = nullptr;
    if (multi) bar = xcd_barrier_post(F.ctl + CW_BAR, F.MISC + 8);
#ifndef PH_MASK
#define PH_MASK 0x1FF
#endif
#define IN(k) (((PH_MASK >> (k)) & 1) && lo <= (k) && (k) < hi)
#define SEAM(k) do { if (IN(k) && IN((k) + 1)) xcd_barrier(bar); } while (0)
    unsigned char* ws = args.ws;
    LAS unsigned char* ring = F.lds;

#define PHASE1(rep) do { \
        pg8::Gemm g{(const u16*)(ws + WS_XN0), (const u16*)(ws + WS_W0T), T, P0W, 1024, 1024}; pg8::StaticOrder S; S.init(T, P0W, F.G, (int)blockIdx.x); \
        pg8::EpiProj0 E{(u16*)(ws + WS_PROJ0)}; \
        pg8::gemm_phase<pg8::EpiProj0>(ring, g, S, E); } while (0)
#define PHASE2(rep) do { if (!NAIVE_ATTN) { \
        for (;;) { \
            const int u = next_unit(F, (rep) ? CW_Q0 + 16 : CW_Q0); \
            if (u >= 2048) break; \
            const int lvl = 31 - (u >> 6), r = u & 63; \
            if (r < 32) { if (!((rep) && REPEAT_SUB == 1)) { const int c = 2 * lvl + 1 - (r >> 4), rr = r & 15; attnB_unit(F, rr >> 1, 2 * c + (rr & 1), (rep) ? REPEAT_SUB : 0); } } \
            else { if (!((rep) && REPEAT_SUB >= 2)) { const int idx = r - 32; attnA_unit(F, args, idx >> 2, idx & 3, lvl); } } \
        } \
        __syncthreads(); } } while (0)
#define PHASE3(rep) do { \
        pg8::Gemm g{(const u16*)(ws + WS_MG0), (const u16*)(ws + WS_WO0T), T, 1024, 1024, 1024}; pg8::StaticOrder S; S.init(T, 1024, F.G, (int)blockIdx.x); \
        pg8::EpiRes0 E{args.in[I_X], (u16*)(ws + WS_XN0), (rep) ? nullptr : (u64*)(ws + WS_SSQ1)}; \
        pg8::gemm_phase<pg8::EpiRes0>(ring, g, S, E); } while (0)
#define PHASE4(rep) do { \
        pg8::Gemm g{(const u16*)(ws + WS_XN0), (const u16*)(ws + WS_W1T), T, P1W, 1024, 1024}; pg8::StaticOrder S; S.init(T, P1W, F.G, (int)blockIdx.x); \
        pg8::EpiProj1 E{(const u64*)(ws + WS_SSQ1), (u16*)(ws + WS_LAT), (u16*)(ws + WS_KROPE), (u16*)(ws + WS_G1), (rep) ? nullptr : (u64*)(ws + WS_SSQKV), (rep) ? nullptr : (u64*)(ws + WS_SSQQ), (const float*)(ws + WS_ROPEC), (const float*)(ws + WS_ROPES)}; \
        pg8::gemm_phase<pg8::EpiProj1>(ring, g, S, E); } while (0)
#define PHASE5(rep) do { \
        { pg8::Gemm g{(const u16*)(ws + WS_LAT) + 256, (const u16*)(ws + WS_WUQT), T, 1536, 384, LATW}; pg8::StaticOrder S; S.init(T, 1536, F.G, (int)blockIdx.x); \
          pg8::EpiQ1 E{(const u64*)(ws + WS_SSQQ), (u16*)(ws + WS_Q1), (const float*)(ws + WS_ROPEC), (const float*)(ws + WS_ROPES)}; \
          pg8::gemm_phase<pg8::EpiQ1>(ring, g, S, E); } \
        { pg8::Gemm g{(const u16*)(ws + WS_LAT), (const u16*)(ws + WS_WUKVT), T, 2048, 256, LATW}; pg8::StaticOrder S; S.init(T, 2048, F.G, (int)blockIdx.x); \
          pg8::EpiKV1 E{(const u64*)(ws + WS_SSQKV), (u16*)(ws + WS_KV1)}; \
          pg8::gemm_phase<pg8::EpiKV1>(ring, g, S, E); } } while (0)
#define PHASE6(rep) do { if (!NAIVE_ATTN) { \
        for (;;) { \
            const int u = next_unit(F, (rep) ? CW_Q1 + 16 : CW_Q1); \
            if (u >= 2048) break; \
            const int qb = 15 - (u >> 7), r = u & 127; \
            attnC_unit(F, r >> 4, r & 15, qb); \
        } \
        __syncthreads(); } } while (0)
#define PHASE7(rep) do { \
        pg8::Gemm g{(const u16*)(ws + WS_MG1), (const u16*)(ws + WS_WO1T), T, 1024, 1024, 1024}; pg8::StaticOrder S; S.init(T, 1024, F.G, (int)blockIdx.x); \
        pg8::EpiRes1 E{(const u16*)(ws + WS_XN0), F.out}; \
        pg8::gemm_phase<pg8::EpiRes1>(ring, g, S, E); } while (0)
#define REPEAT(k, CALL) do { if (REPEAT_PHASE == (k) && multi) { xcd_barrier(bar); CALL; } } while (0)
    if (IN(0)) { p0_prologue(F, args); REPEAT(0, p0_prologue(F, args)); } SEAM(0);
    if (IN(1)) { PHASE1(0); REPEAT(1, PHASE1(1)); } SEAM(1);
    if (IN(2)) { PHASE2(0); REPEAT(2, PHASE2(1)); } SEAM(2);
    if (IN(3)) { PHASE3(0); REPEAT(3, PHASE3(1)); } SEAM(3);
    if (IN(4)) { PHASE4(0); REPEAT(4, PHASE4(1)); } SEAM(4);
    if (IN(5)) { PHASE5(0); REPEAT(5, PHASE5(1)); } SEAM(5);
    if (IN(6)) { PHASE6(0); REPEAT(6, PHASE6(1)); } SEAM(6);
    if (IN(7)) { PHASE7(0); } SEAM(7);
    if (IN(8)) { p8_final(F, args); }
#undef IN
#undef SEAM
}

extern "C" void kernel_launch(void* const* d_in, const int* in_sizes, int n_in, void* d_out, int out_size, void* d_ws, size_t ws_size, hipStream_t stream) {
    static int grid = 0;
    if (grid == 0) {
        if (n_in != 18 || in_sizes[0] != T * DM || out_size != T * DM || ws_size < WS_END) {
            fprintf(stderr, "kernel_launch: unexpected shapes (n_in %d, in0 %d, out %d, ws %zu, need %zu); nothing launched\n", n_in, n_in > 0 ? in_sizes[0] : -1, out_size, ws_size, (size_t)WS_END); grid = -1; return; }
        int dev = 0, cus = 0, per_cu = 0;
        if (hipGetDevice(&dev) != hipSuccess || hipDeviceGetAttribute(&cus, hipDeviceAttributeMultiprocessorCount, dev) != hipSuccess) { fprintf(stderr, "kernel_launch: device query failed\n"); grid = -1; return; }
        if (hipFuncSetAttribute((const void*)hybrid_fwd, hipFuncAttributeMaxDynamicSharedMemorySize, LDS_BYTES) != hipSuccess) { fprintf(stderr, "kernel_launch: hipFuncSetAttribute failed\n"); grid = -1; return; }
        if (hipOccupancyMaxActiveBlocksPerMultiprocessor(&per_cu, (const void*)hybrid_fwd, NWAVES * 64, LDS_BYTES) != hipSuccess || per_cu < 1)
            fprintf(stderr, "kernel_launch: note: occupancy query reports %d workgroups per CU\n", per_cu);
        (void)hipGetLastError();
        grid = cus;
        if (grid % 8 != 0) grid -= grid % 8;
    }
    if (grid <= 0) return;
    (void)hipMemsetAsync((char*)d_ws + WS_CTL, 0, CTL_ZERO_BYTES, stream);
    Args a{};
    for (int i = 0; i < 18; ++i) a.in[i] = (const float*)d_in[i];
    a.out = (float*)d_out; a.ws = (unsigned char*)d_ws;
#if MK_N_LAUNCHES == 1
    a.ph_lo = 0; a.ph_hi = N_PHASES;
    hipLaunchKernelGGL(hybrid_fwd, dim3(grid), dim3(NWAVES * 64), LDS_BYTES, stream, a);
#else
#if DEBUG_CHECK
    hipLaunchKernelGGL(dbg_check, dim3(1), dim3(256), 0, stream, a, 0);
#endif
    for (int p = 0; p < N_PHASES; ++p) { a.ph_lo = p; a.ph_hi = p + 1;
#if NAIVE_ATTN
        if (p == 2) { hipLaunchKernelGGL(naive_attn, dim3(8192), dim3(256), 0, stream, a, 0); continue; }
        if (p == 6) { hipLaunchKernelGGL(naive_attn, dim3(8192), dim3(256), 0, stream, a, 1); continue; }
#endif
        hipLaunchKernelGGL(hybrid_fwd, dim3(grid), dim3(NWAVES * 64), LDS_BYTES, stream, a);
#if DEBUG_CHECK
        if (p <= 6) hipLaunchKernelGGL(dbg_check, dim3((p == 2 || p == 6) ? 96 : 64), dim3(256), 0, stream, a, p + 1);
#endif
    }
#if DEBUG_CHECK
    hipLaunchKernelGGL(dbg_check, dim3(1), dim3(256), 0, stream, a, 9);
#endif
#endif
    const hipError_t le = hipPeekAtLastError();
    if (le != hipSuccess) fprintf(stderr, "kernel_launch: launch failed: %s\n", hipGetErrorName(le));
}
```

```cpp
#include <hip/hip_runtime.h>
#include <cstdio>
#include <cstdint>

#ifndef DEBUG_CHECK
#define DEBUG_CHECK 0
#endif
#define TAPB 3
#define TAPH 5
#define TAPQB 7
#ifndef REPEAT_PHASE
#define REPEAT_PHASE -1
#define REPEAT_SUB 0
#endif
#ifndef MK_N_LAUNCHES
#define MK_N_LAUNCHES 1
#endif

#define LAS __attribute__((address_space(3)))
#define GAS __attribute__((address_space(1)))
typedef unsigned short u16;
typedef unsigned long long u64;
typedef _Float16 h8 __attribute__((ext_vector_type(8)));
typedef _Float16 h2 __attribute__((ext_vector_type(2)));
typedef _Float16 h4 __attribute__((ext_vector_type(4)));
typedef short s16x4 __attribute__((ext_vector_type(4)));
typedef short s16x8 __attribute__((ext_vector_type(8)));
typedef float f32x2 __attribute__((ext_vector_type(2)));
typedef float f32x4 __attribute__((ext_vector_type(4)));
typedef float f32x16 __attribute__((ext_vector_type(16)));
typedef unsigned u32x2 __attribute__((ext_vector_type(2)));
typedef unsigned u32x4 __attribute__((ext_vector_type(4)));

constexpr int SEQ = 4096, NB = 8, T = NB * SEQ, DM = 1024;
constexpr int P0W = 3840;
constexpr int C_QA = 0, C_KA = 512, C_VA = 1024, C_QB = 1536, C_KB = 2048, C_VB = 2112, C_QI = 2176, C_KI = 2688, C_WI = 2752, C_G0 = 2816;
constexpr int L0_SRC = 3784;
constexpr int P1W = 1792;
constexpr int L1_SRC = 1696;
constexpr int LATW = 640;
constexpr int TOPK = 256;
constexpr float LOG2E = 1.4426950408889634f;
constexpr float QS_AB = 0.125f * LOG2E;
constexpr float QS_C = 0.10206207261596575f * LOG2E;
constexpr float RMS_EPS = 1e-6f;
constexpr float FXS = 1048576.0f;

constexpr size_t MiB = 1u << 20;
constexpr size_t WS_CTL = 0, CTL_ZERO_BYTES = 2 * MiB;
constexpr size_t WS_SSQ1 = 1 * MiB, WS_SSQKV = WS_SSQ1 + 256 * 1024, WS_SSQQ = WS_SSQKV + 256 * 1024;
constexpr size_t WS_ROPEC = 2 * MiB, WS_ROPES = WS_ROPEC + 256 * 1024, WS_BTG = WS_ROPES + 256 * 1024, WS_LAM = WS_BTG + 16 * 1024;
constexpr size_t WS_W0T = 4 * MiB;
constexpr size_t WS_WO0T = 12 * MiB;
constexpr size_t WS_W1T = 14 * MiB;
constexpr size_t WS_WUQT = 18 * MiB;
constexpr size_t WS_WUKVT = 20 * MiB;
constexpr size_t WS_WO1T = 22 * MiB;
constexpr size_t WS_XN0 = 32 * MiB;
constexpr size_t WS_PROJ0 = 96 * MiB;
constexpr size_t WS_MG0 = 336 * MiB;
constexpr size_t WS_LAT = 96 * MiB;
constexpr size_t WS_KROPE = 136 * MiB;
constexpr size_t WS_G1 = 140 * MiB;
constexpr size_t WS_Q1 = 204 * MiB;
constexpr size_t WS_KV1 = 300 * MiB;
constexpr size_t WS_MG1 = 428 * MiB;
constexpr size_t WS_END = 492 * MiB;
constexpr size_t WS_DBGBUF = 3 * MiB + 4096;
constexpr int CW_TMO = 0, CW_CODE = 1, CW_Q0 = 64, CW_Q1 = 128, CW_BAR = 4096;

constexpr int RING_BYTES = 131072;
constexpr int MISC_OFF = RING_BYTES + 320;
constexpr int LDS_BYTES = 147456;
constexpr int NWAVES = 8;

__device__ __forceinline__ unsigned pkh(float lo, float hi) { f32x2 v = {lo, hi}; h2 h = __builtin_convertvector(v, h2); return __builtin_bit_cast(unsigned, h); }
__device__ __forceinline__ float h2f(u16 b) { return (float)__builtin_bit_cast(_Float16, b); }
__device__ __forceinline__ float silu_f(float x) { return x * __builtin_amdgcn_rcpf(1.0f + __builtin_amdgcn_exp2f(-x * LOG2E)); }
__device__ __forceinline__ float swap_max(float m) { auto rr = __builtin_amdgcn_permlane32_swap(__float_as_uint(m), __float_as_uint(m), false, false); return fmaxf(__uint_as_float(rr[0]), __uint_as_float(rr[1])); }
__device__ __forceinline__ float swap_sum(float m) { auto rr = __builtin_amdgcn_permlane32_swap(__float_as_uint(m), __float_as_uint(m), false, false); return __uint_as_float(rr[0]) + __uint_as_float(rr[1]); }
__device__ __forceinline__ float wave_sum(float v) {
#pragma unroll
    for (int o = 1; o < 64; o <<= 1) v += __shfl_xor(v, o);
    return v;
}
#define LDS_WAIT() asm volatile("s_waitcnt lgkmcnt(0)" ::: "memory")
#define VM_WAIT() asm volatile("s_waitcnt vmcnt(0)" ::: "memory")

namespace pg8 {
constexpr int BM = 256, BK = 64, HALF = 128, HTB = HALF * BK * 2, STAGE_BYTES = 8 * HTB, NXCD = 8, WGM = 8;
__host__ __device__ __forceinline__ int lds_byte(int r, int c) { const int st = (r >> 4) * 2 + (c >> 5), rr = r & 15, cc = c & 31, ob = rr * 64 + cc * 2; return st * 1024 + (ob ^ (((ob >> 9) & 1) << 5)); }
__host__ __device__ __forceinline__ void stage_rc(int b, int& R, int& C) { const int st = b / 1024, sb = b % 1024, swz = sb ^ (((sb >> 9) & 1) << 5); R = (st >> 1) * 16 + swz / 64; C = (st & 1) * 32 + (swz % 64) / 2; }
__host__ __device__ __forceinline__ int perm32(int rho) { const int n = rho >> 4, i = rho & 15; return 8 * (i >> 2) + 4 * n + (i & 3); }
struct Unit { int pm, pn; };
struct Gemm { const u16* A; const u16* Bt; int M, N, K, lda; };
struct StaticOrder {
    int nM, nN, nwg, G, c;
    __device__ void init(int M, int N, int G_, int c_) { nM = M / BM; nN = N / BM; nwg = nM * nN; G = G_; c = c_; }
    __device__ bool next(int i, Unit& u) const {
        const long L = (long)i * G + c; if (L >= nwg) return false;
        int wgid = (int)L; { const int q = nwg / NXCD, r = nwg % NXCD, xcd = wgid % NXCD, off = wgid / NXCD; wgid = (xcd < r ? xcd * (q + 1) : r * (q + 1) + (xcd - r) * q) + off; }
        const int nig = WGM * nN, gid = wgid / nig, fm = gid * WGM, gsz = (nM - fm) < WGM ? (nM - fm) : WGM;
        u.pm = fm + ((wgid % nig) % gsz); u.pn = (wgid % nig) / gsz; return true;
    }
};
template <class Epi>
__device__ __forceinline__ void gemm_phase(LAS unsigned char* lds, const Gemm g, const StaticOrder& S, const Epi& E) {
    const int tid = threadIdx.x, wid = __builtin_amdgcn_readfirstlane(tid >> 6), lane = tid & 63, wr = wid >> 2, wc = wid & 3, fr = lane & 15, fq = lane >> 4;
    const int K = g.K, nt = K / BK, lda = g.lda;
    unsigned voffA[2], voffB[2];
#pragma unroll
    for (int i = 0; i < 2; ++i) { int R, C; stage_rc(tid * 16 + i * 8192, R, C); const int Rb = Epi::PERM ? ((R & ~31) + perm32(R & 31)) : R;
        voffA[i] = (unsigned)(R * lda + C) * 2u; voffB[i] = (unsigned)(Rb * K + C) * 2u; }
    const size_t kstep = (size_t)(BK * 2);
    const size_t hstepA = (size_t)HALF * lda * 2, tstepA = 2 * hstepA;
    const size_t hstepB = (size_t)HALF * K * 2, tstepB = 2 * hstepB;
    const unsigned ldsw = (unsigned)wid * 1024u;
    const int aoff = lds_byte(wr * 64 + fr, fq * 8), boff = lds_byte(wc * 32 + fr, fq * 8);
#define PG8_SA(b, h) (((b) * 2 + (h)) * HTB)
#define PG8_SB(b, h) ((4 + (b) * 2 + (h)) * HTB)
#define PG8_STAGE(bufoff, gbase, voff) do { _Pragma("unroll") for (int _i = 0; _i < 2; ++_i) \
        __builtin_amdgcn_global_load_lds((const unsigned*)((const char*)(gbase) + (voff)[_i]), (LAS unsigned*)(lds + (bufoff) + ldsw + _i * 8192), 16, 0, 0); } while (0)
#define PG8_LDA(dst, b, h) do { _Pragma("unroll") for (int m = 0; m < 4; ++m) _Pragma("unroll") for (int k = 0; k < 2; ++k) dst[m][k] = *(const LAS h8*)(lds + PG8_SA(b, h) + aoff + m * 2048 + k * 1024); } while (0)
#define PG8_LDB(dst, b, h) do { _Pragma("unroll") for (int n = 0; n < 2; ++n) _Pragma("unroll") for (int k = 0; k < 2; ++k) dst[n][k] = *(const LAS h8*)(lds + PG8_SB(b, h) + boff + n * 2048 + k * 1024); } while (0)
#define PG8_MMA(ai, bj, At, Bt) do { __builtin_amdgcn_s_setprio(1); _Pragma("unroll") for (int m = 0; m < 4; ++m) _Pragma("unroll") for (int n = 0; n < 2; ++n) _Pragma("unroll") for (int k = 0; k < 2; ++k) \
        acc[ai][bj][m][n] = __builtin_amdgcn_mfma_f32_16x16x32_f16(Bt[n][k], At[m][k], acc[ai][bj][m][n], 0, 0, 0); __builtin_amdgcn_s_setprio(0); } while (0)
#define PG8_WAIT_V(n) asm volatile("s_waitcnt vmcnt(" #n ")" ::: "memory")
#define PG8_WAIT_L(n) asm volatile("s_waitcnt lgkmcnt(" #n ")" ::: "memory")
#define PG8_BAR __builtin_amdgcn_s_barrier()
#define PG8_SCHED __builtin_amdgcn_sched_barrier(0)
    Unit cur, nxt; int ui = 0;
    if (!S.next(0, cur)) return;
    f32x4 acc[2][2][4][2];
#pragma unroll
    for (int a = 0; a < 2; ++a)
#pragma unroll
        for (int b = 0; b < 2; ++b)
#pragma unroll
            for (int m = 0; m < 4; ++m)
#pragma unroll
                for (int n = 0; n < 2; ++n) acc[a][b][m][n] = (f32x4){0.f, 0.f, 0.f, 0.f};
    h8 At[4][2], B0[2][2], B1[2][2];
    const char* cA = (const char*)g.A + (size_t)cur.pm * tstepA; const char* cB = (const char*)g.Bt + (size_t)cur.pn * tstepB;
    PG8_STAGE(PG8_SB(0, 0), cB, voffB); PG8_STAGE(PG8_SB(0, 1), cB + hstepB, voffB); PG8_STAGE(PG8_SA(0, 0), cA, voffA); PG8_STAGE(PG8_SA(0, 1), cA + hstepA, voffA);
    if (wr == 1) PG8_BAR;
    PG8_WAIT_V(2); PG8_BAR;
    PG8_STAGE(PG8_SB(1, 0), cB + kstep, voffB); PG8_STAGE(PG8_SA(1, 0), cA + kstep, voffA); PG8_STAGE(PG8_SB(1, 1), cB + hstepB + kstep, voffB);
    PG8_WAIT_V(6); PG8_BAR;
    for (;;) {
        const bool has_next = S.next(ui + 1, nxt);
        const char* nA = has_next ? (const char*)g.A + (size_t)nxt.pm * tstepA : cA; const char* nB = has_next ? (const char*)g.Bt + (size_t)nxt.pn * tstepB : cB;
#pragma unroll 1
        for (int t = 0; t < nt; t += 2) {
            const bool last = (t == nt - 2);
            const char* a1 = cA + (size_t)(t + 1) * kstep;
            const char* a2 = last ? nA : cA + (size_t)(t + 2) * kstep; const char* b2 = last ? nB : cB + (size_t)(t + 2) * kstep;
            const char* a3 = a2 + kstep; const char* b3 = b2 + kstep;
            PG8_LDB(B0, 0, 0); PG8_LDB(B1, 0, 1); PG8_SCHED; PG8_LDA(At, 0, 0); PG8_STAGE(PG8_SA(1, 1), a1 + hstepA, voffA);
            PG8_WAIT_V(8); PG8_WAIT_L(0); PG8_BAR; PG8_MMA(0, 0, At, B0); PG8_MMA(0, 1, At, B1); PG8_BAR; PG8_SCHED;
            PG8_LDA(At, 0, 1); PG8_STAGE(PG8_SB(0, 0), b2, voffB); PG8_STAGE(PG8_SB(0, 1), b2 + hstepB, voffB); PG8_STAGE(PG8_SA(0, 0), a2, voffA);
            PG8_WAIT_V(8); PG8_WAIT_L(0); PG8_BAR; PG8_MMA(1, 0, At, B0); PG8_MMA(1, 1, At, B1); PG8_BAR; PG8_SCHED;
            PG8_LDB(B0, 1, 0); PG8_LDB(B1, 1, 1); PG8_SCHED; PG8_LDA(At, 1, 0); PG8_STAGE(PG8_SA(0, 1), a2 + hstepA, voffA);
            PG8_WAIT_V(8); PG8_WAIT_L(0); PG8_BAR; PG8_MMA(0, 0, At, B0); PG8_MMA(0, 1, At, B1); PG8_BAR; PG8_SCHED;
            PG8_LDA(At, 1, 1); PG8_STAGE(PG8_SB(1, 0), b3, voffB); PG8_STAGE(PG8_SB(1, 1), b3 + hstepB, voffB); PG8_STAGE(PG8_SA(1, 0), a3, voffA);
            PG8_WAIT_V(8); PG8_WAIT_L(0); PG8_BAR; PG8_MMA(1, 0, At, B0); PG8_MMA(1, 1, At, B1); PG8_BAR; PG8_SCHED;
        }
        if (wr == 0) PG8_BAR;
        E(acc, cur, wr, wc, fr, fq);
        if (!has_next) break;
#pragma unroll
        for (int a = 0; a < 2; ++a)
#pragma unroll
            for (int b = 0; b < 2; ++b)
#pragma unroll
                for (int m = 0; m < 4; ++m)
#pragma unroll
                    for (int n = 0; n < 2; ++n) acc[a][b][m][n] = (f32x4){0.f, 0.f, 0.f, 0.f};
        cur = nxt; cA = nA; cB = nB; ++ui;
        if (wr == 1) PG8_BAR;
    }
    PG8_WAIT_V(0);
    PG8_BAR;
#undef PG8_SA
#undef PG8_SB
#undef PG8_STAGE
#undef PG8_LDA
#undef PG8_LDB
#undef PG8_MMA
#undef PG8_WAIT_V
#undef PG8_WAIT_L
#undef PG8_BAR
#undef PG8_SCHED
}

typedef f32x4 Acc[2][2][4][2];
__device__ __forceinline__ float rstd_from(const u64* ssq, int row, float inv_n) { return __builtin_amdgcn_rsqf((float)ssq[row] * (1.0f / FXS) * inv_n + RMS_EPS); }
__device__ __forceinline__ void ssq_add(u64* ssq, int row, float ss, int fq) {
    ss += __shfl_xor(ss, 16); ss += __shfl_xor(ss, 32);
    if (fq == 0) atomicAdd((unsigned long long*)(ssq + row), (unsigned long long)(ss * FXS + 0.5f));
}
struct EpiProj0 {
    static constexpr bool PERM = true;
    u16* O;
    __device__ __forceinline__ void operator()(const Acc& acc, const Unit& u, int wr, int wc, int fr, int fq) const {
        const int row0 = u.pm * BM + wr * 64 + fr, col0 = u.pn * BM + wc * 32 + 8 * fq; const bool gate = u.pn >= 11;
#pragma unroll
        for (int ai = 0; ai < 2; ++ai)
#pragma unroll
            for (int m = 0; m < 4; ++m) { u16* rowp = O + (size_t)(row0 + ai * HALF + m * 16) * P0W + col0;
#pragma unroll
                for (int bj = 0; bj < 2; ++bj) { f32x4 v0 = acc[ai][bj][m][0], v1 = acc[ai][bj][m][1];
                    if (gate) {
#pragma unroll
                        for (int e = 0; e < 4; ++e) { v0[e] = silu_f(v0[e]); v1[e] = silu_f(v1[e]); } }
                    u32x4 w; w.x = pkh(v0[0], v0[1]); w.y = pkh(v0[2], v0[3]); w.z = pkh(v1[0], v1[1]); w.w = pkh(v1[2], v1[3]);
                    *(u32x4*)(rowp + bj * HALF) = w; } }
    }
};
struct EpiRes0 {
    static constexpr bool PERM = false;
    const float* base; u16* outh; u64* ssq;
    __device__ __forceinline__ void operator()(const Acc& acc, const Unit& u, int wr, int wc, int fr, int fq) const {
        const int row0 = u.pm * BM + wr * 64 + fr, col0 = u.pn * BM + wc * 32 + 4 * fq;
#pragma unroll
        for (int ai = 0; ai < 2; ++ai)
#pragma unroll
            for (int m = 0; m < 4; ++m) { const int row = row0 + ai * HALF + m * 16; const size_t off = (size_t)row * DM + col0; float ss = 0.f;
#pragma unroll
                for (int bj = 0; bj < 2; ++bj)
#pragma unroll
                    for (int n = 0; n < 2; ++n) { const f32x4 bs = *(const f32x4*)(base + off + bj * HALF + n * 16); const f32x4 o = bs + acc[ai][bj][m][n];
                        u32x2 w; w.x = pkh(o[0], o[1]); w.y = pkh(o[2], o[3]); *(u32x2*)(outh + off + bj * HALF + n * 16) = w;
                        ss += (o[0] * o[0] + o[1] * o[1]) + (o[2] * o[2] + o[3] * o[3]); }
                if (ssq) ssq_add(ssq, row, ss, fq); }
    }
};
struct EpiRes1 {
    static constexpr bool PERM = false;
    const u16* baseh; float* out;
    __device__ __forceinline__ void operator()(const Acc& acc, const Unit& u, int wr, int wc, int fr, int fq) const {
        const int row0 = u.pm * BM + wr * 64 + fr, col0 = u.pn * BM + wc * 32 + 4 * fq;
#pragma unroll
        for (int ai = 0; ai < 2; ++ai)
#pragma unroll
            for (int m = 0; m < 4; ++m) { const int row = row0 + ai * HALF + m * 16; const size_t off = (size_t)row * DM + col0;
#pragma unroll
                for (int bj = 0; bj < 2; ++bj)
#pragma unroll
                    for (int n = 0; n < 2; ++n) { const h4 bh = *(const h4*)(baseh + off + bj * HALF + n * 16);
                        f32x4 o = acc[ai][bj][m][n]; o[0] += (float)bh[0]; o[1] += (float)bh[1]; o[2] += (float)bh[2]; o[3] += (float)bh[3];
                        *(f32x4*)(out + off + bj * HALF + n * 16) = o; } }
    }
};
struct EpiProj1 {
    static constexpr bool PERM = false;
    const u64* ssq1; u16* lat; u16* krope; u16* g1; u64* ssqkv; u64* ssqq; const float* ropec; const float* ropes;
    __device__ __forceinline__ void operator()(const Acc& acc, const Unit& u, int wr, int wc, int fr, int fq) const {
        const int row0 = u.pm * BM + wr * 64 + fr, pn = u.pn;
#pragma unroll
        for (int ai = 0; ai < 2; ++ai)
#pragma unroll
            for (int m = 0; m < 4; ++m) { const int row = row0 + ai * HALF + m * 16; const float rs = rstd_from(ssq1, row, 1.0f / 1024.0f); float ss = 0.f;
#pragma unroll
                for (int bj = 0; bj < 2; ++bj) { f32x4 v0 = acc[ai][bj][m][0] * rs, v1 = acc[ai][bj][m][1] * rs;
                    const int tc = bj * HALF + wc * 32 + 4 * fq;
                    if (pn >= 3) {
#pragma unroll
                        for (int e = 0; e < 4; ++e) { v0[e] = silu_f(v0[e]); v1[e] = silu_f(v1[e]); }
                        u16* p = g1 + (size_t)row * DM + (pn - 3) * BM + tc;
                        u32x2 w0, w1; w0.x = pkh(v0[0], v0[1]); w0.y = pkh(v0[2], v0[3]); w1.x = pkh(v1[0], v1[1]); w1.y = pkh(v1[2], v1[3]);
                        *(u32x2*)p = w0; *(u32x2*)(p + 16) = w1;
                    } else if (pn < 2 || bj == 0) {
                        u16* p = lat + (size_t)row * LATW + pn * BM + tc;
                        u32x2 w0, w1; w0.x = pkh(v0[0], v0[1]); w0.y = pkh(v0[2], v0[3]); w1.x = pkh(v1[0], v1[1]); w1.y = pkh(v1[2], v1[3]);
                        *(u32x2*)p = w0; *(u32x2*)(p + 16) = w1;
                        ss += (v0[0] * v0[0] + v0[1] * v0[1]) + (v0[2] * v0[2] + v0[3] * v0[3]) + (v1[0] * v1[0] + v1[1] * v1[1]) + (v1[2] * v1[2] + v1[3] * v1[3]);
                    } else if (wc == 0) {
                        const int pos = row & (SEQ - 1); const f32x4 cs = *(const f32x4*)(ropec + pos * 16 + 4 * fq), sn = *(const f32x4*)(ropes + pos * 16 + 4 * fq);
                        const f32x4 o0 = v0 * cs - v1 * sn, o1 = v0 * sn + v1 * cs;
                        u16* p = krope + (size_t)row * 32 + 4 * fq;
                        u32x2 w0, w1; w0.x = pkh(o0[0], o0[1]); w0.y = pkh(o0[2], o0[3]); w1.x = pkh(o1[0], o1[1]); w1.y = pkh(o1[2], o1[3]);
                        *(u32x2*)p = w0; *(u32x2*)(p + 16) = w1;
                    } }
                if (pn == 0) { if (ssqkv) ssq_add(ssqkv, row, ss, fq); } else if (pn <= 2) { if (ssqq) ssq_add(ssqq, row, ss, fq); }
                asm volatile("" ::: "memory"); }
    }
};
struct EpiQ1 {
    static constexpr bool PERM = false;
    const u64* ssqq; u16* q1; const float* ropec; const float* ropes;
    __device__ __forceinline__ void operator()(const Acc& acc, const Unit& u, int wr, int wc, int fr, int fq) const {
        const int row0 = u.pm * BM + wr * 64 + fr;
#pragma unroll
        for (int ai = 0; ai < 2; ++ai)
#pragma unroll
            for (int m = 0; m < 4; ++m) { const int row = row0 + ai * HALF + m * 16; const float rs = rstd_from(ssqq, row, 1.0f / 384.0f);
#pragma unroll
                for (int bj = 0; bj < 2; ++bj) { f32x4 v0 = acc[ai][bj][m][0] * rs, v1 = acc[ai][bj][m][1] * rs;
                    const int g0 = u.pn * BM + bj * HALF + wc * 32;
                    if ((g0 % 96) == 64) { const int pos = row & (SEQ - 1); const f32x4 cs = *(const f32x4*)(ropec + pos * 16 + 4 * fq), sn = *(const f32x4*)(ropes + pos * 16 + 4 * fq);
                        const f32x4 o0 = v0 * cs - v1 * sn, o1 = v0 * sn + v1 * cs; v0 = o0; v1 = o1; }
                    u16* p = q1 + (size_t)row * 1536 + g0 + 4 * fq;
                    u32x2 w0, w1; w0.x = pkh(v0[0], v0[1]); w0.y = pkh(v0[2], v0[3]); w1.x = pkh(v1[0], v1[1]); w1.y = pkh(v1[2], v1[3]);
                    *(u32x2*)p = w0; *(u32x2*)(p + 16) = w1; }
                asm volatile("" ::: "memory"); }
    }
};
struct EpiKV1 {
    static constexpr bool PERM = true;
    const u64* ssqkv; u16* kv1;
    __device__ __forceinline__ void operator()(const Acc& acc, const Unit& u, int wr, int wc, int fr, int fq) const {
        const int row0 = u.pm * BM + wr * 64 + fr, col0 = u.pn * BM + wc * 32 + 8 * fq;
#pragma unroll
        for (int ai = 0; ai < 2; ++ai)
#pragma unroll
            for (int m = 0; m < 4; ++m) { const int row = row0 + ai * HALF + m * 16; const float rs = rstd_from(ssqkv, row, 1.0f / 256.0f); u16* rowp = kv1 + (size_t)row * 2048 + col0;
#pragma unroll
                for (int bj = 0; bj < 2; ++bj) { const f32x4 v0 = acc[ai][bj][m][0] * rs, v1 = acc[ai][bj][m][1] * rs;
                    u32x4 w; w.x = pkh(v0[0], v0[1]); w.y = pkh(v0[2], v0[3]); w.z = pkh(v1[0], v1[1]); w.w = pkh(v1[2], v1[3]);
                    *(u32x4*)(rowp + bj * HALF) = w; }
                if (m & 1) asm volatile("" ::: "memory"); }
    }
};
}

#define XB_TMO      128
#define XB_XCNT(j)  (256  + 64 * (j))
#define XB_XSUB(j)  (1280 + 64 * (j))
#define XB_XGEN(j)  (2304 + 64 * (j))
#define XB_TOP      3328
#define XB_TOPGEN   3392
#define XCD_BAR_WORDS 3456
#define XB_SPIN_CAP (1u << 20)
__device__ __forceinline__ unsigned xb_ld(unsigned* p)              { return __hip_atomic_load(p, __ATOMIC_RELAXED, __HIP_MEMORY_SCOPE_AGENT); }
__device__ __forceinline__ unsigned xb_add(unsigned* p, unsigned v) { return __hip_atomic_fetch_add(p, v, __ATOMIC_RELAXED, __HIP_MEMORY_SCOPE_AGENT); }
__device__ __forceinline__ unsigned xb_xcc_id() { return (unsigned)__builtin_amdgcn_s_getreg((3 << 11) | 20) & 0xFu; }
#define XB_SPIN(cond, bar) do { unsigned _sp = 0; while (cond) { __builtin_amdgcn_s_sleep(1); \
    if ((++_sp & 255u) == 0u) { if (xb_ld(&(bar)[XB_TMO])) break; if (_sp > XB_SPIN_CAP) { atomicAdd(&(bar)[XB_TMO], 1u); break; } } } } while (0)
struct XcdBarrier { unsigned* bar; unsigned x; volatile LAS unsigned* st; };
__device__ __forceinline__ XcdBarrier xcd_barrier_post(unsigned* bar, volatile LAS unsigned* st) {
    XcdBarrier b; b.bar = bar; b.x = xb_xcc_id(); b.st = st;
    if (threadIdx.x == 0) (void)xb_add(&bar[XB_XCNT(b.x)], 1u);
    return b;
}
__device__ __forceinline__ void xcd_barrier_complete(unsigned* bar, unsigned x, unsigned& nloc, unsigned& nx) {
    const unsigned G = gridDim.x * gridDim.y * gridDim.z;
    unsigned sum, cnt, mine, sp = 0u;
    for (;;) {
        sum = 0u; cnt = 0u; mine = 0u;
#pragma unroll
        for (unsigned j = 0; j < 16; ++j) { const unsigned c = xb_ld(&bar[XB_XCNT(j)]); sum += c; cnt += (c > 0u) ? 1u : 0u; mine = (j == x) ? c : mine; }
        if (sum == G) break;
        __builtin_amdgcn_s_sleep(1);
        if ((++sp & 255u) == 0u) { if (xb_ld(&bar[XB_TMO])) break; if (sp > XB_SPIN_CAP) { atomicAdd(&bar[XB_TMO], 1u); break; } }
    }
    nloc = mine > 0u ? mine : 1u; nx = cnt > 0u ? cnt : 1u;
}
__device__ __forceinline__ void xcd_barrier(const XcdBarrier& b) {
    asm volatile("s_waitcnt vmcnt(0)" ::: "memory");
    __syncthreads();
    if (threadIdx.x == 0) {
        unsigned* bar = b.bar;
        __builtin_amdgcn_s_waitcnt(0);
        unsigned nloc = b.st[0], nx = b.st[1];
        if (nloc == 0u) { xcd_barrier_complete(bar, b.x, nloc, nx); b.st[0] = nloc; b.st[1] = nx; }
        const unsigned old = xb_add(&bar[XB_XSUB(b.x)], 1u);
        const unsigned gen = old / nloc;
        if (old + 1u == (gen + 1u) * nloc) {
            __builtin_amdgcn_fence(__ATOMIC_RELEASE, "agent");
            asm volatile("s_waitcnt vmcnt(0)" ::: "memory");
            const unsigned og = xb_add(&bar[XB_TOP], 1u);
            const unsigned tg = og / nx;
            if (og + 1u == (tg + 1u) * nx) xb_add(&bar[XB_TOPGEN], 1u);
            else XB_SPIN(xb_ld(&bar[XB_TOPGEN]) == tg, bar);
            __builtin_amdgcn_fence(__ATOMIC_ACQUIRE, "agent");
            xb_add(&bar[XB_XGEN(b.x)], 1u);
            asm volatile("s_waitcnt vmcnt(0)" ::: "memory");
        } else {
            XB_SPIN(xb_ld(&bar[XB_XGEN(b.x)]) == gen, bar);
            __builtin_amdgcn_fence(__ATOMIC_ACQUIRE, "agent");
            asm volatile("s_waitcnt vmcnt(0)" ::: "memory");
        }
    }
    __syncthreads();
}

struct Args { const float* in[18]; float* out; unsigned char* ws; int ph_lo, ph_hi; };
struct Frame {
    LAS unsigned char* lds;
    volatile LAS unsigned* MISC;
    unsigned* ctl;
    int tid, lane, wave, G;
    float* out;
    unsigned char* ws;
};
enum { I_X = 0, I_RELB, I_ENORM, I_EWIN, I_LQ1, I_LK1, I_LQ2, I_LK2, I_SUBLN, I_EWO, I_ONORM, I_OWIN, I_OQNORM, I_OWUQ, I_OKVNORM, I_OWUKV, I_OWO, I_FNORM };

__device__ __forceinline__ int t5_bucket(int rel) {
    const int n = rel < 0 ? -rel : rel;
    const int v = n < 8 ? n : n < 12 ? 8 : n < 16 ? 9 : n < 23 ? 10 : n < 32 ? 11 : n < 46 ? 12 : n < 64 ? 13 : n < 91 ? 14 : 15;
    return (rel > 0 ? 16 : 0) + v;
}

__device__ __forceinline__ int wsrc_col(int mat, int n) {
    switch (mat) {
        case 0: return n < 2760 ? n : (n < C_G0 ? -1 : n - 56);
        case 2: return n < 256 ? 384 + n : (n < 640 ? n - 256 : (n < 672 ? n : (n < 768 ? -1 : n - 96)));
        default: return n;
    }
}
__device__ __forceinline__ float wcol_scale(int mat, int n) {
    if (mat == 0) return (n < 512 || (n >= C_QB && n < C_QB + 512)) ? QS_AB : 1.0f;
    if (mat == 3) return QS_C;
    return 1.0f;
}
__device__ __forceinline__ void p0_transpose_item(const float* W, int K, int Nsrc, int Npad, const float* gain, int mat, u16* WT, LAS float* scr, int item, int lane) {
    const int nblk = Npad / 32, kb = item / nblk, nb = item % nblk, k0 = 64 * kb, n0 = 32 * nb;
    const int n = n0 + (lane & 31); const int sc = wsrc_col(mat, n); const float cs = wcol_scale(mat, n);
#pragma unroll 8
    for (int i = 0; i < 32; ++i) { const int kk = 2 * i + (lane >> 5); float v = 0.f;
        if (sc >= 0) { v = W[(size_t)(k0 + kk) * Nsrc + sc] * cs; if (gain) v *= gain[k0 + kk]; }
        scr[kk * 33 + (lane & 31)] = v; }
    LDS_WAIT(); asm volatile("" ::: "memory");
    const int c = lane & 7;
#pragma unroll
    for (int j = 0; j < 4; ++j) { const int nn = (lane >> 3) + 8 * j; const LAS float* s = scr + (8 * c) * 33 + nn;
        u32x4 o; o.x = pkh(s[0 * 33], s[1 * 33]); o.y = pkh(s[2 * 33], s[3 * 33]); o.z = pkh(s[4 * 33], s[5 * 33]); o.w = pkh(s[6 * 33], s[7 * 33]);
        *(u32x4*)(WT + (size_t)(n0 + nn) * K + k0 + 8 * c) = o; }
    LDS_WAIT(); asm volatile("" ::: "memory");
}
__device__ __forceinline__ void p0_prologue(Frame& F, const Args& AR) {
    LAS float* scr = (LAS float*)(F.lds + F.wave * 16384);
    const int gw = blockIdx.x * NWAVES + F.wave, NGW = F.G * NWAVES;
    unsigned char* ws = F.ws;
    constexpr int I0 = (1024 / 64) * (P0W / 32), I1 = (1024 / 64) * (1024 / 32), I2 = (1024 / 64) * (P1W / 32), I3 = (384 / 64) * (1536 / 32), I4 = (256 / 64) * (2048 / 32), I5 = I1;
    constexpr int NITEMS = I0 + I1 + I2 + I3 + I4 + I5;
    for (int it = gw; it < NITEMS; it += NGW) {
        int r = it;
        if (r < I0) { p0_transpose_item(AR.in[I_EWIN], 1024, L0_SRC, P0W, nullptr, 0, (u16*)(ws + WS_W0T), scr, r, F.lane); continue; } r -= I0;
        if (r < I1) { p0_transpose_item(AR.in[I_EWO], 1024, 1024, 1024, nullptr, 1, (u16*)(ws + WS_WO0T), scr, r, F.lane); continue; } r -= I1;
        if (r < I2) { p0_transpose_item(AR.in[I_OWIN], 1024, L1_SRC, P1W, AR.in[I_ONORM], 2, (u16*)(ws + WS_W1T), scr, r, F.lane); continue; } r -= I2;
        if (r < I3) { p0_transpose_item(AR.in[I_OWUQ], 384, 1536, 1536, AR.in[I_OQNORM], 3, (u16*)(ws + WS_WUQT), scr, r, F.lane); continue; } r -= I3;
        if (r < I4) { p0_transpose_item(AR.in[I_OWUKV], 256, 2048, 2048, AR.in[I_OKVNORM], 4, (u16*)(ws + WS_WUKVT), scr, r, F.lane); continue; } r -= I4;
        p0_transpose_item(AR.in[I_OWO], 1024, 1024, 1024, nullptr, 5, (u16*)(ws + WS_WO1T), scr, r, F.lane);
    }
    {
        const float* gn = AR.in[I_ENORM]; f32x4 gv[4];
#pragma unroll
        for (int j = 0; j < 4; ++j) gv[j] = *(const f32x4*)(gn + 4 * F.lane + 256 * j);
        u16* XN = (u16*)(ws + WS_XN0);
        for (int mrow = gw; mrow < T; mrow += NGW) {
            const f32x4* xr = (const f32x4*)(AR.in[I_X] + (size_t)mrow * DM) + F.lane;
            f32x4 v[4]; float s = 0.f;
#pragma unroll
            for (int j = 0; j < 4; ++j) { v[j] = xr[64 * j]; s += (v[j].x * v[j].x + v[j].y * v[j].y) + (v[j].z * v[j].z + v[j].w * v[j].w); }
            const float rstd = __builtin_amdgcn_rsqf(wave_sum(s) * (1.f / DM) + RMS_EPS);
            u32x2* o8 = (u32x2*)(XN + (size_t)mrow * DM) + F.lane;
#pragma unroll
            for (int j = 0; j < 4; ++j) { const f32x4 t = v[j] * rstd * gv[j]; u32x2 w; w.x = pkh(t.x, t.y); w.y = pkh(t.z, t.w); o8[64 * j] = w; }
        }
    }
    {
        float* rc = (float*)(ws + WS_ROPEC); float* rs = (float*)(ws + WS_ROPES);
        const int gt = blockIdx.x * 512 + F.tid, NGT = F.G * 512;
        for (int e = gt; e < SEQ * 16; e += NGT) { const int pos = e >> 4, i = e & 15;
            const float inv = (float)pow(10000.0, -(double)i / 16.0); const float ang = (float)pos * inv;
            rc[e] = (float)cos((double)ang); rs[e] = (float)sin((double)ang); }
        float* bt = (float*)(ws + WS_BTG);
        for (int e = gt; e < 12 * 192; e += NGT) { const int hd = e / 192, idx = e % 192; const int rel = idx - 128;
            bt[e] = AR.in[I_RELB][t5_bucket(rel) * 12 + hd] * LOG2E; }
        if (blockIdx.x == 0 && F.wave == 0) {
            const float a = wave_sum(AR.in[I_LQ1][F.lane] * AR.in[I_LK1][F.lane]), b = wave_sum(AR.in[I_LQ2][F.lane] * AR.in[I_LK2][F.lane]);
            if (F.lane == 0) *(float*)(ws + WS_LAM) = expf(a) - expf(b) + 0.2f;
        }
    }
}

__device__ __forceinline__ h8 tr2(LAS const unsigned char* p0, LAS const unsigned char* p1) {
    const s16x4 lo = __builtin_amdgcn_ds_read_tr16_b64_v4i16((LAS s16x4*)p0), hi = __builtin_amdgcn_ds_read_tr16_b64_v4i16((LAS s16x4*)p1);
    const s16x8 v = __builtin_shufflevector(lo, hi, 0, 1, 2, 3, 4, 5, 6, 7); return __builtin_bit_cast(h8, v);
}
constexpr float SM_THR = 8.0f;
template <int ND, bool MASKED>
__device__ __forceinline__ void softmax_step(f32x16& p0, f32x16& p1, float& mref, float& lrun, bool& have, f32x16 (&o)[ND], h8 (&pf)[4]) {
    float mx = fmaxf(fmaxf(p0[0], p1[0]), fmaxf(p0[1], p1[1]));
#pragma unroll
    for (int r = 2; r < 16; r += 2) mx = fmaxf(mx, fmaxf(fmaxf(p0[r], p1[r]), fmaxf(p0[r + 1], p1[r + 1])));
    mx = swap_max(mx);
    const bool valid = MASKED ? (mx > -1e29f) : true;
    const bool trig = valid && (!have || mx > SM_THR);
    if (__any(trig)) {
        const float dl = valid ? (have ? fmaxf(mx, 0.f) : mx) : 0.f;
        have = have || valid;
        mref += dl;
        const float alpha = __builtin_amdgcn_exp2f(-dl);
        lrun *= alpha;
#pragma unroll
        for (int r = 0; r < 16; ++r) { p0[r] -= dl; p1[r] -= dl; }
#pragma unroll
        for (int d = 0; d < ND; ++d)
#pragma unroll
            for (int r = 0; r < 16; ++r) o[d][r] *= alpha;
    }
    float s0 = 0.f, s1 = 0.f;
#pragma unroll
    for (int r = 0; r < 16; ++r) { p0[r] = __builtin_amdgcn_exp2f(p0[r]); p1[r] = __builtin_amdgcn_exp2f(p1[r]); s0 += p0[r]; s1 += p1[r]; }
    lrun += s0 + s1;
#pragma unroll
    for (int ks = 0; ks < 4; ++ks) {
        u32x4 w;
        if (ks < 2) { w.x = pkh(p0[8 * ks + 0], p0[8 * ks + 1]); w.y = pkh(p0[8 * ks + 2], p0[8 * ks + 3]); w.z = pkh(p0[8 * ks + 4], p0[8 * ks + 5]); w.w = pkh(p0[8 * ks + 6], p0[8 * ks + 7]); }
        else { const int k2 = ks - 2; w.x = pkh(p1[8 * k2 + 0], p1[8 * k2 + 1]); w.y = pkh(p1[8 * k2 + 2], p1[8 * k2 + 3]); w.z = pkh(p1[8 * k2 + 4], p1[8 * k2 + 5]); w.w = pkh(p1[8 * k2 + 6], p1[8 * k2 + 7]); }
        pf[ks] = __builtin_bit_cast(h8, w);
    }
}
__device__ __forceinline__ void add_bias(f32x16& p0, f32x16& p1, const LAS float* bt, int idx0) {
#pragma unroll
    for (int r = 0; r < 16; ++r) { const int c = (r & 3) + 8 * (r >> 2);
        const int i0 = idx0 + c, i1 = idx0 + 32 + c;
        p0[r] += bt[i0 < 0 ? 0 : i0]; p1[r] += bt[i1 < 0 ? 0 : i1]; }
}
__device__ __forceinline__ int next_unit(Frame& F, int cw) {
    volatile LAS unsigned* slot = F.MISC + 16;
    __syncthreads();
    if (F.tid == 0) slot[0] = __hip_atomic_fetch_add(F.ctl + cw, 1u, __ATOMIC_RELAXED, __HIP_MEMORY_SCOPE_AGENT);
    __syncthreads();
    return (int)slot[0];
}

__device__ __forceinline__ void attnA_unit(Frame& F, const Args& AR, int b, int h, int qb) {
    LAS unsigned char* lds = F.lds;
    int tid = F.tid; asm volatile("" : "+v"(tid)); int wid = F.wave; asm volatile("" : "+s"(wid));
    const int lane = tid & 63, r32 = lane & 31, hi = lane >> 5;
    const int m = wid & 1, qsub = wid >> 1, q0 = 128 * qb + 32 * qsub, cw = q0 >> 6, nt = 2 * qb + 2;
    const size_t rowb = (size_t)b * SEQ;
    const u16* P0 = (const u16*)(F.ws + WS_PROJ0);
    LAS float* bt = (LAS float*)(lds + 65536);
    if (tid < 192) bt[tid] = ((const float*)(F.ws + WS_BTG))[h * 192 + tid];
    h8 qf[4];
    { const u16* qp = P0 + (rowb + q0 + r32) * P0W + C_QA + h * 128 + m * 64 + hi * 8;
#pragma unroll
      for (int d0 = 0; d0 < 4; ++d0) qf[d0] = *(const h8*)(qp + d0 * 16); }
    f32x16 o[4];
#pragma unroll
    for (int d = 0; d < 4; ++d)
#pragma unroll
        for (int r = 0; r < 16; ++r) o[d][r] = 0.f;
    float mrun = 0.f, lrun = 0.f; bool have = false;
    const int krow = tid >> 3, kch = tid & 7, vrow = tid >> 4, vch = tid & 15;
    const u16* ksrc = P0 + (rowb + krow) * P0W + C_KA + h * 128 + kch * 8;
    const u16* vsrc = P0 + (rowb + vrow) * P0W + C_VA + h * 128 + vch * 8;
    const int kdst = krow * 128 + ((kch ^ ((krow >> 1) & 7)) << 4);
    const int vdst = 16384 + vrow * 256 + ((vch ^ ((vrow & 3) << 2)) << 4);
    u32x4 st0, st1, st2, st3;
#define A_LOAD(t) do { const size_t to = (size_t)(t) * 64 * P0W; st0 = *(const u32x4*)(ksrc + to); st1 = *(const u32x4*)(ksrc + to + 64); st2 = *(const u32x4*)(vsrc + to); st3 = *(const u32x4*)(vsrc + to + (size_t)32 * P0W); } while (0)
#define A_WRITE(s) do { LAS unsigned char* sb = lds + (s) * 32768; *(LAS u32x4*)(sb + kdst) = st0; *(LAS u32x4*)(sb + 8192 + kdst) = st1; *(LAS u32x4*)(sb + vdst) = st2; *(LAS u32x4*)(sb + vdst + 32 * 256) = st3; } while (0)
    const int kfo = r32 * 128, ksw = (r32 >> 1) & 7;
    const int i16 = lane & 15, qrow = i16 >> 2, pp = i16 & 3, g16 = (lane >> 4) & 1;
    const int vlane = (4 * hi + qrow) * 256 + ((2 * g16 + (pp >> 1)) << 4) + 8 * (pp & 1);
    const int qglob = q0 + r32;
    A_LOAD(0); A_WRITE(0); __syncthreads();
    for (int t = 0; t < nt; ++t) {
        if (t + 1 < nt) A_LOAD(t + 1);
        if (t <= cw) {
            LAS const unsigned char* sb = lds + (t & 1) * 32768; LAS const unsigned char* kb = sb + m * 8192 + kfo; LAS const unsigned char* vb = sb + 16384 + vlane;
            const bool nearb = (64 * t + 63 - q0) > -128;
            const float c0 = (nearb ? 0.f : bt[0]) - mrun;
            f32x16 p0, p1;
#pragma unroll
            for (int r = 0; r < 16; ++r) { p0[r] = c0; p1[r] = c0; }
#pragma unroll
            for (int d0 = 0; d0 < 4; ++d0) { const int co = ((2 * d0 + hi) ^ ksw) << 4;
                const h8 ka = *(LAS const h8*)(kb + co), kc = *(LAS const h8*)(kb + 4096 + co);
                p0 = __builtin_amdgcn_mfma_f32_32x32x16_f16(ka, qf[d0], p0, 0, 0, 0); p1 = __builtin_amdgcn_mfma_f32_32x32x16_f16(kc, qf[d0], p1, 0, 0, 0); }
            if (nearb) add_bias(p0, p1, bt, 64 * t + 4 * hi - qglob + 128);
            h8 pf[4];
            softmax_step<4, false>(p0, p1, mrun, lrun, have, o, pf);
#pragma unroll
            for (int d0 = 0; d0 < 4; ++d0) { const int dx = (d0 ^ qrow) << 6;
#pragma unroll
                for (int ks = 0; ks < 4; ++ks) { const h8 vf = tr2(vb + ks * 4096 + dx, vb + ks * 4096 + 2048 + dx);
                    o[d0] = __builtin_amdgcn_mfma_f32_32x32x16_f16(vf, pf[ks], o[d0], 0, 0, 0); } }
        }
        if (t + 1 < nt) A_WRITE((t + 1) & 1);
        __syncthreads();
    }
#undef A_LOAD
#undef A_WRITE
    const float linv = 1.0f / swap_sum(lrun);
    LAS f32x4* xb = (LAS f32x4*)(lds + qsub * 16384);
    if (m == 1) {
#pragma unroll
        for (int d0 = 0; d0 < 4; ++d0)
#pragma unroll
            for (int g = 0; g < 4; ++g) { f32x4 v = {o[d0][4 * g] * linv, o[d0][4 * g + 1] * linv, o[d0][4 * g + 2] * linv, o[d0][4 * g + 3] * linv};
                xb[(8 * d0 + 2 * g + hi) * 32 + r32] = v; }
    }
    __syncthreads();
    if (m == 0) {
        const float lam = *(const float*)(F.ws + WS_LAM);
        float ss = 0.f;
#pragma unroll
        for (int d0 = 0; d0 < 4; ++d0)
#pragma unroll
            for (int g = 0; g < 4; ++g) { const f32x4 v1 = xb[(8 * d0 + 2 * g + hi) * 32 + r32];
#pragma unroll
                for (int e = 0; e < 4; ++e) { const float v = o[d0][4 * g + e] * linv - lam * v1[e]; o[d0][4 * g + e] = v; ss += v * v; } }
        ss = swap_sum(ss);
        const float rs = __builtin_amdgcn_rsqf(ss * (1.0f / 128.0f) + RMS_EPS) * 0.8f;
        const size_t row = rowb + qglob;
        const u16* gp = P0 + row * P0W + C_G0 + h * 128;
        u16* op = (u16*)(F.ws + WS_MG0) + row * DM + h * 128;
        const float* sg = AR.in[I_SUBLN];
#pragma unroll
        for (int d0 = 0; d0 < 4; ++d0)
#pragma unroll
            for (int g = 0; g < 4; ++g) { const int d = 32 * d0 + 8 * g + 4 * hi;
                const h4 gv = *(const h4*)(gp + d); const f32x4 sv = *(const f32x4*)(sg + d);
                u32x2 w; w.x = pkh(o[d0][4 * g] * rs * sv[0] * (float)gv[0], o[d0][4 * g + 1] * rs * sv[1] * (float)gv[1]);
                w.y = pkh(o[d0][4 * g + 2] * rs * sv[2] * (float)gv[2], o[d0][4 * g + 3] * rs * sv[3] * (float)gv[3]);
                *(u32x2*)(op + d) = w; }
    }
}

constexpr int B_XROW = 1028, B_MASK = 66560, B_QF = 82944, B_BT = 99328;
__device__ __forceinline__ float next_up(float x) { if (x == 0.f) return __uint_as_float(1u); const unsigned u = __float_as_uint(x); return __uint_as_float(x > 0.f ? u + 1u : u - 1u); }
template <int OP> __device__ __forceinline__ float hw_red_f(float v) {
#define HWR_STEP(ctrl) { const float o_ = __uint_as_float((unsigned)__builtin_amdgcn_update_dpp(0, (int)__float_as_uint(v), ctrl, 0xf, 0xf, false)); v = OP ? fmaxf(v, o_) : fminf(v, o_); }
    HWR_STEP(0xB1) HWR_STEP(0x4E) HWR_STEP(0x141) HWR_STEP(0x140)
#undef HWR_STEP
    const float o2 = __shfl_xor(v, 16); return OP ? fmaxf(v, o2) : fminf(v, o2);
}
__device__ __forceinline__ unsigned hw_sum_u(unsigned v) {
#define HWS_STEP(ctrl) v += (unsigned)__builtin_amdgcn_update_dpp(0, (int)v, ctrl, 0xf, 0xf, false);
    HWS_STEP(0xB1) HWS_STEP(0x4E) HWS_STEP(0x141) HWS_STEP(0x140)
#undef HWS_STEP
    return v + (unsigned)__shfl_xor((int)v, 16);
}
__device__ __forceinline__ void selB_16(Frame& F, int b, int c, int q0, int mrow0, int abl = 0) {
    LAS unsigned char* lds = F.lds;
    int tid = F.tid; asm volatile("" : "+v"(tid)); int wid = F.wave; asm volatile("" : "+s"(wid));
    const int lane = tid & 63, ql = lane & 15, g = lane >> 4, l31 = lane & 31, hq = lane >> 5;
    const size_t rowb = (size_t)b * SEQ;
    const u16* P0 = (const u16*)(F.ws + WS_PROJ0);
    const int NT16 = 4 * (c + 1), N = 64 * (c + 1);
    if (c < 4) {
        for (int e = tid; e < 16 * (c + 1); e += 512) { const int q = e / (c + 1), t = e % (c + 1); *(LAS u64*)(lds + B_MASK + ((mrow0 + q) * 64 + t) * 8) = ~0ull; }
        return;
    }
    LAS h8* qfl = (LAS h8*)(lds + B_QF);
#pragma unroll
    for (int i = 0; i < 2; ++i) { const int idx = tid + 512 * i, fg = idx >> 6, ln = idx & 63, hh = fg >> 1, ks = fg & 1;
        qfl[idx] = *(const h8*)(P0 + (rowb + q0 + (ln & 15)) * P0W + C_QI + hh * 64 + 32 * ks + 8 * (ln >> 4)); }
    float wq[8];
    { const h8 wv = *(const h8*)(P0 + (rowb + q0 + ql) * P0W + C_WI);
#pragma unroll
      for (int i = 0; i < 8; ++i) wq[i] = (float)wv[i]; }
    __syncthreads();
    float sc[128];
    LAS float* X = (LAS float*)lds;
    const u16* kp = P0 + (rowb + ql) * P0W + C_KI + 8 * g;
    const int nq = (N + 1023) >> 10;
#pragma unroll
    for (int qr = 0; qr < 4; ++qr) {
        if (qr < nq) {
            h8 ka[2][2], kn[2][2];
#pragma unroll
            for (int u = 0; u < 2; ++u) { const int j = 64 * qr + wid + 8 * u; const int jc = j < NT16 ? j : 0;
                ka[u][0] = *(const h8*)(kp + (size_t)(16 * jc) * P0W); ka[u][1] = *(const h8*)(kp + (size_t)(16 * jc) * P0W + 32); }
#pragma unroll
            for (int gq = 0; gq < 4; ++gq) {
                if (64 * qr + wid + 16 * gq < NT16) {
                    if (gq < 3) {
#pragma unroll
                        for (int u = 0; u < 2; ++u) { const int j = 64 * qr + wid + 8 * (2 * gq + 2 + u); const int jc = j < NT16 ? j : 0;
                            kn[u][0] = *(const h8*)(kp + (size_t)(16 * jc) * P0W); kn[u][1] = *(const h8*)(kp + (size_t)(16 * jc) * P0W + 32); } }
                    f32x4 s4[2] = {{0.f, 0.f, 0.f, 0.f}, {0.f, 0.f, 0.f, 0.f}};
                    h8 qc0 = qfl[lane], qc1 = qfl[64 + lane];
#pragma unroll
                    for (int hh = 0; hh < 8; ++hh) {
                        h8 qn0 = qc0, qn1 = qc1;
                        if (hh < 7) { qn0 = qfl[((hh + 1) * 2 + 0) * 64 + lane]; qn1 = qfl[((hh + 1) * 2 + 1) * 64 + lane]; }
                        f32x4 ac0 = {0.f, 0.f, 0.f, 0.f}, ac1 = {0.f, 0.f, 0.f, 0.f};
                        ac0 = __builtin_amdgcn_mfma_f32_16x16x32_f16(ka[0][0], qc0, ac0, 0, 0, 0);
                        ac1 = __builtin_amdgcn_mfma_f32_16x16x32_f16(ka[1][0], qc0, ac1, 0, 0, 0);
                        ac0 = __builtin_amdgcn_mfma_f32_16x16x32_f16(ka[0][1], qc1, ac0, 0, 0, 0);
                        ac1 = __builtin_amdgcn_mfma_f32_16x16x32_f16(ka[1][1], qc1, ac1, 0, 0, 0);
#pragma unroll
                        for (int r = 0; r < 4; ++r) { s4[0][r] += wq[hh] * __int_as_float(max(__float_as_int(ac0[r]), 0)); s4[1][r] += wq[hh] * __int_as_float(max(__float_as_int(ac1[r]), 0)); }
                        qc0 = qn0; qc1 = qn1;
                    }
#pragma unroll
                    for (int u = 0; u < 2; ++u) { const int m = 2 * gq + u; if (64 * qr + wid + 8 * m < NT16) *(LAS f32x4*)(X + ql * B_XROW + 16 * (wid + 8 * m) + 4 * g) = s4[u]; }
#pragma unroll
                    for (int u = 0; u < 2; ++u) { ka[u][0] = kn[u][0]; ka[u][1] = kn[u][1]; }
                }
            }
            {
            __syncthreads();
            { LAS const float* xr = X + (2 * wid + hq) * B_XROW + l31;
#pragma unroll
              for (int i = 0; i < 32; ++i) sc[32 * qr + i] = (1024 * qr + 32 * i < N) ? xr[32 * i] : -INFINITY; }
            __syncthreads(); }
        } else {
#pragma unroll
            for (int i = 0; i < 32; ++i) sc[32 * qr + i] = -INFINITY;
        }
    }
    float mn = INFINITY, mxv = -INFINITY;
#pragma unroll
    for (int e = 0; e < 128; ++e) { const float s = sc[e]; mn = fminf(mn, s > -INFINITY ? s : INFINITY); mxv = fmaxf(mxv, s); }
    float lo = hw_red_f<0>(mn), hi = next_up(hw_red_f<1>(mxv));
    unsigned clo = (unsigned)N, chi = 0u;
    if (abl != 6) {
        const float smn = lo, smx = hw_red_f<1>(mxv);
        LAS unsigned* H = (LAS unsigned*)lds + (2 * wid + hq) * 512;
        LAS unsigned* CS = (LAS unsigned*)(lds + 32768) + (2 * wid + hq) * 32;
#pragma unroll
        for (int i = 0; i < 16; ++i) H[l31 + 32 * i] = 0u;
        const float scale = 1023.5f / fmaxf(smx - smn, 1e-30f);
#pragma unroll
        for (int e = 0; e < 128; ++e) { if (32 * e < N) { int bin = (int)((sc[e] - smn) * scale); bin = bin > 1023 ? 1023 : bin;
            __hip_atomic_fetch_add(H + (bin >> 1), 1u << ((bin & 1) << 4), __ATOMIC_RELAXED, __HIP_MEMORY_SCOPE_WORKGROUP); } }
        asm volatile("s_waitcnt lgkmcnt(0)" ::: "memory");
        unsigned hw[16]; unsigned acc = 0u;
#pragma unroll
        for (int i = 0; i < 4; ++i) { const u32x4 v = *(LAS const u32x4*)(H + 16 * l31 + 4 * i); hw[4 * i] = v.x; hw[4 * i + 1] = v.y; hw[4 * i + 2] = v.z; hw[4 * i + 3] = v.w; acc += v.x + v.y + v.z + v.w; }
        const unsigned cl = (acc & 0xffffu) + (acc >> 16);
        CS[l31] = cl;
        asm volatile("s_waitcnt lgkmcnt(0)" ::: "memory");
        unsigned ssuf = 0u;
#pragma unroll
        for (int i = 0; i < 8; ++i) { const u32x4 v = *(LAS const u32x4*)(CS + 4 * i);
            ssuf += (4 * i >= l31 ? v.x : 0u) + (4 * i + 1 >= l31 ? v.y : 0u) + (4 * i + 2 >= l31 ? v.z : 0u) + (4 * i + 3 >= l31 ? v.w : 0u); }
        const bool flag = ssuf >= (unsigned)TOPK && (ssuf - cl) < (unsigned)TOPK;
        unsigned run = ssuf - cl, bstar = 0u, above = 0u, cntb = 0u; bool found = false;
#pragma unroll
        for (int w = 15; w >= 0; --w) {
            const unsigned h1 = hw[w] >> 16, h0 = hw[w] & 0xffffu;
            run += h1; if (!found && run >= (unsigned)TOPK) { found = true; bstar = 32u * l31 + 2u * w + 1u; above = run - h1; cntb = h1; }
            run += h0; if (!found && run >= (unsigned)TOPK) { found = true; bstar = 32u * l31 + 2u * w; above = run - h0; cntb = h0; }
        }
        const unsigned long long fb = __ballot(flag);
        const int src = hq ? 32 + __builtin_ctz((unsigned)(fb >> 32) | 0x80000000u) : __builtin_ctz((unsigned)fb | 0x80000000u);
        bstar = (unsigned)__shfl((int)bstar, src); above = (unsigned)__shfl((int)above, src); cntb = (unsigned)__shfl((int)cntb, src);
        if (smx > smn) {
            const float inv = (smx - smn) * (1.0f / 1023.5f);
            const float l2 = smn + ((float)bstar - 0.01f) * inv, h2 = smn + ((float)bstar + 1.01f) * inv;
            if (l2 > lo) { lo = l2; clo = above + cntb; }
            if (h2 < hi) { hi = h2; chi = above; }
        }
    }
#define SEL_LTBITS(W, P) do { _Pragma("unroll") for (int w_ = 0; w_ < 4; ++w_) { unsigned a_ = 0u; _Pragma("unroll") for (int k_ = 0; k_ < 32; ++k_) \
        a_ = __builtin_amdgcn_alignbit(a_, __float_as_uint(sc[32 * w_ + k_] - (P)), 31); W[w_] = a_; } } while (0)
    bool done = false, tie = false; float Tv = 0.f;
#define SEL_STEP(it_) do { \
        float mid = lo + (hi - lo) * 0.5f; \
        if ((it_) < 2 && clo > chi + 16u) { const float xi = lo + (hi - lo) * ((float)clo - 255.5f) / (float)(clo - chi); if (xi > lo && xi < hi) mid = xi; } \
        if (!done && !(mid > lo && mid < hi)) { done = true; tie = true; Tv = lo; } \
        const float pv = done ? Tv : mid; \
        unsigned ltw[4]; SEL_LTBITS(ltw, pv); \
        const unsigned tot = hw_sum_u(128u - (unsigned)(__builtin_popcount(ltw[0]) + __builtin_popcount(ltw[1]) + __builtin_popcount(ltw[2]) + __builtin_popcount(ltw[3]))); \
        if (!done) { if (tot == (unsigned)TOPK) { done = true; Tv = mid; } else if (tot > (unsigned)TOPK) { lo = mid; clo = tot; } else { hi = mid; chi = tot; } } } while (0)
    const int it_cap = (abl == 6 ? 1 : abl == 10 ? 6 : abl == 11 ? 12 : 200);
    int it = 0;
    for (; it < 8 && it < it_cap; ++it) { SEL_STEP(it); if (__all(done)) break; }
    if (!__all(done) && it_cap > 8) {
        float p0 = INFINITY, p1 = -INFINITY;
#pragma unroll
        for (int e = 0; e < 128; ++e) { const float sv = sc[e]; p0 = fminf(p0, sv >= lo ? sv : INFINITY); p1 = fmaxf(p1, sv < hi ? sv : -INFINITY); }
        p0 = hw_red_f<0>(p0); p1 = hw_red_f<1>(p1);
        if (!done && p0 == p1) { done = true; tie = true; Tv = p0; }
        for (; it < it_cap; ++it) { if (__all(done)) break; SEL_STEP(8); }
    }
#undef SEL_STEP
    if (abl == 6 || abl == 10 || abl == 11) tie = false;
    unsigned selw[4];
    { unsigned ltw[4]; SEL_LTBITS(ltw, Tv);
#pragma unroll
      for (int w = 0; w < 4; ++w) selw[w] = __builtin_bitreverse32(~ltw[w]); }
    if (__any(tie)) {
        unsigned eqw[4];
        { unsigned lew[4]; const float tn = next_up(Tv); SEL_LTBITS(lew, tn);
#pragma unroll
          for (int w = 0; w < 4; ++w) eqw[w] = __builtin_bitreverse32(lew[w]) & selw[w]; }
        const unsigned rneed = (unsigned)TOPK - chi;
        int ilo = -1, ihi = N - 1, icut = N; bool tdone = !tie;
        for (int it = 0; it < 40; ++it) {
            const int imid = (ilo + ihi) >> 1;
            if (!tdone && (ihi - ilo) <= 1) { tdone = true; icut = ihi; }
            const int iv = (tdone ? icut : imid) - l31;
            const int nle = iv < 0 ? 0 : min(128, (iv >> 5) + 1);
            unsigned cnt = 0u;
#pragma unroll
            for (int w = 0; w < 4; ++w) { const int nw = min(max(nle - 32 * w, 0), 32); const unsigned mk = nw >= 32 ? 0xffffffffu : ((1u << nw) - 1u); cnt += (unsigned)__builtin_popcount(eqw[w] & mk); }
            const unsigned tot = hw_sum_u(cnt);
            if (!tdone) { if (tot == rneed) { tdone = true; icut = imid; } else if (tot < rneed) ilo = imid; else ihi = imid; }
            if (__all(tdone)) break;
        }
        if (tie) {
            const int iv = icut - l31; const int nle = iv < 0 ? 0 : min(128, (iv >> 5) + 1);
#pragma unroll
            for (int w = 0; w < 4; ++w) { const int nw = min(max(nle - 32 * w, 0), 32); const unsigned mk = nw >= 32 ? 0xffffffffu : ((1u << nw) - 1u); selw[w] = (selw[w] & ~eqw[w]) | (eqw[w] & mk); }
        }
    }
#undef SEL_LTBITS
    LAS unsigned* mrow = (LAS unsigned*)(lds + B_MASK) + (mrow0 + 2 * wid + hq) * 128;
#pragma unroll
    for (int e = 0; e < 128; ++e) {
        if (abl == 7) { if (e == 0 && tid == 0) mrow[0] = selw[0] ^ selw[1] ^ selw[2] ^ selw[3]; }
        else if (32 * e < N) {
            const unsigned long long bal = __ballot((selw[e >> 5] >> (e & 31)) & 1u);
            const unsigned wv = hq ? (unsigned)(bal >> 32) : (unsigned)bal;
            if (l31 == 0) mrow[e] = wv;
        }
    }
}
__device__ __forceinline__ void attnB_unit(Frame& F, int b, int qb32, int mode = 0) {
    LAS unsigned char* lds = F.lds;
    int tid = F.tid; asm volatile("" : "+v"(tid)); int wid = F.wave; asm volatile("" : "+s"(wid));
    const int lane = tid & 63, r32 = lane & 31, hi = lane >> 5;
    const int q0 = 32 * qb32, c = q0 >> 6, nt = c + 1;
    const size_t rowb = (size_t)b * SEQ;
    const u16* P0 = (const u16*)(F.ws + WS_PROJ0);
    if (mode != 3) {
#pragma unroll 1
        for (int s2 = 0; s2 < 2; ++s2) { selB_16(F, b, c, q0 + 16 * s2, 16 * s2, mode); __syncthreads(); }
    }
    if (mode >= 4) return;
    LAS float* bt = (LAS float*)(lds + B_BT) + wid * 192;
    for (int e = tid; e < 8 * 192; e += 512) ((LAS float*)(lds + B_BT))[e] = ((const float*)(F.ws + WS_BTG))[4 * 192 + e];
    h8 qf[4];
    { const u16* qp = P0 + (rowb + q0 + r32) * P0W + C_QB + wid * 64 + hi * 8;
#pragma unroll
      for (int d0 = 0; d0 < 4; ++d0) qf[d0] = *(const h8*)(qp + d0 * 16); }
    f32x16 o[2];
#pragma unroll
    for (int d = 0; d < 2; ++d)
#pragma unroll
        for (int r = 0; r < 16; ++r) o[d][r] = 0.f;
    float mrun = 0.f, lrun = 0.f; bool have = false;
    const int krow = tid >> 3, kch = tid & 7;
    const u16* ksrc = P0 + (rowb + krow) * P0W + C_KB + kch * 8;
    const int kdst = krow * 128 + ((kch ^ ((krow >> 1) & 7)) << 4);
    const int vdst = 8192 + krow * 128 + ((kch ^ (((krow >> 1) & 1) << 2)) << 4);
    u32x4 st0, st1;
#define B_LOAD(t) do { const size_t to = (size_t)(t) * 64 * P0W; st0 = *(const u32x4*)(ksrc + to); st1 = *(const u32x4*)(ksrc + to + 64); } while (0)
#define B_WRITE(s) do { LAS unsigned char* sb = lds + (s) * 16384; *(LAS u32x4*)(sb + kdst) = st0; *(LAS u32x4*)(sb + vdst) = st1; } while (0)
    const int kfo = r32 * 128, ksw = (r32 >> 1) & 7;
    const int i16 = lane & 15, qrow = i16 >> 2, pp = i16 & 3, g16 = (lane >> 4) & 1;
    const int vlane = (4 * hi + qrow) * 128 + ((2 * g16 + (pp >> 1)) << 4) + 8 * (pp & 1);
    const int qglob = q0 + r32;
    B_LOAD(0); B_WRITE(0); __syncthreads();
    for (int t = 0; t < nt; ++t) {
        if (t + 1 < nt) B_LOAD(t + 1);
        {
            LAS const unsigned char* sb = lds + (t & 1) * 16384; LAS const unsigned char* kb = sb + kfo; LAS const unsigned char* vb = sb + 8192 + vlane;
            const bool nearb = (64 * t + 63 - q0) > -128;
            const float c0 = (nearb ? 0.f : bt[0]) - mrun;
            f32x16 p0, p1;
#pragma unroll
            for (int r = 0; r < 16; ++r) { p0[r] = c0; p1[r] = c0; }
#pragma unroll
            for (int d0 = 0; d0 < 4; ++d0) { const int co = ((2 * d0 + hi) ^ ksw) << 4;
                const h8 ka = *(LAS const h8*)(kb + co), kc = *(LAS const h8*)(kb + 4096 + co);
                p0 = __builtin_amdgcn_mfma_f32_32x32x16_f16(ka, qf[d0], p0, 0, 0, 0); p1 = __builtin_amdgcn_mfma_f32_32x32x16_f16(kc, qf[d0], p1, 0, 0, 0); }
            if (nearb) add_bias(p0, p1, bt, 64 * t + 4 * hi - qglob + 128);
            const u64 mw = *(LAS const u64*)(lds + B_MASK + (r32 * 64 + t) * 8);
            const unsigned mlo = (unsigned)mw >> (4 * hi), mhi = (unsigned)(mw >> 32) >> (4 * hi);
#pragma unroll
            for (int r = 0; r < 16; ++r) { const int cb = (r & 3) + 8 * (r >> 2);
                if (!((mlo >> cb) & 1u)) p0[r] = -1e30f; if (!((mhi >> cb) & 1u)) p1[r] = -1e30f; }
            h8 pf[4];
            softmax_step<2, true>(p0, p1, mrun, lrun, have, o, pf);
#pragma unroll
            for (int d0 = 0; d0 < 2; ++d0) { const int dx = (d0 ^ (qrow >> 1)) << 6;
#pragma unroll
                for (int ks = 0; ks < 4; ++ks) { const h8 vf = tr2(vb + ks * 2048 + dx, vb + ks * 2048 + 1024 + dx);
                    o[d0] = __builtin_amdgcn_mfma_f32_32x32x16_f16(vf, pf[ks], o[d0], 0, 0, 0); } }
        }
        if (t + 1 < nt) B_WRITE((t + 1) & 1);
        __syncthreads();
    }
#undef B_LOAD
#undef B_WRITE
    const float linv = 1.0f / swap_sum(lrun);
    const size_t row = rowb + qglob;
    const u16* gp = P0 + row * P0W + C_G0 + 512 + wid * 64;
    u16* op = (u16*)(F.ws + WS_MG0) + row * DM + 512 + wid * 64;
#pragma unroll
    for (int d0 = 0; d0 < 2; ++d0)
#pragma unroll
        for (int g = 0; g < 4; ++g) { const int d = 32 * d0 + 8 * g + 4 * hi;
            const h4 gv = *(const h4*)(gp + d);
            u32x2 w; w.x = pkh(o[d0][4 * g] * linv * (float)gv[0], o[d0][4 * g + 1] * linv * (float)gv[1]);
            w.y = pkh(o[d0][4 * g + 2] * linv * (float)gv[2], o[d0][4 * g + 3] * linv * (float)gv[3]);
            *(u32x2*)(op + d) = w; }
}

__device__ __forceinline__ void attnC_unit(Frame& F, int b, int h, int qb) {
    LAS unsigned char* lds = F.lds;
    int tid = F.tid; asm volatile("" : "+v"(tid)); int wid = F.wave; asm volatile("" : "+s"(wid));
    const int lane = tid & 63, r32 = lane & 31, hi = lane >> 5;
    const int q0 = 256 * qb + 32 * wid, cw = q0 >> 6, nt = 4 * qb + 4;
    const size_t rowb = (size_t)b * SEQ;
    const u16* Q1 = (const u16*)(F.ws + WS_Q1); const u16* KV = (const u16*)(F.ws + WS_KV1); const u16* KR = (const u16*)(F.ws + WS_KROPE);
    h8 qf[6];
    { const u16* qp = Q1 + (rowb + q0 + r32) * 1536 + h * 96 + hi * 8;
#pragma unroll
      for (int d0 = 0; d0 < 6; ++d0) qf[d0] = *(const h8*)(qp + d0 * 16); }
    f32x16 o[2];
#pragma unroll
    for (int d = 0; d < 2; ++d)
#pragma unroll
        for (int r = 0; r < 16; ++r) o[d][r] = 0.f;
    float mrun = 0.f, lrun = 0.f; bool have = false;
    const int krow = tid >> 3, kch = tid & 7;
    const u16* ksrc = KV + (rowb + krow) * 2048 + h * 128 + kch * 8;
    const int kdst = krow * 128 + ((kch ^ ((krow >> 1) & 7)) << 4);
    const int vdst = 12288 + krow * 128 + ((kch ^ (((krow >> 1) & 1) << 2)) << 4);
    const int rrow = (tid & 255) >> 2, rch = tid & 3;
    const u16* rsrc = KR + (rowb + rrow) * 32 + rch * 8;
    const int rdst = 8192 + rrow * 64 + ((rch ^ ((rrow >> 2) & 3)) << 4);
    u32x4 st0, st1, st2;
#define C_LOAD(t) do { const size_t tr = (size_t)(t) * 64; st0 = *(const u32x4*)(ksrc + tr * 2048); st1 = *(const u32x4*)(ksrc + tr * 2048 + 64); if (tid < 256) st2 = *(const u32x4*)(rsrc + tr * 32); } while (0)
#define C_WRITE(s) do { LAS unsigned char* sb = lds + (s) * 20480; *(LAS u32x4*)(sb + kdst) = st0; *(LAS u32x4*)(sb + vdst) = st1; if (tid < 256) *(LAS u32x4*)(sb + rdst) = st2; } while (0)
    const int kfo = r32 * 128, ksw = (r32 >> 1) & 7;
    const int rfo = 8192 + r32 * 64, rsw = (r32 >> 2) & 3;
    const int i16 = lane & 15, qrow = i16 >> 2, pp = i16 & 3, g16 = (lane >> 4) & 1;
    const int vlane = (4 * hi + qrow) * 128 + ((2 * g16 + (pp >> 1)) << 4) + 8 * (pp & 1);
    C_LOAD(0); C_WRITE(0); __syncthreads();
    for (int t = 0; t < nt; ++t) {
        if (t + 1 < nt) C_LOAD(t + 1);
        if (t <= cw) {
            LAS const unsigned char* sb = lds + (t & 1) * 20480; LAS const unsigned char* kb = sb + kfo; LAS const unsigned char* rb = sb + rfo; LAS const unsigned char* vb = sb + 12288 + vlane;
            f32x16 p0, p1;
#pragma unroll
            for (int r = 0; r < 16; ++r) { p0[r] = -mrun; p1[r] = -mrun; }
#pragma unroll
            for (int d0 = 0; d0 < 4; ++d0) { const int co = ((2 * d0 + hi) ^ ksw) << 4;
                const h8 ka = *(LAS const h8*)(kb + co), kc = *(LAS const h8*)(kb + 4096 + co);
                p0 = __builtin_amdgcn_mfma_f32_32x32x16_f16(ka, qf[d0], p0, 0, 0, 0); p1 = __builtin_amdgcn_mfma_f32_32x32x16_f16(kc, qf[d0], p1, 0, 0, 0); }
#pragma unroll
            for (int d0 = 0; d0 < 2; ++d0) { const int co = ((2 * d0 + hi) ^ rsw) << 4;
                const h8 ka = *(LAS const h8*)(rb + co), kc = *(LAS const h8*)(rb + 2048 + co);
                p0 = __builtin_amdgcn_mfma_f32_32x32x16_f16(ka, qf[4 + d0], p0, 0, 0, 0); p1 = __builtin_amdgcn_mfma_f32_32x32x16_f16(kc, qf[4 + d0], p1, 0, 0, 0); }
#if DEBUG_CHECK
            if (b == TAPB && h == TAPH && qb == TAPQB && wid == 0 && t == 0) { float* db = (float*)(F.ws + WS_DBGBUF);
#pragma unroll
                for (int r = 0; r < 16; ++r) { const int key = (r & 3) + 8 * (r >> 2) + 4 * hi; db[r32 * 64 + key] = p0[r]; db[r32 * 64 + 32 + key] = p1[r]; } }
#endif
            h8 pf[4];
            softmax_step<2, false>(p0, p1, mrun, lrun, have, o, pf);
#pragma unroll
            for (int d0 = 0; d0 < 2; ++d0) { const int dx = (d0 ^ (qrow >> 1)) << 6;
#pragma unroll
                for (int ks = 0; ks < 4; ++ks) { const h8 vf = tr2(vb + ks * 2048 + dx, vb + ks * 2048 + 1024 + dx);
                    o[d0] = __builtin_amdgcn_mfma_f32_32x32x16_f16(vf, pf[ks], o[d0], 0, 0, 0); } }
        }
        if (t + 1 < nt) C_WRITE((t + 1) & 1);
        __syncthreads();
    }
#undef C_LOAD
#undef C_WRITE
    const float linv = 1.0f / swap_sum(lrun);
    const size_t row = rowb + q0 + r32;
#if DEBUG_CHECK
    if (b == TAPB && h == TAPH && qb == TAPQB) { float* db = (float*)(F.ws + WS_DBGBUF) + 4096;
#pragma unroll
        for (int d0 = 0; d0 < 2; ++d0)
#pragma unroll
            for (int r = 0; r < 16; ++r) db[(32 * wid + r32) * 64 + 32 * d0 + (r & 3) + 8 * (r >> 2) + 4 * hi] = o[d0][r] * linv; }
#endif
    const u16* gp = (const u16*)(F.ws + WS_G1) + row * DM + h * 64;
    u16* op = (u16*)(F.ws + WS_MG1) + row * DM + h * 64;
#pragma unroll
    for (int d0 = 0; d0 < 2; ++d0)
#pragma unroll
        for (int g = 0; g < 4; ++g) { const int d = 32 * d0 + 8 * g + 4 * hi;
            const h4 gv = *(const h4*)(gp + d);
            u32x2 w; w.x = pkh(o[d0][4 * g] * linv * (float)gv[0], o[d0][4 * g + 1] * linv * (float)gv[1]);
            w.y = pkh(o[d0][4 * g + 2] * linv * (float)gv[2], o[d0][4 * g + 3] * linv * (float)gv[3]);
            *(u32x2*)(op + d) = w; }
}

__device__ __forceinline__ void p8_final(Frame& F, const Args& AR) {
    const int gw = blockIdx.x * NWAVES + F.wave, NGW = F.G * NWAVES;
    const float* gn = AR.in[I_FNORM]; f32x4 gv[4];
#pragma unroll
    for (int j = 0; j < 4; ++j) gv[j] = *(const f32x4*)(gn + 4 * F.lane + 256 * j);
    for (int mrow = gw; mrow < T; mrow += NGW) {
        f32x4* xr = (f32x4*)(F.out + (size_t)mrow * DM) + F.lane;
        f32x4 v[4]; float s = 0.f;
#pragma unroll
        for (int j = 0; j < 4; ++j) { v[j] = xr[64 * j]; s += (v[j].x * v[j].x + v[j].y * v[j].y) + (v[j].z * v[j].z + v[j].w * v[j].w); }
        const float rstd = __builtin_amdgcn_rsqf(wave_sum(s) * (1.f / DM) + RMS_EPS);
#pragma unroll
        for (int j = 0; j < 4; ++j) xr[64 * j] = v[j] * rstd * gv[j];
    }
}


#ifndef NAIVE_ATTN
#define NAIVE_ATTN 0
#endif
struct NaiveSh { float sh[4096]; float red[256]; unsigned char sel[4096]; };
__device__ __forceinline__ float blk_max(NaiveSh& S, float v, int tid) { S.red[tid] = v; __syncthreads(); for (int o2 = 128; o2 > 0; o2 >>= 1) { if (tid < o2) S.red[tid] = fmaxf(S.red[tid], S.red[tid + o2]); __syncthreads(); } const float r = S.red[0]; __syncthreads(); return r; }
__device__ __forceinline__ float blk_sum(NaiveSh& S, float v, int tid) { S.red[tid] = v; __syncthreads(); for (int o2 = 128; o2 > 0; o2 >>= 1) { if (tid < o2) S.red[tid] += S.red[tid + o2]; __syncthreads(); } const float r = S.red[0]; __syncthreads(); return r; }
__device__ __forceinline__ float blk_softmax(NaiveSh& S, int nk, int tid) {
    float mx = -1e30f; for (int k = tid; k < nk; k += 256) mx = fmaxf(mx, S.sh[k]); mx = blk_max(S, mx, tid);
    float ls = 0.f; for (int k = tid; k < nk; k += 256) { const float p = S.sh[k] > -1e29f ? exp2f(S.sh[k] - mx) : 0.f; S.sh[k] = p; ls += p; }
    return blk_sum(S, ls, tid);
}
__device__ __forceinline__ float naiveA(NaiveSh& S, const Args& args, int b, int q, int hd, int tid) {
    unsigned char* ws = args.ws; const u16* P0 = (const u16*)(ws + WS_PROJ0); const float* BT = (const float*)(ws + WS_BTG);
    const size_t row = (size_t)b * SEQ + q; const int nk = 64 * (q / 64 + 1); float outv[2] = {0.f, 0.f};
    for (int m = 0; m < 2; ++m) {
        for (int k = tid; k < nk; k += 256) { float sacc = 0.f; const u16* qp = P0 + row * P0W + C_QA + hd * 128 + m * 64; const u16* kp = P0 + ((size_t)b * SEQ + k) * P0W + C_KA + hd * 128 + m * 64;
            for (int d = 0; d < 64; ++d) sacc += h2f(qp[d]) * h2f(kp[d]);
            int rel = k - q; rel = rel < -128 ? -128 : rel; S.sh[k] = sacc + BT[hd * 192 + rel + 128]; }
        __syncthreads();
        const float ls = blk_softmax(S, nk, tid);
        if (tid < 128) { float a = 0.f; for (int k = 0; k < nk; ++k) a += S.sh[k] * h2f(P0[((size_t)b * SEQ + k) * P0W + C_VA + hd * 128 + tid]); outv[m] = a / ls; }
        __syncthreads();
    }
    const float lam = *(const float*)(ws + WS_LAM); const float v = tid < 128 ? outv[0] - lam * outv[1] : 0.f;
    const float ss = blk_sum(S, v * v, tid);
    const float rs = rsqrtf(ss / 128.f + RMS_EPS) * 0.8f;
    return tid < 128 ? v * rs * args.in[I_SUBLN][tid] * h2f(P0[row * P0W + C_G0 + hd * 128 + tid]) : 0.f;
}
__device__ __forceinline__ void naiveB_select(NaiveSh& S, const Args& args, int b, int q, int tid) {
    const u16* P0 = (const u16*)(args.ws + WS_PROJ0); const size_t row = (size_t)b * SEQ + q; const int nk = 64 * (q / 64 + 1);
    for (int k = tid; k < nk; k += 256) { float sc = 0.f;
        for (int hh = 0; hh < 8; ++hh) { float l = 0.f; const u16* qp = P0 + row * P0W + C_QI + hh * 64; const u16* kp = P0 + ((size_t)b * SEQ + k) * P0W + C_KI;
            for (int d = 0; d < 64; ++d) l += h2f(qp[d]) * h2f(kp[d]);
            sc += h2f(P0[row * P0W + C_WI + hh]) * fmaxf(l, 0.f); }
        S.sh[k] = sc; }
    __syncthreads();
    for (int k = tid; k < nk; k += 256) { const float sk = S.sh[k]; int rank = 0; for (int k2 = 0; k2 < nk; ++k2) { const float s2 = S.sh[k2]; rank += (s2 > sk || (s2 == sk && k2 < k)) ? 1 : 0; } S.sel[k] = rank < TOPK ? 1 : 0; }
    __syncthreads();
}
__device__ __forceinline__ float naiveB_head(NaiveSh& S, const Args& args, int b, int q, int hd, int tid) {
    const u16* P0 = (const u16*)(args.ws + WS_PROJ0); const float* BT = (const float*)(args.ws + WS_BTG); const size_t row = (size_t)b * SEQ + q; const int nk = 64 * (q / 64 + 1);
    for (int k = tid; k < nk; k += 256) { float sacc = -1e30f;
        if (S.sel[k]) { sacc = 0.f; const u16* qp = P0 + row * P0W + C_QB + hd * 64; const u16* kp = P0 + ((size_t)b * SEQ + k) * P0W + C_KB;
            for (int d = 0; d < 64; ++d) sacc += h2f(qp[d]) * h2f(kp[d]);
            int rel = k - q; rel = rel < -128 ? -128 : rel; sacc += BT[(4 + hd) * 192 + rel + 128]; }
        S.sh[k] = sacc; }
    __syncthreads();
    const float ls = blk_softmax(S, nk, tid);
    float r = 0.f;
    if (tid < 64) { float a = 0.f; for (int k = 0; k < nk; ++k) a += S.sh[k] * h2f(P0[((size_t)b * SEQ + k) * P0W + C_VB + tid]); r = a / ls * h2f(P0[row * P0W + C_G0 + 512 + hd * 64 + tid]); }
    __syncthreads();
    return r;
}
__device__ __forceinline__ float naiveC(NaiveSh& S, const Args& args, int b, int q, int hd, int tid) {
    unsigned char* ws = args.ws; const size_t row = (size_t)b * SEQ + q; const int nk = 64 * (q / 64 + 1);
    const u16* Q1 = (const u16*)(ws + WS_Q1); const u16* KV = (const u16*)(ws + WS_KV1); const u16* KR = (const u16*)(ws + WS_KROPE);
    for (int k = tid; k < nk; k += 256) { float sacc = 0.f; const u16* qp = Q1 + row * 1536 + hd * 96; const size_t kr = (size_t)b * SEQ + k;
        for (int d = 0; d < 64; ++d) sacc += h2f(qp[d]) * h2f(KV[kr * 2048 + hd * 128 + d]);
        for (int d = 0; d < 32; ++d) sacc += h2f(qp[64 + d]) * h2f(KR[kr * 32 + d]);
        S.sh[k] = sacc; }
    __syncthreads();
    const float ls = blk_softmax(S, nk, tid);
    float r = 0.f;
    if (tid < 64) { float a = 0.f; for (int k = 0; k < nk; ++k) a += S.sh[k] * h2f(KV[((size_t)b * SEQ + k) * 2048 + hd * 128 + 64 + tid]); r = a / ls * h2f(((const u16*)(ws + WS_G1))[row * DM + hd * 64 + tid]); }
    __syncthreads();
    return r;
}
#if NAIVE_ATTN
__global__ void __launch_bounds__(256) naive_attn(Args args, int which) {
    __shared__ NaiveSh S; const int tid = threadIdx.x; unsigned char* ws = args.ws;
    if (which == 0) {
        for (int it = blockIdx.x; it < T * 5; it += gridDim.x) {
            const int row = it / 5, sub = it % 5, b = row / SEQ, q = row % SEQ;
            if (sub < 4) { const float v = naiveA(S, args, b, q, sub, tid); if (tid < 128) ((u16*)(ws + WS_MG0))[(size_t)row * DM + sub * 128 + tid] = (u16)(pkh(v, 0.f) & 0xffffu); }
            else { naiveB_select(S, args, b, q, tid);
                for (int hd = 0; hd < 8; ++hd) { const float v = naiveB_head(S, args, b, q, hd, tid); if (tid < 64) ((u16*)(ws + WS_MG0))[(size_t)row * DM + 512 + hd * 64 + tid] = (u16)(pkh(v, 0.f) & 0xffffu); } }
        }
    } else {
        for (int it = blockIdx.x; it < T * 16; it += gridDim.x) {
            const int row = it >> 4, hd = it & 15, b = row / SEQ, q = row % SEQ;
            const float v = naiveC(S, args, b, q, hd, tid); if (tid < 64) ((u16*)(ws + WS_MG1))[(size_t)row * DM + hd * 64 + tid] = (u16)(pkh(v, 0.f) & 0xffffu);
        }
    }
}
#endif

#if DEBUG_CHECK
constexpr size_t WS_DBG = 3 * MiB;
#ifndef DBG_BITS_MODE
#define DBG_BITS_MODE 1
#define DBG_BITS_IDS 14, 4, 5, 21, 22, 23
#endif
#ifndef DBG_SKIP_MASK
#define DBG_SKIP_MASK 0x10
#endif
#ifndef DBG_REPORT_ID
#define DBG_REPORT_ID 0
#endif
__device__ __forceinline__ unsigned dhash(unsigned x) { x ^= x >> 16; x *= 0x7feb352du; x ^= x >> 15; x *= 0x846ca68bu; x ^= x >> 16; return x; }
__device__ __forceinline__ void dbg_rec(unsigned char* ws, int id, float got, float ref, float scale) {
    float e = fabsf(got - ref) / (fabsf(ref) + scale); if (!(e == e)) e = 1e6f;
    atomicMax((unsigned*)(ws + WS_DBG) + id, __float_as_uint(e));
}
__device__ __forceinline__ float dh(const u16* p, size_t i) { return h2f(p[i]); }
__global__ void __launch_bounds__(256) dbg_check(Args args, int stage) {
    unsigned char* ws = args.ws; const int tid = threadIdx.x, bid = blockIdx.x, gid = bid * 256 + tid;
    if (stage == 0) { if (gid < 64) ((unsigned*)(ws + WS_DBG))[gid] = (gid == 44) ? 0xffffu : 0u; return; }
    if (stage == 1) {
        const unsigned h = dhash(gid * 7919u + 13u);
        { const int n = h % P0W, k = (h >> 12) % 1024; const int sc = wsrc_col(0, n); const float ref = sc < 0 ? 0.f : args.in[I_EWIN][(size_t)k * L0_SRC + sc] * wcol_scale(0, n);
          dbg_rec(ws, 1, dh((const u16*)(ws + WS_W0T), (size_t)n * 1024 + k), ref, 1e-3f); }
        { const int n = h % P1W, k = (h >> 12) % 1024; const int sc = wsrc_col(2, n); const float ref = sc < 0 ? 0.f : args.in[I_OWIN][(size_t)k * L1_SRC + sc] * args.in[I_ONORM][k];
          dbg_rec(ws, 1, dh((const u16*)(ws + WS_W1T), (size_t)n * 1024 + k), ref, 1e-3f); }
        { const int n = h % 1536, k = (h >> 12) % 384; const float ref = args.in[I_OWUQ][(size_t)k * 1536 + n] * args.in[I_OQNORM][k] * QS_C;
          dbg_rec(ws, 1, dh((const u16*)(ws + WS_WUQT), (size_t)n * 384 + k), ref, 1e-3f); }
        { const int n = h % 2048, k = (h >> 12) % 256; const float ref = args.in[I_OWUKV][(size_t)k * 2048 + n] * args.in[I_OKVNORM][k];
          dbg_rec(ws, 1, dh((const u16*)(ws + WS_WUKVT), (size_t)n * 256 + k), ref, 1e-3f); }
        { const int n = h % 1024, k = (h >> 12) % 1024; dbg_rec(ws, 1, dh((const u16*)(ws + WS_WO0T), (size_t)n * 1024 + k), args.in[I_EWO][(size_t)k * 1024 + n], 1e-3f);
          dbg_rec(ws, 1, dh((const u16*)(ws + WS_WO1T), (size_t)n * 1024 + k), args.in[I_OWO][(size_t)k * 1024 + n], 1e-3f); }
        { const int row = h % T, col = (h >> 15) % 1024; const float* xr = args.in[I_X] + (size_t)row * DM; float ss = 0.f; for (int k = 0; k < DM; ++k) ss += xr[k] * xr[k];
          const float ref = xr[col] * rsqrtf(ss / DM + RMS_EPS) * args.in[I_ENORM][col]; dbg_rec(ws, 2, dh((const u16*)(ws + WS_XN0), (size_t)row * DM + col), ref, 1e-2f); }
        return;
    }
    if (stage == 2) {
        const unsigned h = dhash(gid * 104729u + 7u); const int row = h % T; int col = (h >> 15) % P0W; if (gid & 1) col = C_G0 + (col & 1023); if ((gid & 7) == 2) col = C_KI + (col & 63);
        const u16* a = (const u16*)(ws + WS_XN0) + (size_t)row * DM; const u16* b = (const u16*)(ws + WS_W0T) + (size_t)col * 1024; float acc = 0.f;
        for (int k = 0; k < 1024; ++k) acc += h2f(a[k]) * h2f(b[k]);
        if (col >= C_G0) acc = acc / (1.f + expf(-acc));
        dbg_rec(ws, 3, dh((const u16*)(ws + WS_PROJ0), (size_t)row * P0W + col), acc, 2e-2f);
        return;
    }
    if (stage == 3) {
        __shared__ NaiveSh NS;
        const unsigned h = dhash(bid * 2654435761u + 99u);
        int q = h % SEQ; const int b = (h >> 12) % NB; if (bid % 5 == 0) q = q % 320;
        const size_t row = (size_t)b * SEQ + q;
        if (bid < 48) { const int hd = (h >> 20) % 4; const float ref = naiveA(NS, args, b, q, hd, tid);
            if (tid < 128) dbg_rec(ws, 4, dh((const u16*)(ws + WS_MG0), row * DM + hd * 128 + tid), ref, 2e-2f); }
        else { const int hd = (h >> 20) % 8; naiveB_select(NS, args, b, q, tid); const float ref = naiveB_head(NS, args, b, q, hd, tid);
            if (tid < 64) dbg_rec(ws, 5, dh((const u16*)(ws + WS_MG0), row * DM + 512 + hd * 64 + tid), ref, 2e-2f); }
        return;
    }
    if (stage == 4) {
        const unsigned h = dhash(gid * 15485863u + 3u); const int row = h % T, col = (h >> 15) % 1024;
        const u16* a = (const u16*)(ws + WS_MG0) + (size_t)row * DM; const u16* b = (const u16*)(ws + WS_WO0T) + (size_t)col * 1024; float acc = 0.f;
        for (int k = 0; k < 1024; ++k) acc += h2f(a[k]) * h2f(b[k]);
        const float ref = args.in[I_X][(size_t)row * DM + col] + acc;
        dbg_rec(ws, 6, args.out[(size_t)row * DM + col], ref, 1e-2f); dbg_rec(ws, 6, dh((const u16*)(ws + WS_XN0), (size_t)row * DM + col), ref, 1e-2f);
        if (gid < 2048) { float ss = 0.f; for (int k = 0; k < DM; ++k) { const float v = args.out[(size_t)row * DM + k]; ss += v * v; }
            dbg_rec(ws, 7, (float)((const u64*)(ws + WS_SSQ1))[row] / FXS, ss, 1e-3f); }
        return;
    }
    if (stage == 5) {
        const unsigned h = dhash(gid * 32452843u + 5u); const int row = h % T; int col = (h >> 15) % P1W; if ((gid & 3) == 1) col = 640 + (col & 31);
        if (col >= 672 && col < 768) col -= 200;
        const u16* a = (const u16*)(ws + WS_XN0) + (size_t)row * DM; float ss = 0.f; for (int k = 0; k < DM; ++k) { const float v = args.out[(size_t)row * DM + k]; ss += v * v; }
        const float rs = rsqrtf(ss / DM + RMS_EPS);
        auto dotc = [&](int c) { const u16* b = (const u16*)(ws + WS_W1T) + (size_t)c * 1024; float acc = 0.f; for (int k = 0; k < 1024; ++k) acc += h2f(a[k]) * h2f(b[k]); return acc * rs; };
        const float v = dotc(col);
        if (col < 640) dbg_rec(ws, 8, dh((const u16*)(ws + WS_LAT), (size_t)row * LATW + col), v, 2e-2f);
        else if (col < 672) { const int j = col - 640, pos = row & (SEQ - 1), i = j & 15; const float inv = (float)pow(10000.0, -(double)i / 16.0), ang = (float)pos * inv; const float cs = cosf(ang), sn = sinf(ang);
            const float other = dotc(j < 16 ? col + 16 : col - 16); const float ref = j < 16 ? v * cs - other * sn : other * sn + v * cs;
            dbg_rec(ws, 9, dh((const u16*)(ws + WS_KROPE), (size_t)row * 32 + j), ref, 2e-2f); }
        else dbg_rec(ws, 10, dh((const u16*)(ws + WS_G1), (size_t)row * DM + col - 768), v / (1.f + expf(-v)), 2e-2f);
        if (gid < 1024) { const u16* lat = (const u16*)(ws + WS_LAT) + (size_t)row * LATW; float s1 = 0.f, s2 = 0.f; for (int k = 0; k < 256; ++k) s1 += h2f(lat[k]) * h2f(lat[k]); for (int k = 256; k < 640; ++k) s2 += h2f(lat[k]) * h2f(lat[k]);
            dbg_rec(ws, 11, (float)((const u64*)(ws + WS_SSQKV))[row] / FXS, s1, 1e-2f); dbg_rec(ws, 11, (float)((const u64*)(ws + WS_SSQQ))[row] / FXS, s2, 1e-2f); }
        return;
    }
    if (stage == 6) {
        const unsigned h = dhash(gid * 49979687u + 11u); const int row = h % T; const u16* lat = (const u16*)(ws + WS_LAT) + (size_t)row * LATW;
        { const int col = (h >> 15) % 2048; float s1 = 0.f; for (int k = 0; k < 256; ++k) s1 += h2f(lat[k]) * h2f(lat[k]); const float rs = rsqrtf(s1 / 256.f + RMS_EPS);
          const u16* b = (const u16*)(ws + WS_WUKVT) + (size_t)col * 256; float acc = 0.f; for (int k = 0; k < 256; ++k) acc += h2f(lat[k]) * h2f(b[k]);
          dbg_rec(ws, 13, dh((const u16*)(ws + WS_KV1), (size_t)row * 2048 + col), acc * rs, 2e-2f); }
        { int col = (h >> 15) % 1536; if (gid & 1) col = (col / 96) * 96 + 64 + (col & 31);
          float s2 = 0.f; for (int k = 256; k < 640; ++k) s2 += h2f(lat[k]) * h2f(lat[k]); const float rs = rsqrtf(s2 / 384.f + RMS_EPS);
          auto dotc = [&](int c) { const u16* b = (const u16*)(ws + WS_WUQT) + (size_t)c * 384; float acc = 0.f; for (int k = 0; k < 384; ++k) acc += h2f(lat[256 + k]) * h2f(b[k]); return acc * rs; };
          float v = dotc(col); const int jj = col % 96;
          if (jj >= 64) { const int j = jj - 64, pos = row & (SEQ - 1), i = j & 15; const float inv = (float)pow(10000.0, -(double)i / 16.0), ang = (float)pos * inv; const float cs = cosf(ang), sn = sinf(ang);
              const float other = dotc(j < 16 ? col + 16 : col - 16); v = j < 16 ? v * cs - other * sn : other * sn + v * cs; }
          dbg_rec(ws, 12, dh((const u16*)(ws + WS_Q1), (size_t)row * 1536 + col), v, 2e-2f); }
        return;
    }
    if (stage == 7) {
        __shared__ NaiveSh NS;
        const unsigned h = dhash(bid * 2654435761u + 777u); int q = h % SEQ; const int b = (h >> 12) % NB, hd = (h >> 20) % 16; if (bid % 5 == 0) q = q % 320;
        const size_t row = (size_t)b * SEQ + q; const float ref = naiveC(NS, args, b, q, hd, tid);
        if (tid < 64) dbg_rec(ws, 14, dh((const u16*)(ws + WS_MG1), row * DM + hd * 64 + tid), ref, 2e-2f);
        { const float got = tid < 64 ? dh((const u16*)(ws + WS_MG1), row * DM + hd * 64 + tid) : 0.f; const bool bad = tid < 64 && fabsf(got - ref) / (fabsf(ref) + 2e-2f) > 0.05f;
          if (__syncthreads_or(bad ? 1 : 0) && tid == 0) { atomicAdd((unsigned*)(ws + WS_DBG) + 43, 1u); atomicMin((unsigned*)(ws + WS_DBG) + 44, (unsigned)(q / 64)); atomicMax((unsigned*)(ws + WS_DBG) + 45, (unsigned)(q / 64)); } }
        {
            const u16* Q1 = (const u16*)(ws + WS_Q1); const u16* KV = (const u16*)(ws + WS_KV1); const u16* KR = (const u16*)(ws + WS_KROPE); const float* db = (const float*)(ws + WS_DBGBUF) + 4096;
            for (int e = gid; e < 256 * 64; e += gridDim.x * 256) { const int qq = e >> 6, d = e & 63, qpos = 256 * TAPQB + qq, nkk = 64 * (qpos / 64 + 1); float mx = -1e30f, ls = 0.f, a = 0.f;
                const size_t rb = (size_t)TAPB * SEQ; const u16* qp = Q1 + (rb + qpos) * 1536 + TAPH * 96;
                for (int pass = 0; pass < 2; ++pass)
                for (int k = 0; k < nkk; ++k) { float sacc = 0.f; for (int dd = 0; dd < 64; ++dd) sacc += h2f(qp[dd]) * h2f(KV[(rb + k) * 2048 + TAPH * 128 + dd]);
                    for (int dd = 0; dd < 32; ++dd) sacc += h2f(qp[64 + dd]) * h2f(KR[(rb + k) * 32 + dd]);
                    if (pass == 0) mx = fmaxf(mx, sacc); else { const float p = exp2f(sacc - mx); ls += p; a += p * h2f(KV[(rb + k) * 2048 + TAPH * 128 + 64 + d]); } }
                dbg_rec(ws, 21 + (qq >> 6), db[e], a / ls, 2e-2f); }
        }
        if (bid == 0) {
            const u16* Q1 = (const u16*)(ws + WS_Q1); const u16* KV = (const u16*)(ws + WS_KV1); const u16* KR = (const u16*)(ws + WS_KROPE); const float* db = (const float*)(ws + WS_DBGBUF);
            for (int e = tid; e < 32 * 64; e += 256) { const int qq = e >> 6, k = e & 63; float sacc = 0.f;
                for (int d = 0; d < 64; ++d) sacc += h2f(Q1[(size_t)qq * 1536 + d]) * h2f(KV[(size_t)k * 2048 + d]);
                for (int d = 0; d < 32; ++d) sacc += h2f(Q1[(size_t)qq * 1536 + 64 + d]) * h2f(KR[(size_t)k * 32 + d]);
                dbg_rec(ws, 20, db[e], sacc, 2e-2f); dbg_rec(ws, 41, db[e], 0.f, 1.0f); dbg_rec(ws, 42, sacc, 0.f, 1.0f); }
            (void)0;
        }
        return;
    }
    if (stage == 9) {
        if (gid == 0) { const unsigned* e = (const unsigned*)(ws + WS_DBG);
            if (DBG_REPORT_ID >= 43 && DBG_REPORT_ID <= 45) { args.out[0] = 100.0f * (float)e[DBG_REPORT_ID] + 50.f; }
            else if (DBG_REPORT_ID == 40) { args.out[0] = 100.0f * (float)(e[40] / 32u) + 50.f; }
            else if (DBG_REPORT_ID > 0) { args.out[0] = 1000.0f * __uint_as_float(e[DBG_REPORT_ID]); }
            else if (DBG_BITS_MODE) { const int ids[6] = {DBG_BITS_IDS}; int v = 0; for (int i = 0; i < 6; ++i) if (ids[i] > 0 && __uint_as_float(e[ids[i]]) > 0.05f) v |= 1 << i; if (v) args.out[0] = 100.0f * v; }
            else { int first = 0; for (int id = 1; id < 32 && !first; ++id) if (!((DBG_SKIP_MASK >> id) & 1) && __uint_as_float(e[id]) > 0.05f) first = id; if (first) args.out[0] = 100.0f * first; } }
        return;
    }
}
#endif

constexpr int N_PHASES = 9;
__global__ void __launch_bounds__(NWAVES * 64) hybrid_fwd(Args args) {
    extern __shared__ __attribute__((aligned(16))) unsigned char lds_raw[];
    Frame F;
    F.lds = (LAS unsigned char*)lds_raw;
    F.MISC = (volatile LAS unsigned*)(F.lds + MISC_OFF);
    F.tid = threadIdx.x; F.lane = F.tid & 63; F.wave = __builtin_amdgcn_readfirstlane(F.tid >> 6);
    F.G = gridDim.x;
    F.out = args.out; F.ws = args.ws; F.ctl = (unsigned*)(args.ws + WS_CTL);
    for (int u = F.tid; u < (LDS_BYTES - RING_BYTES) / 4; u += NWAVES * 64) ((LAS unsigned*)(F.lds + RING_BYTES))[u] = 0u;
    __syncthreads();
    const int lo = args.ph_lo, hi = args.ph_hi;
    const bool multi = (hi - lo) > 1;
    XcdBarrier bar; bar.bar = F.ctl + CW_BAR; bar.x = 0; bar.st = nullptr;
    if (multi) bar = xcd_barrier_post(F.ctl + CW_BAR, F.MISC + 8);
#ifndef PH_MASK
#define PH_MASK 0x1FF
#endif
#define IN(k) (((PH_MASK >> (k)) & 1) && lo <= (k) && (k) < hi)
#define SEAM(k) do { if (IN(k) && IN((k) + 1)) xcd_barrier(bar); } while (0)
    unsigned char* ws = args.ws;
    LAS unsigned char* ring = F.lds;

#define PHASE1(rep) do { \
        pg8::Gemm g{(const u16*)(ws + WS_XN0), (const u16*)(ws + WS_W0T), T, P0W, 1024, 1024}; pg8::StaticOrder S; S.init(T, P0W, F.G, (int)blockIdx.x); \
        pg8::EpiProj0 E{(u16*)(ws + WS_PROJ0)}; \
        pg8::gemm_phase<pg8::EpiProj0>(ring, g, S, E); } while (0)
#define PHASE2(rep) do { if (!NAIVE_ATTN) { \
        for (;;) { \
            const int u = next_unit(F, (rep) ? CW_Q0 + 16 : CW_Q0); \
            if (u >= 2048) break; \
            const int lvl = 31 - (u >> 6), r = u & 63; \
            if (r < 32) { if (!((rep) && REPEAT_SUB == 1)) { const int c = 2 * lvl + 1 - (r >> 4), rr = r & 15; attnB_unit(F, rr >> 1, 2 * c + (rr & 1), (rep) ? REPEAT_SUB : 0); } } \
            else { if (!((rep) && REPEAT_SUB >= 2)) { const int idx = r - 32; attnA_unit(F, args, idx >> 2, idx & 3, lvl); } } \
        } \
        __syncthreads(); } } while (0)
#define PHASE3(rep) do { \
        pg8::Gemm g{(const u16*)(ws + WS_MG0), (const u16*)(ws + WS_WO0T), T, 1024, 1024, 1024}; pg8::StaticOrder S; S.init(T, 1024, F.G, (int)blockIdx.x); \
        pg8::EpiRes0 E{args.in[I_X], (u16*)(ws + WS_XN0), (rep) ? nullptr : (u64*)(ws + WS_SSQ1)}; \
        pg8::gemm_phase<pg8::EpiRes0>(ring, g, S, E); } while (0)
#define PHASE4(rep) do { \
        pg8::Gemm g{(const u16*)(ws + WS_XN0), (const u16*)(ws + WS_W1T), T, P1W, 1024, 1024}; pg8::StaticOrder S; S.init(T, P1W, F.G, (int)blockIdx.x); \
        pg8::EpiProj1 E{(const u64*)(ws + WS_SSQ1), (u16*)(ws + WS_LAT), (u16*)(ws + WS_KROPE), (u16*)(ws + WS_G1), (rep) ? nullptr : (u64*)(ws + WS_SSQKV), (rep) ? nullptr : (u64*)(ws + WS_SSQQ), (const float*)(ws + WS_ROPEC), (const float*)(ws + WS_ROPES)}; \
        pg8::gemm_phase<pg8::EpiProj1>(ring, g, S, E); } while (0)
#define PHASE5(rep) do { \
        { pg8::Gemm g{(const u16*)(ws + WS_LAT) + 256, (const u16*)(ws + WS_WUQT), T, 1536, 384, LATW}; pg8::StaticOrder S; S.init(T, 1536, F.G, (int)blockIdx.x); \
          pg8::EpiQ1 E{(const u64*)(ws + WS_SSQQ), (u16*)(ws + WS_Q1), (const float*)(ws + WS_ROPEC), (const float*)(ws + WS_ROPES)}; \
          pg8::gemm_phase<pg8::EpiQ1>(ring, g, S, E); } \
        { pg8::Gemm g{(const u16*)(ws + WS_LAT), (const u16*)(ws + WS_WUKVT), T, 2048, 256, LATW}; pg8::StaticOrder S; S.init(T, 2048, F.G, (int)blockIdx.x); \
          pg8::EpiKV1 E{(const u64*)(ws + WS_SSQKV), (u16*)(ws + WS_KV1)}; \
          pg8::gemm_phase<pg8::EpiKV1>(ring, g, S, E); } } while (0)
#define PHASE6(rep) do { if (!NAIVE_ATTN) { \
        for (;;) { \
            const int u = next_unit(F, (rep) ? CW_Q1 + 16 : CW_Q1); \
            if (u >= 2048) break; \
            const int qb = 15 - (u >> 7), r = u & 127; \
            attnC_unit(F, r >> 4, r & 15, qb); \
        } \
        __syncthreads(); } } while (0)
#define PHASE7(rep) do { \
        pg8::Gemm g{(const u16*)(ws + WS_MG1), (const u16*)(ws + WS_WO1T), T, 1024, 1024, 1024}; pg8::StaticOrder S; S.init(T, 1024, F.G, (int)blockIdx.x); \
        pg8::EpiRes1 E{(const u16*)(ws + WS_XN0), F.out}; \
        pg8::gemm_phase<pg8::EpiRes1>(ring, g, S, E); } while (0)
#define REPEAT(k, CALL) do { if (REPEAT_PHASE == (k) && multi) { xcd_barrier(bar); CALL; } } while (0)
    if (IN(0)) { p0_prologue(F, args); REPEAT(0, p0_prologue(F, args)); } SEAM(0);
    if (IN(1)) { PHASE1(0); REPEAT(1, PHASE1(1)); } SEAM(1);
    if (IN(2)) { PHASE2(0); REPEAT(2, PHASE2(1)); } SEAM(2);
    if (IN(3)) { PHASE3(0); REPEAT(3, PHASE3(1)); } SEAM(3);
    if (IN(4)) { PHASE4(0); REPEAT(4, PHASE4(1)); } SEAM(4);
    if (IN(5)) { PHASE5(0); REPEAT(5, PHASE5(1)); } SEAM(5);
    if (IN(6)) { PHASE6(0); REPEAT(6, PHASE6(1)); } SEAM(6);
    if (IN(7)) { PHASE7(0); } SEAM(7);
    if (IN(8)) { p8_final(F, args); }
#undef IN
#undef SEAM
}

extern "C" void kernel_launch(void* const* d_in, const int* in_sizes, int n_in, void* d_out, int out_size, void* d_ws, size_t ws_size, hipStream_t stream) {
    static int grid = 0;
    if (grid == 0) {
        if (n_in != 18 || in_sizes[0] != T * DM || out_size != T * DM || ws_size < WS_END) {
            fprintf(stderr, "kernel_launch: unexpected shapes (n_in %d, in0 %d, out %d, ws %zu, need %zu); nothing launched\n", n_in, n_in > 0 ? in_sizes[0] : -1, out_size, ws_size, (size_t)WS_END); grid = -1; return; }
        int dev = 0, cus = 0, per_cu = 0;
        if (hipGetDevice(&dev) != hipSuccess || hipDeviceGetAttribute(&cus, hipDeviceAttributeMultiprocessorCount, dev) != hipSuccess) { fprintf(stderr, "kernel_launch: device query failed\n"); grid = -1; return; }
        if (hipFuncSetAttribute((const void*)hybrid_fwd, hipFuncAttributeMaxDynamicSharedMemorySize, LDS_BYTES) != hipSuccess) { fprintf(stderr, "kernel_launch: hipFuncSetAttribute failed\n"); grid = -1; return; }
        if (hipOccupancyMaxActiveBlocksPerMultiprocessor(&per_cu, (const void*)hybrid_fwd, NWAVES * 64, LDS_BYTES) != hipSuccess || per_cu < 1)
            fprintf(stderr, "kernel_launch: note: occupancy query reports %d workgroups per CU\n", per_cu);
        (void)hipGetLastError();
        grid = cus;
        if (grid % 8 != 0) grid -= grid % 8;
    }
    if (grid <= 0) return;
    (void)hipMemsetAsync((char*)d_ws + WS_CTL, 0, CTL_ZERO_BYTES, stream);
    Args a{};
    for (int i = 0; i < 18; ++i) a.in[i] = (const float*)d_in[i];
    a.out = (float*)d_out; a.ws = (unsigned char*)d_ws;
#if MK_N_LAUNCHES == 1
    a.ph_lo = 0; a.ph_hi = N_PHASES;
    hipLaunchKernelGGL(hybrid_fwd, dim3(grid), dim3(NWAVES * 64), LDS_BYTES, stream, a);
#else
#if DEBUG_CHECK
    hipLaunchKernelGGL(dbg_check, dim3(1), dim3(256), 0, stream, a, 0);
#endif
    for (int p = 0; p < N_PHASES; ++p) { a.ph_lo = p; a.ph_hi = p + 1;
#if NAIVE_ATTN
        if (p == 2) { hipLaunchKernelGGL(naive_attn, dim3(8192), dim3(256), 0, stream, a, 0); continue; }
        if (p == 6) { hipLaunchKernelGGL(naive_attn, dim3(8192), dim3(256), 0, stream, a, 1); continue; }
#endif
        hipLaunchKernelGGL(hybrid_fwd, dim3(grid), dim3(NWAVES * 64), LDS_BYTES, stream, a);
#if DEBUG_CHECK
        if (p <= 6) hipLaunchKernelGGL(dbg_check, dim3((p == 2 || p == 6) ? 96 : 64), dim3(256), 0, stream, a, p + 1);
#endif
    }
#if DEBUG_CHECK
    hipLaunchKernelGGL(dbg_check, dim3(1), dim3(256), 0, stream, a, 9);
#endif
#endif
    const hipError_t le = hipPeekAtLastError();
    if (le != hipSuccess) fprintf(stderr, "kernel_launch: launch failed: %s\n", hipGetErrorName(le));
}
```

```cpp
#include <hip/hip_runtime.h>
#include <cstdio>
#include <cstdint>

#ifndef DEBUG_CHECK
#define DEBUG_CHECK 0
#endif
#define TAPB 3
#define TAPH 5
#define TAPQB 7
#ifndef REPEAT_PHASE
#define REPEAT_PHASE -1
#define REPEAT_SUB 0
#endif
#ifndef MK_N_LAUNCHES
#define MK_N_LAUNCHES 1
#endif

#define LAS __attribute__((address_space(3)))
#define GAS __attribute__((address_space(1)))
typedef unsigned short u16;
typedef unsigned long long u64;
typedef _Float16 h8 __attribute__((ext_vector_type(8)));
typedef _Float16 h2 __attribute__((ext_vector_type(2)));
typedef _Float16 h4 __attribute__((ext_vector_type(4)));
typedef short s16x4 __attribute__((ext_vector_type(4)));
typedef short s16x8 __attribute__((ext_vector_type(8)));
typedef float f32x2 __attribute__((ext_vector_type(2)));
typedef float f32x4 __attribute__((ext_vector_type(4)));
typedef float f32x16 __attribute__((ext_vector_type(16)));
typedef unsigned u32x2 __attribute__((ext_vector_type(2)));
typedef unsigned u32x4 __attribute__((ext_vector_type(4)));

constexpr int SEQ = 4096, NB = 8, T = NB * SEQ, DM = 1024;
constexpr int P0W = 3840;
constexpr int C_QA = 0, C_KA = 512, C_VA = 1024, C_QB = 1536, C_KB = 2048, C_VB = 2112, C_QI = 2176, C_KI = 2688, C_WI = 2752, C_G0 = 2816;
constexpr int L0_SRC = 3784;
constexpr int P1W = 1792;
constexpr int L1_SRC = 1696;
constexpr int LATW = 640;
constexpr int TOPK = 256;
constexpr float LOG2E = 1.4426950408889634f;
constexpr float QS_AB = 0.125f * LOG2E;
constexpr float QS_C = 0.10206207261596575f * LOG2E;
constexpr float RMS_EPS = 1e-6f;
constexpr float FXS = 1048576.0f;

constexpr size_t MiB = 1u << 20;
constexpr size_t WS_CTL = 0, CTL_ZERO_BYTES = 2 * MiB;
constexpr size_t WS_SSQ1 = 1 * MiB, WS_SSQKV = WS_SSQ1 + 256 * 1024, WS_SSQQ = WS_SSQKV + 256 * 1024;
constexpr size_t WS_ROPEC = 2 * MiB, WS_ROPES = WS_ROPEC + 256 * 1024, WS_BTG = WS_ROPES + 256 * 1024, WS_LAM = WS_BTG + 16 * 1024;
constexpr size_t WS_W0T = 4 * MiB;
constexpr size_t WS_WO0T = 12 * MiB;
constexpr size_t WS_W1T = 14 * MiB;
constexpr size_t WS_WUQT = 18 * MiB;
constexpr size_t WS_WUKVT = 20 * MiB;
constexpr size_t WS_WO1T = 22 * MiB;
constexpr size_t WS_XN0 = 32 * MiB;
constexpr size_t WS_PROJ0 = 96 * MiB;
constexpr size_t WS_MG0 = 336 * MiB;
constexpr size_t WS_LAT = 96 * MiB;
constexpr size_t WS_KROPE = 136 * MiB;
constexpr size_t WS_G1 = 140 * MiB;
constexpr size_t WS_Q1 = 204 * MiB;
constexpr size_t WS_KV1 = 300 * MiB;
constexpr size_t WS_MG1 = 428 * MiB;
constexpr size_t WS_X2H = 96 * MiB;
constexpr size_t WS_END = 492 * MiB;
constexpr size_t WS_DBGBUF = 3 * MiB + 4096;
constexpr int CW_TMO = 0, CW_CODE = 1, CW_Q0 = 64, CW_Q1 = 128, CW_BAR = 4096;

constexpr int RING_BYTES = 131072;
constexpr int MISC_OFF = RING_BYTES + 320;
constexpr int LDS_BYTES = 147456;
constexpr int NWAVES = 8;

__device__ __forceinline__ unsigned pkh(float lo, float hi) { f32x2 v = {lo, hi}; h2 h = __builtin_convertvector(v, h2); return __builtin_bit_cast(unsigned, h); }
__device__ __forceinline__ float h2f(u16 b) { return (float)__builtin_bit_cast(_Float16, b); }
__device__ __forceinline__ float silu_f(float x) { return x * __builtin_amdgcn_rcpf(1.0f + __builtin_amdgcn_exp2f(-x * LOG2E)); }
__device__ __forceinline__ float swap_max(float m) { auto rr = __builtin_amdgcn_permlane32_swap(__float_as_uint(m), __float_as_uint(m), false, false); return fmaxf(__uint_as_float(rr[0]), __uint_as_float(rr[1])); }
__device__ __forceinline__ float swap_sum(float m) { auto rr = __builtin_amdgcn_permlane32_swap(__float_as_uint(m), __float_as_uint(m), false, false); return __uint_as_float(rr[0]) + __uint_as_float(rr[1]); }
__device__ __forceinline__ float wave_sum(float v) {
#pragma unroll
    for (int o = 1; o < 64; o <<= 1) v += __shfl_xor(v, o);
    return v;
}
#define LDS_WAIT() asm volatile("s_waitcnt lgkmcnt(0)" ::: "memory")
#define VM_WAIT() asm volatile("s_waitcnt vmcnt(0)" ::: "memory")

namespace pg8 {
constexpr int BM = 256, BK = 64, HALF = 128, HTB = HALF * BK * 2, STAGE_BYTES = 8 * HTB, NXCD = 8, WGM = 8;
__host__ __device__ __forceinline__ int lds_byte(int r, int c) { const int st = (r >> 4) * 2 + (c >> 5), rr = r & 15, cc = c & 31, ob = rr * 64 + cc * 2; return st * 1024 + (ob ^ (((ob >> 9) & 1) << 5)); }
__host__ __device__ __forceinline__ void stage_rc(int b, int& R, int& C) { const int st = b / 1024, sb = b % 1024, swz = sb ^ (((sb >> 9) & 1) << 5); R = (st >> 1) * 16 + swz / 64; C = (st & 1) * 32 + (swz % 64) / 2; }
__host__ __device__ __forceinline__ int perm32(int rho) { const int n = rho >> 4, i = rho & 15; return 8 * (i >> 2) + 4 * n + (i & 3); }
struct Unit { int pm, pn; };
struct Gemm { const u16* A; const u16* Bt; int M, N, K, lda; };
struct StaticOrder {
    int nM, nN, nwg, G, c;
    __device__ void init(int M, int N, int G_, int c_) { nM = M / BM; nN = N / BM; nwg = nM * nN; G = G_; c = c_; }
    __device__ bool next(int i, Unit& u) const {
        const long L = (long)i * G + c; if (L >= nwg) return false;
        int wgid = (int)L; { const int q = nwg / NXCD, r = nwg % NXCD, xcd = wgid % NXCD, off = wgid / NXCD; wgid = (xcd < r ? xcd * (q + 1) : r * (q + 1) + (xcd - r) * q) + off; }
        const int nig = WGM * nN, gid = wgid / nig, fm = gid * WGM, gsz = (nM - fm) < WGM ? (nM - fm) : WGM;
        u.pm = fm + ((wgid % nig) % gsz); u.pn = (wgid % nig) / gsz; return true;
    }
};
template <class Epi>
__device__ __forceinline__ void gemm_phase(LAS unsigned char* lds, const Gemm g, const StaticOrder& S, const Epi& E) {
    const int tid = threadIdx.x, wid = __builtin_amdgcn_readfirstlane(tid >> 6), lane = tid & 63, wr = wid >> 2, wc = wid & 3, fr = lane & 15, fq = lane >> 4;
    const int K = g.K, nt = K / BK, lda = g.lda;
    unsigned voffA[2], voffB[2];
#pragma unroll
    for (int i = 0; i < 2; ++i) { int R, C; stage_rc(tid * 16 + i * 8192, R, C); const int Rb = Epi::PERM ? ((R & ~31) + perm32(R & 31)) : R;
        voffA[i] = (unsigned)(R * lda + C) * 2u; voffB[i] = (unsigned)(Rb * K + C) * 2u; }
    const size_t kstep = (size_t)(BK * 2);
    const size_t hstepA = (size_t)HALF * lda * 2, tstepA = 2 * hstepA;
    const size_t hstepB = (size_t)HALF * K * 2, tstepB = 2 * hstepB;
    const unsigned ldsw = (unsigned)wid * 1024u;
    const int aoff = lds_byte(wr * 64 + fr, fq * 8), boff = lds_byte(wc * 32 + fr, fq * 8);
#define PG8_SA(b, h) (((b) * 2 + (h)) * HTB)
#define PG8_SB(b, h) ((4 + (b) * 2 + (h)) * HTB)
#define PG8_STAGE(bufoff, gbase, voff) do { _Pragma("unroll") for (int _i = 0; _i < 2; ++_i) \
        __builtin_amdgcn_global_load_lds((const unsigned*)((const char*)(gbase) + (voff)[_i]), (LAS unsigned*)(lds + (bufoff) + ldsw + _i * 8192), 16, 0, 0); } while (0)
#define PG8_LDA(dst, b, h) do { _Pragma("unroll") for (int m = 0; m < 4; ++m) _Pragma("unroll") for (int k = 0; k < 2; ++k) dst[m][k] = *(const LAS h8*)(lds + PG8_SA(b, h) + aoff + m * 2048 + k * 1024); } while (0)
#define PG8_LDB(dst, b, h) do { _Pragma("unroll") for (int n = 0; n < 2; ++n) _Pragma("unroll") for (int k = 0; k < 2; ++k) dst[n][k] = *(const LAS h8*)(lds + PG8_SB(b, h) + boff + n * 2048 + k * 1024); } while (0)
#define PG8_MMA(ai, bj, At, Bt) do { __builtin_amdgcn_s_setprio(1); _Pragma("unroll") for (int m = 0; m < 4; ++m) _Pragma("unroll") for (int n = 0; n < 2; ++n) _Pragma("unroll") for (int k = 0; k < 2; ++k) \
        acc[ai][bj][m][n] = __builtin_amdgcn_mfma_f32_16x16x32_f16(Bt[n][k], At[m][k], acc[ai][bj][m][n], 0, 0, 0); __builtin_amdgcn_s_setprio(0); } while (0)
#define PG8_WAIT_V(n) asm volatile("s_waitcnt vmcnt(" #n ")" ::: "memory")
#define PG8_WAIT_L(n) asm volatile("s_waitcnt lgkmcnt(" #n ")" ::: "memory")
#define PG8_BAR __builtin_amdgcn_s_barrier()
#define PG8_SCHED __builtin_amdgcn_sched_barrier(0)
    Unit cur, nxt; int ui = 0;
    if (!S.next(0, cur)) return;
    f32x4 acc[2][2][4][2];
#pragma unroll
    for (int a = 0; a < 2; ++a)
#pragma unroll
        for (int b = 0; b < 2; ++b)
#pragma unroll
            for (int m = 0; m < 4; ++m)
#pragma unroll
                for (int n = 0; n < 2; ++n) acc[a][b][m][n] = (f32x4){0.f, 0.f, 0.f, 0.f};
    h8 At[4][2], B0[2][2], B1[2][2];
    const char* cA = (const char*)g.A + (size_t)cur.pm * tstepA; const char* cB = (const char*)g.Bt + (size_t)cur.pn * tstepB;
    PG8_STAGE(PG8_SB(0, 0), cB, voffB); PG8_STAGE(PG8_SB(0, 1), cB + hstepB, voffB); PG8_STAGE(PG8_SA(0, 0), cA, voffA); PG8_STAGE(PG8_SA(0, 1), cA + hstepA, voffA);
    if (wr == 1) PG8_BAR;
    PG8_WAIT_V(2); PG8_BAR;
    PG8_STAGE(PG8_SB(1, 0), cB + kstep, voffB); PG8_STAGE(PG8_SA(1, 0), cA + kstep, voffA); PG8_STAGE(PG8_SB(1, 1), cB + hstepB + kstep, voffB);
    PG8_WAIT_V(6); PG8_BAR;
    for (;;) {
        const bool has_next = S.next(ui + 1, nxt);
        const char* nA = has_next ? (const char*)g.A + (size_t)nxt.pm * tstepA : cA; const char* nB = has_next ? (const char*)g.Bt + (size_t)nxt.pn * tstepB : cB;
#pragma unroll 1
        for (int t = 0; t < nt; t += 2) {
            const bool last = (t == nt - 2);
            const char* a1 = cA + (size_t)(t + 1) * kstep;
            const char* a2 = last ? nA : cA + (size_t)(t + 2) * kstep; const char* b2 = last ? nB : cB + (size_t)(t + 2) * kstep;
            const char* a3 = a2 + kstep; const char* b3 = b2 + kstep;
            PG8_LDB(B0, 0, 0); PG8_LDB(B1, 0, 1); PG8_SCHED; PG8_LDA(At, 0, 0); PG8_STAGE(PG8_SA(1, 1), a1 + hstepA, voffA);
            PG8_WAIT_V(8); PG8_WAIT_L(0); PG8_BAR; PG8_MMA(0, 0, At, B0); PG8_MMA(0, 1, At, B1); PG8_BAR; PG8_SCHED;
            PG8_LDA(At, 0, 1); PG8_STAGE(PG8_SB(0, 0), b2, voffB); PG8_STAGE(PG8_SB(0, 1), b2 + hstepB, voffB); PG8_STAGE(PG8_SA(0, 0), a2, voffA);
            PG8_WAIT_V(8); PG8_WAIT_L(0); PG8_BAR; PG8_MMA(1, 0, At, B0); PG8_MMA(1, 1, At, B1); PG8_BAR; PG8_SCHED;
            PG8_LDB(B0, 1, 0); PG8_LDB(B1, 1, 1); PG8_SCHED; PG8_LDA(At, 1, 0); PG8_STAGE(PG8_SA(0, 1), a2 + hstepA, voffA);
            PG8_WAIT_V(8); PG8_WAIT_L(0); PG8_BAR; PG8_MMA(0, 0, At, B0); PG8_MMA(0, 1, At, B1); PG8_BAR; PG8_SCHED;
            PG8_LDA(At, 1, 1); PG8_STAGE(PG8_SB(1, 0), b3, voffB); PG8_STAGE(PG8_SB(1, 1), b3 + hstepB, voffB); PG8_STAGE(PG8_SA(1, 0), a3, voffA);
            PG8_WAIT_V(8); PG8_WAIT_L(0); PG8_BAR; PG8_MMA(1, 0, At, B0); PG8_MMA(1, 1, At, B1); PG8_BAR; PG8_SCHED;
        }
        if (wr == 0) PG8_BAR;
        E(acc, cur, wr, wc, fr, fq);
        if (!has_next) break;
#pragma unroll
        for (int a = 0; a < 2; ++a)
#pragma unroll
            for (int b = 0; b < 2; ++b)
#pragma unroll
                for (int m = 0; m < 4; ++m)
#pragma unroll
                    for (int n = 0; n < 2; ++n) acc[a][b][m][n] = (f32x4){0.f, 0.f, 0.f, 0.f};
        cur = nxt; cA = nA; cB = nB; ++ui;
        if (wr == 1) PG8_BAR;
    }
    PG8_WAIT_V(0);
    PG8_BAR;
#undef PG8_SA
#undef PG8_SB
#undef PG8_STAGE
#undef PG8_LDA
#undef PG8_LDB
#undef PG8_MMA
#undef PG8_WAIT_V
#undef PG8_WAIT_L
#undef PG8_BAR
#undef PG8_SCHED
}

typedef f32x4 Acc[2][2][4][2];
__device__ __forceinline__ float rstd_from(const u64* ssq, int row, float inv_n) { return __builtin_amdgcn_rsqf((float)ssq[row] * (1.0f / FXS) * inv_n + RMS_EPS); }
__device__ __forceinline__ void ssq_add(u64* ssq, int row, float ss, int fq) {
    ss += __shfl_xor(ss, 16); ss += __shfl_xor(ss, 32);
    if (fq == 0) atomicAdd((unsigned long long*)(ssq + row), (unsigned long long)(ss * FXS + 0.5f));
}
struct EpiProj0 {
    static constexpr bool PERM = true;
    u16* O;
    __device__ __forceinline__ void operator()(const Acc& acc, const Unit& u, int wr, int wc, int fr, int fq) const {
        const int row0 = u.pm * BM + wr * 64 + fr, col0 = u.pn * BM + wc * 32 + 8 * fq; const bool gate = u.pn >= 11;
#pragma unroll
        for (int ai = 0; ai < 2; ++ai)
#pragma unroll
            for (int m = 0; m < 4; ++m) { u16* rowp = O + (size_t)(row0 + ai * HALF + m * 16) * P0W + col0;
#pragma unroll
                for (int bj = 0; bj < 2; ++bj) { f32x4 v0 = acc[ai][bj][m][0], v1 = acc[ai][bj][m][1];
                    if (gate) {
#pragma unroll
                        for (int e = 0; e < 4; ++e) { v0[e] = silu_f(v0[e]); v1[e] = silu_f(v1[e]); } }
                    u32x4 w; w.x = pkh(v0[0], v0[1]); w.y = pkh(v0[2], v0[3]); w.z = pkh(v1[0], v1[1]); w.w = pkh(v1[2], v1[3]);
                    *(u32x4*)(rowp + bj * HALF) = w; } }
    }
};
struct EpiRes0 {
    static constexpr bool PERM = false;
    const float* base; u16* outh; u64* ssq;
    __device__ __forceinline__ void operator()(const Acc& acc, const Unit& u, int wr, int wc, int fr, int fq) const {
        const int row0 = u.pm * BM + wr * 64 + fr, col0 = u.pn * BM + wc * 32 + 4 * fq;
#pragma unroll
        for (int ai = 0; ai < 2; ++ai)
#pragma unroll
            for (int m = 0; m < 4; ++m) { const int row = row0 + ai * HALF + m * 16; const size_t off = (size_t)row * DM + col0; float ss = 0.f;
#pragma unroll
                for (int bj = 0; bj < 2; ++bj)
#pragma unroll
                    for (int n = 0; n < 2; ++n) { const f32x4 bs = *(const f32x4*)(base + off + bj * HALF + n * 16); const f32x4 o = bs + acc[ai][bj][m][n];
                        u32x2 w; w.x = pkh(o[0], o[1]); w.y = pkh(o[2], o[3]); *(u32x2*)(outh + off + bj * HALF + n * 16) = w;
                        ss += (o[0] * o[0] + o[1] * o[1]) + (o[2] * o[2] + o[3] * o[3]); }
                if (ssq) ssq_add(ssq, row, ss, fq); }
    }
};
struct EpiRes1 {
    static constexpr bool PERM = false;
    const u16* baseh; u16* outh;
    __device__ __forceinline__ void operator()(const Acc& acc, const Unit& u, int wr, int wc, int fr, int fq) const {
        const int row0 = u.pm * BM + wr * 64 + fr, col0 = u.pn * BM + wc * 32 + 4 * fq;
#pragma unroll
        for (int ai = 0; ai < 2; ++ai)
#pragma unroll
            for (int m = 0; m < 4; ++m) { const int row = row0 + ai * HALF + m * 16; const size_t off = (size_t)row * DM + col0;
#pragma unroll
                for (int bj = 0; bj < 2; ++bj)
#pragma unroll
                    for (int n = 0; n < 2; ++n) { const h4 bh = *(const h4*)(baseh + off + bj * HALF + n * 16);
                        const f32x4 a = acc[ai][bj][m][n];
                        u32x2 w; w.x = pkh(a[0] + (float)bh[0], a[1] + (float)bh[1]); w.y = pkh(a[2] + (float)bh[2], a[3] + (float)bh[3]);
                        *(u32x2*)(outh + off + bj * HALF + n * 16) = w; } }
    }
};
struct EpiProj1 {
    static constexpr bool PERM = false;
    const u64* ssq1; u16* lat; u16* krope; u16* g1; u64* ssqkv; u64* ssqq; const float* ropec; const float* ropes;
    __device__ __forceinline__ void operator()(const Acc& acc, const Unit& u, int wr, int wc, int fr, int fq) const {
        const int row0 = u.pm * BM + wr * 64 + fr, pn = u.pn;
#pragma unroll
        for (int ai = 0; ai < 2; ++ai)
#pragma unroll
            for (int m = 0; m < 4; ++m) { const int row = row0 + ai * HALF + m * 16; const float rs = rstd_from(ssq1, row, 1.0f / 1024.0f); float ss = 0.f;
#pragma unroll
                for (int bj = 0; bj < 2; ++bj) { f32x4 v0 = acc[ai][bj][m][0] * rs, v1 = acc[ai][bj][m][1] * rs;
                    const int tc = bj * HALF + wc * 32 + 4 * fq;
                    if (pn >= 3) {
#pragma unroll
                        for (int e = 0; e < 4; ++e) { v0[e] = silu_f(v0[e]); v1[e] = silu_f(v1[e]); }
                        u16* p = g1 + (size_t)row * DM + (pn - 3) * BM + tc;
                        u32x2 w0, w1; w0.x = pkh(v0[0], v0[1]); w0.y = pkh(v0[2], v0[3]); w1.x = pkh(v1[0], v1[1]); w1.y = pkh(v1[2], v1[3]);
                        *(u32x2*)p = w0; *(u32x2*)(p + 16) = w1;
                    } else if (pn < 2 || bj == 0) {
                        u16* p = lat + (size_t)row * LATW + pn * BM + tc;
                        u32x2 w0, w1; w0.x = pkh(v0[0], v0[1]); w0.y = pkh(v0[2], v0[3]); w1.x = pkh(v1[0], v1[1]); w1.y = pkh(v1[2], v1[3]);
                        *(u32x2*)p = w0; *(u32x2*)(p + 16) = w1;
                        ss += (v0[0] * v0[0] + v0[1] * v0[1]) + (v0[2] * v0[2] + v0[3] * v0[3]) + (v1[0] * v1[0] + v1[1] * v1[1]) + (v1[2] * v1[2] + v1[3] * v1[3]);
                    } else if (wc == 0) {
                        const int pos = row & (SEQ - 1); const f32x4 cs = *(const f32x4*)(ropec + pos * 16 + 4 * fq), sn = *(const f32x4*)(ropes + pos * 16 + 4 * fq);
                        const f32x4 o0 = v0 * cs - v1 * sn, o1 = v0 * sn + v1 * cs;
                        u16* p = krope + (size_t)row * 32 + 4 * fq;
                        u32x2 w0, w1; w0.x = pkh(o0[0], o0[1]); w0.y = pkh(o0[2], o0[3]); w1.x = pkh(o1[0], o1[1]); w1.y = pkh(o1[2], o1[3]);
                        *(u32x2*)p = w0; *(u32x2*)(p + 16) = w1;
                    } }
                if (pn == 0) { if (ssqkv) ssq_add(ssqkv, row, ss, fq); } else if (pn <= 2) { if (ssqq) ssq_add(ssqq, row, ss, fq); }
                asm volatile("" ::: "memory"); }
    }
};
struct EpiQ1 {
    static constexpr bool PERM = false;
    const u64* ssqq; u16* q1; const float* ropec; const float* ropes;
    __device__ __forceinline__ void operator()(const Acc& acc, const Unit& u, int wr, int wc, int fr, int fq) const {
        const int row0 = u.pm * BM + wr * 64 + fr;
#pragma unroll
        for (int ai = 0; ai < 2; ++ai)
#pragma unroll
            for (int m = 0; m < 4; ++m) { const int row = row0 + ai * HALF + m * 16; const float rs = rstd_from(ssqq, row, 1.0f / 384.0f);
#pragma unroll
                for (int bj = 0; bj < 2; ++bj) { f32x4 v0 = acc[ai][bj][m][0] * rs, v1 = acc[ai][bj][m][1] * rs;
                    const int g0 = u.pn * BM + bj * HALF + wc * 32;
                    if ((g0 % 96) == 64) { const int pos = row & (SEQ - 1); const f32x4 cs = *(const f32x4*)(ropec + pos * 16 + 4 * fq), sn = *(const f32x4*)(ropes + pos * 16 + 4 * fq);
                        const f32x4 o0 = v0 * cs - v1 * sn, o1 = v0 * sn + v1 * cs; v0 = o0; v1 = o1; }
                    u16* p = q1 + (size_t)row * 1536 + g0 + 4 * fq;
                    u32x2 w0, w1; w0.x = pkh(v0[0], v0[1]); w0.y = pkh(v0[2], v0[3]); w1.x = pkh(v1[0], v1[1]); w1.y = pkh(v1[2], v1[3]);
                    *(u32x2*)p = w0; *(u32x2*)(p + 16) = w1; }
                asm volatile("" ::: "memory"); }
    }
};
struct EpiKV1 {
    static constexpr bool PERM = true;
    const u64* ssqkv; u16* kv1;
    __device__ __forceinline__ void operator()(const Acc& acc, const Unit& u, int wr, int wc, int fr, int fq) const {
        const int row0 = u.pm * BM + wr * 64 + fr, col0 = u.pn * BM + wc * 32 + 8 * fq;
#pragma unroll
        for (int ai = 0; ai < 2; ++ai)
#pragma unroll
            for (int m = 0; m < 4; ++m) { const int row = row0 + ai * HALF + m * 16; const float rs = rstd_from(ssqkv, row, 1.0f / 256.0f); u16* rowp = kv1 + (size_t)row * 2048 + col0;
#pragma unroll
                for (int bj = 0; bj < 2; ++bj) { const f32x4 v0 = acc[ai][bj][m][0] * rs, v1 = acc[ai][bj][m][1] * rs;
                    u32x4 w; w.x = pkh(v0[0], v0[1]); w.y = pkh(v0[2], v0[3]); w.z = pkh(v1[0], v1[1]); w.w = pkh(v1[2], v1[3]);
                    *(u32x4*)(rowp + bj * HALF) = w; }
                if (m & 1) asm volatile("" ::: "memory"); }
    }
};
}

#define XB_TMO      128
#define XB_XCNT(j)  (256  + 64 * (j))
#define XB_XSUB(j)  (1280 + 64 * (j))
#define XB_XGEN(j)  (2304 + 64 * (j))
#define XB_TOP      3328
#define XB_TOPGEN   3392
#define XCD_BAR_WORDS 3456
#define XB_SPIN_CAP (1u << 20)
__device__ __forceinline__ unsigned xb_ld(unsigned* p)              { return __hip_atomic_load(p, __ATOMIC_RELAXED, __HIP_MEMORY_SCOPE_AGENT); }
__device__ __forceinline__ unsigned xb_add(unsigned* p, unsigned v) { return __hip_atomic_fetch_add(p, v, __ATOMIC_RELAXED, __HIP_MEMORY_SCOPE_AGENT); }
__device__ __forceinline__ unsigned xb_xcc_id() { return (unsigned)__builtin_amdgcn_s_getreg((3 << 11) | 20) & 0xFu; }
#define XB_SPIN(cond, bar) do { unsigned _sp = 0; while (cond) { __builtin_amdgcn_s_sleep(1); \
    if ((++_sp & 255u) == 0u) { if (xb_ld(&(bar)[XB_TMO])) break; if (_sp > XB_SPIN_CAP) { atomicAdd(&(bar)[XB_TMO], 1u); break; } } } } while (0)
struct XcdBarrier { unsigned* bar; unsigned x; volatile LAS unsigned* st; };
__device__ __forceinline__ XcdBarrier xcd_barrier_post(unsigned* bar, volatile LAS unsigned* st) {
    XcdBarrier b; b.bar = bar; b.x = xb_xcc_id(); b.st = st;
    if (threadIdx.x == 0) (void)xb_add(&bar[XB_XCNT(b.x)], 1u);
    return b;
}
__device__ __forceinline__ void xcd_barrier_complete(unsigned* bar, unsigned x, unsigned& nloc, unsigned& nx) {
    const unsigned G = gridDim.x * gridDim.y * gridDim.z;
    unsigned sum, cnt, mine, sp = 0u;
    for (;;) {
        sum = 0u; cnt = 0u; mine = 0u;
#pragma unroll
        for (unsigned j = 0; j < 16; ++j) { const unsigned c = xb_ld(&bar[XB_XCNT(j)]); sum += c; cnt += (c > 0u) ? 1u : 0u; mine = (j == x) ? c : mine; }
        if (sum == G) break;
        __builtin_amdgcn_s_sleep(1);
        if ((++sp & 255u) == 0u) { if (xb_ld(&bar[XB_TMO])) break; if (sp > XB_SPIN_CAP) { atomicAdd(&bar[XB_TMO], 1u); break; } }
    }
    nloc = mine > 0u ? mine : 1u; nx = cnt > 0u ? cnt : 1u;
}
__device__ __forceinline__ void xcd_barrier(const XcdBarrier& b) {
    asm volatile("s_waitcnt vmcnt(0)" ::: "memory");
    __syncthreads();
    if (threadIdx.x == 0) {
        unsigned* bar = b.bar;
        __builtin_amdgcn_s_waitcnt(0);
        unsigned nloc = b.st[0], nx = b.st[1];
        if (nloc == 0u) { xcd_barrier_complete(bar, b.x, nloc, nx); b.st[0] = nloc; b.st[1] = nx; }
        const unsigned old = xb_add(&bar[XB_XSUB(b.x)], 1u);
        const unsigned gen = old / nloc;
        if (old + 1u == (gen + 1u) * nloc) {
            __builtin_amdgcn_fence(__ATOMIC_RELEASE, "agent");
            asm volatile("s_waitcnt vmcnt(0)" ::: "memory");
            const unsigned og = xb_add(&bar[XB_TOP], 1u);
            const unsigned tg = og / nx;
            if (og + 1u == (tg + 1u) * nx) xb_add(&bar[XB_TOPGEN], 1u);
            else XB_SPIN(xb_ld(&bar[XB_TOPGEN]) == tg, bar);
            __builtin_amdgcn_fence(__ATOMIC_ACQUIRE, "agent");
            xb_add(&bar[XB_XGEN(b.x)], 1u);
            asm volatile("s_waitcnt vmcnt(0)" ::: "memory");
        } else {
            XB_SPIN(xb_ld(&bar[XB_XGEN(b.x)]) == gen, bar);
            __builtin_amdgcn_fence(__ATOMIC_ACQUIRE, "agent");
            asm volatile("s_waitcnt vmcnt(0)" ::: "memory");
        }
    }
    __syncthreads();
}

struct Args { const float* in[18]; float* out; unsigned char* ws; int ph_lo, ph_hi; };
struct Frame {
    LAS unsigned char* lds;
    volatile LAS unsigned* MISC;
    unsigned* ctl;
    int tid, lane, wave, G;
    float* out;
    unsigned char* ws;
};
enum { I_X = 0, I_RELB, I_ENORM, I_EWIN, I_LQ1, I_LK1, I_LQ2, I_LK2, I_SUBLN, I_EWO, I_ONORM, I_OWIN, I_OQNORM, I_OWUQ, I_OKVNORM, I_OWUKV, I_OWO, I_FNORM };

__device__ __forceinline__ int t5_bucket(int rel) {
    const int n = rel < 0 ? -rel : rel;
    const int v = n < 8 ? n : n < 12 ? 8 : n < 16 ? 9 : n < 23 ? 10 : n < 32 ? 11 : n < 46 ? 12 : n < 64 ? 13 : n < 91 ? 14 : 15;
    return (rel > 0 ? 16 : 0) + v;
}

__device__ __forceinline__ int wsrc_col(int mat, int n) {
    switch (mat) {
        case 0: return n < 2760 ? n : (n < C_G0 ? -1 : n - 56);
        case 2: return n < 256 ? 384 + n : (n < 640 ? n - 256 : (n < 672 ? n : (n < 768 ? -1 : n - 96)));
        default: return n;
    }
}
__device__ __forceinline__ float wcol_scale(int mat, int n) {
    if (mat == 0) return (n < 512 || (n >= C_QB && n < C_QB + 512)) ? QS_AB : 1.0f;
    if (mat == 3) return QS_C;
    return 1.0f;
}
__device__ __forceinline__ void p0_transpose_item(const float* W, int K, int Nsrc, int Npad, const float* gain, int mat, u16* WT, LAS float* scr, int item, int lane) {
    const int nblk = Npad / 32, kb = item / nblk, nb = item % nblk, k0 = 64 * kb, n0 = 32 * nb;
    const int n = n0 + (lane & 31); const int sc = wsrc_col(mat, n); const float cs = wcol_scale(mat, n);
#pragma unroll 8
    for (int i = 0; i < 32; ++i) { const int kk = 2 * i + (lane >> 5); float v = 0.f;
        if (sc >= 0) { v = W[(size_t)(k0 + kk) * Nsrc + sc] * cs; if (gain) v *= gain[k0 + kk]; }
        scr[kk * 33 + (lane & 31)] = v; }
    LDS_WAIT(); asm volatile("" ::: "memory");
    const int c = lane & 7;
#pragma unroll
    for (int j = 0; j < 4; ++j) { const int nn = (lane >> 3) + 8 * j; const LAS float* s = scr + (8 * c) * 33 + nn;
        u32x4 o; o.x = pkh(s[0 * 33], s[1 * 33]); o.y = pkh(s[2 * 33], s[3 * 33]); o.z = pkh(s[4 * 33], s[5 * 33]); o.w = pkh(s[6 * 33], s[7 * 33]);
        *(u32x4*)(WT + (size_t)(n0 + nn) * K + k0 + 8 * c) = o; }
    LDS_WAIT(); asm volatile("" ::: "memory");
}
__device__ __forceinline__ void p0_prologue(Frame& F, const Args& AR) {
    LAS float* scr = (LAS float*)(F.lds + F.wave * 16384);
    const int gw = blockIdx.x * NWAVES + F.wave, NGW = F.G * NWAVES;
    unsigned char* ws = F.ws;
    constexpr int I0 = (1024 / 64) * (P0W / 32), I1 = (1024 / 64) * (1024 / 32), I2 = (1024 / 64) * (P1W / 32), I3 = (384 / 64) * (1536 / 32), I4 = (256 / 64) * (2048 / 32), I5 = I1;
    constexpr int NITEMS = I0 + I1 + I2 + I3 + I4 + I5;
    for (int it = gw; it < NITEMS; it += NGW) {
        int r = it;
        if (r < I0) { p0_transpose_item(AR.in[I_EWIN], 1024, L0_SRC, P0W, nullptr, 0, (u16*)(ws + WS_W0T), scr, r, F.lane); continue; } r -= I0;
        if (r < I1) { p0_transpose_item(AR.in[I_EWO], 1024, 1024, 1024, nullptr, 1, (u16*)(ws + WS_WO0T), scr, r, F.lane); continue; } r -= I1;
        if (r < I2) { p0_transpose_item(AR.in[I_OWIN], 1024, L1_SRC, P1W, AR.in[I_ONORM], 2, (u16*)(ws + WS_W1T), scr, r, F.lane); continue; } r -= I2;
        if (r < I3) { p0_transpose_item(AR.in[I_OWUQ], 384, 1536, 1536, AR.in[I_OQNORM], 3, (u16*)(ws + WS_WUQT), scr, r, F.lane); continue; } r -= I3;
        if (r < I4) { p0_transpose_item(AR.in[I_OWUKV], 256, 2048, 2048, AR.in[I_OKVNORM], 4, (u16*)(ws + WS_WUKVT), scr, r, F.lane); continue; } r -= I4;
        p0_transpose_item(AR.in[I_OWO], 1024, 1024, 1024, nullptr, 5, (u16*)(ws + WS_WO1T), scr, r, F.lane);
    }
    {
        const float* gn = AR.in[I_ENORM]; f32x4 gv[4];
#pragma unroll
        for (int j = 0; j < 4; ++j) gv[j] = *(const f32x4*)(gn + 4 * F.lane + 256 * j);
        u16* XN = (u16*)(ws + WS_XN0);
        for (int mrow = gw; mrow < T; mrow += NGW) {
            const f32x4* xr = (const f32x4*)(AR.in[I_X] + (size_t)mrow * DM) + F.lane;
            f32x4 v[4]; float s = 0.f;
#pragma unroll
            for (int j = 0; j < 4; ++j) { v[j] = xr[64 * j]; s += (v[j].x * v[j].x + v[j].y * v[j].y) + (v[j].z * v[j].z + v[j].w * v[j].w); }
            const float rstd = __builtin_amdgcn_rsqf(wave_sum(s) * (1.f / DM) + RMS_EPS);
            u32x2* o8 = (u32x2*)(XN + (size_t)mrow * DM) + F.lane;
#pragma unroll
            for (int j = 0; j < 4; ++j) { const f32x4 t = v[j] * rstd * gv[j]; u32x2 w; w.x = pkh(t.x, t.y); w.y = pkh(t.z, t.w); o8[64 * j] = w; }
        }
    }
    {
        float* rc = (float*)(ws + WS_ROPEC); float* rs = (float*)(ws + WS_ROPES);
        const int gt = blockIdx.x * 512 + F.tid, NGT = F.G * 512;
        for (int e = gt; e < SEQ * 16; e += NGT) { const int pos = e >> 4, i = e & 15;
            const float inv = (float)pow(10000.0, -(double)i / 16.0); const float ang = (float)pos * inv;
            rc[e] = (float)cos((double)ang); rs[e] = (float)sin((double)ang); }
        float* bt = (float*)(ws + WS_BTG);
        for (int e = gt; e < 12 * 192; e += NGT) { const int hd = e / 192, idx = e % 192; const int rel = idx - 128;
            bt[e] = AR.in[I_RELB][t5_bucket(rel) * 12 + hd] * LOG2E; }
        if (blockIdx.x == 0 && F.wave == 0) {
            const float a = wave_sum(AR.in[I_LQ1][F.lane] * AR.in[I_LK1][F.lane]), b = wave_sum(AR.in[I_LQ2][F.lane] * AR.in[I_LK2][F.lane]);
            if (F.lane == 0) *(float*)(ws + WS_LAM) = expf(a) - expf(b) + 0.2f;
        }
    }
}

__device__ __forceinline__ h8 tr2(LAS const unsigned char* p0, LAS const unsigned char* p1) {
    const s16x4 lo = __builtin_amdgcn_ds_read_tr16_b64_v4i16((LAS s16x4*)p0), hi = __builtin_amdgcn_ds_read_tr16_b64_v4i16((LAS s16x4*)p1);
    const s16x8 v = __builtin_shufflevector(lo, hi, 0, 1, 2, 3, 4, 5, 6, 7); return __builtin_bit_cast(h8, v);
}
constexpr float SM_THR = 8.0f;
template <int ND, bool MASKED>
__device__ __forceinline__ void softmax_step(f32x16& p0, f32x16& p1, float& mref, float& lrun, bool& have, f32x16 (&o)[ND], h8 (&pf)[4]) {
    float mx = fmaxf(fmaxf(p0[0], p1[0]), fmaxf(p0[1], p1[1]));
#pragma unroll
    for (int r = 2; r < 16; r += 2) mx = fmaxf(mx, fmaxf(fmaxf(p0[r], p1[r]), fmaxf(p0[r + 1], p1[r + 1])));
    mx = swap_max(mx);
    const bool valid = MASKED ? (mx > -1e29f) : true;
    const bool trig = valid && (!have || mx > SM_THR);
    if (__any(trig)) {
        const float dl = valid ? (have ? fmaxf(mx, 0.f) : mx) : 0.f;
        have = have || valid;
        mref += dl;
        const float alpha = __builtin_amdgcn_exp2f(-dl);
        lrun *= alpha;
#pragma unroll
        for (int r = 0; r < 16; ++r) { p0[r] -= dl; p1[r] -= dl; }
#pragma unroll
        for (int d = 0; d < ND; ++d)
#pragma unroll
            for (int r = 0; r < 16; ++r) o[d][r] *= alpha;
    }
    float s0 = 0.f, s1 = 0.f;
#pragma unroll
    for (int r = 0; r < 16; ++r) { p0[r] = __builtin_amdgcn_exp2f(p0[r]); p1[r] = __builtin_amdgcn_exp2f(p1[r]); s0 += p0[r]; s1 += p1[r]; }
    lrun += s0 + s1;
#pragma unroll
    for (int ks = 0; ks < 4; ++ks) {
        u32x4 w;
        if (ks < 2) { w.x = pkh(p0[8 * ks + 0], p0[8 * ks + 1]); w.y = pkh(p0[8 * ks + 2], p0[8 * ks + 3]); w.z = pkh(p0[8 * ks + 4], p0[8 * ks + 5]); w.w = pkh(p0[8 * ks + 6], p0[8 * ks + 7]); }
        else { const int k2 = ks - 2; w.x = pkh(p1[8 * k2 + 0], p1[8 * k2 + 1]); w.y = pkh(p1[8 * k2 + 2], p1[8 * k2 + 3]); w.z = pkh(p1[8 * k2 + 4], p1[8 * k2 + 5]); w.w = pkh(p1[8 * k2 + 6], p1[8 * k2 + 7]); }
        pf[ks] = __builtin_bit_cast(h8, w);
    }
}
__device__ __forceinline__ void add_bias(f32x16& p0, f32x16& p1, const LAS float* bt, int idx0) {
#pragma unroll
    for (int r = 0; r < 16; ++r) { const int c = (r & 3) + 8 * (r >> 2);
        const int i0 = idx0 + c, i1 = idx0 + 32 + c;
        p0[r] += bt[i0 < 0 ? 0 : i0]; p1[r] += bt[i1 < 0 ? 0 : i1]; }
}
__device__ __forceinline__ int next_unit(Frame& F, int cw) {
    volatile LAS unsigned* slot = F.MISC + 16;
    __syncthreads();
    if (F.tid == 0) slot[0] = __hip_atomic_fetch_add(F.ctl + cw, 1u, __ATOMIC_RELAXED, __HIP_MEMORY_SCOPE_AGENT);
    __syncthreads();
    return (int)slot[0];
}

__device__ __forceinline__ void attnA_unit(Frame& F, const Args& AR, int b, int h, int qb) {
    LAS unsigned char* lds = F.lds;
    int tid = F.tid; asm volatile("" : "+v"(tid)); int wid = F.wave; asm volatile("" : "+s"(wid));
    const int lane = tid & 63, r32 = lane & 31, hi = lane >> 5;
    const int m = wid & 1, qsub = wid >> 1, q0 = 128 * qb + 32 * qsub, cw = q0 >> 6, nt = 2 * qb + 2;
    const size_t rowb = (size_t)b * SEQ;
    const u16* P0 = (const u16*)(F.ws + WS_PROJ0);
    LAS float* bt = (LAS float*)(lds + 65536);
    if (tid < 192) bt[tid] = ((const float*)(F.ws + WS_BTG))[h * 192 + tid];
    h8 qf[4];
    { const u16* qp = P0 + (rowb + q0 + r32) * P0W + C_QA + h * 128 + m * 64 + hi * 8;
#pragma unroll
      for (int d0 = 0; d0 < 4; ++d0) qf[d0] = *(const h8*)(qp + d0 * 16); }
    f32x16 o[4];
#pragma unroll
    for (int d = 0; d < 4; ++d)
#pragma unroll
        for (int r = 0; r < 16; ++r) o[d][r] = 0.f;
    float mrun = 0.f, lrun = 0.f; bool have = false;
    const int krow = tid >> 3, kch = tid & 7, vrow = tid >> 4, vch = tid & 15;
    const u16* ksrc = P0 + (rowb + krow) * P0W + C_KA + h * 128 + kch * 8;
    const u16* vsrc = P0 + (rowb + vrow) * P0W + C_VA + h * 128 + vch * 8;
    const int kdst = krow * 128 + ((kch ^ ((krow >> 1) & 7)) << 4);
    const int vdst = 16384 + vrow * 256 + ((vch ^ ((vrow & 3) << 2)) << 4);
    u32x4 st0, st1, st2, st3;
#define A_LOAD(t) do { const size_t to = (size_t)(t) * 64 * P0W; st0 = *(const u32x4*)(ksrc + to); st1 = *(const u32x4*)(ksrc + to + 64); st2 = *(const u32x4*)(vsrc + to); st3 = *(const u32x4*)(vsrc + to + (size_t)32 * P0W); } while (0)
#define A_WRITE(s) do { LAS unsigned char* sb = lds + (s) * 32768; *(LAS u32x4*)(sb + kdst) = st0; *(LAS u32x4*)(sb + 8192 + kdst) = st1; *(LAS u32x4*)(sb + vdst) = st2; *(LAS u32x4*)(sb + vdst + 32 * 256) = st3; } while (0)
    const int kfo = r32 * 128, ksw = (r32 >> 1) & 7;
    const int i16 = lane & 15, qrow = i16 >> 2, pp = i16 & 3, g16 = (lane >> 4) & 1;
    const int vlane = (4 * hi + qrow) * 256 + ((2 * g16 + (pp >> 1)) << 4) + 8 * (pp & 1);
    const int qglob = q0 + r32;
    A_LOAD(0); A_WRITE(0); __syncthreads();
    for (int t = 0; t < nt; ++t) {
        if (t + 1 < nt) A_LOAD(t + 1);
        if (t <= cw) {
            LAS const unsigned char* sb = lds + (t & 1) * 32768; LAS const unsigned char* kb = sb + m * 8192 + kfo; LAS const unsigned char* vb = sb + 16384 + vlane;
            const bool nearb = (64 * t + 63 - q0) > -128;
            const float c0 = (nearb ? 0.f : bt[0]) - mrun;
            f32x16 p0, p1;
#pragma unroll
            for (int r = 0; r < 16; ++r) { p0[r] = c0; p1[r] = c0; }
#pragma unroll
            for (int d0 = 0; d0 < 4; ++d0) { const int co = ((2 * d0 + hi) ^ ksw) << 4;
                const h8 ka = *(LAS const h8*)(kb + co), kc = *(LAS const h8*)(kb + 4096 + co);
                p0 = __builtin_amdgcn_mfma_f32_32x32x16_f16(ka, qf[d0], p0, 0, 0, 0); p1 = __builtin_amdgcn_mfma_f32_32x32x16_f16(kc, qf[d0], p1, 0, 0, 0); }
            if (nearb) add_bias(p0, p1, bt, 64 * t + 4 * hi - qglob + 128);
            h8 pf[4];
            softmax_step<4, false>(p0, p1, mrun, lrun, have, o, pf);
#pragma unroll
            for (int d0 = 0; d0 < 4; ++d0) { const int dx = (d0 ^ qrow) << 6;
#pragma unroll
                for (int ks = 0; ks < 4; ++ks) { const h8 vf = tr2(vb + ks * 4096 + dx, vb + ks * 4096 + 2048 + dx);
                    o[d0] = __builtin_amdgcn_mfma_f32_32x32x16_f16(vf, pf[ks], o[d0], 0, 0, 0); } }
        }
        if (t + 1 < nt) A_WRITE((t + 1) & 1);
        __syncthreads();
    }
#undef A_LOAD
#undef A_WRITE
    const float linv = 1.0f / swap_sum(lrun);
    LAS f32x4* xb = (LAS f32x4*)(lds + qsub * 16384);
    if (m == 1) {
#pragma unroll
        for (int d0 = 0; d0 < 4; ++d0)
#pragma unroll
            for (int g = 0; g < 4; ++g) { f32x4 v = {o[d0][4 * g] * linv, o[d0][4 * g + 1] * linv, o[d0][4 * g + 2] * linv, o[d0][4 * g + 3] * linv};
                xb[(8 * d0 + 2 * g + hi) * 32 + r32] = v; }
    }
    __syncthreads();
    if (m == 0) {
        const float lam = *(const float*)(F.ws + WS_LAM);
        float ss = 0.f;
#pragma unroll
        for (int d0 = 0; d0 < 4; ++d0)
#pragma unroll
            for (int g = 0; g < 4; ++g) { const f32x4 v1 = xb[(8 * d0 + 2 * g + hi) * 32 + r32];
#pragma unroll
                for (int e = 0; e < 4; ++e) { const float v = o[d0][4 * g + e] * linv - lam * v1[e]; o[d0][4 * g + e] = v; ss += v * v; } }
        ss = swap_sum(ss);
        const float rs = __builtin_amdgcn_rsqf(ss * (1.0f / 128.0f) + RMS_EPS) * 0.8f;
        const size_t row = rowb + qglob;
        const u16* gp = P0 + row * P0W + C_G0 + h * 128;
        u16* op = (u16*)(F.ws + WS_MG0) + row * DM + h * 128;
        const float* sg = AR.in[I_SUBLN];
#pragma unroll
        for (int d0 = 0; d0 < 4; ++d0)
#pragma unroll
            for (int g = 0; g < 4; ++g) { const int d = 32 * d0 + 8 * g + 4 * hi;
                const h4 gv = *(const h4*)(gp + d); const f32x4 sv = *(const f32x4*)(sg + d);
                u32x2 w; w.x = pkh(o[d0][4 * g] * rs * sv[0] * (float)gv[0], o[d0][4 * g + 1] * rs * sv[1] * (float)gv[1]);
                w.y = pkh(o[d0][4 * g + 2] * rs * sv[2] * (float)gv[2], o[d0][4 * g + 3] * rs * sv[3] * (float)gv[3]);
                *(u32x2*)(op + d) = w; }
    }
}

constexpr int B_XROW = 1028, B_MASK = 66560, B_QF = 82944, B_BT = 99328;
__device__ __forceinline__ float next_up(float x) { if (x == 0.f) return __uint_as_float(1u); const unsigned u = __float_as_uint(x); return __uint_as_float(x > 0.f ? u + 1u : u - 1u); }
template <int OP> __device__ __forceinline__ float hw_red_f(float v) {
#define HWR_STEP(ctrl) { const float o_ = __uint_as_float((unsigned)__builtin_amdgcn_update_dpp(0, (int)__float_as_uint(v), ctrl, 0xf, 0xf, false)); v = OP ? fmaxf(v, o_) : fminf(v, o_); }
    HWR_STEP(0xB1) HWR_STEP(0x4E) HWR_STEP(0x141) HWR_STEP(0x140)
#undef HWR_STEP
    const float o2 = __shfl_xor(v, 16); return OP ? fmaxf(v, o2) : fminf(v, o2);
}
__device__ __forceinline__ unsigned hw_sum_u(unsigned v) {
#define HWS_STEP(ctrl) v += (unsigned)__builtin_amdgcn_update_dpp(0, (int)v, ctrl, 0xf, 0xf, false);
    HWS_STEP(0xB1) HWS_STEP(0x4E) HWS_STEP(0x141) HWS_STEP(0x140)
#undef HWS_STEP
    return v + (unsigned)__shfl_xor((int)v, 16);
}
__device__ __forceinline__ void selB_16(Frame& F, int b, int c, int q0, int mrow0, int abl = 0) {
    LAS unsigned char* lds = F.lds;
    int tid = F.tid; asm volatile("" : "+v"(tid)); int wid = F.wave; asm volatile("" : "+s"(wid));
    const int lane = tid & 63, ql = lane & 15, g = lane >> 4, l31 = lane & 31, hq = lane >> 5;
    const size_t rowb = (size_t)b * SEQ;
    const u16* P0 = (const u16*)(F.ws + WS_PROJ0);
    const int NT16 = 4 * (c + 1), N = 64 * (c + 1);
    if (c < 4) {
        for (int e = tid; e < 16 * (c + 1); e += 512) { const int q = e / (c + 1), t = e % (c + 1); *(LAS u64*)(lds + B_MASK + ((mrow0 + q) * 64 + t) * 8) = ~0ull; }
        return;
    }
    LAS h8* qfl = (LAS h8*)(lds + B_QF);
#pragma unroll
    for (int i = 0; i < 2; ++i) { const int idx = tid + 512 * i, fg = idx >> 6, ln = idx & 63, hh = fg >> 1, ks = fg & 1;
        qfl[idx] = *(const h8*)(P0 + (rowb + q0 + (ln & 15)) * P0W + C_QI + hh * 64 + 32 * ks + 8 * (ln >> 4)); }
    float wq[8];
    { const h8 wv = *(const h8*)(P0 + (rowb + q0 + ql) * P0W + C_WI);
#pragma unroll
      for (int i = 0; i < 8; ++i) wq[i] = (float)wv[i]; }
    __syncthreads();
    float sc[128]; float mn = INFINITY, mxv = -INFINITY;
    LAS float* X = (LAS float*)lds;
    const u16* kp = P0 + (rowb + ql) * P0W + C_KI + 8 * g;
    const int nq = (N + 1023) >> 10;
#pragma unroll
    for (int qr = 0; qr < 4; ++qr) {
        if (qr < nq) {
            h8 ka[2][2], kn[2][2];
#pragma unroll
            for (int u = 0; u < 2; ++u) { const int j = 64 * qr + wid + 8 * u; const int jc = j < NT16 ? j : 0;
                ka[u][0] = *(const h8*)(kp + (size_t)(16 * jc) * P0W); ka[u][1] = *(const h8*)(kp + (size_t)(16 * jc) * P0W + 32); }
#pragma unroll
            for (int gq = 0; gq < 4; ++gq) {
                if (64 * qr + wid + 16 * gq < NT16) {
                    if (gq < 3) {
#pragma unroll
                        for (int u = 0; u < 2; ++u) { const int j = 64 * qr + wid + 8 * (2 * gq + 2 + u); const int jc = j < NT16 ? j : 0;
                            kn[u][0] = *(const h8*)(kp + (size_t)(16 * jc) * P0W); kn[u][1] = *(const h8*)(kp + (size_t)(16 * jc) * P0W + 32); } }
                    f32x4 s4[2] = {{0.f, 0.f, 0.f, 0.f}, {0.f, 0.f, 0.f, 0.f}};
                    h8 qc0 = qfl[lane], qc1 = qfl[64 + lane];
#pragma unroll
                    for (int hh = 0; hh < 8; ++hh) {
                        h8 qn0 = qc0, qn1 = qc1;
                        if (hh < 7) { qn0 = qfl[((hh + 1) * 2 + 0) * 64 + lane]; qn1 = qfl[((hh + 1) * 2 + 1) * 64 + lane]; }
                        f32x4 ac0 = {0.f, 0.f, 0.f, 0.f}, ac1 = {0.f, 0.f, 0.f, 0.f};
                        ac0 = __builtin_amdgcn_mfma_f32_16x16x32_f16(ka[0][0], qc0, ac0, 0, 0, 0);
                        ac1 = __builtin_amdgcn_mfma_f32_16x16x32_f16(ka[1][0], qc0, ac1, 0, 0, 0);
                        ac0 = __builtin_amdgcn_mfma_f32_16x16x32_f16(ka[0][1], qc1, ac0, 0, 0, 0);
                        ac1 = __builtin_amdgcn_mfma_f32_16x16x32_f16(ka[1][1], qc1, ac1, 0, 0, 0);
#pragma unroll
                        for (int r = 0; r < 4; ++r) { s4[0][r] += wq[hh] * __int_as_float(max(__float_as_int(ac0[r]), 0)); s4[1][r] += wq[hh] * __int_as_float(max(__float_as_int(ac1[r]), 0)); }
                        qc0 = qn0; qc1 = qn1;
                    }
#pragma unroll
                    for (int u = 0; u < 2; ++u) { const int m = 2 * gq + u; if (64 * qr + wid + 8 * m < NT16) *(LAS f32x4*)(X + ql * B_XROW + 16 * (wid + 8 * m) + 4 * g) = s4[u]; }
#pragma unroll
                    for (int u = 0; u < 2; ++u) { ka[u][0] = kn[u][0]; ka[u][1] = kn[u][1]; }
                }
            }
            {
            __syncthreads();
            { LAS const float* xr = X + (2 * wid + hq) * B_XROW + l31;
#pragma unroll
              for (int i = 0; i < 32; ++i) { if (1024 * qr + 32 * i < N) { const float v = xr[32 * i]; sc[32 * qr + i] = v; mn = fminf(mn, v); mxv = fmaxf(mxv, v); } else sc[32 * qr + i] = -INFINITY; } }
            __syncthreads(); }
        } else {
#pragma unroll
            for (int i = 0; i < 32; ++i) sc[32 * qr + i] = -INFINITY;
        }
    }
    float lo = hw_red_f<0>(mn), hi = next_up(hw_red_f<1>(mxv));
    unsigned clo = (unsigned)N, chi = 0u;
    if (abl != 6) {
        const float smn = lo, smx = hw_red_f<1>(mxv);
        LAS unsigned* H = (LAS unsigned*)lds + (2 * wid + hq) * 1024;
        LAS unsigned* CS = (LAS unsigned*)(lds + B_QF) + (2 * wid + hq) * 32;
#pragma unroll
        for (int i = 0; i < 32; ++i) H[l31 + 32 * i] = 0u;
        const float scale = 1023.5f / fmaxf(smx - smn, 1e-30f), nsm = -smn * scale;
#pragma unroll
        for (int e = 0; e < 128; ++e) { if (32 * e < N) { int bin = (int)__builtin_fmaf(sc[e], scale, nsm); bin = bin > 1023 ? 1023 : (bin < 0 ? 0 : bin);
            __hip_atomic_fetch_add(H + bin, 1u, __ATOMIC_RELAXED, __HIP_MEMORY_SCOPE_WORKGROUP); } }
        asm volatile("s_waitcnt lgkmcnt(0)" ::: "memory");
        unsigned hw[32]; unsigned cl = 0u;
#pragma unroll
        for (int i = 0; i < 8; ++i) { const u32x4 v = *(LAS const u32x4*)(H + 32 * l31 + 4 * i); hw[4 * i] = v.x; hw[4 * i + 1] = v.y; hw[4 * i + 2] = v.z; hw[4 * i + 3] = v.w; cl += (v.x + v.y) + (v.z + v.w); }
        CS[l31] = cl;
        asm volatile("s_waitcnt lgkmcnt(0)" ::: "memory");
        unsigned ssuf = 0u;
#pragma unroll
        for (int i = 0; i < 8; ++i) { const u32x4 v = *(LAS const u32x4*)(CS + 4 * i);
            ssuf += (4 * i >= l31 ? v.x : 0u) + (4 * i + 1 >= l31 ? v.y : 0u) + (4 * i + 2 >= l31 ? v.z : 0u) + (4 * i + 3 >= l31 ? v.w : 0u); }
        const bool flag = ssuf >= (unsigned)TOPK && (ssuf - cl) < (unsigned)TOPK;
        unsigned run = ssuf - cl, bstar = 0u, above = 0u, cntb = 0u; bool found = false;
#pragma unroll
        for (int w = 31; w >= 0; --w) { run += hw[w]; if (!found && run >= (unsigned)TOPK) { found = true; bstar = 32u * l31 + (unsigned)w; above = run - hw[w]; cntb = hw[w]; } }
        const unsigned long long fb = __ballot(flag);
        const int src = hq ? 32 + __builtin_ctz((unsigned)(fb >> 32) | 0x80000000u) : __builtin_ctz((unsigned)fb | 0x80000000u);
        bstar = (unsigned)__shfl((int)bstar, src); above = (unsigned)__shfl((int)above, src); cntb = (unsigned)__shfl((int)cntb, src);
        if (smx > smn) {
            const float inv = (smx - smn) * (1.0f / 1023.5f);
            const float l2 = smn + ((float)bstar - 0.01f) * inv, h2 = smn + ((float)bstar + 1.01f) * inv;
            if (l2 > lo) { lo = l2; clo = above + cntb; }
            if (h2 < hi) { hi = h2; chi = above; }
        }
    }
#define SEL_LTBITS(W, P) do { _Pragma("unroll") for (int w_ = 0; w_ < 4; ++w_) { unsigned a_ = 0u; _Pragma("unroll") for (int k_ = 0; k_ < 32; ++k_) \
        a_ = __builtin_amdgcn_alignbit(a_, __float_as_uint(sc[32 * w_ + k_] - (P)), 31); W[w_] = a_; } } while (0)
    bool done = false, tie = false; float Tv = 0.f;
#define SEL_STEP(it_) do { \
        float mid = lo + (hi - lo) * 0.5f; \
        if ((it_) < 2 && clo > chi + 16u) { const float xi = lo + (hi - lo) * ((float)clo - 255.5f) / (float)(clo - chi); if (xi > lo && xi < hi) mid = xi; } \
        if (!done && !(mid > lo && mid < hi)) { done = true; tie = true; Tv = lo; } \
        const float pv = done ? Tv : mid; \
        unsigned ltw[4]; SEL_LTBITS(ltw, pv); \
        const unsigned tot = hw_sum_u(128u - (unsigned)(__builtin_popcount(ltw[0]) + __builtin_popcount(ltw[1]) + __builtin_popcount(ltw[2]) + __builtin_popcount(ltw[3]))); \
        if (!done) { if (tot == (unsigned)TOPK) { done = true; Tv = mid; } else if (tot > (unsigned)TOPK) { lo = mid; clo = tot; } else { hi = mid; chi = tot; } } } while (0)
    const int it_cap = (abl == 6 ? 1 : abl == 10 ? 6 : abl == 11 ? 12 : 200);
    int it = 0;
    for (; it < 8 && it < it_cap; ++it) { SEL_STEP(it); if (__all(done)) break; }
    if (!__all(done) && it_cap > 8) {
        float p0 = INFINITY, p1 = -INFINITY;
#pragma unroll
        for (int e = 0; e < 128; ++e) { const float sv = sc[e]; p0 = fminf(p0, sv >= lo ? sv : INFINITY); p1 = fmaxf(p1, sv < hi ? sv : -INFINITY); }
        p0 = hw_red_f<0>(p0); p1 = hw_red_f<1>(p1);
        if (!done && p0 == p1) { done = true; tie = true; Tv = p0; }
        for (; it < it_cap; ++it) { if (__all(done)) break; SEL_STEP(8); }
    }
#undef SEL_STEP
    if (abl == 6 || abl == 10 || abl == 11) tie = false;
    unsigned selw[4];
    { unsigned ltw[4]; SEL_LTBITS(ltw, Tv);
#pragma unroll
      for (int w = 0; w < 4; ++w) selw[w] = __builtin_bitreverse32(~ltw[w]); }
    if (__any(tie)) {
        unsigned eqw[4];
        { unsigned lew[4]; const float tn = next_up(Tv); SEL_LTBITS(lew, tn);
#pragma unroll
          for (int w = 0; w < 4; ++w) eqw[w] = __builtin_bitreverse32(lew[w]) & selw[w]; }
        const unsigned rneed = (unsigned)TOPK - chi;
        int ilo = -1, ihi = N - 1, icut = N; bool tdone = !tie;
        for (int it = 0; it < 40; ++it) {
            const int imid = (ilo + ihi) >> 1;
            if (!tdone && (ihi - ilo) <= 1) { tdone = true; icut = ihi; }
            const int iv = (tdone ? icut : imid) - l31;
            const int nle = iv < 0 ? 0 : min(128, (iv >> 5) + 1);
            unsigned cnt = 0u;
#pragma unroll
            for (int w = 0; w < 4; ++w) { const int nw = min(max(nle - 32 * w, 0), 32); const unsigned mk = nw >= 32 ? 0xffffffffu : ((1u << nw) - 1u); cnt += (unsigned)__builtin_popcount(eqw[w] & mk); }
            const unsigned tot = hw_sum_u(cnt);
            if (!tdone) { if (tot == rneed) { tdone = true; icut = imid; } else if (tot < rneed) ilo = imid; else ihi = imid; }
            if (__all(tdone)) break;
        }
        if (tie) {
            const int iv = icut - l31; const int nle = iv < 0 ? 0 : min(128, (iv >> 5) + 1);
#pragma unroll
            for (int w = 0; w < 4; ++w) { const int nw = min(max(nle - 32 * w, 0), 32); const unsigned mk = nw >= 32 ? 0xffffffffu : ((1u << nw) - 1u); selw[w] = (selw[w] & ~eqw[w]) | (eqw[w] & mk); }
        }
    }
#undef SEL_LTBITS
    LAS unsigned* mrow = (LAS unsigned*)(lds + B_MASK) + (mrow0 + 2 * wid + hq) * 128;
#pragma unroll
    for (int w = 0; w < 4; ++w) {
        unsigned x = selw[w];
#define TR_STEP(S, MK) { const unsigned y_ = (unsigned)__shfl_xor((int)x, S); x = (l31 & S) ? ((x & ~(MK)) | ((y_ >> S) & (MK))) : ((x & (MK)) | ((y_ << S) & ~(MK))); }
        TR_STEP(16, 0x0000ffffu) TR_STEP(8, 0x00ff00ffu) TR_STEP(4, 0x0f0f0f0fu) TR_STEP(2, 0x33333333u) TR_STEP(1, 0x55555555u)
#undef TR_STEP
        if (32 * (32 * w + l31) < N) mrow[32 * w + l31] = x;
    }
}
__device__ __forceinline__ void attnB_unit(Frame& F, int b, int qb32, int mode = 0) {
    LAS unsigned char* lds = F.lds;
    int tid = F.tid; asm volatile("" : "+v"(tid)); int wid = F.wave; asm volatile("" : "+s"(wid));
    const int lane = tid & 63, r32 = lane & 31, hi = lane >> 5;
    const int q0 = 32 * qb32, c = q0 >> 6, nt = c + 1;
    const size_t rowb = (size_t)b * SEQ;
    const u16* P0 = (const u16*)(F.ws + WS_PROJ0);
    if (mode != 3) {
#pragma unroll 1
        for (int s2 = 0; s2 < 2; ++s2) { selB_16(F, b, c, q0 + 16 * s2, 16 * s2, mode); __syncthreads(); }
    }
    if (mode >= 4) return;
    LAS float* bt = (LAS float*)(lds + B_BT) + wid * 192;
    for (int e = tid; e < 8 * 192; e += 512) ((LAS float*)(lds + B_BT))[e] = ((const float*)(F.ws + WS_BTG))[4 * 192 + e];
    h8 qf[4];
    { const u16* qp = P0 + (rowb + q0 + r32) * P0W + C_QB + wid * 64 + hi * 8;
#pragma unroll
      for (int d0 = 0; d0 < 4; ++d0) qf[d0] = *(const h8*)(qp + d0 * 16); }
    f32x16 o[2];
#pragma unroll
    for (int d = 0; d < 2; ++d)
#pragma unroll
        for (int r = 0; r < 16; ++r) o[d][r] = 0.f;
    float mrun = 0.f, lrun = 0.f; bool have = false;
    const int krow = tid >> 3, kch = tid & 7;
    const u16* ksrc = P0 + (rowb + krow) * P0W + C_KB + kch * 8;
    const int kdst = krow * 128 + ((kch ^ ((krow >> 1) & 7)) << 4);
    const int vdst = 8192 + krow * 128 + ((kch ^ (((krow >> 1) & 1) << 2)) << 4);
    u32x4 st0, st1;
#define B_LOAD(t) do { const size_t to = (size_t)(t) * 64 * P0W; st0 = *(const u32x4*)(ksrc + to); st1 = *(const u32x4*)(ksrc + to + 64); } while (0)
#define B_WRITE(s) do { LAS unsigned char* sb = lds + (s) * 16384; *(LAS u32x4*)(sb + kdst) = st0; *(LAS u32x4*)(sb + vdst) = st1; } while (0)
    const int kfo = r32 * 128, ksw = (r32 >> 1) & 7;
    const int i16 = lane & 15, qrow = i16 >> 2, pp = i16 & 3, g16 = (lane >> 4) & 1;
    const int vlane = (4 * hi + qrow) * 128 + ((2 * g16 + (pp >> 1)) << 4) + 8 * (pp & 1);
    const int qglob = q0 + r32;
    B_LOAD(0); B_WRITE(0); __syncthreads();
    for (int t = 0; t < nt; ++t) {
        if (t + 1 < nt) B_LOAD(t + 1);
        {
            LAS const unsigned char* sb = lds + (t & 1) * 16384; LAS const unsigned char* kb = sb + kfo; LAS const unsigned char* vb = sb + 8192 + vlane;
            const bool nearb = (64 * t + 63 - q0) > -128;
            const float c0 = (nearb ? 0.f : bt[0]) - mrun;
            f32x16 p0, p1;
#pragma unroll
            for (int r = 0; r < 16; ++r) { p0[r] = c0; p1[r] = c0; }
#pragma unroll
            for (int d0 = 0; d0 < 4; ++d0) { const int co = ((2 * d0 + hi) ^ ksw) << 4;
                const h8 ka = *(LAS const h8*)(kb + co), kc = *(LAS const h8*)(kb + 4096 + co);
                p0 = __builtin_amdgcn_mfma_f32_32x32x16_f16(ka, qf[d0], p0, 0, 0, 0); p1 = __builtin_amdgcn_mfma_f32_32x32x16_f16(kc, qf[d0], p1, 0, 0, 0); }
            if (nearb) add_bias(p0, p1, bt, 64 * t + 4 * hi - qglob + 128);
            const u64 mw = *(LAS const u64*)(lds + B_MASK + (r32 * 64 + t) * 8);
            const unsigned mlo = (unsigned)mw >> (4 * hi), mhi = (unsigned)(mw >> 32) >> (4 * hi);
#pragma unroll
            for (int r = 0; r < 16; ++r) { const int cb = (r & 3) + 8 * (r >> 2);
                if (!((mlo >> cb) & 1u)) p0[r] = -1e30f; if (!((mhi >> cb) & 1u)) p1[r] = -1e30f; }
            h8 pf[4];
            softmax_step<2, true>(p0, p1, mrun, lrun, have, o, pf);
#pragma unroll
            for (int d0 = 0; d0 < 2; ++d0) { const int dx = (d0 ^ (qrow >> 1)) << 6;
#pragma unroll
                for (int ks = 0; ks < 4; ++ks) { const h8 vf = tr2(vb + ks * 2048 + dx, vb + ks * 2048 + 1024 + dx);
                    o[d0] = __builtin_amdgcn_mfma_f32_32x32x16_f16(vf, pf[ks], o[d0], 0, 0, 0); } }
        }
        if (t + 1 < nt) B_WRITE((t + 1) & 1);
        __syncthreads();
    }
#undef B_LOAD
#undef B_WRITE
    const float linv = 1.0f / swap_sum(lrun);
    const size_t row = rowb + qglob;
    const u16* gp = P0 + row * P0W + C_G0 + 512 + wid * 64;
    u16* op = (u16*)(F.ws + WS_MG0) + row * DM + 512 + wid * 64;
#pragma unroll
    for (int d0 = 0; d0 < 2; ++d0)
#pragma unroll
        for (int g = 0; g < 4; ++g) { const int d = 32 * d0 + 8 * g + 4 * hi;
            const h4 gv = *(const h4*)(gp + d);
            u32x2 w; w.x = pkh(o[d0][4 * g] * linv * (float)gv[0], o[d0][4 * g + 1] * linv * (float)gv[1]);
            w.y = pkh(o[d0][4 * g + 2] * linv * (float)gv[2], o[d0][4 * g + 3] * linv * (float)gv[3]);
            *(u32x2*)(op + d) = w; }
}

__device__ __forceinline__ void pv_tile64_asm(f32x16 (&o)[2], unsigned va0, unsigned va1, const h8 (&pf)[4]) {
#pragma unroll
    for (int d0 = 0; d0 < 2; ++d0) { const unsigned va = d0 ? va1 : va0; s16x4 lo[4], hi[4];
        asm volatile("ds_read_b64_tr_b16 %0, %1 offset:0" : "=&v"(lo[0]) : "v"(va) : "memory");    asm volatile("ds_read_b64_tr_b16 %0, %1 offset:1024" : "=&v"(hi[0]) : "v"(va) : "memory");
        asm volatile("ds_read_b64_tr_b16 %0, %1 offset:2048" : "=&v"(lo[1]) : "v"(va) : "memory"); asm volatile("ds_read_b64_tr_b16 %0, %1 offset:3072" : "=&v"(hi[1]) : "v"(va) : "memory");
        asm volatile("ds_read_b64_tr_b16 %0, %1 offset:4096" : "=&v"(lo[2]) : "v"(va) : "memory"); asm volatile("ds_read_b64_tr_b16 %0, %1 offset:5120" : "=&v"(hi[2]) : "v"(va) : "memory");
        asm volatile("ds_read_b64_tr_b16 %0, %1 offset:6144" : "=&v"(lo[3]) : "v"(va) : "memory"); asm volatile("ds_read_b64_tr_b16 %0, %1 offset:7168" : "=&v"(hi[3]) : "v"(va) : "memory");
        asm volatile("s_waitcnt lgkmcnt(0)" ::: "memory"); __builtin_amdgcn_sched_barrier(0);
#pragma unroll
        for (int ks = 0; ks < 4; ++ks) { const s16x8 v = __builtin_shufflevector(lo[ks], hi[ks], 0, 1, 2, 3, 4, 5, 6, 7);
            o[d0] = __builtin_amdgcn_mfma_f32_32x32x16_f16(__builtin_bit_cast(h8, v), pf[ks], o[d0], 0, 0, 0); } }
}
__device__ __forceinline__ void attnC_unit(Frame& F, int b, int h, int qb) {
    LAS unsigned char* lds = F.lds;
    int tid = F.tid; asm volatile("" : "+v"(tid)); int wid = F.wave; asm volatile("" : "+s"(wid));
    const int lane = tid & 63, r32 = lane & 31, hi = lane >> 5;
    const int q0 = 256 * qb + 32 * wid, cw = q0 >> 6, nt = 4 * qb + 4;
    const size_t rowb = (size_t)b * SEQ;
    const u16* Q1 = (const u16*)(F.ws + WS_Q1); const u16* KV = (const u16*)(F.ws + WS_KV1); const u16* KR = (const u16*)(F.ws + WS_KROPE);
    h8 qf[6];
    { const u16* qp = Q1 + (rowb + q0 + r32) * 1536 + h * 96 + hi * 8;
#pragma unroll
      for (int d0 = 0; d0 < 6; ++d0) qf[d0] = *(const h8*)(qp + d0 * 16); }
    f32x16 o[2];
#pragma unroll
    for (int d = 0; d < 2; ++d)
#pragma unroll
        for (int r = 0; r < 16; ++r) o[d][r] = 0.f;
    float mrun = 0.f, lrun = 0.f; bool have = false;
    const int krow = 8 * wid + (lane >> 3), kcp = lane & 7;
    const u16* ksrc = KV + (rowb + krow) * 2048 + h * 128 + ((kcp ^ ((krow >> 1) & 7)) << 3);
    const u16* vsrc = KV + (rowb + krow) * 2048 + h * 128 + 64 + ((kcp ^ (((krow >> 1) & 1) << 2)) << 3);
    const int rrow = 16 * (wid & 3) + (lane >> 2), rcp = lane & 3;
    const u16* rsrc = KR + (rowb + rrow) * 32 + ((rcp ^ ((rrow >> 2) & 3)) << 3);
    const int kofs = wid * 1024, rofs = 8192 + (wid & 3) * 1024, vofs = 12288 + wid * 1024;
#define C_DMA(t, slot) do { LAS unsigned char* sb_ = lds + (slot) * 20480; \
        __builtin_amdgcn_global_load_lds((const unsigned*)(ksrc + (size_t)(t) * 64 * 2048), (LAS unsigned*)(sb_ + kofs), 16, 0, 0); \
        __builtin_amdgcn_global_load_lds((const unsigned*)(rsrc + (size_t)(t) * 64 * 32), (LAS unsigned*)(sb_ + rofs), 16, 0, 0); \
        __builtin_amdgcn_global_load_lds((const unsigned*)(vsrc + (size_t)(t) * 64 * 2048), (LAS unsigned*)(sb_ + vofs), 16, 0, 0); } while (0)
    const int kfo = r32 * 128, ksw = (r32 >> 1) & 7;
    const int rfo = 8192 + r32 * 64, rsw = (r32 >> 2) & 3;
    const int i16 = lane & 15, qrow = i16 >> 2, pp = i16 & 3, g16 = (lane >> 4) & 1;
    const int vlane = (4 * hi + qrow) * 128 + ((2 * g16 + (pp >> 1)) << 4) + 8 * (pp & 1);
    asm volatile("s_waitcnt vmcnt(0)" ::: "memory");
    C_DMA(0, 0); C_DMA(1, 1);
    int slot = 0;
    for (int t = 0; t < nt; ++t) {
        if (t + 1 < nt) asm volatile("s_waitcnt vmcnt(3)" ::: "memory"); else asm volatile("s_waitcnt vmcnt(0)" ::: "memory");
        __builtin_amdgcn_s_barrier(); asm volatile("" ::: "memory");
        if (t + 2 < nt) { const int s2 = slot == 0 ? 2 : slot - 1; C_DMA(t + 2, s2); }
        if (t <= cw) {
            LAS const unsigned char* sb = lds + slot * 20480; LAS const unsigned char* kb = sb + kfo; LAS const unsigned char* rb = sb + rfo; LAS const unsigned char* vb = sb + 12288 + vlane;
            f32x16 p0, p1;
#pragma unroll
            for (int r = 0; r < 16; ++r) { p0[r] = -mrun; p1[r] = -mrun; }
#pragma unroll
            for (int d0 = 0; d0 < 4; ++d0) { const int co = ((2 * d0 + hi) ^ ksw) << 4;
                const h8 ka = *(LAS const h8*)(kb + co), kc = *(LAS const h8*)(kb + 4096 + co);
                p0 = __builtin_amdgcn_mfma_f32_32x32x16_f16(ka, qf[d0], p0, 0, 0, 0); p1 = __builtin_amdgcn_mfma_f32_32x32x16_f16(kc, qf[d0], p1, 0, 0, 0); }
#pragma unroll
            for (int d0 = 0; d0 < 2; ++d0) { const int co = ((2 * d0 + hi) ^ rsw) << 4;
                const h8 ka = *(LAS const h8*)(rb + co), kc = *(LAS const h8*)(rb + 2048 + co);
                p0 = __builtin_amdgcn_mfma_f32_32x32x16_f16(ka, qf[4 + d0], p0, 0, 0, 0); p1 = __builtin_amdgcn_mfma_f32_32x32x16_f16(kc, qf[4 + d0], p1, 0, 0, 0); }
            h8 pf[4];
            softmax_step<2, false>(p0, p1, mrun, lrun, have, o, pf);
            { const unsigned vb32 = (unsigned)(size_t)vb; pv_tile64_asm(o, vb32 + ((0 ^ (qrow >> 1)) << 6), vb32 + ((1 ^ (qrow >> 1)) << 6), pf); }
        }
        slot = slot == 2 ? 0 : slot + 1;
    }
#undef C_DMA
    const float linv = 1.0f / swap_sum(lrun);
    const size_t row = rowb + q0 + r32;
    const u16* gp = (const u16*)(F.ws + WS_G1) + row * DM + h * 64;
    u16* op = (u16*)(F.ws + WS_MG1) + row * DM + h * 64;
#pragma unroll
    for (int d0 = 0; d0 < 2; ++d0)
#pragma unroll
        for (int g = 0; g < 4; ++g) { const int d = 32 * d0 + 8 * g + 4 * hi;
            const h4 gv = *(const h4*)(gp + d);
            u32x2 w; w.x = pkh(o[d0][4 * g] * linv * (float)gv[0], o[d0][4 * g + 1] * linv * (float)gv[1]);
            w.y = pkh(o[d0][4 * g + 2] * linv * (float)gv[2], o[d0][4 * g + 3] * linv * (float)gv[3]);
            *(u32x2*)(op + d) = w; }
}

__device__ __forceinline__ void p8_final(Frame& F, const Args& AR) {
    const int gw = blockIdx.x * NWAVES + F.wave, NGW = F.G * NWAVES;
    const float* gn = AR.in[I_FNORM]; f32x4 gv[4];
#pragma unroll
    for (int j = 0; j < 4; ++j) gv[j] = *(const f32x4*)(gn + 4 * F.lane + 256 * j);
    const u16* X2 = (const u16*)(F.ws + WS_X2H);
    for (int mrow = gw; mrow < T; mrow += NGW) {
        const h4* xr = (const h4*)(X2 + (size_t)mrow * DM) + F.lane;
        f32x4 v[4]; float s = 0.f;
#pragma unroll
        for (int j = 0; j < 4; ++j) { const h4 hv = xr[64 * j]; v[j] = (f32x4){(float)hv[0], (float)hv[1], (float)hv[2], (float)hv[3]}; s += (v[j].x * v[j].x + v[j].y * v[j].y) + (v[j].z * v[j].z + v[j].w * v[j].w); }
        const float rstd = __builtin_amdgcn_rsqf(wave_sum(s) * (1.f / DM) + RMS_EPS);
        f32x4* orow = (f32x4*)(F.out + (size_t)mrow * DM) + F.lane;
#pragma unroll
        for (int j = 0; j < 4; ++j) orow[64 * j] = v[j] * rstd * gv[j];
    }
}

#ifndef NAIVE_ATTN
#define NAIVE_ATTN 0
#endif
struct NaiveSh { float sh[4096]; float red[256]; unsigned char sel[4096]; };
__device__ __forceinline__ float blk_max(NaiveSh& S, float v, int tid) { S.red[tid] = v; __syncthreads(); for (int o2 = 128; o2 > 0; o2 >>= 1) { if (tid < o2) S.red[tid] = fmaxf(S.red[tid], S.red[tid + o2]); __syncthreads(); } const float r = S.red[0]; __syncthreads(); return r; }
__device__ __forceinline__ float blk_sum(NaiveSh& S, float v, int tid) { S.red[tid] = v; __syncthreads(); for (int o2 = 128; o2 > 0; o2 >>= 1) { if (tid < o2) S.red[tid] += S.red[tid + o2]; __syncthreads(); } const float r = S.red[0]; __syncthreads(); return r; }
__device__ __forceinline__ float blk_softmax(NaiveSh& S, int nk, int tid) {
    float mx = -1e30f; for (int k = tid; k < nk; k += 256) mx = fmaxf(mx, S.sh[k]); mx = blk_max(S, mx, tid);
    float ls = 0.f; for (int k = tid; k < nk; k += 256) { const float p = S.sh[k] > -1e29f ? exp2f(S.sh[k] - mx) : 0.f; S.sh[k] = p; ls += p; }
    return blk_sum(S, ls, tid);
}
__device__ __forceinline__ float naiveA(NaiveSh& S, const Args& args, int b, int q, int hd, int tid) {
    unsigned char* ws = args.ws; const u16* P0 = (const u16*)(ws + WS_PROJ0); const float* BT = (const float*)(ws + WS_BTG);
    const size_t row = (size_t)b * SEQ + q; const int nk = 64 * (q / 64 + 1); float outv[2] = {0.f, 0.f};
    for (int m = 0; m < 2; ++m) {
        for (int k = tid; k < nk; k += 256) { float sacc = 0.f; const u16* qp = P0 + row * P0W + C_QA + hd * 128 + m * 64; const u16* kp = P0 + ((size_t)b * SEQ + k) * P0W + C_KA + hd * 128 + m * 64;
            for (int d = 0; d < 64; ++d) sacc += h2f(qp[d]) * h2f(kp[d]);
            int rel = k - q; rel = rel < -128 ? -128 : rel; S.sh[k] = sacc + BT[hd * 192 + rel + 128]; }
        __syncthreads();
        const float ls = blk_softmax(S, nk, tid);
        if (tid < 128) { float a = 0.f; for (int k = 0; k < nk; ++k) a += S.sh[k] * h2f(P0[((size_t)b * SEQ + k) * P0W + C_VA + hd * 128 + tid]); outv[m] = a / ls; }
        __syncthreads();
    }
    const float lam = *(const float*)(ws + WS_LAM); const float v = tid < 128 ? outv[0] - lam * outv[1] : 0.f;
    const float ss = blk_sum(S, v * v, tid);
    const float rs = rsqrtf(ss / 128.f + RMS_EPS) * 0.8f;
    return tid < 128 ? v * rs * args.in[I_SUBLN][tid] * h2f(P0[row * P0W + C_G0 + hd * 128 + tid]) : 0.f;
}
__device__ __forceinline__ void naiveB_select(NaiveSh& S, const Args& args, int b, int q, int tid) {
    const u16* P0 = (const u16*)(args.ws + WS_PROJ0); const size_t row = (size_t)b * SEQ + q; const int nk = 64 * (q / 64 + 1);
    for (int k = tid; k < nk; k += 256) { float sc = 0.f;
        for (int hh = 0; hh < 8; ++hh) { float l = 0.f; const u16* qp = P0 + row * P0W + C_QI + hh * 64; const u16* kp = P0 + ((size_t)b * SEQ + k) * P0W + C_KI;
            for (int d = 0; d < 64; ++d) l += h2f(qp[d]) * h2f(kp[d]);
            sc += h2f(P0[row * P0W + C_WI + hh]) * fmaxf(l, 0.f); }
        S.sh[k] = sc; }
    __syncthreads();
    for (int k = tid; k < nk; k += 256) { const float sk = S.sh[k]; int rank = 0; for (int k2 = 0; k2 < nk; ++k2) { const float s2 = S.sh[k2]; rank += (s2 > sk || (s2 == sk && k2 < k)) ? 1 : 0; } S.sel[k] = rank < TOPK ? 1 : 0; }
    __syncthreads();
}
__device__ __forceinline__ float naiveB_head(NaiveSh& S, const Args& args, int b, int q, int hd, int tid) {
    const u16* P0 = (const u16*)(args.ws + WS_PROJ0); const float* BT = (const float*)(args.ws + WS_BTG); const size_t row = (size_t)b * SEQ + q; const int nk = 64 * (q / 64 + 1);
    for (int k = tid; k < nk; k += 256) { float sacc = -1e30f;
        if (S.sel[k]) { sacc = 0.f; const u16* qp = P0 + row * P0W + C_QB + hd * 64; const u16* kp = P0 + ((size_t)b * SEQ + k) * P0W + C_KB;
            for (int d = 0; d < 64; ++d) sacc += h2f(qp[d]) * h2f(kp[d]);
            int rel = k - q; rel = rel < -128 ? -128 : rel; sacc += BT[(4 + hd) * 192 + rel + 128]; }
        S.sh[k] = sacc; }
    __syncthreads();
    const float ls = blk_softmax(S, nk, tid);
    float r = 0.f;
    if (tid < 64) { float a = 0.f; for (int k = 0; k < nk; ++k) a += S.sh[k] * h2f(P0[((size_t)b * SEQ + k) * P0W + C_VB + tid]); r = a / ls * h2f(P0[row * P0W + C_G0 + 512 + hd * 64 + tid]); }
    __syncthreads();
    return r;
}
__device__ __forceinline__ float naiveC(NaiveSh& S, const Args& args, int b, int q, int hd, int tid) {
    unsigned char* ws = args.ws; const size_t row = (size_t)b * SEQ + q; const int nk = 64 * (q / 64 + 1);
    const u16* Q1 = (const u16*)(ws + WS_Q1); const u16* KV = (const u16*)(ws + WS_KV1); const u16* KR = (const u16*)(ws + WS_KROPE);
    for (int k = tid; k < nk; k += 256) { float sacc = 0.f; const u16* qp = Q1 + row * 1536 + hd * 96; const size_t kr = (size_t)b * SEQ + k;
        for (int d = 0; d < 64; ++d) sacc += h2f(qp[d]) * h2f(KV[kr * 2048 + hd * 128 + d]);
        for (int d = 0; d < 32; ++d) sacc += h2f(qp[64 + d]) * h2f(KR[kr * 32 + d]);
        S.sh[k] = sacc; }
    __syncthreads();
    const float ls = blk_softmax(S, nk, tid);
    float r = 0.f;
    if (tid < 64) { float a = 0.f; for (int k = 0; k < nk; ++k) a += S.sh[k] * h2f(KV[((size_t)b * SEQ + k) * 2048 + hd * 128 + 64 + tid]); r = a / ls * h2f(((const u16*)(ws + WS_G1))[row * DM + hd * 64 + tid]); }
    __syncthreads();
    return r;
}
#if NAIVE_ATTN
__global__ void __launch_bounds__(256) naive_attn(Args args, int which) {
    __shared__ NaiveSh S; const int tid = threadIdx.x; unsigned char* ws = args.ws;
    if (which == 0) {
        for (int it = blockIdx.x; it < T * 5; it += gridDim.x) {
            const int row = it / 5, sub = it % 5, b = row / SEQ, q = row % SEQ;
            if (sub < 4) { const float v = naiveA(S, args, b, q, sub, tid); if (tid < 128) ((u16*)(ws + WS_MG0))[(size_t)row * DM + sub * 128 + tid] = (u16)(pkh(v, 0.f) & 0xffffu); }
            else { naiveB_select(S, args, b, q, tid);
                for (int hd = 0; hd < 8; ++hd) { const float v = naiveB_head(S, args, b, q, hd, tid); if (tid < 64) ((u16*)(ws + WS_MG0))[(size_t)row * DM + 512 + hd * 64 + tid] = (u16)(pkh(v, 0.f) & 0xffffu); } }
        }
    } else {
        for (int it = blockIdx.x; it < T * 16; it += gridDim.x) {
            const int row = it >> 4, hd = it & 15, b = row / SEQ, q = row % SEQ;
            const float v = naiveC(S, args, b, q, hd, tid); if (tid < 64) ((u16*)(ws + WS_MG1))[(size_t)row * DM + hd * 64 + tid] = (u16)(pkh(v, 0.f) & 0xffffu);
        }
    }
}
#endif

#if DEBUG_CHECK
constexpr size_t WS_DBG = 3 * MiB;
#ifndef DBG_BITS_MODE
#define DBG_BITS_MODE 1
#define DBG_BITS_IDS 14, 4, 5, 21, 22, 23
#endif
#ifndef DBG_SKIP_MASK
#define DBG_SKIP_MASK 0x10
#endif
#ifndef DBG_REPORT_ID
#define DBG_REPORT_ID 0
#endif
__device__ __forceinline__ unsigned dhash(unsigned x) { x ^= x >> 16; x *= 0x7feb352du; x ^= x >> 15; x *= 0x846ca68bu; x ^= x >> 16; return x; }
__device__ __forceinline__ void dbg_rec(unsigned char* ws, int id, float got, float ref, float scale) {
    float e = fabsf(got - ref) / (fabsf(ref) + scale); if (!(e == e)) e = 1e6f;
    atomicMax((unsigned*)(ws + WS_DBG) + id, __float_as_uint(e));
}
__device__ __forceinline__ float dh(const u16* p, size_t i) { return h2f(p[i]); }
__global__ void __launch_bounds__(256) dbg_check(Args args, int stage) {
    unsigned char* ws = args.ws; const int tid = threadIdx.x, bid = blockIdx.x, gid = bid * 256 + tid;
    if (stage == 0) { if (gid < 64) ((unsigned*)(ws + WS_DBG))[gid] = (gid == 44) ? 0xffffu : 0u; return; }
    if (stage == 1) {
        const unsigned h = dhash(gid * 7919u + 13u);
        { const int n = h % P0W, k = (h >> 12) % 1024; const int sc = wsrc_col(0, n); const float ref = sc < 0 ? 0.f : args.in[I_EWIN][(size_t)k * L0_SRC + sc] * wcol_scale(0, n);
          dbg_rec(ws, 1, dh((const u16*)(ws + WS_W0T), (size_t)n * 1024 + k), ref, 1e-3f); }
        { const int n = h % P1W, k = (h >> 12) % 1024; const int sc = wsrc_col(2, n); const float ref = sc < 0 ? 0.f : args.in[I_OWIN][(size_t)k * L1_SRC + sc] * args.in[I_ONORM][k];
          dbg_rec(ws, 1, dh((const u16*)(ws + WS_W1T), (size_t)n * 1024 + k), ref, 1e-3f); }
        { const int n = h % 1536, k = (h >> 12) % 384; const float ref = args.in[I_OWUQ][(size_t)k * 1536 + n] * args.in[I_OQNORM][k] * QS_C;
          dbg_rec(ws, 1, dh((const u16*)(ws + WS_WUQT), (size_t)n * 384 + k), ref, 1e-3f); }
        { const int n = h % 2048, k = (h >> 12) % 256; const float ref = args.in[I_OWUKV][(size_t)k * 2048 + n] * args.in[I_OKVNORM][k];
          dbg_rec(ws, 1, dh((const u16*)(ws + WS_WUKVT), (size_t)n * 256 + k), ref, 1e-3f); }
        { const int n = h % 1024, k = (h >> 12) % 1024; dbg_rec(ws, 1, dh((const u16*)(ws + WS_WO0T), (size_t)n * 1024 + k), args.in[I_EWO][(size_t)k * 1024 + n], 1e-3f);
          dbg_rec(ws, 1, dh((const u16*)(ws + WS_WO1T), (size_t)n * 1024 + k), args.in[I_OWO][(size_t)k * 1024 + n], 1e-3f); }
        { const int row = h % T, col = (h >> 15) % 1024; const float* xr = args.in[I_X] + (size_t)row * DM; float ss = 0.f; for (int k = 0; k < DM; ++k) ss += xr[k] * xr[k];
          const float ref = xr[col] * rsqrtf(ss / DM + RMS_EPS) * args.in[I_ENORM][col]; dbg_rec(ws, 2, dh((const u16*)(ws + WS_XN0), (size_t)row * DM + col), ref, 1e-2f); }
        return;
    }
    if (stage == 2) {
        const unsigned h = dhash(gid * 104729u + 7u); const int row = h % T; int col = (h >> 15) % P0W; if (gid & 1) col = C_G0 + (col & 1023); if ((gid & 7) == 2) col = C_KI + (col & 63);
        const u16* a = (const u16*)(ws + WS_XN0) + (size_t)row * DM; const u16* b = (const u16*)(ws + WS_W0T) + (size_t)col * 1024; float acc = 0.f;
        for (int k = 0; k < 1024; ++k) acc += h2f(a[k]) * h2f(b[k]);
        if (col >= C_G0) acc = acc / (1.f + expf(-acc));
        dbg_rec(ws, 3, dh((const u16*)(ws + WS_PROJ0), (size_t)row * P0W + col), acc, 2e-2f);
        return;
    }
    if (stage == 3) {
        __shared__ NaiveSh NS;
        const unsigned h = dhash(bid * 2654435761u + 99u);
        int q = h % SEQ; const int b = (h >> 12) % NB; if (bid % 5 == 0) q = q % 320;
        const size_t row = (size_t)b * SEQ + q;
        if (bid < 48) { const int hd = (h >> 20) % 4; const float ref = naiveA(NS, args, b, q, hd, tid);
            if (tid < 128) dbg_rec(ws, 4, dh((const u16*)(ws + WS_MG0), row * DM + hd * 128 + tid), ref, 2e-2f); }
        else { const int hd = (h >> 20) % 8; naiveB_select(NS, args, b, q, tid); const float ref = naiveB_head(NS, args, b, q, hd, tid);
            if (tid < 64) dbg_rec(ws, 5, dh((const u16*)(ws + WS_MG0), row * DM + 512 + hd * 64 + tid), ref, 2e-2f); }
        return;
    }
    if (stage == 4) {
        const unsigned h = dhash(gid * 15485863u + 3u); const int row = h % T, col = (h >> 15) % 1024;
        const u16* a = (const u16*)(ws + WS_MG0) + (size_t)row * DM; const u16* b = (const u16*)(ws + WS_WO0T) + (size_t)col * 1024; float acc = 0.f;
        for (int k = 0; k < 1024; ++k) acc += h2f(a[k]) * h2f(b[k]);
        const float ref = args.in[I_X][(size_t)row * DM + col] + acc;
        dbg_rec(ws, 6, args.out[(size_t)row * DM + col], ref, 1e-2f); dbg_rec(ws, 6, dh((const u16*)(ws + WS_XN0), (size_t)row * DM + col), ref, 1e-2f);
        if (gid < 2048) { float ss = 0.f; for (int k = 0; k < DM; ++k) { const float v = args.out[(size_t)row * DM + k]; ss += v * v; }
            dbg_rec(ws, 7, (float)((const u64*)(ws + WS_SSQ1))[row] / FXS, ss, 1e-3f); }
        return;
    }
    if (stage == 5) {
        const unsigned h = dhash(gid * 32452843u + 5u); const int row = h % T; int col = (h >> 15) % P1W; if ((gid & 3) == 1) col = 640 + (col & 31);
        if (col >= 672 && col < 768) col -= 200;
        const u16* a = (const u16*)(ws + WS_XN0) + (size_t)row * DM; float ss = 0.f; for (int k = 0; k < DM; ++k) { const float v = args.out[(size_t)row * DM + k]; ss += v * v; }
        const float rs = rsqrtf(ss / DM + RMS_EPS);
        auto dotc = [&](int c) { const u16* b = (const u16*)(ws + WS_W1T) + (size_t)c * 1024; float acc = 0.f; for (int k = 0; k < 1024; ++k) acc += h2f(a[k]) * h2f(b[k]); return acc * rs; };
        const float v = dotc(col);
        if (col < 640) dbg_rec(ws, 8, dh((const u16*)(ws + WS_LAT), (size_t)row * LATW + col), v, 2e-2f);
        else if (col < 672) { const int j = col - 640, pos = row & (SEQ - 1), i = j & 15; const float inv = (float)pow(10000.0, -(double)i / 16.0), ang = (float)pos * inv; const float cs = cosf(ang), sn = sinf(ang);
            const float other = dotc(j < 16 ? col + 16 : col - 16); const float ref = j < 16 ? v * cs - other * sn : other * sn + v * cs;
            dbg_rec(ws, 9, dh((const u16*)(ws + WS_KROPE), (size_t)row * 32 + j), ref, 2e-2f); }
        else dbg_rec(ws, 10, dh((const u16*)(ws + WS_G1), (size_t)row * DM + col - 768), v / (1.f + expf(-v)), 2e-2f);
        if (gid < 1024) { const u16* lat = (const u16*)(ws + WS_LAT) + (size_t)row * LATW; float s1 = 0.f, s2 = 0.f; for (int k = 0; k < 256; ++k) s1 += h2f(lat[k]) * h2f(lat[k]); for (int k = 256; k < 640; ++k) s2 += h2f(lat[k]) * h2f(lat[k]);
            dbg_rec(ws, 11, (float)((const u64*)(ws + WS_SSQKV))[row] / FXS, s1, 1e-2f); dbg_rec(ws, 11, (float)((const u64*)(ws + WS_SSQQ))[row] / FXS, s2, 1e-2f); }
        return;
    }
    if (stage == 6) {
        const unsigned h = dhash(gid * 49979687u + 11u); const int row = h % T; const u16* lat = (const u16*)(ws + WS_LAT) + (size_t)row * LATW;
        { const int col = (h >> 15) % 2048; float s1 = 0.f; for (int k = 0; k < 256; ++k) s1 += h2f(lat[k]) * h2f(lat[k]); const float rs = rsqrtf(s1 / 256.f + RMS_EPS);
          const u16* b = (const u16*)(ws + WS_WUKVT) + (size_t)col * 256; float acc = 0.f; for (int k = 0; k < 256; ++k) acc += h2f(lat[k]) * h2f(b[k]);
          dbg_rec(ws, 13, dh((const u16*)(ws + WS_KV1), (size_t)row * 2048 + col), acc * rs, 2e-2f); }
        { int col = (h >> 15) % 1536; if (gid & 1) col = (col / 96) * 96 + 64 + (col & 31);
          float s2 = 0.f; for (int k = 256; k < 640; ++k) s2 += h2f(lat[k]) * h2f(lat[k]); const float rs = rsqrtf(s2 / 384.f + RMS_EPS);
          auto dotc = [&](int c) { const u16* b = (const u16*)(ws + WS_WUQT) + (size_t)c * 384; float acc = 0.f; for (int k = 0; k < 384; ++k) acc += h2f(lat[256 + k]) * h2f(b[k]); return acc * rs; };
          float v = dotc(col); const int jj = col % 96;
          if (jj >= 64) { const int j = jj - 64, pos = row & (SEQ - 1), i = j & 15; const float inv = (float)pow(10000.0, -(double)i / 16.0), ang = (float)pos * inv; const float cs = cosf(ang), sn = sinf(ang);
              const float other = dotc(j < 16 ? col + 16 : col - 16); v = j < 16 ? v * cs - other * sn : other * sn + v * cs; }
          dbg_rec(ws, 12, dh((const u16*)(ws + WS_Q1), (size_t)row * 1536 + col), v, 2e-2f); }
        return;
    }
    if (stage == 7) {
        __shared__ NaiveSh NS;
        const unsigned h = dhash(bid * 2654435761u + 777u); int q = h % SEQ; const int b = (h >> 12) % NB, hd = (h >> 20) % 16; if (bid % 5 == 0) q = q % 320;
        const size_t row = (size_t)b * SEQ + q; const float ref = naiveC(NS, args, b, q, hd, tid);
        if (tid < 64) dbg_rec(ws, 14, dh((const u16*)(ws + WS_MG1), row * DM + hd * 64 + tid), ref, 2e-2f);
        { const float got = tid < 64 ? dh((const u16*)(ws + WS_MG1), row * DM + hd * 64 + tid) : 0.f; const bool bad = tid < 64 && fabsf(got - ref) / (fabsf(ref) + 2e-2f) > 0.05f;
          if (__syncthreads_or(bad ? 1 : 0) && tid == 0) { atomicAdd((unsigned*)(ws + WS_DBG) + 43, 1u); atomicMin((unsigned*)(ws + WS_DBG) + 44, (unsigned)(q / 64)); atomicMax((unsigned*)(ws + WS_DBG) + 45, (unsigned)(q / 64)); } }
        {
            const u16* Q1 = (const u16*)(ws + WS_Q1); const u16* KV = (const u16*)(ws + WS_KV1); const u16* KR = (const u16*)(ws + WS_KROPE); const float* db = (const float*)(ws + WS_DBGBUF) + 4096;
            for (int e = gid; e < 256 * 64; e += gridDim.x * 256) { const int qq = e >> 6, d = e & 63, qpos = 256 * TAPQB + qq, nkk = 64 * (qpos / 64 + 1); float mx = -1e30f, ls = 0.f, a = 0.f;
                const size_t rb = (size_t)TAPB * SEQ; const u16* qp = Q1 + (rb + qpos) * 1536 + TAPH * 96;
                for (int pass = 0; pass < 2; ++pass)
                for (int k = 0; k < nkk; ++k) { float sacc = 0.f; for (int dd = 0; dd < 64; ++dd) sacc += h2f(qp[dd]) * h2f(KV[(rb + k) * 2048 + TAPH * 128 + dd]);
                    for (int dd = 0; dd < 32; ++dd) sacc += h2f(qp[64 + dd]) * h2f(KR[(rb + k) * 32 + dd]);
                    if (pass == 0) mx = fmaxf(mx, sacc); else { const float p = exp2f(sacc - mx); ls += p; a += p * h2f(KV[(rb + k) * 2048 + TAPH * 128 + 64 + d]); } }
                dbg_rec(ws, 21 + (qq >> 6), db[e], a / ls, 2e-2f); }
        }
        if (bid == 0) {
            const u16* Q1 = (const u16*)(ws + WS_Q1); const u16* KV = (const u16*)(ws + WS_KV1); const u16* KR = (const u16*)(ws + WS_KROPE); const float* db = (const float*)(ws + WS_DBGBUF);
            for (int e = tid; e < 32 * 64; e += 256) { const int qq = e >> 6, k = e & 63; float sacc = 0.f;
                for (int d = 0; d < 64; ++d) sacc += h2f(Q1[(size_t)qq * 1536 + d]) * h2f(KV[(size_t)k * 2048 + d]);
                for (int d = 0; d < 32; ++d) sacc += h2f(Q1[(size_t)qq * 1536 + 64 + d]) * h2f(KR[(size_t)k * 32 + d]);
                dbg_rec(ws, 20, db[e], sacc, 2e-2f); dbg_rec(ws, 41, db[e], 0.f, 1.0f); dbg_rec(ws, 42, sacc, 0.f, 1.0f); }
            (void)0;
        }
        return;
    }
    if (stage == 9) {
        if (gid == 0) { const unsigned* e = (const unsigned*)(ws + WS_DBG);
            if (DBG_REPORT_ID >= 43 && DBG_REPORT_ID <= 45) { args.out[0] = 100.0f * (float)e[DBG_REPORT_ID] + 50.f; }
            else if (DBG_REPORT_ID == 40) { args.out[0] = 100.0f * (float)(e[40] / 32u) + 50.f; }
            else if (DBG_REPORT_ID > 0) { args.out[0] = 1000.0f * __uint_as_float(e[DBG_REPORT_ID]); }
            else if (DBG_BITS_MODE) { const int ids[6] = {DBG_BITS_IDS}; int v = 0; for (int i = 0; i < 6; ++i) if (ids[i] > 0 && __uint_as_float(e[ids[i]]) > 0.05f) v |= 1 << i; if (v) args.out[0] = 100.0f * v; }
            else { int first = 0; for (int id = 1; id < 32 && !first; ++id) if (!((DBG_SKIP_MASK >> id) & 1) && __uint_as_float(e[id]) > 0.05f) first = id; if (first) args.out[0] = 100.0f * first; } }
        return;
    }
}
#endif

constexpr int N_PHASES = 9;
__global__ void __launch_bounds__(NWAVES * 64) hybrid_fwd(Args args) {
    extern __shared__ __attribute__((aligned(16))) unsigned char lds_raw[];
    Frame F;
    F.lds = (LAS unsigned char*)lds_raw;
    F.MISC = (volatile LAS unsigned*)(F.lds + MISC_OFF);
    F.tid = threadIdx.x; F.lane = F.tid & 63; F.wave = __builtin_amdgcn_readfirstlane(F.tid >> 6);
    F.G = gridDim.x;
    F.out = args.out; F.ws = args.ws; F.ctl = (unsigned*)(args.ws + WS_CTL);
    for (int u = F.tid; u < (LDS_BYTES - RING_BYTES) / 4; u += NWAVES * 64) ((LAS unsigned*)(F.lds + RING_BYTES))[u] = 0u;
    __syncthreads();
    const int lo = args.ph_lo, hi = args.ph_hi;
    const bool multi = (hi - lo) > 1;
    XcdBarrier bar; bar.bar = F.ctl + CW_BAR; bar.x = 0; bar.st = nullptr;
    if (multi) bar = xcd_barrier_post(F.ctl + CW_BAR, F.MISC + 8);
#ifndef PH_MASK
#define PH_MASK 0x1FF
#endif
#define IN(k) (((PH_MASK >> (k)) & 1) && lo <= (k) && (k) < hi)
#define SEAM(k) do { if (IN(k) && IN((k) + 1)) xcd_barrier(bar); } while (0)
    unsigned char* ws = args.ws;
    LAS unsigned char* ring = F.lds;

#define PHASE1(rep) do { \
        pg8::Gemm g{(const u16*)(ws + WS_XN0), (const u16*)(ws + WS_W0T), T, P0W, 1024, 1024}; pg8::StaticOrder S; S.init(T, P0W, F.G, (int)blockIdx.x); \
        pg8::EpiProj0 E{(u16*)(ws + WS_PROJ0)}; \
        pg8::gemm_phase<pg8::EpiProj0>(ring, g, S, E); } while (0)
#define PHASE2(rep) do { if (!NAIVE_ATTN) { \
        for (;;) { \
            const int u = next_unit(F, (rep) ? CW_Q0 + 16 : CW_Q0); \
            if (u >= 2048) break; \
            const int lvl = 31 - (u >> 6), r = u & 63; \
            if (r < 32) { if (!((rep) && REPEAT_SUB == 1)) { const int c = 2 * lvl + 1 - (r >> 4), rr = r & 15; attnB_unit(F, rr >> 1, 2 * c + (rr & 1), (rep) ? REPEAT_SUB : 0); } } \
            else { if (!((rep) && REPEAT_SUB >= 2)) { const int idx = r - 32; attnA_unit(F, args, idx >> 2, idx & 3, lvl); } } \
        } \
        __syncthreads(); } } while (0)
#define PHASE3(rep) do { \
        pg8::Gemm g{(const u16*)(ws + WS_MG0), (const u16*)(ws + WS_WO0T), T, 1024, 1024, 1024}; pg8::StaticOrder S; S.init(T, 1024, F.G, (int)blockIdx.x); \
        pg8::EpiRes0 E{args.in[I_X], (u16*)(ws + WS_XN0), (rep) ? nullptr : (u64*)(ws + WS_SSQ1)}; \
        pg8::gemm_phase<pg8::EpiRes0>(ring, g, S, E); } while (0)
#define PHASE4(rep) do { \
        pg8::Gemm g{(const u16*)(ws + WS_XN0), (const u16*)(ws + WS_W1T), T, P1W, 1024, 1024}; pg8::StaticOrder S; S.init(T, P1W, F.G, (int)blockIdx.x); \
        pg8::EpiProj1 E{(const u64*)(ws + WS_SSQ1), (u16*)(ws + WS_LAT), (u16*)(ws + WS_KROPE), (u16*)(ws + WS_G1), (rep) ? nullptr : (u64*)(ws + WS_SSQKV), (rep) ? nullptr : (u64*)(ws + WS_SSQQ), (const float*)(ws + WS_ROPEC), (const float*)(ws + WS_ROPES)}; \
        pg8::gemm_phase<pg8::EpiProj1>(ring, g, S, E); } while (0)
#define PHASE5(rep) do { \
        { pg8::Gemm g{(const u16*)(ws + WS_LAT) + 256, (const u16*)(ws + WS_WUQT), T, 1536, 384, LATW}; pg8::StaticOrder S; S.init(T, 1536, F.G, (int)blockIdx.x); \
          pg8::EpiQ1 E{(const u64*)(ws + WS_SSQQ), (u16*)(ws + WS_Q1), (const float*)(ws + WS_ROPEC), (const float*)(ws + WS_ROPES)}; \
          pg8::gemm_phase<pg8::EpiQ1>(ring, g, S, E); } \
        { pg8::Gemm g{(const u16*)(ws + WS_LAT), (const u16*)(ws + WS_WUKVT), T, 2048, 256, LATW}; pg8::StaticOrder S; S.init(T, 2048, F.G, (int)blockIdx.x); \
          pg8::EpiKV1 E{(const u64*)(ws + WS_SSQKV), (u16*)(ws + WS_KV1)}; \
          pg8::gemm_phase<pg8::EpiKV1>(ring, g, S, E); } } while (0)
#define PHASE6(rep) do { if (!NAIVE_ATTN) { \
        for (;;) { \
            const int u = next_unit(F, (rep) ? CW_Q1 + 16 : CW_Q1); \
            if (u >= 2048) break; \
            const int qb = 15 - (u >> 7), r = u & 127; \
            attnC_unit(F, r >> 4, r & 15, qb); \
        } \
        __syncthreads(); } } while (0)
#define PHASE7(rep) do { \
        pg8::Gemm g{(const u16*)(ws + WS_MG1), (const u16*)(ws + WS_WO1T), T, 1024, 1024, 1024}; pg8::StaticOrder S; S.init(T, 1024, F.G, (int)blockIdx.x); \
        pg8::EpiRes1 E{(const u16*)(ws + WS_XN0), (u16*)(ws + WS_X2H)}; \
        pg8::gemm_phase<pg8::EpiRes1>(ring, g, S, E); } while (0)
#define REPEAT(k, CALL) do { if (REPEAT_PHASE == (k) && multi) { xcd_barrier(bar); CALL; } } while (0)
    if (IN(0)) { p0_prologue(F, args); REPEAT(0, p0_prologue(F, args)); } SEAM(0);
    if (IN(1)) { PHASE1(0); REPEAT(1, PHASE1(1)); } SEAM(1);
    if (IN(2)) { PHASE2(0); REPEAT(2, PHASE2(1)); } SEAM(2);
    if (IN(3)) { PHASE3(0); REPEAT(3, PHASE3(1)); } SEAM(3);
    if (IN(4)) { PHASE4(0); REPEAT(4, PHASE4(1)); } SEAM(4);
    if (IN(5)) { PHASE5(0); REPEAT(5, PHASE5(1)); } SEAM(5);
    if (IN(6)) { PHASE6(0); REPEAT(6, PHASE6(1)); } SEAM(6);
    if (IN(7)) { PHASE7(0); } SEAM(7);
    if (IN(8)) { p8_final(F, args); }
#undef IN
#undef SEAM
}

extern "C" void kernel_launch(void* const* d_in, const int* in_sizes, int n_in, void* d_out, int out_size, void* d_ws, size_t ws_size, hipStream_t stream) {
    static int grid = 0;
    if (grid == 0) {
        if (n_in != 18 || in_sizes[0] != T * DM || out_size != T * DM || ws_size < WS_END) {
            fprintf(stderr, "kernel_launch: unexpected shapes (n_in %d, in0 %d, out %d, ws %zu, need %zu); nothing launched\n", n_in, n_in > 0 ? in_sizes[0] : -1, out_size, ws_size, (size_t)WS_END); grid = -1; return; }
        int dev = 0, cus = 0, per_cu = 0;
        if (hipGetDevice(&dev) != hipSuccess || hipDeviceGetAttribute(&cus, hipDeviceAttributeMultiprocessorCount, dev) != hipSuccess) { fprintf(stderr, "kernel_launch: device query failed\n"); grid = -1; return; }
        if (hipFuncSetAttribute((const void*)hybrid_fwd, hipFuncAttributeMaxDynamicSharedMemorySize, LDS_BYTES) != hipSuccess) { fprintf(stderr, "kernel_launch: hipFuncSetAttribute failed\n"); grid = -1; return; }
        if (hipOccupancyMaxActiveBlocksPerMultiprocessor(&per_cu, (const void*)hybrid_fwd, NWAVES * 64, LDS_BYTES) != hipSuccess || per_cu < 1)
            fprintf(stderr, "kernel_launch: note: occupancy query reports %d workgroups per CU\n", per_cu);
        (void)hipGetLastError();
        grid = cus;
        if (grid % 8 != 0) grid -= grid % 8;
    }
    if (grid <= 0) return;
    (void)hipMemsetAsync((char*)d_ws + WS_CTL, 0, CTL_ZERO_BYTES, stream);
    Args a{};
    for (int i = 0; i < 18; ++i) a.in[i] = (const float*)d_in[i];
    a.out = (float*)d_out; a.ws = (unsigned char*)d_ws;
#if MK_N_LAUNCHES == 1
    a.ph_lo = 0; a.ph_hi = N_PHASES;
    hipLaunchKernelGGL(hybrid_fwd, dim3(grid), dim3(NWAVES * 64), LDS_BYTES, stream, a);
#else
#if DEBUG_CHECK
    hipLaunchKernelGGL(dbg_check, dim3(1), dim3(256), 0, stream, a, 0);
#endif
    for (int p = 0; p < N_PHASES; ++p) { a.ph_lo = p; a.ph_hi = p + 1;
#if NAIVE_ATTN
        if (p == 2) { hipLaunchKernelGGL(naive_attn, dim3(8192), dim3(256), 0, stream, a, 0); continue; }
        if (p == 6) { hipLaunchKernelGGL(naive_attn, dim3(8192), dim3(256), 0, stream, a, 1); continue; }
#endif
        hipLaunchKernelGGL(hybrid_fwd, dim3(grid), dim3(NWAVES * 64), LDS_BYTES, stream, a);
#if DEBUG_CHECK
        if (p <= 6) hipLaunchKernelGGL(dbg_check, dim3((p == 2 || p == 6) ? 96 : 64), dim3(256), 0, stream, a, p + 1);
#endif
    }
#if DEBUG_CHECK
    hipLaunchKernelGGL(dbg_check, dim3(1), dim3(256), 0, stream, a, 9);
#endif
#endif
    const hipError_t le = hipPeekAtLastError();
    if (le != hipSuccess) fprintf(stderr, "kernel_launch: launch failed: %s\n", hipGetErrorName(le));
}
```

```cpp
#include <hip/hip_runtime.h>
#include <cstdio>
#include <cstdint>

#ifndef DEBUG_CHECK
#define DEBUG_CHECK 0
#endif
#define TAPB 3
#define TAPH 5
#define TAPQB 7
#ifndef REPEAT_PHASE
#define REPEAT_PHASE -1
#define REPEAT_SUB 0
#endif
#ifndef MK_N_LAUNCHES
#define MK_N_LAUNCHES 1
#endif

#define LAS __attribute__((address_space(3)))
#define GAS __attribute__((address_space(1)))
typedef unsigned short u16;
typedef unsigned long long u64;
typedef _Float16 h8 __attribute__((ext_vector_type(8)));
typedef _Float16 h2 __attribute__((ext_vector_type(2)));
typedef _Float16 h4 __attribute__((ext_vector_type(4)));
typedef short s16x4 __attribute__((ext_vector_type(4)));
typedef short s16x8 __attribute__((ext_vector_type(8)));
typedef float f32x2 __attribute__((ext_vector_type(2)));
typedef float f32x4 __attribute__((ext_vector_type(4)));
typedef float f32x16 __attribute__((ext_vector_type(16)));
typedef unsigned u32x2 __attribute__((ext_vector_type(2)));
typedef unsigned u32x4 __attribute__((ext_vector_type(4)));

constexpr int SEQ = 4096, NB = 8, T = NB * SEQ, DM = 1024;
constexpr int P0W = 3840;
constexpr int C_QA = 0, C_KA = 512, C_VA = 1024, C_QB = 1536, C_KB = 2048, C_VB = 2112, C_QI = 2176, C_KI = 2688, C_WI = 2752, C_G0 = 2816;
constexpr int L0_SRC = 3784;
constexpr int P1W = 1792;
constexpr int L1_SRC = 1696;
constexpr int LATW = 640;
constexpr int TOPK = 256;
constexpr float LOG2E = 1.4426950408889634f;
constexpr float QS_AB = 0.125f * LOG2E;
constexpr float QS_C = 0.10206207261596575f * LOG2E;
constexpr float RMS_EPS = 1e-6f;
constexpr float FXS = 1048576.0f;

constexpr size_t MiB = 1u << 20;
constexpr size_t WS_CTL = 0, CTL_ZERO_BYTES = 2 * MiB;
constexpr size_t WS_SSQ1 = 1 * MiB, WS_SSQKV = WS_SSQ1 + 256 * 1024, WS_SSQQ = WS_SSQKV + 256 * 1024;
constexpr size_t WS_ROPEC = 2 * MiB, WS_ROPES = WS_ROPEC + 256 * 1024, WS_BTG = WS_ROPES + 256 * 1024, WS_LAM = WS_BTG + 16 * 1024;
constexpr size_t WS_W0T = 4 * MiB;
constexpr size_t WS_WO0T = 12 * MiB;
constexpr size_t WS_W1T = 14 * MiB;
constexpr size_t WS_WUQT = 18 * MiB;
constexpr size_t WS_WUKVT = 20 * MiB;
constexpr size_t WS_WO1T = 22 * MiB;
constexpr size_t WS_XN0 = 32 * MiB;
constexpr size_t WS_PROJ0 = 96 * MiB;
constexpr size_t WS_MG0 = 336 * MiB;
constexpr size_t WS_LAT = 96 * MiB;
constexpr size_t WS_KROPE = 136 * MiB;
constexpr size_t WS_G1 = 140 * MiB;
constexpr size_t WS_Q1 = 204 * MiB;
constexpr size_t WS_KV1 = 300 * MiB;
constexpr size_t WS_MG1 = 428 * MiB;
constexpr size_t WS_X2H = 96 * MiB;
constexpr size_t WS_END = 492 * MiB;
constexpr size_t WS_DBGBUF = 3 * MiB + 4096;
constexpr int CW_TMO = 0, CW_CODE = 1, CW_Q0 = 64, CW_Q1 = 128, CW_BAR = 4096;

constexpr int RING_BYTES = 131072;
constexpr int MISC_OFF = RING_BYTES + 320;
constexpr int LDS_BYTES = 147456;
constexpr int NWAVES = 8;

__device__ __forceinline__ unsigned pkh(float lo, float hi) { f32x2 v = {lo, hi}; h2 h = __builtin_convertvector(v, h2); return __builtin_bit_cast(unsigned, h); }
__device__ __forceinline__ float h2f(u16 b) { return (float)__builtin_bit_cast(_Float16, b); }
__device__ __forceinline__ float silu_f(float x) { return x * __builtin_amdgcn_rcpf(1.0f + __builtin_amdgcn_exp2f(-x * LOG2E)); }
__device__ __forceinline__ float swap_max(float m) { auto rr = __builtin_amdgcn_permlane32_swap(__float_as_uint(m), __float_as_uint(m), false, false); return fmaxf(__uint_as_float(rr[0]), __uint_as_float(rr[1])); }
__device__ __forceinline__ float swap_sum(float m) { auto rr = __builtin_amdgcn_permlane32_swap(__float_as_uint(m), __float_as_uint(m), false, false); return __uint_as_float(rr[0]) + __uint_as_float(rr[1]); }
__device__ __forceinline__ float wave_sum(float v) {
#pragma unroll
    for (int o = 1; o < 64; o <<= 1) v += __shfl_xor(v, o);
    return v;
}
#define LDS_WAIT() asm volatile("s_waitcnt lgkmcnt(0)" ::: "memory")
#define VM_WAIT() asm volatile("s_waitcnt vmcnt(0)" ::: "memory")

namespace pg8 {
constexpr int BM = 256, BK = 64, HALF = 128, HTB = HALF * BK * 2, STAGE_BYTES = 8 * HTB, NXCD = 8, WGM = 8;
__host__ __device__ __forceinline__ int lds_byte(int r, int c) { const int st = (r >> 4) * 2 + (c >> 5), rr = r & 15, cc = c & 31, ob = rr * 64 + cc * 2; return st * 1024 + (ob ^ (((ob >> 9) & 1) << 5)); }
__host__ __device__ __forceinline__ void stage_rc(int b, int& R, int& C) { const int st = b / 1024, sb = b % 1024, swz = sb ^ (((sb >> 9) & 1) << 5); R = (st >> 1) * 16 + swz / 64; C = (st & 1) * 32 + (swz % 64) / 2; }
__host__ __device__ __forceinline__ int perm32(int rho) { const int n = rho >> 4, i = rho & 15; return 8 * (i >> 2) + 4 * n + (i & 3); }
struct Unit { int pm, pn; };
struct Gemm { const u16* A; const u16* Bt; int M, N, K, lda; };
struct StaticOrder {
    int nM, nN, nwg, G, c;
    __device__ void init(int M, int N, int G_, int c_) { nM = M / BM; nN = N / BM; nwg = nM * nN; G = G_; c = c_; }
    __device__ bool next(int i, Unit& u) const {
        const long L = (long)i * G + c; if (L >= nwg) return false;
        int wgid = (int)L; { const int q = nwg / NXCD, r = nwg % NXCD, xcd = wgid % NXCD, off = wgid / NXCD; wgid = (xcd < r ? xcd * (q + 1) : r * (q + 1) + (xcd - r) * q) + off; }
        const int nig = WGM * nN, gid = wgid / nig, fm = gid * WGM, gsz = (nM - fm) < WGM ? (nM - fm) : WGM;
        u.pm = fm + ((wgid % nig) % gsz); u.pn = (wgid % nig) / gsz; return true;
    }
};
template <class Epi>
__device__ __forceinline__ void gemm_phase(LAS unsigned char* lds, const Gemm g, const StaticOrder& S, const Epi& E) {
    const int tid = threadIdx.x, wid = __builtin_amdgcn_readfirstlane(tid >> 6), lane = tid & 63, wr = wid >> 2, wc = wid & 3, fr = lane & 15, fq = lane >> 4;
    const int K = g.K, nt = K / BK, lda = g.lda;
    unsigned voffA[2], voffB[2];
#pragma unroll
    for (int i = 0; i < 2; ++i) { int R, C; stage_rc(tid * 16 + i * 8192, R, C); const int Rb = Epi::PERM ? ((R & ~31) + perm32(R & 31)) : R;
        voffA[i] = (unsigned)(R * lda + C) * 2u; voffB[i] = (unsigned)(Rb * K + C) * 2u; }
    const size_t kstep = (size_t)(BK * 2);
    const size_t hstepA = (size_t)HALF * lda * 2, tstepA = 2 * hstepA;
    const size_t hstepB = (size_t)HALF * K * 2, tstepB = 2 * hstepB;
    const unsigned ldsw = (unsigned)wid * 1024u;
    const int aoff = lds_byte(wr * 64 + fr, fq * 8), boff = lds_byte(wc * 32 + fr, fq * 8);
#define PG8_SA(b, h) (((b) * 2 + (h)) * HTB)
#define PG8_SB(b, h) ((4 + (b) * 2 + (h)) * HTB)
#define PG8_STAGE(bufoff, gbase, voff) do { _Pragma("unroll") for (int _i = 0; _i < 2; ++_i) \
        __builtin_amdgcn_global_load_lds((const unsigned*)((const char*)(gbase) + (voff)[_i]), (LAS unsigned*)(lds + (bufoff) + ldsw + _i * 8192), 16, 0, 0); } while (0)
#define PG8_LDA(dst, b, h) do { _Pragma("unroll") for (int m = 0; m < 4; ++m) _Pragma("unroll") for (int k = 0; k < 2; ++k) dst[m][k] = *(const LAS h8*)(lds + PG8_SA(b, h) + aoff + m * 2048 + k * 1024); } while (0)
#define PG8_LDB(dst, b, h) do { _Pragma("unroll") for (int n = 0; n < 2; ++n) _Pragma("unroll") for (int k = 0; k < 2; ++k) dst[n][k] = *(const LAS h8*)(lds + PG8_SB(b, h) + boff + n * 2048 + k * 1024); } while (0)
#define PG8_MMA(ai, bj, At, Bt) do { __builtin_amdgcn_s_setprio(1); _Pragma("unroll") for (int m = 0; m < 4; ++m) _Pragma("unroll") for (int n = 0; n < 2; ++n) _Pragma("unroll") for (int k = 0; k < 2; ++k) \
        acc[ai][bj][m][n] = __builtin_amdgcn_mfma_f32_16x16x32_f16(Bt[n][k], At[m][k], acc[ai][bj][m][n], 0, 0, 0); __builtin_amdgcn_s_setprio(0); } while (0)
#define PG8_WAIT_V(n) asm volatile("s_waitcnt vmcnt(" #n ")" ::: "memory")
#define PG8_WAIT_L(n) asm volatile("s_waitcnt lgkmcnt(" #n ")" ::: "memory")
#define PG8_BAR __builtin_amdgcn_s_barrier()
#define PG8_SCHED __builtin_amdgcn_sched_barrier(0)
    Unit cur, nxt; int ui = 0;
    if (!S.next(0, cur)) return;
    f32x4 acc[2][2][4][2];
#pragma unroll
    for (int a = 0; a < 2; ++a)
#pragma unroll
        for (int b = 0; b < 2; ++b)
#pragma unroll
            for (int m = 0; m < 4; ++m)
#pragma unroll
                for (int n = 0; n < 2; ++n) acc[a][b][m][n] = (f32x4){0.f, 0.f, 0.f, 0.f};
    h8 At[4][2], B0[2][2], B1[2][2];
    const char* cA = (const char*)g.A + (size_t)cur.pm * tstepA; const char* cB = (const char*)g.Bt + (size_t)cur.pn * tstepB;
    PG8_STAGE(PG8_SB(0, 0), cB, voffB); PG8_STAGE(PG8_SB(0, 1), cB + hstepB, voffB); PG8_STAGE(PG8_SA(0, 0), cA, voffA); PG8_STAGE(PG8_SA(0, 1), cA + hstepA, voffA);
    if (wr == 1) PG8_BAR;
    PG8_WAIT_V(2); PG8_BAR;
    PG8_STAGE(PG8_SB(1, 0), cB + kstep, voffB); PG8_STAGE(PG8_SA(1, 0), cA + kstep, voffA); PG8_STAGE(PG8_SB(1, 1), cB + hstepB + kstep, voffB);
    PG8_WAIT_V(6); PG8_BAR;
    for (;;) {
        const bool has_next = S.next(ui + 1, nxt);
        const char* nA = has_next ? (const char*)g.A + (size_t)nxt.pm * tstepA : cA; const char* nB = has_next ? (const char*)g.Bt + (size_t)nxt.pn * tstepB : cB;
#pragma unroll 1
        for (int t = 0; t < nt; t += 2) {
            const bool last = (t == nt - 2);
            const char* a1 = cA + (size_t)(t + 1) * kstep;
            const char* a2 = last ? nA : cA + (size_t)(t + 2) * kstep; const char* b2 = last ? nB : cB + (size_t)(t + 2) * kstep;
            const char* a3 = a2 + kstep; const char* b3 = b2 + kstep;
            PG8_LDB(B0, 0, 0); PG8_LDB(B1, 0, 1); PG8_SCHED; PG8_LDA(At, 0, 0); PG8_STAGE(PG8_SA(1, 1), a1 + hstepA, voffA);
            PG8_WAIT_V(8); PG8_WAIT_L(0); PG8_BAR; PG8_MMA(0, 0, At, B0); PG8_MMA(0, 1, At, B1); PG8_BAR; PG8_SCHED;
            PG8_LDA(At, 0, 1); PG8_STAGE(PG8_SB(0, 0), b2, voffB); PG8_STAGE(PG8_SB(0, 1), b2 + hstepB, voffB); PG8_STAGE(PG8_SA(0, 0), a2, voffA);
            PG8_WAIT_V(8); PG8_WAIT_L(0); PG8_BAR; PG8_MMA(1, 0, At, B0); PG8_MMA(1, 1, At, B1); PG8_BAR; PG8_SCHED;
            PG8_LDB(B0, 1, 0); PG8_LDB(B1, 1, 1); PG8_SCHED; PG8_LDA(At, 1, 0); PG8_STAGE(PG8_SA(0, 1), a2 + hstepA, voffA);
            PG8_WAIT_V(8); PG8_WAIT_L(0); PG8_BAR; PG8_MMA(0, 0, At, B0); PG8_MMA(0, 1, At, B1); PG8_BAR; PG8_SCHED;
            PG8_LDA(At, 1, 1); PG8_STAGE(PG8_SB(1, 0), b3, voffB); PG8_STAGE(PG8_SB(1, 1), b3 + hstepB, voffB); PG8_STAGE(PG8_SA(1, 0), a3, voffA);
            PG8_WAIT_V(8); PG8_WAIT_L(0); PG8_BAR; PG8_MMA(1, 0, At, B0); PG8_MMA(1, 1, At, B1); PG8_BAR; PG8_SCHED;
        }
        if (wr == 0) PG8_BAR;
        E(acc, cur, wr, wc, fr, fq);
        if (!has_next) break;
#pragma unroll
        for (int a = 0; a < 2; ++a)
#pragma unroll
            for (int b = 0; b < 2; ++b)
#pragma unroll
                for (int m = 0; m < 4; ++m)
#pragma unroll
                    for (int n = 0; n < 2; ++n) acc[a][b][m][n] = (f32x4){0.f, 0.f, 0.f, 0.f};
        cur = nxt; cA = nA; cB = nB; ++ui;
        if (wr == 1) PG8_BAR;
    }
    PG8_WAIT_V(0);
    PG8_BAR;
#undef PG8_SA
#undef PG8_SB
#undef PG8_STAGE
#undef PG8_LDA
#undef PG8_LDB
#undef PG8_MMA
#undef PG8_WAIT_V
#undef PG8_WAIT_L
#undef PG8_BAR
#undef PG8_SCHED
}

typedef f32x4 Acc[2][2][4][2];
__device__ __forceinline__ float rstd_from(const u64* ssq, int row, float inv_n) { return __builtin_amdgcn_rsqf((float)ssq[row] * (1.0f / FXS) * inv_n + RMS_EPS); }
__device__ __forceinline__ void ssq_add(u64* ssq, int row, float ss, int fq) {
    ss += __shfl_xor(ss, 16); ss += __shfl_xor(ss, 32);
    if (fq == 0) atomicAdd((unsigned long long*)(ssq + row), (unsigned long long)(ss * FXS + 0.5f));
}
struct EpiProj0 {
    static constexpr bool PERM = true;
    u16* O;
    __device__ __forceinline__ void operator()(const Acc& acc, const Unit& u, int wr, int wc, int fr, int fq) const {
        const int row0 = u.pm * BM + wr * 64 + fr, col0 = u.pn * BM + wc * 32 + 8 * fq; const bool gate = u.pn >= 11;
#pragma unroll
        for (int ai = 0; ai < 2; ++ai)
#pragma unroll
            for (int m = 0; m < 4; ++m) { u16* rowp = O + (size_t)(row0 + ai * HALF + m * 16) * P0W + col0;
#pragma unroll
                for (int bj = 0; bj < 2; ++bj) { f32x4 v0 = acc[ai][bj][m][0], v1 = acc[ai][bj][m][1];
                    if (gate) {
#pragma unroll
                        for (int e = 0; e < 4; ++e) { v0[e] = silu_f(v0[e]); v1[e] = silu_f(v1[e]); } }
                    u32x4 w; w.x = pkh(v0[0], v0[1]); w.y = pkh(v0[2], v0[3]); w.z = pkh(v1[0], v1[1]); w.w = pkh(v1[2], v1[3]);
                    *(u32x4*)(rowp + bj * HALF) = w; } }
    }
};
struct EpiRes0 {
    static constexpr bool PERM = false;
    const float* base; u16* outh; u64* ssq;
    __device__ __forceinline__ void operator()(const Acc& acc, const Unit& u, int wr, int wc, int fr, int fq) const {
        const int row0 = u.pm * BM + wr * 64 + fr, col0 = u.pn * BM + wc * 32 + 4 * fq;
#pragma unroll
        for (int ai = 0; ai < 2; ++ai)
#pragma unroll
            for (int m = 0; m < 4; ++m) { const int row = row0 + ai * HALF + m * 16; const size_t off = (size_t)row * DM + col0; float ss = 0.f;
#pragma unroll
                for (int bj = 0; bj < 2; ++bj)
#pragma unroll
                    for (int n = 0; n < 2; ++n) { const f32x4 bs = *(const f32x4*)(base + off + bj * HALF + n * 16); const f32x4 o = bs + acc[ai][bj][m][n];
                        u32x2 w; w.x = pkh(o[0], o[1]); w.y = pkh(o[2], o[3]); *(u32x2*)(outh + off + bj * HALF + n * 16) = w;
                        ss += (o[0] * o[0] + o[1] * o[1]) + (o[2] * o[2] + o[3] * o[3]); }
                if (ssq) ssq_add(ssq, row, ss, fq); }
    }
};
struct EpiRes1 {
    static constexpr bool PERM = false;
    const u16* baseh; u16* outh;
    __device__ __forceinline__ void operator()(const Acc& acc, const Unit& u, int wr, int wc, int fr, int fq) const {
        const int row0 = u.pm * BM + wr * 64 + fr, col0 = u.pn * BM + wc * 32 + 4 * fq;
#pragma unroll
        for (int ai = 0; ai < 2; ++ai)
#pragma unroll
            for (int m = 0; m < 4; ++m) { const int row = row0 + ai * HALF + m * 16; const size_t off = (size_t)row * DM + col0;
#pragma unroll
                for (int bj = 0; bj < 2; ++bj)
#pragma unroll
                    for (int n = 0; n < 2; ++n) { const h4 bh = *(const h4*)(baseh + off + bj * HALF + n * 16);
                        const f32x4 a = acc[ai][bj][m][n];
                        u32x2 w; w.x = pkh(a[0] + (float)bh[0], a[1] + (float)bh[1]); w.y = pkh(a[2] + (float)bh[2], a[3] + (float)bh[3]);
                        *(u32x2*)(outh + off + bj * HALF + n * 16) = w; } }
    }
};
struct EpiProj1 {
    static constexpr bool PERM = false;
    const u64* ssq1; u16* lat; u16* krope; u16* g1; u64* ssqkv; u64* ssqq; const float* ropec; const float* ropes;
    __device__ __forceinline__ void operator()(const Acc& acc, const Unit& u, int wr, int wc, int fr, int fq) const {
        const int row0 = u.pm * BM + wr * 64 + fr, pn = u.pn;
#pragma unroll
        for (int ai = 0; ai < 2; ++ai)
#pragma unroll
            for (int m = 0; m < 4; ++m) { const int row = row0 + ai * HALF + m * 16; const float rs = rstd_from(ssq1, row, 1.0f / 1024.0f); float ss = 0.f;
#pragma unroll
                for (int bj = 0; bj < 2; ++bj) { f32x4 v0 = acc[ai][bj][m][0] * rs, v1 = acc[ai][bj][m][1] * rs;
                    const int tc = bj * HALF + wc * 32 + 4 * fq;
                    if (pn >= 3) {
#pragma unroll
                        for (int e = 0; e < 4; ++e) { v0[e] = silu_f(v0[e]); v1[e] = silu_f(v1[e]); }
                        u16* p = g1 + (size_t)row * DM + (pn - 3) * BM + tc;
                        u32x2 w0, w1; w0.x = pkh(v0[0], v0[1]); w0.y = pkh(v0[2], v0[3]); w1.x = pkh(v1[0], v1[1]); w1.y = pkh(v1[2], v1[3]);
                        *(u32x2*)p = w0; *(u32x2*)(p + 16) = w1;
                    } else if (pn < 2 || bj == 0) {
                        u16* p = lat + (size_t)row * LATW + pn * BM + tc;
                        u32x2 w0, w1; w0.x = pkh(v0[0], v0[1]); w0.y = pkh(v0[2], v0[3]); w1.x = pkh(v1[0], v1[1]); w1.y = pkh(v1[2], v1[3]);
                        *(u32x2*)p = w0; *(u32x2*)(p + 16) = w1;
                        ss += (v0[0] * v0[0] + v0[1] * v0[1]) + (v0[2] * v0[2] + v0[3] * v0[3]) + (v1[0] * v1[0] + v1[1] * v1[1]) + (v1[2] * v1[2] + v1[3] * v1[3]);
                    } else if (wc == 0) {
                        const int pos = row & (SEQ - 1); const f32x4 cs = *(const f32x4*)(ropec + pos * 16 + 4 * fq), sn = *(const f32x4*)(ropes + pos * 16 + 4 * fq);
                        const f32x4 o0 = v0 * cs - v1 * sn, o1 = v0 * sn + v1 * cs;
                        u16* p = krope + (size_t)row * 32 + 4 * fq;
                        u32x2 w0, w1; w0.x = pkh(o0[0], o0[1]); w0.y = pkh(o0[2], o0[3]); w1.x = pkh(o1[0], o1[1]); w1.y = pkh(o1[2], o1[3]);
                        *(u32x2*)p = w0; *(u32x2*)(p + 16) = w1;
                    } }
                if (pn == 0) { if (ssqkv) ssq_add(ssqkv, row, ss, fq); } else if (pn <= 2) { if (ssqq) ssq_add(ssqq, row, ss, fq); }
                asm volatile("" ::: "memory"); }
    }
};
struct EpiQ1 {
    static constexpr bool PERM = false;
    const u64* ssqq; u16* q1; const float* ropec; const float* ropes;
    __device__ __forceinline__ void operator()(const Acc& acc, const Unit& u, int wr, int wc, int fr, int fq) const {
        const int row0 = u.pm * BM + wr * 64 + fr;
#pragma unroll
        for (int ai = 0; ai < 2; ++ai)
#pragma unroll
            for (int m = 0; m < 4; ++m) { const int row = row0 + ai * HALF + m * 16; const float rs = rstd_from(ssqq, row, 1.0f / 384.0f);
#pragma unroll
                for (int bj = 0; bj < 2; ++bj) { f32x4 v0 = acc[ai][bj][m][0] * rs, v1 = acc[ai][bj][m][1] * rs;
                    const int g0 = u.pn * BM + bj * HALF + wc * 32;
                    if ((g0 % 96) == 64) { const int pos = row & (SEQ - 1); const f32x4 cs = *(const f32x4*)(ropec + pos * 16 + 4 * fq), sn = *(const f32x4*)(ropes + pos * 16 + 4 * fq);
                        const f32x4 o0 = v0 * cs - v1 * sn, o1 = v0 * sn + v1 * cs; v0 = o0; v1 = o1; }
                    u16* p = q1 + (size_t)row * 1536 + g0 + 4 * fq;
                    u32x2 w0, w1; w0.x = pkh(v0[0], v0[1]); w0.y = pkh(v0[2], v0[3]); w1.x = pkh(v1[0], v1[1]); w1.y = pkh(v1[2], v1[3]);
                    *(u32x2*)p = w0; *(u32x2*)(p + 16) = w1; }
                asm volatile("" ::: "memory"); }
    }
};
struct EpiKV1 {
    static constexpr bool PERM = true;
    const u64* ssqkv; u16* kv1;
    __device__ __forceinline__ void operator()(const Acc& acc, const Unit& u, int wr, int wc, int fr, int fq) const {
        const int row0 = u.pm * BM + wr * 64 + fr, col0 = u.pn * BM + wc * 32 + 8 * fq;
#pragma unroll
        for (int ai = 0; ai < 2; ++ai)
#pragma unroll
            for (int m = 0; m < 4; ++m) { const int row = row0 + ai * HALF + m * 16; const float rs = rstd_from(ssqkv, row, 1.0f / 256.0f); u16* rowp = kv1 + (size_t)row * 2048 + col0;
#pragma unroll
                for (int bj = 0; bj < 2; ++bj) { const f32x4 v0 = acc[ai][bj][m][0] * rs, v1 = acc[ai][bj][m][1] * rs;
                    u32x4 w; w.x = pkh(v0[0], v0[1]); w.y = pkh(v0[2], v0[3]); w.z = pkh(v1[0], v1[1]); w.w = pkh(v1[2], v1[3]);
                    *(u32x4*)(rowp + bj * HALF) = w; }
                if (m & 1) asm volatile("" ::: "memory"); }
    }
};
}

#define XB_TMO      128
#define XB_XCNT(j)  (256  + 64 * (j))
#define XB_XSUB(j)  (1280 + 64 * (j))
#define XB_XGEN(j)  (2304 + 64 * (j))
#define XB_TOP      3328
#define XB_TOPGEN   3392
#define XCD_BAR_WORDS 3456
#define XB_SPIN_CAP (1u << 20)
__device__ __forceinline__ unsigned xb_ld(unsigned* p)              { return __hip_atomic_load(p, __ATOMIC_RELAXED, __HIP_MEMORY_SCOPE_AGENT); }
__device__ __forceinline__ unsigned xb_add(unsigned* p, unsigned v) { return __hip_atomic_fetch_add(p, v, __ATOMIC_RELAXED, __HIP_MEMORY_SCOPE_AGENT); }
__device__ __forceinline__ unsigned xb_xcc_id() { return (unsigned)__builtin_amdgcn_s_getreg((3 << 11) | 20) & 0xFu; }
#define XB_SPIN(cond, bar) do { unsigned _sp = 0; while (cond) { __builtin_amdgcn_s_sleep(1); \
    if ((++_sp & 255u) == 0u) { if (xb_ld(&(bar)[XB_TMO])) break; if (_sp > XB_SPIN_CAP) { atomicAdd(&(bar)[XB_TMO], 1u); break; } } } } while (0)
struct XcdBarrier { unsigned* bar; unsigned x; volatile LAS unsigned* st; };
__device__ __forceinline__ XcdBarrier xcd_barrier_post(unsigned* bar, volatile LAS unsigned* st) {
    XcdBarrier b; b.bar = bar; b.x = xb_xcc_id(); b.st = st;
    if (threadIdx.x == 0) (void)xb_add(&bar[XB_XCNT(b.x)], 1u);
    return b;
}
__device__ __forceinline__ void xcd_barrier_complete(unsigned* bar, unsigned x, unsigned& nloc, unsigned& nx) {
    const unsigned G = gridDim.x * gridDim.y * gridDim.z;
    unsigned sum, cnt, mine, sp = 0u;
    for (;;) {
        sum = 0u; cnt = 0u; mine = 0u;
#pragma unroll
        for (unsigned j = 0; j < 16; ++j) { const unsigned c = xb_ld(&bar[XB_XCNT(j)]); sum += c; cnt += (c > 0u) ? 1u : 0u; mine = (j == x) ? c : mine; }
        if (sum == G) break;
        __builtin_amdgcn_s_sleep(1);
        if ((++sp & 255u) == 0u) { if (xb_ld(&bar[XB_TMO])) break; if (sp > XB_SPIN_CAP) { atomicAdd(&bar[XB_TMO], 1u); break; } }
    }
    nloc = mine > 0u ? mine : 1u; nx = cnt > 0u ? cnt : 1u;
}
__device__ __forceinline__ void xcd_barrier(const XcdBarrier& b) {
    asm volatile("s_waitcnt vmcnt(0)" ::: "memory");
    __syncthreads();
    if (threadIdx.x == 0) {
        unsigned* bar = b.bar;
        __builtin_amdgcn_s_waitcnt(0);
        unsigned nloc = b.st[0], nx = b.st[1];
        if (nloc == 0u) { xcd_barrier_complete(bar, b.x, nloc, nx); b.st[0] = nloc; b.st[1] = nx; }
        const unsigned old = xb_add(&bar[XB_XSUB(b.x)], 1u);
        const unsigned gen = old / nloc;
        if (old + 1u == (gen + 1u) * nloc) {
            __builtin_amdgcn_fence(__ATOMIC_RELEASE, "agent");
            asm volatile("s_waitcnt vmcnt(0)" ::: "memory");
            const unsigned og = xb_add(&bar[XB_TOP], 1u);
            const unsigned tg = og / nx;
            if (og + 1u == (tg + 1u) * nx) xb_add(&bar[XB_TOPGEN], 1u);
            else XB_SPIN(xb_ld(&bar[XB_TOPGEN]) == tg, bar);
            __builtin_amdgcn_fence(__ATOMIC_ACQUIRE, "agent");
            xb_add(&bar[XB_XGEN(b.x)], 1u);
            asm volatile("s_waitcnt vmcnt(0)" ::: "memory");
        } else {
            XB_SPIN(xb_ld(&bar[XB_XGEN(b.x)]) == gen, bar);
            __builtin_amdgcn_fence(__ATOMIC_ACQUIRE, "agent");
            asm volatile("s_waitcnt vmcnt(0)" ::: "memory");
        }
    }
    __syncthreads();
}

struct Args { const float* in[18]; float* out; unsigned char* ws; int ph_lo, ph_hi; };
struct Frame {
    LAS unsigned char* lds;
    volatile LAS unsigned* MISC;
    unsigned* ctl;
    int tid, lane, wave, G;
    float* out;
    unsigned char* ws;
};
enum { I_X = 0, I_RELB, I_ENORM, I_EWIN, I_LQ1, I_LK1, I_LQ2, I_LK2, I_SUBLN, I_EWO, I_ONORM, I_OWIN, I_OQNORM, I_OWUQ, I_OKVNORM, I_OWUKV, I_OWO, I_FNORM };

__device__ __forceinline__ int t5_bucket(int rel) {
    const int n = rel < 0 ? -rel : rel;
    const int v = n < 8 ? n : n < 12 ? 8 : n < 16 ? 9 : n < 23 ? 10 : n < 32 ? 11 : n < 46 ? 12 : n < 64 ? 13 : n < 91 ? 14 : 15;
    return (rel > 0 ? 16 : 0) + v;
}

__device__ __forceinline__ int wsrc_col(int mat, int n) {
    switch (mat) {
        case 0: return n < 2760 ? n : (n < C_G0 ? -1 : n - 56);
        case 2: return n < 256 ? 384 + n : (n < 640 ? n - 256 : (n < 672 ? n : (n < 768 ? -1 : n - 96)));
        default: return n;
    }
}
__device__ __forceinline__ float wcol_scale(int mat, int n) {
    if (mat == 0) return (n < 512 || (n >= C_QB && n < C_QB + 512)) ? QS_AB : 1.0f;
    if (mat == 3) return QS_C;
    return 1.0f;
}
__device__ __forceinline__ void p0_transpose_item(const float* W, int K, int Nsrc, int Npad, const float* gain, int mat, u16* WT, LAS float* scr, int item, int lane) {
    const int nblk = Npad / 32, kb = item / nblk, nb = item % nblk, k0 = 64 * kb, n0 = 32 * nb;
    const int n = n0 + (lane & 31); const int sc = wsrc_col(mat, n); const float cs = wcol_scale(mat, n);
#pragma unroll 8
    for (int i = 0; i < 32; ++i) { const int kk = 2 * i + (lane >> 5); float v = 0.f;
        if (sc >= 0) { v = W[(size_t)(k0 + kk) * Nsrc + sc] * cs; if (gain) v *= gain[k0 + kk]; }
        scr[kk * 33 + (lane & 31)] = v; }
    LDS_WAIT(); asm volatile("" ::: "memory");
    const int c = lane & 7;
#pragma unroll
    for (int j = 0; j < 4; ++j) { const int nn = (lane >> 3) + 8 * j; const LAS float* s = scr + (8 * c) * 33 + nn;
        u32x4 o; o.x = pkh(s[0 * 33], s[1 * 33]); o.y = pkh(s[2 * 33], s[3 * 33]); o.z = pkh(s[4 * 33], s[5 * 33]); o.w = pkh(s[6 * 33], s[7 * 33]);
        *(u32x4*)(WT + (size_t)(n0 + nn) * K + k0 + 8 * c) = o; }
    LDS_WAIT(); asm volatile("" ::: "memory");
}
__device__ __forceinline__ void p0_prologue(Frame& F, const Args& AR) {
    LAS float* scr = (LAS float*)(F.lds + F.wave * 16384);
    const int gw = blockIdx.x * NWAVES + F.wave, NGW = F.G * NWAVES;
    unsigned char* ws = F.ws;
    constexpr int I0 = (1024 / 64) * (P0W / 32), I1 = (1024 / 64) * (1024 / 32), I2 = (1024 / 64) * (P1W / 32), I3 = (384 / 64) * (1536 / 32), I4 = (256 / 64) * (2048 / 32), I5 = I1;
    constexpr int NITEMS = I0 + I1 + I2 + I3 + I4 + I5;
    for (int it = gw; it < NITEMS; it += NGW) {
        int r = it;
        if (r < I0) { p0_transpose_item(AR.in[I_EWIN], 1024, L0_SRC, P0W, nullptr, 0, (u16*)(ws + WS_W0T), scr, r, F.lane); continue; } r -= I0;
        if (r < I1) { p0_transpose_item(AR.in[I_EWO], 1024, 1024, 1024, nullptr, 1, (u16*)(ws + WS_WO0T), scr, r, F.lane); continue; } r -= I1;
        if (r < I2) { p0_transpose_item(AR.in[I_OWIN], 1024, L1_SRC, P1W, AR.in[I_ONORM], 2, (u16*)(ws + WS_W1T), scr, r, F.lane); continue; } r -= I2;
        if (r < I3) { p0_transpose_item(AR.in[I_OWUQ], 384, 1536, 1536, AR.in[I_OQNORM], 3, (u16*)(ws + WS_WUQT), scr, r, F.lane); continue; } r -= I3;
        if (r < I4) { p0_transpose_item(AR.in[I_OWUKV], 256, 2048, 2048, AR.in[I_OKVNORM], 4, (u16*)(ws + WS_WUKVT), scr, r, F.lane); continue; } r -= I4;
        p0_transpose_item(AR.in[I_OWO], 1024, 1024, 1024, nullptr, 5, (u16*)(ws + WS_WO1T), scr, r, F.lane);
    }
    {
        const float* gn = AR.in[I_ENORM]; f32x4 gv[4];
#pragma unroll
        for (int j = 0; j < 4; ++j) gv[j] = *(const f32x4*)(gn + 4 * F.lane + 256 * j);
        u16* XN = (u16*)(ws + WS_XN0);
        for (int mrow = gw; mrow < T; mrow += NGW) {
            const f32x4* xr = (const f32x4*)(AR.in[I_X] + (size_t)mrow * DM) + F.lane;
            f32x4 v[4]; float s = 0.f;
#pragma unroll
            for (int j = 0; j < 4; ++j) { v[j] = xr[64 * j]; s += (v[j].x * v[j].x + v[j].y * v[j].y) + (v[j].z * v[j].z + v[j].w * v[j].w); }
            const float rstd = __builtin_amdgcn_rsqf(wave_sum(s) * (1.f / DM) + RMS_EPS);
            u32x2* o8 = (u32x2*)(XN + (size_t)mrow * DM) + F.lane;
#pragma unroll
            for (int j = 0; j < 4; ++j) { const f32x4 t = v[j] * rstd * gv[j]; u32x2 w; w.x = pkh(t.x, t.y); w.y = pkh(t.z, t.w); o8[64 * j] = w; }
        }
    }
    {
        float* rc = (float*)(ws + WS_ROPEC); float* rs = (float*)(ws + WS_ROPES);
        const int gt = blockIdx.x * 512 + F.tid, NGT = F.G * 512;
        for (int e = gt; e < SEQ * 16; e += NGT) { const int pos = e >> 4, i = e & 15;
            const float inv = (float)pow(10000.0, -(double)i / 16.0); const float ang = (float)pos * inv;
            rc[e] = (float)cos((double)ang); rs[e] = (float)sin((double)ang); }
        float* bt = (float*)(ws + WS_BTG);
        for (int e = gt; e < 12 * 192; e += NGT) { const int hd = e / 192, idx = e % 192; const int rel = idx - 128;
            bt[e] = AR.in[I_RELB][t5_bucket(rel) * 12 + hd] * LOG2E; }
        if (blockIdx.x == 0 && F.wave == 0) {
            const float a = wave_sum(AR.in[I_LQ1][F.lane] * AR.in[I_LK1][F.lane]), b = wave_sum(AR.in[I_LQ2][F.lane] * AR.in[I_LK2][F.lane]);
            if (F.lane == 0) *(float*)(ws + WS_LAM) = expf(a) - expf(b) + 0.2f;
        }
    }
}

__device__ __forceinline__ h8 tr2(LAS const unsigned char* p0, LAS const unsigned char* p1) {
    const s16x4 lo = __builtin_amdgcn_ds_read_tr16_b64_v4i16((LAS s16x4*)p0), hi = __builtin_amdgcn_ds_read_tr16_b64_v4i16((LAS s16x4*)p1);
    const s16x8 v = __builtin_shufflevector(lo, hi, 0, 1, 2, 3, 4, 5, 6, 7); return __builtin_bit_cast(h8, v);
}
constexpr float SM_THR = 8.0f;
__device__ __forceinline__ float max3f(float a, float b, float c) { float r; asm("v_max3_f32 %0, %1, %2, %3" : "=v"(r) : "v"(a), "v"(b), "v"(c)); return r; }
template <int ND, bool MASKED>
__device__ __forceinline__ void softmax_step(f32x16& p0, f32x16& p1, float& mref, float& lrun, bool& have, f32x16 (&o)[ND], h8 (&pf)[4]) {
    float mx = fmaxf(fmaxf(p0[0], p1[0]), fmaxf(p0[1], p1[1]));
#pragma unroll
    for (int r = 2; r < 16; r += 2) mx = fmaxf(mx, fmaxf(fmaxf(p0[r], p1[r]), fmaxf(p0[r + 1], p1[r + 1])));
    mx = swap_max(mx);
    const bool valid = MASKED ? (mx > -1e29f) : true;
    const bool trig = valid && (!have || mx > SM_THR);
    if (__any(trig)) {
        const float dl = valid ? (have ? fmaxf(mx, 0.f) : mx) : 0.f;
        have = have || valid;
        mref += dl;
        const float alpha = __builtin_amdgcn_exp2f(-dl);
        lrun *= alpha;
#pragma unroll
        for (int r = 0; r < 16; ++r) { p0[r] -= dl; p1[r] -= dl; }
#pragma unroll
        for (int d = 0; d < ND; ++d)
#pragma unroll
            for (int r = 0; r < 16; ++r) o[d][r] *= alpha;
    }
    float s0 = 0.f, s1 = 0.f;
#pragma unroll
    for (int r = 0; r < 16; ++r) { p0[r] = __builtin_amdgcn_exp2f(p0[r]); p1[r] = __builtin_amdgcn_exp2f(p1[r]); s0 += p0[r]; s1 += p1[r]; }
    lrun += s0 + s1;
#pragma unroll
    for (int ks = 0; ks < 4; ++ks) {
        u32x4 w;
        if (ks < 2) { w.x = pkh(p0[8 * ks + 0], p0[8 * ks + 1]); w.y = pkh(p0[8 * ks + 2], p0[8 * ks + 3]); w.z = pkh(p0[8 * ks + 4], p0[8 * ks + 5]); w.w = pkh(p0[8 * ks + 6], p0[8 * ks + 7]); }
        else { const int k2 = ks - 2; w.x = pkh(p1[8 * k2 + 0], p1[8 * k2 + 1]); w.y = pkh(p1[8 * k2 + 2], p1[8 * k2 + 3]); w.z = pkh(p1[8 * k2 + 4], p1[8 * k2 + 5]); w.w = pkh(p1[8 * k2 + 6], p1[8 * k2 + 7]); }
        pf[ks] = __builtin_bit_cast(h8, w);
    }
}
__device__ __forceinline__ void add_bias(f32x16& p0, f32x16& p1, const LAS float* bt, int idx0) {
#pragma unroll
    for (int r = 0; r < 16; ++r) { const int c = (r & 3) + 8 * (r >> 2);
        const int i0 = idx0 + c, i1 = idx0 + 32 + c;
        p0[r] += bt[i0 < 0 ? 0 : i0]; p1[r] += bt[i1 < 0 ? 0 : i1]; }
}
__device__ __forceinline__ int next_unit(Frame& F, int cw) {
    volatile LAS unsigned* slot = F.MISC + 16;
    __syncthreads();
    if (F.tid == 0) slot[0] = __hip_atomic_fetch_add(F.ctl + cw, 1u, __ATOMIC_RELAXED, __HIP_MEMORY_SCOPE_AGENT);
    __syncthreads();
    return (int)slot[0];
}

__device__ __forceinline__ void attnA_unit(Frame& F, const Args& AR, int b, int h, int qb) {
    LAS unsigned char* lds = F.lds;
    int tid = F.tid; asm volatile("" : "+v"(tid)); int wid = F.wave; asm volatile("" : "+s"(wid));
    const int lane = tid & 63, r32 = lane & 31, hi = lane >> 5;
    const int m = wid & 1, qsub = wid >> 1, q0 = 128 * qb + 32 * qsub, cw = q0 >> 6, nt = 2 * qb + 2;
    const size_t rowb = (size_t)b * SEQ;
    const u16* P0 = (const u16*)(F.ws + WS_PROJ0);
    LAS float* bt = (LAS float*)(lds + 65536);
    if (tid < 192) bt[tid] = ((const float*)(F.ws + WS_BTG))[h * 192 + tid];
    h8 qf[4];
    { const u16* qp = P0 + (rowb + q0 + r32) * P0W + C_QA + h * 128 + m * 64 + hi * 8;
#pragma unroll
      for (int d0 = 0; d0 < 4; ++d0) qf[d0] = *(const h8*)(qp + d0 * 16); }
    f32x16 o[4];
#pragma unroll
    for (int d = 0; d < 4; ++d)
#pragma unroll
        for (int r = 0; r < 16; ++r) o[d][r] = 0.f;
    float mrun = 0.f, lrun = 0.f; bool have = false;
    const int krow = tid >> 3, kch = tid & 7, vrow = tid >> 4, vch = tid & 15;
    const u16* ksrc = P0 + (rowb + krow) * P0W + C_KA + h * 128 + kch * 8;
    const u16* vsrc = P0 + (rowb + vrow) * P0W + C_VA + h * 128 + vch * 8;
    const int kdst = krow * 128 + ((kch ^ ((krow >> 1) & 7)) << 4);
    const int vdst = 16384 + vrow * 256 + ((vch ^ ((vrow & 3) << 2)) << 4);
    u32x4 st0, st1, st2, st3;
#define A_LOAD(t) do { const size_t to = (size_t)(t) * 64 * P0W; st0 = *(const u32x4*)(ksrc + to); st1 = *(const u32x4*)(ksrc + to + 64); st2 = *(const u32x4*)(vsrc + to); st3 = *(const u32x4*)(vsrc + to + (size_t)32 * P0W); } while (0)
#define A_WRITE(s) do { LAS unsigned char* sb = lds + (s) * 32768; *(LAS u32x4*)(sb + kdst) = st0; *(LAS u32x4*)(sb + 8192 + kdst) = st1; *(LAS u32x4*)(sb + vdst) = st2; *(LAS u32x4*)(sb + vdst + 32 * 256) = st3; } while (0)
    const int kfo = r32 * 128, ksw = (r32 >> 1) & 7;
    const int i16 = lane & 15, qrow = i16 >> 2, pp = i16 & 3, g16 = (lane >> 4) & 1;
    const int vlane = (4 * hi + qrow) * 256 + ((2 * g16 + (pp >> 1)) << 4) + 8 * (pp & 1);
    const int qglob = q0 + r32;
    A_LOAD(0); A_WRITE(0); __syncthreads();
    for (int t = 0; t < nt; ++t) {
        if (t + 1 < nt) A_LOAD(t + 1);
        if (t <= cw) {
            LAS const unsigned char* sb = lds + (t & 1) * 32768; LAS const unsigned char* kb = sb + m * 8192 + kfo; LAS const unsigned char* vb = sb + 16384 + vlane;
            const bool nearb = (64 * t + 63 - q0) > -128;
            const float c0 = (nearb ? 0.f : bt[0]) - mrun;
            f32x16 p0, p1;
#pragma unroll
            for (int r = 0; r < 16; ++r) { p0[r] = c0; p1[r] = c0; }
#pragma unroll
            for (int d0 = 0; d0 < 4; ++d0) { const int co = ((2 * d0 + hi) ^ ksw) << 4;
                const h8 ka = *(LAS const h8*)(kb + co), kc = *(LAS const h8*)(kb + 4096 + co);
                p0 = __builtin_amdgcn_mfma_f32_32x32x16_f16(ka, qf[d0], p0, 0, 0, 0); p1 = __builtin_amdgcn_mfma_f32_32x32x16_f16(kc, qf[d0], p1, 0, 0, 0); }
            if (nearb) add_bias(p0, p1, bt, 64 * t + 4 * hi - qglob + 128);
            h8 pf[4];
            softmax_step<4, false>(p0, p1, mrun, lrun, have, o, pf);
#pragma unroll
            for (int d0 = 0; d0 < 4; ++d0) { const int dx = (d0 ^ qrow) << 6;
#pragma unroll
                for (int ks = 0; ks < 4; ++ks) { const h8 vf = tr2(vb + ks * 4096 + dx, vb + ks * 4096 + 2048 + dx);
                    o[d0] = __builtin_amdgcn_mfma_f32_32x32x16_f16(vf, pf[ks], o[d0], 0, 0, 0); } }
        }
        if (t + 1 < nt) A_WRITE((t + 1) & 1);
        __syncthreads();
    }
#undef A_LOAD
#undef A_WRITE
    const float linv = 1.0f / swap_sum(lrun);
    LAS f32x4* xb = (LAS f32x4*)(lds + qsub * 16384);
    if (m == 1) {
#pragma unroll
        for (int d0 = 0; d0 < 4; ++d0)
#pragma unroll
            for (int g = 0; g < 4; ++g) { f32x4 v = {o[d0][4 * g] * linv, o[d0][4 * g + 1] * linv, o[d0][4 * g + 2] * linv, o[d0][4 * g + 3] * linv};
                xb[(8 * d0 + 2 * g + hi) * 32 + r32] = v; }
    }
    __syncthreads();
    if (m == 0) {
        const float lam = *(const float*)(F.ws + WS_LAM);
        float ss = 0.f;
#pragma unroll
        for (int d0 = 0; d0 < 4; ++d0)
#pragma unroll
            for (int g = 0; g < 4; ++g) { const f32x4 v1 = xb[(8 * d0 + 2 * g + hi) * 32 + r32];
#pragma unroll
                for (int e = 0; e < 4; ++e) { const float v = o[d0][4 * g + e] * linv - lam * v1[e]; o[d0][4 * g + e] = v; ss += v * v; } }
        ss = swap_sum(ss);
        const float rs = __builtin_amdgcn_rsqf(ss * (1.0f / 128.0f) + RMS_EPS) * 0.8f;
        const size_t row = rowb + qglob;
        const u16* gp = P0 + row * P0W + C_G0 + h * 128;
        u16* op = (u16*)(F.ws + WS_MG0) + row * DM + h * 128;
        const float* sg = AR.in[I_SUBLN];
#pragma unroll
        for (int d0 = 0; d0 < 4; ++d0)
#pragma unroll
            for (int g = 0; g < 4; ++g) { const int d = 32 * d0 + 8 * g + 4 * hi;
                const h4 gv = *(const h4*)(gp + d); const f32x4 sv = *(const f32x4*)(sg + d);
                u32x2 w; w.x = pkh(o[d0][4 * g] * rs * sv[0] * (float)gv[0], o[d0][4 * g + 1] * rs * sv[1] * (float)gv[1]);
                w.y = pkh(o[d0][4 * g + 2] * rs * sv[2] * (float)gv[2], o[d0][4 * g + 3] * rs * sv[3] * (float)gv[3]);
                *(u32x2*)(op + d) = w; }
    }
}

constexpr int B_XROW = 1028, B_MASK = 66560, B_QF = 82944, B_BT = 99328;
__device__ __forceinline__ float next_up(float x) { if (x == 0.f) return __uint_as_float(1u); const unsigned u = __float_as_uint(x); return __uint_as_float(x > 0.f ? u + 1u : u - 1u); }
template <int OP> __device__ __forceinline__ float hw_red_f(float v) {
#define HWR_STEP(ctrl) { const float o_ = __uint_as_float((unsigned)__builtin_amdgcn_update_dpp(0, (int)__float_as_uint(v), ctrl, 0xf, 0xf, false)); v = OP ? fmaxf(v, o_) : fminf(v, o_); }
    HWR_STEP(0xB1) HWR_STEP(0x4E) HWR_STEP(0x141) HWR_STEP(0x140)
#undef HWR_STEP
    const float o2 = __shfl_xor(v, 16); return OP ? fmaxf(v, o2) : fminf(v, o2);
}
__device__ __forceinline__ unsigned hw_sum_u(unsigned v) {
#define HWS_STEP(ctrl) v += (unsigned)__builtin_amdgcn_update_dpp(0, (int)v, ctrl, 0xf, 0xf, false);
    HWS_STEP(0xB1) HWS_STEP(0x4E) HWS_STEP(0x141) HWS_STEP(0x140)
#undef HWS_STEP
    return v + (unsigned)__shfl_xor((int)v, 16);
}
__device__ __forceinline__ void selB_16(Frame& F, int b, int c, int q0, int mrow0, int abl = 0) {
    LAS unsigned char* lds = F.lds;
    int tid = F.tid; asm volatile("" : "+v"(tid)); int wid = F.wave; asm volatile("" : "+s"(wid));
    const int lane = tid & 63, ql = lane & 15, g = lane >> 4, l31 = lane & 31, hq = lane >> 5;
    const size_t rowb = (size_t)b * SEQ;
    const u16* P0 = (const u16*)(F.ws + WS_PROJ0);
    const int NT16 = 4 * (c + 1), N = 64 * (c + 1);
    if (c < 4) {
        for (int e = tid; e < 16 * (c + 1); e += 512) { const int q = e / (c + 1), t = e % (c + 1); *(LAS u64*)(lds + B_MASK + ((mrow0 + q) * 64 + t) * 8) = ~0ull; }
        return;
    }
    LAS h8* qfl = (LAS h8*)(lds + B_QF);
#pragma unroll
    for (int i = 0; i < 2; ++i) { const int idx = tid + 512 * i, fg = idx >> 6, ln = idx & 63, hh = fg >> 1, ks = fg & 1;
        qfl[idx] = *(const h8*)(P0 + (rowb + q0 + (ln & 15)) * P0W + C_QI + hh * 64 + 32 * ks + 8 * (ln >> 4)); }
    float wq[8];
    { const h8 wv = *(const h8*)(P0 + (rowb + q0 + ql) * P0W + C_WI);
#pragma unroll
      for (int i = 0; i < 8; ++i) wq[i] = (float)wv[i]; }
    __syncthreads();
    float sc[128]; float mn = INFINITY, mxv = -INFINITY;
    LAS float* X = (LAS float*)lds;
    const u16* kp = P0 + (rowb + ql) * P0W + C_KI + 8 * g;
    const int nq = (N + 1023) >> 10;
#pragma unroll
    for (int qr = 0; qr < 4; ++qr) {
        if (qr < nq) {
            h8 ka[2][2], kn[2][2];
#pragma unroll
            for (int u = 0; u < 2; ++u) { const int j = 64 * qr + wid + 8 * u; const int jc = j < NT16 ? j : 0;
                ka[u][0] = *(const h8*)(kp + (size_t)(16 * jc) * P0W); ka[u][1] = *(const h8*)(kp + (size_t)(16 * jc) * P0W + 32); }
#pragma unroll
            for (int gq = 0; gq < 4; ++gq) {
                if (64 * qr + wid + 16 * gq < NT16) {
                    if (gq < 3) {
#pragma unroll
                        for (int u = 0; u < 2; ++u) { const int j = 64 * qr + wid + 8 * (2 * gq + 2 + u); const int jc = j < NT16 ? j : 0;
                            kn[u][0] = *(const h8*)(kp + (size_t)(16 * jc) * P0W); kn[u][1] = *(const h8*)(kp + (size_t)(16 * jc) * P0W + 32); } }
                    f32x4 s4[2] = {{0.f, 0.f, 0.f, 0.f}, {0.f, 0.f, 0.f, 0.f}};
                    h8 qc0 = qfl[lane], qc1 = qfl[64 + lane];
#pragma unroll
                    for (int hh = 0; hh < 8; ++hh) {
                        h8 qn0 = qc0, qn1 = qc1;
                        if (hh < 7) { qn0 = qfl[((hh + 1) * 2 + 0) * 64 + lane]; qn1 = qfl[((hh + 1) * 2 + 1) * 64 + lane]; }
                        f32x4 ac0 = {0.f, 0.f, 0.f, 0.f}, ac1 = {0.f, 0.f, 0.f, 0.f};
                        ac0 = __builtin_amdgcn_mfma_f32_16x16x32_f16(ka[0][0], qc0, ac0, 0, 0, 0);
                        ac1 = __builtin_amdgcn_mfma_f32_16x16x32_f16(ka[1][0], qc0, ac1, 0, 0, 0);
                        ac0 = __builtin_amdgcn_mfma_f32_16x16x32_f16(ka[0][1], qc1, ac0, 0, 0, 0);
                        ac1 = __builtin_amdgcn_mfma_f32_16x16x32_f16(ka[1][1], qc1, ac1, 0, 0, 0);
#pragma unroll
                        for (int r = 0; r < 4; ++r) { s4[0][r] += wq[hh] * __int_as_float(max(__float_as_int(ac0[r]), 0)); s4[1][r] += wq[hh] * __int_as_float(max(__float_as_int(ac1[r]), 0)); }
                        qc0 = qn0; qc1 = qn1;
                    }
#pragma unroll
                    for (int u = 0; u < 2; ++u) { const int m = 2 * gq + u; if (64 * qr + wid + 8 * m < NT16) *(LAS f32x4*)(X + ql * B_XROW + 16 * (wid + 8 * m) + 4 * g) = s4[u]; }
#pragma unroll
                    for (int u = 0; u < 2; ++u) { ka[u][0] = kn[u][0]; ka[u][1] = kn[u][1]; }
                }
            }
            {
            __syncthreads();
            { LAS const float* xr = X + (2 * wid + hq) * B_XROW + l31;
#pragma unroll
              for (int i = 0; i < 32; ++i) { if (1024 * qr + 32 * i < N) { const float v = xr[32 * i]; sc[32 * qr + i] = v; mn = fminf(mn, v); mxv = fmaxf(mxv, v); } else sc[32 * qr + i] = -INFINITY; } }
            __syncthreads(); }
        } else {
#pragma unroll
            for (int i = 0; i < 32; ++i) sc[32 * qr + i] = -INFINITY;
        }
    }
    float lo = hw_red_f<0>(mn), hi = next_up(hw_red_f<1>(mxv));
    unsigned clo = (unsigned)N, chi = 0u;
    if (abl != 6) {
        const float smn = lo, smx = hw_red_f<1>(mxv);
        LAS unsigned* H = (LAS unsigned*)lds + (2 * wid + hq) * 1024;
        LAS unsigned* CS = (LAS unsigned*)(lds + B_QF) + (2 * wid + hq) * 32;
#pragma unroll
        for (int i = 0; i < 32; ++i) H[l31 + 32 * i] = 0u;
        const float scale = 1023.5f / fmaxf(smx - smn, 1e-30f), nsm = -smn * scale;
#pragma unroll
        for (int e = 0; e < 128; ++e) { if (32 * e < N) { int bin = (int)__builtin_fmaf(sc[e], scale, nsm); bin = bin > 1023 ? 1023 : (bin < 0 ? 0 : bin);
            __hip_atomic_fetch_add(H + bin, 1u, __ATOMIC_RELAXED, __HIP_MEMORY_SCOPE_WORKGROUP); } }
        asm volatile("s_waitcnt lgkmcnt(0)" ::: "memory");
        unsigned hw[32]; unsigned cl = 0u;
#pragma unroll
        for (int i = 0; i < 8; ++i) { const u32x4 v = *(LAS const u32x4*)(H + 32 * l31 + 4 * i); hw[4 * i] = v.x; hw[4 * i + 1] = v.y; hw[4 * i + 2] = v.z; hw[4 * i + 3] = v.w; cl += (v.x + v.y) + (v.z + v.w); }
        CS[l31] = cl;
        asm volatile("s_waitcnt lgkmcnt(0)" ::: "memory");
        unsigned ssuf = 0u;
#pragma unroll
        for (int i = 0; i < 8; ++i) { const u32x4 v = *(LAS const u32x4*)(CS + 4 * i);
            ssuf += (4 * i >= l31 ? v.x : 0u) + (4 * i + 1 >= l31 ? v.y : 0u) + (4 * i + 2 >= l31 ? v.z : 0u) + (4 * i + 3 >= l31 ? v.w : 0u); }
        const bool flag = ssuf >= (unsigned)TOPK && (ssuf - cl) < (unsigned)TOPK;
        unsigned run = ssuf - cl, bstar = 0u, above = 0u, cntb = 0u; bool found = false;
#pragma unroll
        for (int w = 31; w >= 0; --w) { run += hw[w]; if (!found && run >= (unsigned)TOPK) { found = true; bstar = 32u * l31 + (unsigned)w; above = run - hw[w]; cntb = hw[w]; } }
        const unsigned long long fb = __ballot(flag);
        const int src = hq ? 32 + __builtin_ctz((unsigned)(fb >> 32) | 0x80000000u) : __builtin_ctz((unsigned)fb | 0x80000000u);
        bstar = (unsigned)__shfl((int)bstar, src); above = (unsigned)__shfl((int)above, src); cntb = (unsigned)__shfl((int)cntb, src);
        if (smx > smn) {
            const float inv = (smx - smn) * (1.0f / 1023.5f);
            const float l2 = smn + ((float)bstar - 0.01f) * inv, h2 = smn + ((float)bstar + 1.01f) * inv;
            if (l2 > lo) { lo = l2; clo = above + cntb; }
            if (h2 < hi) { hi = h2; chi = above; }
        }
    }
#define SEL_LTBITS(W, P) do { _Pragma("unroll") for (int w_ = 0; w_ < 4; ++w_) { unsigned a_ = 0u; _Pragma("unroll") for (int k_ = 0; k_ < 32; ++k_) \
        a_ = __builtin_amdgcn_alignbit(a_, __float_as_uint(sc[32 * w_ + k_] - (P)), 31); W[w_] = a_; } } while (0)
    bool done = false, tie = false; float Tv = 0.f;
#define SEL_STEP(it_) do { \
        float mid = lo + (hi - lo) * 0.5f; \
        if ((it_) < 2 && clo > chi + 16u) { const float xi = lo + (hi - lo) * ((float)clo - 255.5f) / (float)(clo - chi); if (xi > lo && xi < hi) mid = xi; } \
        if (!done && !(mid > lo && mid < hi)) { done = true; tie = true; Tv = lo; } \
        const float pv = done ? Tv : mid; \
        unsigned ltw[4]; SEL_LTBITS(ltw, pv); \
        const unsigned tot = hw_sum_u(128u - (unsigned)(__builtin_popcount(ltw[0]) + __builtin_popcount(ltw[1]) + __builtin_popcount(ltw[2]) + __builtin_popcount(ltw[3]))); \
        if (!done) { if (tot == (unsigned)TOPK) { done = true; Tv = mid; } else if (tot > (unsigned)TOPK) { lo = mid; clo = tot; } else { hi = mid; chi = tot; } } } while (0)
    const int it_cap = (abl == 6 ? 1 : abl == 10 ? 6 : abl == 11 ? 12 : 200);
    int it = 0;
    for (; it < 8 && it < it_cap; ++it) { SEL_STEP(it); if (__all(done)) break; }
    if (!__all(done) && it_cap > 8) {
        float p0 = INFINITY, p1 = -INFINITY;
#pragma unroll
        for (int e = 0; e < 128; ++e) { const float sv = sc[e]; p0 = fminf(p0, sv >= lo ? sv : INFINITY); p1 = fmaxf(p1, sv < hi ? sv : -INFINITY); }
        p0 = hw_red_f<0>(p0); p1 = hw_red_f<1>(p1);
        if (!done && p0 == p1) { done = true; tie = true; Tv = p0; }
        for (; it < it_cap; ++it) { if (__all(done)) break; SEL_STEP(8); }
    }
#undef SEL_STEP
    if (abl == 6 || abl == 10 || abl == 11) tie = false;
    unsigned selw[4];
    { unsigned ltw[4]; SEL_LTBITS(ltw, Tv);
#pragma unroll
      for (int w = 0; w < 4; ++w) selw[w] = __builtin_bitreverse32(~ltw[w]); }
    if (__any(tie)) {
        unsigned eqw[4];
        { unsigned lew[4]; const float tn = next_up(Tv); SEL_LTBITS(lew, tn);
#pragma unroll
          for (int w = 0; w < 4; ++w) eqw[w] = __builtin_bitreverse32(lew[w]) & selw[w]; }
        const unsigned rneed = (unsigned)TOPK - chi;
        int ilo = -1, ihi = N - 1, icut = N; bool tdone = !tie;
        for (int it = 0; it < 40; ++it) {
            const int imid = (ilo + ihi) >> 1;
            if (!tdone && (ihi - ilo) <= 1) { tdone = true; icut = ihi; }
            const int iv = (tdone ? icut : imid) - l31;
            const int nle = iv < 0 ? 0 : min(128, (iv >> 5) + 1);
            unsigned cnt = 0u;
#pragma unroll
            for (int w = 0; w < 4; ++w) { const int nw = min(max(nle - 32 * w, 0), 32); const unsigned mk = nw >= 32 ? 0xffffffffu : ((1u << nw) - 1u); cnt += (unsigned)__builtin_popcount(eqw[w] & mk); }
            const unsigned tot = hw_sum_u(cnt);
            if (!tdone) { if (tot == rneed) { tdone = true; icut = imid; } else if (tot < rneed) ilo = imid; else ihi = imid; }
            if (__all(tdone)) break;
        }
        if (tie) {
            const int iv = icut - l31; const int nle = iv < 0 ? 0 : min(128, (iv >> 5) + 1);
#pragma unroll
            for (int w = 0; w < 4; ++w) { const int nw = min(max(nle - 32 * w, 0), 32); const unsigned mk = nw >= 32 ? 0xffffffffu : ((1u << nw) - 1u); selw[w] = (selw[w] & ~eqw[w]) | (eqw[w] & mk); }
        }
    }
#undef SEL_LTBITS
    LAS unsigned* mrow = (LAS unsigned*)(lds + B_MASK) + (mrow0 + 2 * wid + hq) * 128;
#pragma unroll
    for (int w = 0; w < 4; ++w) {
        unsigned x = selw[w];
#define TR_STEP(S, MK) { const unsigned y_ = (unsigned)__shfl_xor((int)x, S); x = (l31 & S) ? ((x & ~(MK)) | ((y_ >> S) & (MK))) : ((x & (MK)) | ((y_ << S) & ~(MK))); }
        TR_STEP(16, 0x0000ffffu) TR_STEP(8, 0x00ff00ffu) TR_STEP(4, 0x0f0f0f0fu) TR_STEP(2, 0x33333333u) TR_STEP(1, 0x55555555u)
#undef TR_STEP
        if (32 * (32 * w + l31) < N) mrow[32 * w + l31] = x;
    }
}
__device__ __forceinline__ void attnB_unit(Frame& F, int b, int qb32, int mode = 0) {
    LAS unsigned char* lds = F.lds;
    int tid = F.tid; asm volatile("" : "+v"(tid)); int wid = F.wave; asm volatile("" : "+s"(wid));
    const int lane = tid & 63, r32 = lane & 31, hi = lane >> 5;
    const int q0 = 32 * qb32, c = q0 >> 6, nt = c + 1;
    const size_t rowb = (size_t)b * SEQ;
    const u16* P0 = (const u16*)(F.ws + WS_PROJ0);
    if (mode != 3) {
#pragma unroll 1
        for (int s2 = 0; s2 < 2; ++s2) { selB_16(F, b, c, q0 + 16 * s2, 16 * s2, mode); __syncthreads(); }
    }
    if (mode >= 4) return;
    LAS float* bt = (LAS float*)(lds + B_BT) + wid * 192;
    for (int e = tid; e < 8 * 192; e += 512) ((LAS float*)(lds + B_BT))[e] = ((const float*)(F.ws + WS_BTG))[4 * 192 + e];
    h8 qf[4];
    { const u16* qp = P0 + (rowb + q0 + r32) * P0W + C_QB + wid * 64 + hi * 8;
#pragma unroll
      for (int d0 = 0; d0 < 4; ++d0) qf[d0] = *(const h8*)(qp + d0 * 16); }
    f32x16 o[2];
#pragma unroll
    for (int d = 0; d < 2; ++d)
#pragma unroll
        for (int r = 0; r < 16; ++r) o[d][r] = 0.f;
    float mrun = 0.f, lrun = 0.f; bool have = false;
    const int krow = tid >> 3, kch = tid & 7;
    const u16* ksrc = P0 + (rowb + krow) * P0W + C_KB + kch * 8;
    const int kdst = krow * 128 + ((kch ^ ((krow >> 1) & 7)) << 4);
    const int vdst = 8192 + krow * 128 + ((kch ^ (((krow >> 1) & 1) << 2)) << 4);
    u32x4 st0, st1;
#define B_LOAD(t) do { const size_t to = (size_t)(t) * 64 * P0W; st0 = *(const u32x4*)(ksrc + to); st1 = *(const u32x4*)(ksrc + to + 64); } while (0)
#define B_WRITE(s) do { LAS unsigned char* sb = lds + (s) * 16384; *(LAS u32x4*)(sb + kdst) = st0; *(LAS u32x4*)(sb + vdst) = st1; } while (0)
    const int kfo = r32 * 128, ksw = (r32 >> 1) & 7;
    const int i16 = lane & 15, qrow = i16 >> 2, pp = i16 & 3, g16 = (lane >> 4) & 1;
    const int vlane = (4 * hi + qrow) * 128 + ((2 * g16 + (pp >> 1)) << 4) + 8 * (pp & 1);
    const int qglob = q0 + r32;
    B_LOAD(0); B_WRITE(0); __syncthreads();
    for (int t = 0; t < nt; ++t) {
        if (t + 1 < nt) B_LOAD(t + 1);
        {
            LAS const unsigned char* sb = lds + (t & 1) * 16384; LAS const unsigned char* kb = sb + kfo; LAS const unsigned char* vb = sb + 8192 + vlane;
            const bool nearb = (64 * t + 63 - q0) > -128;
            const float c0 = (nearb ? 0.f : bt[0]) - mrun;
            f32x16 p0, p1;
#pragma unroll
            for (int r = 0; r < 16; ++r) { p0[r] = c0; p1[r] = c0; }
#pragma unroll
            for (int d0 = 0; d0 < 4; ++d0) { const int co = ((2 * d0 + hi) ^ ksw) << 4;
                const h8 ka = *(LAS const h8*)(kb + co), kc = *(LAS const h8*)(kb + 4096 + co);
                p0 = __builtin_amdgcn_mfma_f32_32x32x16_f16(ka, qf[d0], p0, 0, 0, 0); p1 = __builtin_amdgcn_mfma_f32_32x32x16_f16(kc, qf[d0], p1, 0, 0, 0); }
            if (nearb) add_bias(p0, p1, bt, 64 * t + 4 * hi - qglob + 128);
            const u64 mw = *(LAS const u64*)(lds + B_MASK + (r32 * 64 + t) * 8);
            const unsigned mlo = (unsigned)mw >> (4 * hi), mhi = (unsigned)(mw >> 32) >> (4 * hi);
#pragma unroll
            for (int r = 0; r < 16; ++r) { const int cb = (r & 3) + 8 * (r >> 2);
                if (!((mlo >> cb) & 1u)) p0[r] = -1e30f; if (!((mhi >> cb) & 1u)) p1[r] = -1e30f; }
            h8 pf[4];
            softmax_step<2, true>(p0, p1, mrun, lrun, have, o, pf);
#pragma unroll
            for (int d0 = 0; d0 < 2; ++d0) { const int dx = (d0 ^ (qrow >> 1)) << 6;
#pragma unroll
                for (int ks = 0; ks < 4; ++ks) { const h8 vf = tr2(vb + ks * 2048 + dx, vb + ks * 2048 + 1024 + dx);
                    o[d0] = __builtin_amdgcn_mfma_f32_32x32x16_f16(vf, pf[ks], o[d0], 0, 0, 0); } }
        }
        if (t + 1 < nt) B_WRITE((t + 1) & 1);
        __syncthreads();
    }
#undef B_LOAD
#undef B_WRITE
    const float linv = 1.0f / swap_sum(lrun);
    const size_t row = rowb + qglob;
    const u16* gp = P0 + row * P0W + C_G0 + 512 + wid * 64;
    u16* op = (u16*)(F.ws + WS_MG0) + row * DM + 512 + wid * 64;
#pragma unroll
    for (int d0 = 0; d0 < 2; ++d0)
#pragma unroll
        for (int g = 0; g < 4; ++g) { const int d = 32 * d0 + 8 * g + 4 * hi;
            const h4 gv = *(const h4*)(gp + d);
            u32x2 w; w.x = pkh(o[d0][4 * g] * linv * (float)gv[0], o[d0][4 * g + 1] * linv * (float)gv[1]);
            w.y = pkh(o[d0][4 * g + 2] * linv * (float)gv[2], o[d0][4 * g + 3] * linv * (float)gv[3]);
            *(u32x2*)(op + d) = w; }
}

__device__ __forceinline__ void pv_tile64_asm(f32x16 (&o)[2], unsigned va0, unsigned va1, const h8 (&pf)[4]) {
#pragma unroll
    for (int d0 = 0; d0 < 2; ++d0) { const unsigned va = d0 ? va1 : va0; s16x4 lo[4], hi[4];
        asm volatile("ds_read_b64_tr_b16 %0, %1 offset:0" : "=&v"(lo[0]) : "v"(va) : "memory");    asm volatile("ds_read_b64_tr_b16 %0, %1 offset:1024" : "=&v"(hi[0]) : "v"(va) : "memory");
        asm volatile("ds_read_b64_tr_b16 %0, %1 offset:2048" : "=&v"(lo[1]) : "v"(va) : "memory"); asm volatile("ds_read_b64_tr_b16 %0, %1 offset:3072" : "=&v"(hi[1]) : "v"(va) : "memory");
        asm volatile("ds_read_b64_tr_b16 %0, %1 offset:4096" : "=&v"(lo[2]) : "v"(va) : "memory"); asm volatile("ds_read_b64_tr_b16 %0, %1 offset:5120" : "=&v"(hi[2]) : "v"(va) : "memory");
        asm volatile("ds_read_b64_tr_b16 %0, %1 offset:6144" : "=&v"(lo[3]) : "v"(va) : "memory"); asm volatile("ds_read_b64_tr_b16 %0, %1 offset:7168" : "=&v"(hi[3]) : "v"(va) : "memory");
        asm volatile("s_waitcnt lgkmcnt(0)" ::: "memory"); __builtin_amdgcn_sched_barrier(0);
#pragma unroll
        for (int ks = 0; ks < 4; ++ks) { const s16x8 v = __builtin_shufflevector(lo[ks], hi[ks], 0, 1, 2, 3, 4, 5, 6, 7);
            o[d0] = __builtin_amdgcn_mfma_f32_32x32x16_f16(__builtin_bit_cast(h8, v), pf[ks], o[d0], 0, 0, 0); } }
}
__device__ __forceinline__ void qk64C(f32x16& p0, f32x16& p1, LAS const unsigned char* sb, const h8 (&qf)[6], int kfo, int ksw, int rfo, int rsw, int hi, const f32x16& negm) {
    LAS const unsigned char* kb = sb + kfo; LAS const unsigned char* rb = sb + rfo;
#pragma unroll
    for (int d0 = 0; d0 < 4; ++d0) { const int co = ((2 * d0 + hi) ^ ksw) << 4;
        const h8 ka = *(LAS const h8*)(kb + co), kc = *(LAS const h8*)(kb + 4096 + co);
        if (d0 == 0) { p0 = __builtin_amdgcn_mfma_f32_32x32x16_f16(ka, qf[0], negm, 0, 0, 0); p1 = __builtin_amdgcn_mfma_f32_32x32x16_f16(kc, qf[0], negm, 0, 0, 0); }
        else { p0 = __builtin_amdgcn_mfma_f32_32x32x16_f16(ka, qf[d0], p0, 0, 0, 0); p1 = __builtin_amdgcn_mfma_f32_32x32x16_f16(kc, qf[d0], p1, 0, 0, 0); } }
#pragma unroll
    for (int d0 = 0; d0 < 2; ++d0) { const int co = ((2 * d0 + hi) ^ rsw) << 4;
        const h8 ka = *(LAS const h8*)(rb + co), kc = *(LAS const h8*)(rb + 2048 + co);
        p0 = __builtin_amdgcn_mfma_f32_32x32x16_f16(ka, qf[4 + d0], p0, 0, 0, 0); p1 = __builtin_amdgcn_mfma_f32_32x32x16_f16(kc, qf[4 + d0], p1, 0, 0, 0); }
}
__device__ __forceinline__ void pack4(h8 (&pf)[4], const f32x16& p0, const f32x16& p1) {
#pragma unroll
    for (int ks = 0; ks < 4; ++ks) { const f32x16& pp = ks < 2 ? p0 : p1; const int k2 = ks & 1; u32x4 w;
        w.x = pkh(pp[8 * k2 + 0], pp[8 * k2 + 1]); w.y = pkh(pp[8 * k2 + 2], pp[8 * k2 + 3]); w.z = pkh(pp[8 * k2 + 4], pp[8 * k2 + 5]); w.w = pkh(pp[8 * k2 + 6], pp[8 * k2 + 7]);
        pf[ks] = __builtin_bit_cast(h8, w); }
}
__device__ __forceinline__ void attnC_unit(Frame& F, int b, int h, int qb) {
    LAS unsigned char* lds = F.lds;
    int tid = F.tid; asm volatile("" : "+v"(tid)); int wid = F.wave; asm volatile("" : "+s"(wid));
    const int lane = tid & 63, r32 = lane & 31, hi = lane >> 5;
    const int q0 = 256 * qb + 32 * wid, cw = q0 >> 6, nt = 4 * qb + 4;
    const size_t rowb = (size_t)b * SEQ;
    const u16* Q1 = (const u16*)(F.ws + WS_Q1); const u16* KV = (const u16*)(F.ws + WS_KV1); const u16* KR = (const u16*)(F.ws + WS_KROPE);
    h8 qf[6];
    { const u16* qp = Q1 + (rowb + q0 + r32) * 1536 + h * 96 + hi * 8;
#pragma unroll
      for (int d0 = 0; d0 < 6; ++d0) qf[d0] = *(const h8*)(qp + d0 * 16); }
    f32x16 o[2];
#pragma unroll
    for (int d = 0; d < 2; ++d)
#pragma unroll
        for (int r = 0; r < 16; ++r) o[d][r] = 0.f;
    float mrun = 0.f, lrun = 0.f; bool have = false;
    f32x16 negm;
#pragma unroll
    for (int r = 0; r < 16; ++r) negm[r] = 0.f;
    const int krow = 8 * wid + (lane >> 3), kcp = lane & 7;
    const u16* ksrc = KV + (rowb + krow) * 2048 + h * 128 + ((kcp ^ ((krow >> 1) & 7)) << 3);
    const u16* vsrc = KV + (rowb + krow) * 2048 + h * 128 + 64 + ((kcp ^ (((krow >> 1) & 1) << 2)) << 3);
    const int rrow = 16 * (wid & 3) + (lane >> 2), rcp = lane & 3;
    const u16* rsrc = KR + (rowb + rrow) * 32 + ((rcp ^ ((rrow >> 2) & 3)) << 3);
    const int kofs = wid * 1024, rofs = 8192 + (wid & 3) * 1024, vofs = 12288 + wid * 1024;
#define C_DMA(t, slot) do { LAS unsigned char* sb_ = lds + (slot) * 20480; \
        __builtin_amdgcn_global_load_lds((const unsigned*)(ksrc + (size_t)(t) * 64 * 2048), (LAS unsigned*)(sb_ + kofs), 16, 0, 0); \
        __builtin_amdgcn_global_load_lds((const unsigned*)(rsrc + (size_t)(t) * 64 * 32), (LAS unsigned*)(sb_ + rofs), 16, 0, 0); \
        __builtin_amdgcn_global_load_lds((const unsigned*)(vsrc + (size_t)(t) * 64 * 2048), (LAS unsigned*)(sb_ + vofs), 16, 0, 0); } while (0)
    const int kfo = r32 * 128, ksw = (r32 >> 1) & 7;
    const int rfo = 8192 + r32 * 64, rsw = (r32 >> 2) & 3;
    const int i16 = lane & 15, qrow = i16 >> 2, pp = i16 & 3, g16 = (lane >> 4) & 1;
    const int vlane = (4 * hi + qrow) * 128 + ((2 * g16 + (pp >> 1)) << 4) + 8 * (pp & 1);
    const unsigned dx0 = (unsigned)((0 ^ (qrow >> 1)) << 6), dx1 = (unsigned)((1 ^ (qrow >> 1)) << 6);
    asm volatile("s_waitcnt vmcnt(0)" ::: "memory");
    C_DMA(0, 0); C_DMA(1, 1);
    const int np = nt >> 1;
    for (int T = 0; T < np; ++T) {
        asm volatile("s_waitcnt vmcnt(0)" ::: "memory");
        __builtin_amdgcn_s_barrier(); asm volatile("" ::: "memory");
        const int sA = (T & 1) * 2;
        if (T + 1 < np) { C_DMA(2 * T + 2, sA ^ 2); C_DMA(2 * T + 3, (sA ^ 2) + 1); }
        if (2 * T <= cw) {
            LAS const unsigned char* sb0 = lds + sA * 20480; LAS const unsigned char* sb1 = sb0 + 20480;
            f32x16 p0, p1, p2, p3;
            qk64C(p0, p1, sb0, qf, kfo, ksw, rfo, rsw, hi, negm);
            qk64C(p2, p3, sb1, qf, kfo, ksw, rfo, rsw, hi, negm);
            if (2 * T + 1 > cw) {
#pragma unroll
                for (int r = 0; r < 16; ++r) { p2[r] = -1e30f; p3[r] = -1e30f; } }
            float ma[4];
#pragma unroll
            for (int i = 0; i < 4; ++i) { float t = max3f(p0[i], p0[i + 4], p0[i + 8]); t = max3f(t, p0[i + 12], p1[i]); t = max3f(t, p1[i + 4], p1[i + 8]); t = max3f(t, p1[i + 12], p2[i]);
                t = max3f(t, p2[i + 4], p2[i + 8]); t = max3f(t, p2[i + 12], p3[i]); t = max3f(t, p3[i + 4], p3[i + 8]); ma[i] = max3f(t, p3[i + 12], t); }
            const float mx = swap_max(max3f(max3f(ma[0], ma[1], ma[2]), ma[3], ma[3]));
            if (__any(!have || mx > SM_THR)) {
                const float dl = have ? fmaxf(mx, 0.f) : mx; have = true; mrun += dl;
                const float alpha = __builtin_amdgcn_exp2f(-dl); lrun *= alpha;
#pragma unroll
                for (int r = 0; r < 16; ++r) { p0[r] -= dl; p1[r] -= dl; p2[r] -= dl; p3[r] -= dl; negm[r] -= dl; o[0][r] *= alpha; o[1][r] *= alpha; }
            }
            float s0 = 0.f, s1 = 0.f, s2 = 0.f, s3 = 0.f;
#pragma unroll
            for (int r = 0; r < 16; ++r) { p0[r] = __builtin_amdgcn_exp2f(p0[r]); p1[r] = __builtin_amdgcn_exp2f(p1[r]); p2[r] = __builtin_amdgcn_exp2f(p2[r]); p3[r] = __builtin_amdgcn_exp2f(p3[r]);
                s0 += p0[r]; s1 += p1[r]; s2 += p2[r]; s3 += p3[r]; }
            lrun += (s0 + s1) + (s2 + s3);
            h8 pfa[4], pfb[4]; pack4(pfa, p0, p1); pack4(pfb, p2, p3);
            const unsigned vb0 = (unsigned)(size_t)(sb0 + 12288 + vlane), vb1 = (unsigned)(size_t)(sb1 + 12288 + vlane);
            pv_tile64_asm(o, vb0 + dx0, vb0 + dx1, pfa);
            pv_tile64_asm(o, vb1 + dx0, vb1 + dx1, pfb);
        }
    }
#undef C_DMA
    const float linv = 1.0f / swap_sum(lrun);
    const size_t row = rowb + q0 + r32;
    const u16* gp = (const u16*)(F.ws + WS_G1) + row * DM + h * 64;
    u16* op = (u16*)(F.ws + WS_MG1) + row * DM + h * 64;
#pragma unroll
    for (int d0 = 0; d0 < 2; ++d0)
#pragma unroll
        for (int g = 0; g < 4; ++g) { const int d = 32 * d0 + 8 * g + 4 * hi;
            const h4 gv = *(const h4*)(gp + d);
            u32x2 w; w.x = pkh(o[d0][4 * g] * linv * (float)gv[0], o[d0][4 * g + 1] * linv * (float)gv[1]);
            w.y = pkh(o[d0][4 * g + 2] * linv * (float)gv[2], o[d0][4 * g + 3] * linv * (float)gv[3]);
            *(u32x2*)(op + d) = w; }
}

__device__ __forceinline__ void p8_final(Frame& F, const Args& AR) {
    const int gw = blockIdx.x * NWAVES + F.wave, NGW = F.G * NWAVES;
    const float* gn = AR.in[I_FNORM]; f32x4 gv[4];
#pragma unroll
    for (int j = 0; j < 4; ++j) gv[j] = *(const f32x4*)(gn + 4 * F.lane + 256 * j);
    const u16* X2 = (const u16*)(F.ws + WS_X2H);
    for (int mrow = gw; mrow < T; mrow += NGW) {
        const h4* xr = (const h4*)(X2 + (size_t)mrow * DM) + F.lane;
        f32x4 v[4]; float s = 0.f;
#pragma unroll
        for (int j = 0; j < 4; ++j) { const h4 hv = xr[64 * j]; v[j] = (f32x4){(float)hv[0], (float)hv[1], (float)hv[2], (float)hv[3]}; s += (v[j].x * v[j].x + v[j].y * v[j].y) + (v[j].z * v[j].z + v[j].w * v[j].w); }
        const float rstd = __builtin_amdgcn_rsqf(wave_sum(s) * (1.f / DM) + RMS_EPS);
        f32x4* orow = (f32x4*)(F.out + (size_t)mrow * DM) + F.lane;
#pragma unroll
        for (int j = 0; j < 4; ++j) orow[64 * j] = v[j] * rstd * gv[j];
    }
}

#ifndef NAIVE_ATTN
#define NAIVE_ATTN 0
#endif
struct NaiveSh { float sh[4096]; float red[256]; unsigned char sel[4096]; };
__device__ __forceinline__ float blk_max(NaiveSh& S, float v, int tid) { S.red[tid] = v; __syncthreads(); for (int o2 = 128; o2 > 0; o2 >>= 1) { if (tid < o2) S.red[tid] = fmaxf(S.red[tid], S.red[tid + o2]); __syncthreads(); } const float r = S.red[0]; __syncthreads(); return r; }
__device__ __forceinline__ float blk_sum(NaiveSh& S, float v, int tid) { S.red[tid] = v; __syncthreads(); for (int o2 = 128; o2 > 0; o2 >>= 1) { if (tid < o2) S.red[tid] += S.red[tid + o2]; __syncthreads(); } const float r = S.red[0]; __syncthreads(); return r; }
__device__ __forceinline__ float blk_softmax(NaiveSh& S, int nk, int tid) {
    float mx = -1e30f; for (int k = tid; k < nk; k += 256) mx = fmaxf(mx, S.sh[k]); mx = blk_max(S, mx, tid);
    float ls = 0.f; for (int k = tid; k < nk; k += 256) { const float p = S.sh[k] > -1e29f ? exp2f(S.sh[k] - mx) : 0.f; S.sh[k] = p; ls += p; }
    return blk_sum(S, ls, tid);
}
__device__ __forceinline__ float naiveA(NaiveSh& S, const Args& args, int b, int q, int hd, int tid) {
    unsigned char* ws = args.ws; const u16* P0 = (const u16*)(ws + WS_PROJ0); const float* BT = (const float*)(ws + WS_BTG);
    const size_t row = (size_t)b * SEQ + q; const int nk = 64 * (q / 64 + 1); float outv[2] = {0.f, 0.f};
    for (int m = 0; m < 2; ++m) {
        for (int k = tid; k < nk; k += 256) { float sacc = 0.f; const u16* qp = P0 + row * P0W + C_QA + hd * 128 + m * 64; const u16* kp = P0 + ((size_t)b * SEQ + k) * P0W + C_KA + hd * 128 + m * 64;
            for (int d = 0; d < 64; ++d) sacc += h2f(qp[d]) * h2f(kp[d]);
            int rel = k - q; rel = rel < -128 ? -128 : rel; S.sh[k] = sacc + BT[hd * 192 + rel + 128]; }
        __syncthreads();
        const float ls = blk_softmax(S, nk, tid);
        if (tid < 128) { float a = 0.f; for (int k = 0; k < nk; ++k) a += S.sh[k] * h2f(P0[((size_t)b * SEQ + k) * P0W + C_VA + hd * 128 + tid]); outv[m] = a / ls; }
        __syncthreads();
    }
    const float lam = *(const float*)(ws + WS_LAM); const float v = tid < 128 ? outv[0] - lam * outv[1] : 0.f;
    const float ss = blk_sum(S, v * v, tid);
    const float rs = rsqrtf(ss / 128.f + RMS_EPS) * 0.8f;
    return tid < 128 ? v * rs * args.in[I_SUBLN][tid] * h2f(P0[row * P0W + C_G0 + hd * 128 + tid]) : 0.f;
}
__device__ __forceinline__ void naiveB_select(NaiveSh& S, const Args& args, int b, int q, int tid) {
    const u16* P0 = (const u16*)(args.ws + WS_PROJ0); const size_t row = (size_t)b * SEQ + q; const int nk = 64 * (q / 64 + 1);
    for (int k = tid; k < nk; k += 256) { float sc = 0.f;
        for (int hh = 0; hh < 8; ++hh) { float l = 0.f; const u16* qp = P0 + row * P0W + C_QI + hh * 64; const u16* kp = P0 + ((size_t)b * SEQ + k) * P0W + C_KI;
            for (int d = 0; d < 64; ++d) l += h2f(qp[d]) * h2f(kp[d]);
            sc += h2f(P0[row * P0W + C_WI + hh]) * fmaxf(l, 0.f); }
        S.sh[k] = sc; }
    __syncthreads();
    for (int k = tid; k < nk; k += 256) { const float sk = S.sh[k]; int rank = 0; for (int k2 = 0; k2 < nk; ++k2) { const float s2 = S.sh[k2]; rank += (s2 > sk || (s2 == sk && k2 < k)) ? 1 : 0; } S.sel[k] = rank < TOPK ? 1 : 0; }
    __syncthreads();
}
__device__ __forceinline__ float naiveB_head(NaiveSh& S, const Args& args, int b, int q, int hd, int tid) {
    const u16* P0 = (const u16*)(args.ws + WS_PROJ0); const float* BT = (const float*)(args.ws + WS_BTG); const size_t row = (size_t)b * SEQ + q; const int nk = 64 * (q / 64 + 1);
    for (int k = tid; k < nk; k += 256) { float sacc = -1e30f;
        if (S.sel[k]) { sacc = 0.f; const u16* qp = P0 + row * P0W + C_QB + hd * 64; const u16* kp = P0 + ((size_t)b * SEQ + k) * P0W + C_KB;
            for (int d = 0; d < 64; ++d) sacc += h2f(qp[d]) * h2f(kp[d]);
            int rel = k - q; rel = rel < -128 ? -128 : rel; sacc += BT[(4 + hd) * 192 + rel + 128]; }
        S.sh[k] = sacc; }
    __syncthreads();
    const float ls = blk_softmax(S, nk, tid);
    float r = 0.f;
    if (tid < 64) { float a = 0.f; for (int k = 0; k < nk; ++k) a += S.sh[k] * h2f(P0[((size_t)b * SEQ + k) * P0W + C_VB + tid]); r = a / ls * h2f(P0[row * P0W + C_G0 + 512 + hd * 64 + tid]); }
    __syncthreads();
    return r;
}
__device__ __forceinline__ float naiveC(NaiveSh& S, const Args& args, int b, int q, int hd, int tid) {
    unsigned char* ws = args.ws; const size_t row = (size_t)b * SEQ + q; const int nk = 64 * (q / 64 + 1);
    const u16* Q1 = (const u16*)(ws + WS_Q1); const u16* KV = (const u16*)(ws + WS_KV1); const u16* KR = (const u16*)(ws + WS_KROPE);
    for (int k = tid; k < nk; k += 256) { float sacc = 0.f; const u16* qp = Q1 + row * 1536 + hd * 96; const size_t kr = (size_t)b * SEQ + k;
        for (int d = 0; d < 64; ++d) sacc += h2f(qp[d]) * h2f(KV[kr * 2048 + hd * 128 + d]);
        for (int d = 0; d < 32; ++d) sacc += h2f(qp[64 + d]) * h2f(KR[kr * 32 + d]);
        S.sh[k] = sacc; }
    __syncthreads();
    const float ls = blk_softmax(S, nk, tid);
    float r = 0.f;
    if (tid < 64) { float a = 0.f; for (int k = 0; k < nk; ++k) a += S.sh[k] * h2f(KV[((size_t)b * SEQ + k) * 2048 + hd * 128 + 64 + tid]); r = a / ls * h2f(((const u16*)(ws + WS_G1))[row * DM + hd * 64 + tid]); }
    __syncthreads();
    return r;
}
#if NAIVE_ATTN
__global__ void __launch_bounds__(256) naive_attn(Args args, int which) {
    __shared__ NaiveSh S; const int tid = threadIdx.x; unsigned char* ws = args.ws;
    if (which == 0) {
        for (int it = blockIdx.x; it < T * 5; it += gridDim.x) {
            const int row = it / 5, sub = it % 5, b = row / SEQ, q = row % SEQ;
            if (sub < 4) { const float v = naiveA(S, args, b, q, sub, tid); if (tid < 128) ((u16*)(ws + WS_MG0))[(size_t)row * DM + sub * 128 + tid] = (u16)(pkh(v, 0.f) & 0xffffu); }
            else { naiveB_select(S, args, b, q, tid);
                for (int hd = 0; hd < 8; ++hd) { const float v = naiveB_head(S, args, b, q, hd, tid); if (tid < 64) ((u16*)(ws + WS_MG0))[(size_t)row * DM + 512 + hd * 64 + tid] = (u16)(pkh(v, 0.f) & 0xffffu); } }
        }
    } else {
        for (int it = blockIdx.x; it < T * 16; it += gridDim.x) {
            const int row = it >> 4, hd = it & 15, b = row / SEQ, q = row % SEQ;
            const float v = naiveC(S, args, b, q, hd, tid); if (tid < 64) ((u16*)(ws + WS_MG1))[(size_t)row * DM + hd * 64 + tid] = (u16)(pkh(v, 0.f) & 0xffffu);
        }
    }
}
#endif

#if DEBUG_CHECK
constexpr size_t WS_DBG = 3 * MiB;
#ifndef DBG_BITS_MODE
#define DBG_BITS_MODE 1
#define DBG_BITS_IDS 14, 4, 5, 21, 22, 23
#endif
#ifndef DBG_SKIP_MASK
#define DBG_SKIP_MASK 0x10
#endif
#ifndef DBG_REPORT_ID
#define DBG_REPORT_ID 0
#endif
__device__ __forceinline__ unsigned dhash(unsigned x) { x ^= x >> 16; x *= 0x7feb352du; x ^= x >> 15; x *= 0x846ca68bu; x ^= x >> 16; return x; }
__device__ __forceinline__ void dbg_rec(unsigned char* ws, int id, float got, float ref, float scale) {
    float e = fabsf(got - ref) / (fabsf(ref) + scale); if (!(e == e)) e = 1e6f;
    atomicMax((unsigned*)(ws + WS_DBG) + id, __float_as_uint(e));
}
__device__ __forceinline__ float dh(const u16* p, size_t i) { return h2f(p[i]); }
__global__ void __launch_bounds__(256) dbg_check(Args args, int stage) {
    unsigned char* ws = args.ws; const int tid = threadIdx.x, bid = blockIdx.x, gid = bid * 256 + tid;
    if (stage == 0) { if (gid < 64) ((unsigned*)(ws + WS_DBG))[gid] = (gid == 44) ? 0xffffu : 0u; return; }
    if (stage == 1) {
        const unsigned h = dhash(gid * 7919u + 13u);
        { const int n = h % P0W, k = (h >> 12) % 1024; const int sc = wsrc_col(0, n); const float ref = sc < 0 ? 0.f : args.in[I_EWIN][(size_t)k * L0_SRC + sc] * wcol_scale(0, n);
          dbg_rec(ws, 1, dh((const u16*)(ws + WS_W0T), (size_t)n * 1024 + k), ref, 1e-3f); }
        { const int n = h % P1W, k = (h >> 12) % 1024; const int sc = wsrc_col(2, n); const float ref = sc < 0 ? 0.f : args.in[I_OWIN][(size_t)k * L1_SRC + sc] * args.in[I_ONORM][k];
          dbg_rec(ws, 1, dh((const u16*)(ws + WS_W1T), (size_t)n * 1024 + k), ref, 1e-3f); }
        { const int n = h % 1536, k = (h >> 12) % 384; const float ref = args.in[I_OWUQ][(size_t)k * 1536 + n] * args.in[I_OQNORM][k] * QS_C;
          dbg_rec(ws, 1, dh((const u16*)(ws + WS_WUQT), (size_t)n * 384 + k), ref, 1e-3f); }
        { const int n = h % 2048, k = (h >> 12) % 256; const float ref = args.in[I_OWUKV][(size_t)k * 2048 + n] * args.in[I_OKVNORM][k];
          dbg_rec(ws, 1, dh((const u16*)(ws + WS_WUKVT), (size_t)n * 256 + k), ref, 1e-3f); }
        { const int n = h % 1024, k = (h >> 12) % 1024; dbg_rec(ws, 1, dh((const u16*)(ws + WS_WO0T), (size_t)n * 1024 + k), args.in[I_EWO][(size_t)k * 1024 + n], 1e-3f);
          dbg_rec(ws, 1, dh((const u16*)(ws + WS_WO1T), (size_t)n * 1024 + k), args.in[I_OWO][(size_t)k * 1024 + n], 1e-3f); }
        { const int row = h % T, col = (h >> 15) % 1024; const float* xr = args.in[I_X] + (size_t)row * DM; float ss = 0.f; for (int k = 0; k < DM; ++k) ss += xr[k] * xr[k];
          const float ref = xr[col] * rsqrtf(ss / DM + RMS_EPS) * args.in[I_ENORM][col]; dbg_rec(ws, 2, dh((const u16*)(ws + WS_XN0), (size_t)row * DM + col), ref, 1e-2f); }
        return;
    }
    if (stage == 2) {
        const unsigned h = dhash(gid * 104729u + 7u); const int row = h % T; int col = (h >> 15) % P0W; if (gid & 1) col = C_G0 + (col & 1023); if ((gid & 7) == 2) col = C_KI + (col & 63);
        const u16* a = (const u16*)(ws + WS_XN0) + (size_t)row * DM; const u16* b = (const u16*)(ws + WS_W0T) + (size_t)col * 1024; float acc = 0.f;
        for (int k = 0; k < 1024; ++k) acc += h2f(a[k]) * h2f(b[k]);
        if (col >= C_G0) acc = acc / (1.f + expf(-acc));
        dbg_rec(ws, 3, dh((const u16*)(ws + WS_PROJ0), (size_t)row * P0W + col), acc, 2e-2f);
        return;
    }
    if (stage == 3) {
        __shared__ NaiveSh NS;
        const unsigned h = dhash(bid * 2654435761u + 99u);
        int q = h % SEQ; const int b = (h >> 12) % NB; if (bid % 5 == 0) q = q % 320;
        const size_t row = (size_t)b * SEQ + q;
        if (bid < 48) { const int hd = (h >> 20) % 4; const float ref = naiveA(NS, args, b, q, hd, tid);
            if (tid < 128) dbg_rec(ws, 4, dh((const u16*)(ws + WS_MG0), row * DM + hd * 128 + tid), ref, 2e-2f); }
        else { const int hd = (h >> 20) % 8; naiveB_select(NS, args, b, q, tid); const float ref = naiveB_head(NS, args, b, q, hd, tid);
            if (tid < 64) dbg_rec(ws, 5, dh((const u16*)(ws + WS_MG0), row * DM + 512 + hd * 64 + tid), ref, 2e-2f); }
        return;
    }
    if (stage == 4) {
        const unsigned h = dhash(gid * 15485863u + 3u); const int row = h % T, col = (h >> 15) % 1024;
        const u16* a = (const u16*)(ws + WS_MG0) + (size_t)row * DM; const u16* b = (const u16*)(ws + WS_WO0T) + (size_t)col * 1024; float acc = 0.f;
        for (int k = 0; k < 1024; ++k) acc += h2f(a[k]) * h2f(b[k]);
        const float ref = args.in[I_X][(size_t)row * DM + col] + acc;
        dbg_rec(ws, 6, args.out[(size_t)row * DM + col], ref, 1e-2f); dbg_rec(ws, 6, dh((const u16*)(ws + WS_XN0), (size_t)row * DM + col), ref, 1e-2f);
        if (gid < 2048) { float ss = 0.f; for (int k = 0; k < DM; ++k) { const float v = args.out[(size_t)row * DM + k]; ss += v * v; }
            dbg_rec(ws, 7, (float)((const u64*)(ws + WS_SSQ1))[row] / FXS, ss, 1e-3f); }
        return;
    }
    if (stage == 5) {
        const unsigned h = dhash(gid * 32452843u + 5u); const int row = h % T; int col = (h >> 15) % P1W; if ((gid & 3) == 1) col = 640 + (col & 31);
        if (col >= 672 && col < 768) col -= 200;
        const u16* a = (const u16*)(ws + WS_XN0) + (size_t)row * DM; float ss = 0.f; for (int k = 0; k < DM; ++k) { const float v = args.out[(size_t)row * DM + k]; ss += v * v; }
        const float rs = rsqrtf(ss / DM + RMS_EPS);
        auto dotc = [&](int c) { const u16* b = (const u16*)(ws + WS_W1T) + (size_t)c * 1024; float acc = 0.f; for (int k = 0; k < 1024; ++k) acc += h2f(a[k]) * h2f(b[k]); return acc * rs; };
        const float v = dotc(col);
        if (col < 640) dbg_rec(ws, 8, dh((const u16*)(ws + WS_LAT), (size_t)row * LATW + col), v, 2e-2f);
        else if (col < 672) { const int j = col - 640, pos = row & (SEQ - 1), i = j & 15; const float inv = (float)pow(10000.0, -(double)i / 16.0), ang = (float)pos * inv; const float cs = cosf(ang), sn = sinf(ang);
            const float other = dotc(j < 16 ? col + 16 : col - 16); const float ref = j < 16 ? v * cs - other * sn : other * sn + v * cs;
            dbg_rec(ws, 9, dh((const u16*)(ws + WS_KROPE), (size_t)row * 32 + j), ref, 2e-2f); }
        else dbg_rec(ws, 10, dh((const u16*)(ws + WS_G1), (size_t)row * DM + col - 768), v / (1.f + expf(-v)), 2e-2f);
        if (gid < 1024) { const u16* lat = (const u16*)(ws + WS_LAT) + (size_t)row * LATW; float s1 = 0.f, s2 = 0.f; for (int k = 0; k < 256; ++k) s1 += h2f(lat[k]) * h2f(lat[k]); for (int k = 256; k < 640; ++k) s2 += h2f(lat[k]) * h2f(lat[k]);
            dbg_rec(ws, 11, (float)((const u64*)(ws + WS_SSQKV))[row] / FXS, s1, 1e-2f); dbg_rec(ws, 11, (float)((const u64*)(ws + WS_SSQQ))[row] / FXS, s2, 1e-2f); }
        return;
    }
    if (stage == 6) {
        const unsigned h = dhash(gid * 49979687u + 11u); const int row = h % T; const u16* lat = (const u16*)(ws + WS_LAT) + (size_t)row * LATW;
        { const int col = (h >> 15) % 2048; float s1 = 0.f; for (int k = 0; k < 256; ++k) s1 += h2f(lat[k]) * h2f(lat[k]); const float rs = rsqrtf(s1 / 256.f + RMS_EPS);
          const u16* b = (const u16*)(ws + WS_WUKVT) + (size_t)col * 256; float acc = 0.f; for (int k = 0; k < 256; ++k) acc += h2f(lat[k]) * h2f(b[k]);
          dbg_rec(ws, 13, dh((const u16*)(ws + WS_KV1), (size_t)row * 2048 + col), acc * rs, 2e-2f); }
        { int col = (h >> 15) % 1536; if (gid & 1) col = (col / 96) * 96 + 64 + (col & 31);
          float s2 = 0.f; for (int k = 256; k < 640; ++k) s2 += h2f(lat[k]) * h2f(lat[k]); const float rs = rsqrtf(s2 / 384.f + RMS_EPS);
          auto dotc = [&](int c) { const u16* b = (const u16*)(ws + WS_WUQT) + (size_t)c * 384; float acc = 0.f; for (int k = 0; k < 384; ++k) acc += h2f(lat[256 + k]) * h2f(b[k]); return acc * rs; };
          float v = dotc(col); const int jj = col % 96;
          if (jj >= 64) { const int j = jj - 64, pos = row & (SEQ - 1), i = j & 15; const float inv = (float)pow(10000.0, -(double)i / 16.0), ang = (float)pos * inv; const float cs = cosf(ang), sn = sinf(ang);
              const float other = dotc(j < 16 ? col + 16 : col - 16); v = j < 16 ? v * cs - other * sn : other * sn + v * cs; }
          dbg_rec(ws, 12, dh((const u16*)(ws + WS_Q1), (size_t)row * 1536 + col), v, 2e-2f); }
        return;
    }
    if (stage == 7) {
        __shared__ NaiveSh NS;
        const unsigned h = dhash(bid * 2654435761u + 777u); int q = h % SEQ; const int b = (h >> 12) % NB, hd = (h >> 20) % 16; if (bid % 5 == 0) q = q % 320;
        const size_t row = (size_t)b * SEQ + q; const float ref = naiveC(NS, args, b, q, hd, tid);
        if (tid < 64) dbg_rec(ws, 14, dh((const u16*)(ws + WS_MG1), row * DM + hd * 64 + tid), ref, 2e-2f);
        { const float got = tid < 64 ? dh((const u16*)(ws + WS_MG1), row * DM + hd * 64 + tid) : 0.f; const bool bad = tid < 64 && fabsf(got - ref) / (fabsf(ref) + 2e-2f) > 0.05f;
          if (__syncthreads_or(bad ? 1 : 0) && tid == 0) { atomicAdd((unsigned*)(ws + WS_DBG) + 43, 1u); atomicMin((unsigned*)(ws + WS_DBG) + 44, (unsigned)(q / 64)); atomicMax((unsigned*)(ws + WS_DBG) + 45, (unsigned)(q / 64)); } }
        {
            const u16* Q1 = (const u16*)(ws + WS_Q1); const u16* KV = (const u16*)(ws + WS_KV1); const u16* KR = (const u16*)(ws + WS_KROPE); const float* db = (const float*)(ws + WS_DBGBUF) + 4096;
            for (int e = gid; e < 256 * 64; e += gridDim.x * 256) { const int qq = e >> 6, d = e & 63, qpos = 256 * TAPQB + qq, nkk = 64 * (qpos / 64 + 1); float mx = -1e30f, ls = 0.f, a = 0.f;
                const size_t rb = (size_t)TAPB * SEQ; const u16* qp = Q1 + (rb + qpos) * 1536 + TAPH * 96;
                for (int pass = 0; pass < 2; ++pass)
                for (int k = 0; k < nkk; ++k) { float sacc = 0.f; for (int dd = 0; dd < 64; ++dd) sacc += h2f(qp[dd]) * h2f(KV[(rb + k) * 2048 + TAPH * 128 + dd]);
                    for (int dd = 0; dd < 32; ++dd) sacc += h2f(qp[64 + dd]) * h2f(KR[(rb + k) * 32 + dd]);
                    if (pass == 0) mx = fmaxf(mx, sacc); else { const float p = exp2f(sacc - mx); ls += p; a += p * h2f(KV[(rb + k) * 2048 + TAPH * 128 + 64 + d]); } }
                dbg_rec(ws, 21 + (qq >> 6), db[e], a / ls, 2e-2f); }
        }
        if (bid == 0) {
            const u16* Q1 = (const u16*)(ws + WS_Q1); const u16* KV = (const u16*)(ws + WS_KV1); const u16* KR = (const u16*)(ws + WS_KROPE); const float* db = (const float*)(ws + WS_DBGBUF);
            for (int e = tid; e < 32 * 64; e += 256) { const int qq = e >> 6, k = e & 63; float sacc = 0.f;
                for (int d = 0; d < 64; ++d) sacc += h2f(Q1[(size_t)qq * 1536 + d]) * h2f(KV[(size_t)k * 2048 + d]);
                for (int d = 0; d < 32; ++d) sacc += h2f(Q1[(size_t)qq * 1536 + 64 + d]) * h2f(KR[(size_t)k * 32 + d]);
                dbg_rec(ws, 20, db[e], sacc, 2e-2f); dbg_rec(ws, 41, db[e], 0.f, 1.0f); dbg_rec(ws, 42, sacc, 0.f, 1.0f); }
            (void)0;
        }
        return;
    }
    if (stage == 9) {
        if (gid == 0) { const unsigned* e = (const unsigned*)(ws + WS_DBG);
            if (DBG_REPORT_ID >= 43 && DBG_REPORT_ID <= 45) { args.out[0] = 100.0f * (float)e[DBG_REPORT_ID] + 50.f; }
            else if (DBG_REPORT_ID == 40) { args.out[0] = 100.0f * (float)(e[40] / 32u) + 50.f; }
            else if (DBG_REPORT_ID > 0) { args.out[0] = 1000.0f * __uint_as_float(e[DBG_REPORT_ID]); }
            else if (DBG_BITS_MODE) { const int ids[6] = {DBG_BITS_IDS}; int v = 0; for (int i = 0; i < 6; ++i) if (ids[i] > 0 && __uint_as_float(e[ids[i]]) > 0.05f) v |= 1 << i; if (v) args.out[0] = 100.0f * v; }
            else { int first = 0; for (int id = 1; id < 32 && !first; ++id) if (!((DBG_SKIP_MASK >> id) & 1) && __uint_as_float(e[id]) > 0.05f) first = id; if (first) args.out[0] = 100.0f * first; } }
        return;
    }
}
#endif

constexpr int N_PHASES = 9;
__global__ void __launch_bounds__(NWAVES * 64) hybrid_fwd(Args args) {
    extern __shared__ __attribute__((aligned(16))) unsigned char lds_raw[];
    Frame F;
    F.lds = (LAS unsigned char*)lds_raw;
    F.MISC = (volatile LAS unsigned*)(F.lds + MISC_OFF);
    F.tid = threadIdx.x; F.lane = F.tid & 63; F.wave = __builtin_amdgcn_readfirstlane(F.tid >> 6);
    F.G = gridDim.x;
    F.out = args.out; F.ws = args.ws; F.ctl = (unsigned*)(args.ws + WS_CTL);
    for (int u = F.tid; u < (LDS_BYTES - RING_BYTES) / 4; u += NWAVES * 64) ((LAS unsigned*)(F.lds + RING_BYTES))[u] = 0u;
    __syncthreads();
    const int lo = args.ph_lo, hi = args.ph_hi;
    const bool multi = (hi - lo) > 1;
    XcdBarrier bar; bar.bar = F.ctl + CW_BAR; bar.x = 0; bar.st = nullptr;
    if (multi) bar = xcd_barrier_post(F.ctl + CW_BAR, F.MISC + 8);
#ifndef PH_MASK
#define PH_MASK 0x1FF
#endif
#define IN(k) (((PH_MASK >> (k)) & 1) && lo <= (k) && (k) < hi)
#define SEAM(k) do { if (IN(k) && IN((k) + 1)) xcd_barrier(bar); } while (0)
    unsigned char* ws = args.ws;
    LAS unsigned char* ring = F.lds;

#define PHASE1(rep) do { \
        pg8::Gemm g{(const u16*)(ws + WS_XN0), (const u16*)(ws + WS_W0T), T, P0W, 1024, 1024}; pg8::StaticOrder S; S.init(T, P0W, F.G, (int)blockIdx.x); \
        pg8::EpiProj0 E{(u16*)(ws + WS_PROJ0)}; \
        pg8::gemm_phase<pg8::EpiProj0>(ring, g, S, E); } while (0)
#define PHASE2(rep) do { if (!NAIVE_ATTN) { \
        for (;;) { \
            const int u = next_unit(F, (rep) ? CW_Q0 + 16 : CW_Q0); \
            if (u >= 2048) break; \
            const int lvl = 31 - (u >> 6), r = u & 63; \
            if (r < 32) { if (!((rep) && REPEAT_SUB == 1)) { const int c = 2 * lvl + 1 - (r >> 4), rr = r & 15; attnB_unit(F, rr >> 1, 2 * c + (rr & 1), (rep) ? REPEAT_SUB : 0); } } \
            else { if (!((rep) && REPEAT_SUB >= 2)) { const int idx = r - 32; attnA_unit(F, args, idx >> 2, idx & 3, lvl); } } \
        } \
        __syncthreads(); } } while (0)
#define PHASE3(rep) do { \
        pg8::Gemm g{(const u16*)(ws + WS_MG0), (const u16*)(ws + WS_WO0T), T, 1024, 1024, 1024}; pg8::StaticOrder S; S.init(T, 1024, F.G, (int)blockIdx.x); \
        pg8::EpiRes0 E{args.in[I_X], (u16*)(ws + WS_XN0), (rep) ? nullptr : (u64*)(ws + WS_SSQ1)}; \
        pg8::gemm_phase<pg8::EpiRes0>(ring, g, S, E); } while (0)
#define PHASE4(rep) do { \
        pg8::Gemm g{(const u16*)(ws + WS_XN0), (const u16*)(ws + WS_W1T), T, P1W, 1024, 1024}; pg8::StaticOrder S; S.init(T, P1W, F.G, (int)blockIdx.x); \
        pg8::EpiProj1 E{(const u64*)(ws + WS_SSQ1), (u16*)(ws + WS_LAT), (u16*)(ws + WS_KROPE), (u16*)(ws + WS_G1), (rep) ? nullptr : (u64*)(ws + WS_SSQKV), (rep) ? nullptr : (u64*)(ws + WS_SSQQ), (const float*)(ws + WS_ROPEC), (const float*)(ws + WS_ROPES)}; \
        pg8::gemm_phase<pg8::EpiProj1>(ring, g, S, E); } while (0)
#define PHASE5(rep) do { \
        { pg8::Gemm g{(const u16*)(ws + WS_LAT) + 256, (const u16*)(ws + WS_WUQT), T, 1536, 384, LATW}; pg8::StaticOrder S; S.init(T, 1536, F.G, (int)blockIdx.x); \
          pg8::EpiQ1 E{(const u64*)(ws + WS_SSQQ), (u16*)(ws + WS_Q1), (const float*)(ws + WS_ROPEC), (const float*)(ws + WS_ROPES)}; \
          pg8::gemm_phase<pg8::EpiQ1>(ring, g, S, E); } \
        { pg8::Gemm g{(const u16*)(ws + WS_LAT), (const u16*)(ws + WS_WUKVT), T, 2048, 256, LATW}; pg8::StaticOrder S; S.init(T, 2048, F.G, (int)blockIdx.x); \
          pg8::EpiKV1 E{(const u64*)(ws + WS_SSQKV), (u16*)(ws + WS_KV1)}; \
          pg8::gemm_phase<pg8::EpiKV1>(ring, g, S, E); } } while (0)
#define PHASE6(rep) do { if (!NAIVE_ATTN) { \
        for (;;) { \
            const int u = next_unit(F, (rep) ? CW_Q1 + 16 : CW_Q1); \
            if (u >= 2048) break; \
            const int qb = 15 - (u >> 7), r = u & 127; \
            attnC_unit(F, r >> 4, r & 15, qb); \
        } \
        __syncthreads(); } } while (0)
#define PHASE7(rep) do { \
        pg8::Gemm g{(const u16*)(ws + WS_MG1), (const u16*)(ws + WS_WO1T), T, 1024, 1024, 1024}; pg8::StaticOrder S; S.init(T, 1024, F.G, (int)blockIdx.x); \
        pg8::EpiRes1 E{(const u16*)(ws + WS_XN0), (u16*)(ws + WS_X2H)}; \
        pg8::gemm_phase<pg8::EpiRes1>(ring, g, S, E); } while (0)
#define REPEAT(k, CALL) do { if (REPEAT_PHASE == (k) && multi) { xcd_barrier(bar); CALL; } } while (0)
    if (IN(0)) { p0_prologue(F, args); REPEAT(0, p0_prologue(F, args)); } SEAM(0);
    if (IN(1)) { PHASE1(0); REPEAT(1, PHASE1(1)); } SEAM(1);
    if (IN(2)) { PHASE2(0); REPEAT(2, PHASE2(1)); } SEAM(2);
    if (IN(3)) { PHASE3(0); REPEAT(3, PHASE3(1)); } SEAM(3);
    if (IN(4)) { PHASE4(0); REPEAT(4, PHASE4(1)); } SEAM(4);
    if (IN(5)) { PHASE5(0); REPEAT(5, PHASE5(1)); } SEAM(5);
    if (IN(6)) { PHASE6(0); REPEAT(6, PHASE6(1)); } SEAM(6);
    if (IN(7)) { PHASE7(0); } SEAM(7);
    if (IN(8)) { p8_final(F, args); }
#undef IN
#undef SEAM
}

extern "C" void kernel_launch(void* const* d_in, const int* in_sizes, int n_in, void* d_out, int out_size, void* d_ws, size_t ws_size, hipStream_t stream) {
    static int grid = 0;
    if (grid == 0) {
        if (n_in != 18 || in_sizes[0] != T * DM || out_size != T * DM || ws_size < WS_END) {
            fprintf(stderr, "kernel_launch: unexpected shapes (n_in %d, in0 %d, out %d, ws %zu, need %zu); nothing launched\n", n_in, n_in > 0 ? in_sizes[0] : -1, out_size, ws_size, (size_t)WS_END); grid = -1; return; }
        int dev = 0, cus = 0, per_cu = 0;
        if (hipGetDevice(&dev) != hipSuccess || hipDeviceGetAttribute(&cus, hipDeviceAttributeMultiprocessorCount, dev) != hipSuccess) { fprintf(stderr, "kernel_launch: device query failed\n"); grid = -1; return; }
        if (hipFuncSetAttribute((const void*)hybrid_fwd, hipFuncAttributeMaxDynamicSharedMemorySize, LDS_BYTES) != hipSuccess) { fprintf(stderr, "kernel_launch: hipFuncSetAttribute failed\n"); grid = -1; return; }
        if (hipOccupancyMaxActiveBlocksPerMultiprocessor(&per_cu, (const void*)hybrid_fwd, NWAVES * 64, LDS_BYTES) != hipSuccess || per_cu < 1)
            fprintf(stderr, "kernel_launch: note: occupancy query reports %d workgroups per CU\n", per_cu);
        (void)hipGetLastError();
        grid = cus;
        if (grid % 8 != 0) grid -= grid % 8;
    }
    if (grid <= 0) return;
    (void)hipMemsetAsync((char*)d_ws + WS_CTL, 0, CTL_ZERO_BYTES, stream);
    Args a{};
    for (int i = 0; i < 18; ++i) a.in[i] = (const float*)d_in[i];
    a.out = (float*)d_out; a.ws = (unsigned char*)d_ws;
#if MK_N_LAUNCHES == 1
    a.ph_lo = 0; a.ph_hi = N_PHASES;
    hipLaunchKernelGGL(hybrid_fwd, dim3(grid), dim3(NWAVES * 64), LDS_BYTES, stream, a);
#else
#if DEBUG_CHECK
    hipLaunchKernelGGL(dbg_check, dim3(1), dim3(256), 0, stream, a, 0);
#endif
    for (int p = 0; p < N_PHASES; ++p) { a.ph_lo = p; a.ph_hi = p + 1;
#if NAIVE_ATTN
        if (p == 2) { hipLaunchKernelGGL(naive_attn, dim3(8192), dim3(256), 0, stream, a, 0); continue; }
        if (p == 6) { hipLaunchKernelGGL(naive_attn, dim3(8192), dim3(256), 0, stream, a, 1); continue; }
#endif
        hipLaunchKernelGGL(hybrid_fwd, dim3(grid), dim3(NWAVES * 64), LDS_BYTES, stream, a);
#if DEBUG_CHECK
        if (p <= 6) hipLaunchKernelGGL(dbg_check, dim3((p == 2 || p == 6) ? 96 : 64), dim3(256), 0, stream, a, p + 1);
#endif
    }
#if DEBUG_CHECK
    hipLaunchKernelGGL(dbg_check, dim3(1), dim3(256), 0, stream, a, 9);
#endif
#endif
    const hipError_t le = hipPeekAtLastError();
    if (le != hipSuccess) fprintf(stderr, "kernel_launch: launch failed: %s\n", hipGetErrorName(le));
}
```

```cpp
#include <hip/hip_runtime.h>
#include <cstdio>
#include <cstdint>

#ifndef DEBUG_CHECK
#define DEBUG_CHECK 0
#endif
#define TAPB 3
#define TAPH 5
#define TAPQB 7
#ifndef REPEAT_PHASE
#define REPEAT_PHASE -1
#define REPEAT_SUB 0
#endif
#ifndef MK_N_LAUNCHES
#define MK_N_LAUNCHES 1
#endif

#define LAS __attribute__((address_space(3)))
#define GAS __attribute__((address_space(1)))
typedef unsigned short u16;
typedef unsigned long long u64;
typedef _Float16 h8 __attribute__((ext_vector_type(8)));
typedef _Float16 h2 __attribute__((ext_vector_type(2)));
typedef _Float16 h4 __attribute__((ext_vector_type(4)));
typedef short s16x4 __attribute__((ext_vector_type(4)));
typedef short s16x8 __attribute__((ext_vector_type(8)));
typedef float f32x2 __attribute__((ext_vector_type(2)));
typedef float f32x4 __attribute__((ext_vector_type(4)));
typedef float f32x16 __attribute__((ext_vector_type(16)));
typedef unsigned u32x2 __attribute__((ext_vector_type(2)));
typedef unsigned u32x4 __attribute__((ext_vector_type(4)));

constexpr int SEQ = 4096, NB = 8, T = NB * SEQ, DM = 1024;
constexpr int P0W = 3840;
constexpr int C_QA = 0, C_KA = 512, C_VA = 1024, C_QB = 1536, C_KB = 2048, C_VB = 2112, C_QI = 2176, C_KI = 2688, C_WI = 2752, C_G0 = 2816;
constexpr int L0_SRC = 3784;
constexpr int P1W = 1792;
constexpr int L1_SRC = 1696;
constexpr int LATW = 640;
constexpr int TOPK = 256;
constexpr float LOG2E = 1.4426950408889634f;
constexpr float QS_AB = 0.125f * LOG2E;
constexpr float QS_C = 0.10206207261596575f * LOG2E;
constexpr float RMS_EPS = 1e-6f;
constexpr float FXS = 1048576.0f;

constexpr size_t MiB = 1u << 20;
constexpr size_t WS_CTL = 0, CTL_ZERO_BYTES = 2 * MiB;
constexpr size_t WS_SSQ1 = 1 * MiB, WS_SSQKV = WS_SSQ1 + 256 * 1024, WS_SSQQ = WS_SSQKV + 256 * 1024;
constexpr size_t WS_ROPEC = 2 * MiB, WS_ROPES = WS_ROPEC + 256 * 1024, WS_BTG = WS_ROPES + 256 * 1024, WS_LAM = WS_BTG + 16 * 1024;
constexpr size_t WS_W0T = 4 * MiB;
constexpr size_t WS_WO0T = 12 * MiB;
constexpr size_t WS_W1T = 14 * MiB;
constexpr size_t WS_WUQT = 18 * MiB;
constexpr size_t WS_WUKVT = 20 * MiB;
constexpr size_t WS_WO1T = 22 * MiB;
constexpr size_t WS_XN0 = 32 * MiB;
constexpr size_t WS_PROJ0 = 96 * MiB;
constexpr size_t WS_MG0 = 336 * MiB;
constexpr size_t WS_LAT = 96 * MiB;
constexpr size_t WS_KROPE = 136 * MiB;
constexpr size_t WS_G1 = 140 * MiB;
constexpr size_t WS_Q1 = 204 * MiB;
constexpr size_t WS_KV1 = 300 * MiB;
constexpr size_t WS_MG1 = 428 * MiB;
constexpr size_t WS_X2H = 96 * MiB;
constexpr size_t WS_END = 492 * MiB;
constexpr size_t WS_DBGBUF = 3 * MiB + 4096;
constexpr int CW_TMO = 0, CW_CODE = 1, CW_Q0 = 64, CW_Q1 = 128, CW_BAR = 4096;

constexpr int RING_BYTES = 131072;
constexpr int MISC_OFF = RING_BYTES + 320;
constexpr int LDS_BYTES = 147456;
constexpr int NWAVES = 8;

__device__ __forceinline__ unsigned pkh(float lo, float hi) { f32x2 v = {lo, hi}; h2 h = __builtin_convertvector(v, h2); return __builtin_bit_cast(unsigned, h); }
__device__ __forceinline__ float h2f(u16 b) { return (float)__builtin_bit_cast(_Float16, b); }
__device__ __forceinline__ float silu_f(float x) { return x * __builtin_amdgcn_rcpf(1.0f + __builtin_amdgcn_exp2f(-x * LOG2E)); }
__device__ __forceinline__ float swap_max(float m) { auto rr = __builtin_amdgcn_permlane32_swap(__float_as_uint(m), __float_as_uint(m), false, false); return fmaxf(__uint_as_float(rr[0]), __uint_as_float(rr[1])); }
__device__ __forceinline__ float swap_sum(float m) { auto rr = __builtin_amdgcn_permlane32_swap(__float_as_uint(m), __float_as_uint(m), false, false); return __uint_as_float(rr[0]) + __uint_as_float(rr[1]); }
__device__ __forceinline__ float wave_sum(float v) {
#pragma unroll
    for (int o = 1; o < 64; o <<= 1) v += __shfl_xor(v, o);
    return v;
}
#define LDS_WAIT() asm volatile("s_waitcnt lgkmcnt(0)" ::: "memory")
#define VM_WAIT() asm volatile("s_waitcnt vmcnt(0)" ::: "memory")

namespace pg8 {
constexpr int BM = 256, BK = 64, HALF = 128, HTB = HALF * BK * 2, STAGE_BYTES = 8 * HTB, NXCD = 8, WGM = 8;
__host__ __device__ __forceinline__ int lds_byte(int r, int c) { const int st = (r >> 4) * 2 + (c >> 5), rr = r & 15, cc = c & 31, ob = rr * 64 + cc * 2; return st * 1024 + (ob ^ (((ob >> 9) & 1) << 5)); }
__host__ __device__ __forceinline__ void stage_rc(int b, int& R, int& C) { const int st = b / 1024, sb = b % 1024, swz = sb ^ (((sb >> 9) & 1) << 5); R = (st >> 1) * 16 + swz / 64; C = (st & 1) * 32 + (swz % 64) / 2; }
__host__ __device__ __forceinline__ int perm32(int rho) { const int n = rho >> 4, i = rho & 15; return 8 * (i >> 2) + 4 * n + (i & 3); }
struct Unit { int pm, pn; };
struct Gemm { const u16* A; const u16* Bt; int M, N, K, lda; };
struct StaticOrder {
    int nM, nN, nwg, G, c;
    __device__ void init(int M, int N, int G_, int c_) { nM = M / BM; nN = N / BM; nwg = nM * nN; G = G_; c = c_; }
    __device__ bool next(int i, Unit& u) const {
        const long L = (long)i * G + c; if (L >= nwg) return false;
        int wgid = (int)L; { const int q = nwg / NXCD, r = nwg % NXCD, xcd = wgid % NXCD, off = wgid / NXCD; wgid = (xcd < r ? xcd * (q + 1) : r * (q + 1) + (xcd - r) * q) + off; }
        const int nig = WGM * nN, gid = wgid / nig, fm = gid * WGM, gsz = (nM - fm) < WGM ? (nM - fm) : WGM;
        u.pm = fm + ((wgid % nig) % gsz); u.pn = (wgid % nig) / gsz; return true;
    }
};
template <class Epi>
__device__ __forceinline__ void gemm_phase(LAS unsigned char* lds, const Gemm g, const StaticOrder& S, const Epi& E) {
    const int tid = threadIdx.x, wid = __builtin_amdgcn_readfirstlane(tid >> 6), lane = tid & 63, wr = wid >> 2, wc = wid & 3, fr = lane & 15, fq = lane >> 4;
    const int K = g.K, nt = K / BK, lda = g.lda;
    unsigned voffA[2], voffB[2];
#pragma unroll
    for (int i = 0; i < 2; ++i) { int R, C; stage_rc(tid * 16 + i * 8192, R, C); const int Rb = Epi::PERM ? ((R & ~31) + perm32(R & 31)) : R;
        voffA[i] = (unsigned)(R * lda + C) * 2u; voffB[i] = (unsigned)(Rb * K + C) * 2u; }
    const size_t kstep = (size_t)(BK * 2);
    const size_t hstepA = (size_t)HALF * lda * 2, tstepA = 2 * hstepA;
    const size_t hstepB = (size_t)HALF * K * 2, tstepB = 2 * hstepB;
    const unsigned ldsw = (unsigned)wid * 1024u;
    const int aoff = lds_byte(wr * 64 + fr, fq * 8), boff = lds_byte(wc * 32 + fr, fq * 8);
#define PG8_SA(b, h) (((b) * 2 + (h)) * HTB)
#define PG8_SB(b, h) ((4 + (b) * 2 + (h)) * HTB)
#define PG8_STAGE(bufoff, gbase, voff) do { _Pragma("unroll") for (int _i = 0; _i < 2; ++_i) \
        __builtin_amdgcn_global_load_lds((const unsigned*)((const char*)(gbase) + (voff)[_i]), (LAS unsigned*)(lds + (bufoff) + ldsw + _i * 8192), 16, 0, 0); } while (0)
#define PG8_LDA(dst, b, h) do { _Pragma("unroll") for (int m = 0; m < 4; ++m) _Pragma("unroll") for (int k = 0; k < 2; ++k) dst[m][k] = *(const LAS h8*)(lds + PG8_SA(b, h) + aoff + m * 2048 + k * 1024); } while (0)
#define PG8_LDB(dst, b, h) do { _Pragma("unroll") for (int n = 0; n < 2; ++n) _Pragma("unroll") for (int k = 0; k < 2; ++k) dst[n][k] = *(const LAS h8*)(lds + PG8_SB(b, h) + boff + n * 2048 + k * 1024); } while (0)
#define PG8_MMA(ai, bj, At, Bt) do { __builtin_amdgcn_s_setprio(1); _Pragma("unroll") for (int m = 0; m < 4; ++m) _Pragma("unroll") for (int n = 0; n < 2; ++n) _Pragma("unroll") for (int k = 0; k < 2; ++k) \
        acc[ai][bj][m][n] = __builtin_amdgcn_mfma_f32_16x16x32_f16(Bt[n][k], At[m][k], acc[ai][bj][m][n], 0, 0, 0); __builtin_amdgcn_s_setprio(0); } while (0)
#define PG8_WAIT_V(n) asm volatile("s_waitcnt vmcnt(" #n ")" ::: "memory")
#define PG8_WAIT_L(n) asm volatile("s_waitcnt lgkmcnt(" #n ")" ::: "memory")
#define PG8_BAR __builtin_amdgcn_s_barrier()
#define PG8_SCHED __builtin_amdgcn_sched_barrier(0)
    Unit cur, nxt; int ui = 0;
    if (!S.next(0, cur)) return;
    f32x4 acc[2][2][4][2];
#pragma unroll
    for (int a = 0; a < 2; ++a)
#pragma unroll
        for (int b = 0; b < 2; ++b)
#pragma unroll
            for (int m = 0; m < 4; ++m)
#pragma unroll
                for (int n = 0; n < 2; ++n) acc[a][b][m][n] = (f32x4){0.f, 0.f, 0.f, 0.f};
    h8 At[4][2], B0[2][2], B1[2][2];
    const char* cA = (const char*)g.A + (size_t)cur.pm * tstepA; const char* cB = (const char*)g.Bt + (size_t)cur.pn * tstepB;
    PG8_STAGE(PG8_SB(0, 0), cB, voffB); PG8_STAGE(PG8_SB(0, 1), cB + hstepB, voffB); PG8_STAGE(PG8_SA(0, 0), cA, voffA); PG8_STAGE(PG8_SA(0, 1), cA + hstepA, voffA);
    if (wr == 1) PG8_BAR;
    PG8_WAIT_V(2); PG8_BAR;
    PG8_STAGE(PG8_SB(1, 0), cB + kstep, voffB); PG8_STAGE(PG8_SA(1, 0), cA + kstep, voffA); PG8_STAGE(PG8_SB(1, 1), cB + hstepB + kstep, voffB);
    PG8_WAIT_V(6); PG8_BAR;
    for (;;) {
        const bool has_next = S.next(ui + 1, nxt);
        const char* nA = has_next ? (const char*)g.A + (size_t)nxt.pm * tstepA : cA; const char* nB = has_next ? (const char*)g.Bt + (size_t)nxt.pn * tstepB : cB;
#pragma unroll 1
        for (int t = 0; t < nt; t += 2) {
            const bool last = (t == nt - 2);
            const char* a1 = cA + (size_t)(t + 1) * kstep;
            const char* a2 = last ? nA : cA + (size_t)(t + 2) * kstep; const char* b2 = last ? nB : cB + (size_t)(t + 2) * kstep;
            const char* a3 = a2 + kstep; const char* b3 = b2 + kstep;
            PG8_LDB(B0, 0, 0); PG8_LDB(B1, 0, 1); PG8_SCHED; PG8_LDA(At, 0, 0); PG8_STAGE(PG8_SA(1, 1), a1 + hstepA, voffA);
            PG8_WAIT_V(8); PG8_WAIT_L(0); PG8_BAR; PG8_MMA(0, 0, At, B0); PG8_MMA(0, 1, At, B1); PG8_BAR; PG8_SCHED;
            PG8_LDA(At, 0, 1); PG8_STAGE(PG8_SB(0, 0), b2, voffB); PG8_STAGE(PG8_SB(0, 1), b2 + hstepB, voffB); PG8_STAGE(PG8_SA(0, 0), a2, voffA);
            PG8_WAIT_V(8); PG8_WAIT_L(0); PG8_BAR; PG8_MMA(1, 0, At, B0); PG8_MMA(1, 1, At, B1); PG8_BAR; PG8_SCHED;
            PG8_LDB(B0, 1, 0); PG8_LDB(B1, 1, 1); PG8_SCHED; PG8_LDA(At, 1, 0); PG8_STAGE(PG8_SA(0, 1), a2 + hstepA, voffA);
            PG8_WAIT_V(8); PG8_WAIT_L(0); PG8_BAR; PG8_MMA(0, 0, At, B0); PG8_MMA(0, 1, At, B1); PG8_BAR; PG8_SCHED;
            PG8_LDA(At, 1, 1); PG8_STAGE(PG8_SB(1, 0), b3, voffB); PG8_STAGE(PG8_SB(1, 1), b3 + hstepB, voffB); PG8_STAGE(PG8_SA(1, 0), a3, voffA);
            PG8_WAIT_V(8); PG8_WAIT_L(0); PG8_BAR; PG8_MMA(1, 0, At, B0); PG8_MMA(1, 1, At, B1); PG8_BAR; PG8_SCHED;
        }
        if (wr == 0) PG8_BAR;
        E(acc, cur, wr, wc, fr, fq);
        if (!has_next) break;
#pragma unroll
        for (int a = 0; a < 2; ++a)
#pragma unroll
            for (int b = 0; b < 2; ++b)
#pragma unroll
                for (int m = 0; m < 4; ++m)
#pragma unroll
                    for (int n = 0; n < 2; ++n) acc[a][b][m][n] = (f32x4){0.f, 0.f, 0.f, 0.f};
        cur = nxt; cA = nA; cB = nB; ++ui;
        if (wr == 1) PG8_BAR;
    }
    PG8_WAIT_V(0);
    PG8_BAR;
#undef PG8_SA
#undef PG8_SB
#undef PG8_STAGE
#undef PG8_LDA
#undef PG8_LDB
#undef PG8_MMA
#undef PG8_WAIT_V
#undef PG8_WAIT_L
#undef PG8_BAR
#undef PG8_SCHED
}

typedef f32x4 Acc[2][2][4][2];
__device__ __forceinline__ float rstd_from(const u64* ssq, int row, float inv_n) { return __builtin_amdgcn_rsqf((float)ssq[row] * (1.0f / FXS) * inv_n + RMS_EPS); }
__device__ __forceinline__ void ssq_add(u64* ssq, int row, float ss, int fq) {
    ss += __shfl_xor(ss, 16); ss += __shfl_xor(ss, 32);
    if (fq == 0) atomicAdd((unsigned long long*)(ssq + row), (unsigned long long)(ss * FXS + 0.5f));
}
struct EpiProj0 {
    static constexpr bool PERM = true;
    u16* O;
    __device__ __forceinline__ void operator()(const Acc& acc, const Unit& u, int wr, int wc, int fr, int fq) const {
        const int row0 = u.pm * BM + wr * 64 + fr, col0 = u.pn * BM + wc * 32 + 8 * fq; const bool gate = u.pn >= 11;
#pragma unroll
        for (int ai = 0; ai < 2; ++ai)
#pragma unroll
            for (int m = 0; m < 4; ++m) { u16* rowp = O + (size_t)(row0 + ai * HALF + m * 16) * P0W + col0;
#pragma unroll
                for (int bj = 0; bj < 2; ++bj) { f32x4 v0 = acc[ai][bj][m][0], v1 = acc[ai][bj][m][1];
                    if (gate) {
#pragma unroll
                        for (int e = 0; e < 4; ++e) { v0[e] = silu_f(v0[e]); v1[e] = silu_f(v1[e]); } }
                    u32x4 w; w.x = pkh(v0[0], v0[1]); w.y = pkh(v0[2], v0[3]); w.z = pkh(v1[0], v1[1]); w.w = pkh(v1[2], v1[3]);
                    *(u32x4*)(rowp + bj * HALF) = w; } }
    }
};
struct EpiRes0 {
    static constexpr bool PERM = false;
    const float* base; u16* outh; u64* ssq;
    __device__ __forceinline__ void operator()(const Acc& acc, const Unit& u, int wr, int wc, int fr, int fq) const {
        const int row0 = u.pm * BM + wr * 64 + fr, col0 = u.pn * BM + wc * 32 + 4 * fq;
#pragma unroll
        for (int ai = 0; ai < 2; ++ai)
#pragma unroll
            for (int m = 0; m < 4; ++m) { const int row = row0 + ai * HALF + m * 16; const size_t off = (size_t)row * DM + col0; float ss = 0.f;
#pragma unroll
                for (int bj = 0; bj < 2; ++bj)
#pragma unroll
                    for (int n = 0; n < 2; ++n) { const f32x4 bs = *(const f32x4*)(base + off + bj * HALF + n * 16); const f32x4 o = bs + acc[ai][bj][m][n];
                        u32x2 w; w.x = pkh(o[0], o[1]); w.y = pkh(o[2], o[3]); *(u32x2*)(outh + off + bj * HALF + n * 16) = w;
                        ss += (o[0] * o[0] + o[1] * o[1]) + (o[2] * o[2] + o[3] * o[3]); }
                if (ssq) ssq_add(ssq, row, ss, fq); }
    }
};
struct EpiRes1 {
    static constexpr bool PERM = false;
    const u16* baseh; u16* outh;
    __device__ __forceinline__ void operator()(const Acc& acc, const Unit& u, int wr, int wc, int fr, int fq) const {
        const int row0 = u.pm * BM + wr * 64 + fr, col0 = u.pn * BM + wc * 32 + 4 * fq;
#pragma unroll
        for (int ai = 0; ai < 2; ++ai)
#pragma unroll
            for (int m = 0; m < 4; ++m) { const int row = row0 + ai * HALF + m * 16; const size_t off = (size_t)row * DM + col0;
#pragma unroll
                for (int bj = 0; bj < 2; ++bj)
#pragma unroll
                    for (int n = 0; n < 2; ++n) { const h4 bh = *(const h4*)(baseh + off + bj * HALF + n * 16);
                        const f32x4 a = acc[ai][bj][m][n];
                        u32x2 w; w.x = pkh(a[0] + (float)bh[0], a[1] + (float)bh[1]); w.y = pkh(a[2] + (float)bh[2], a[3] + (float)bh[3]);
                        *(u32x2*)(outh + off + bj * HALF + n * 16) = w; } }
    }
};
struct EpiProj1 {
    static constexpr bool PERM = false;
    const u64* ssq1; u16* lat; u16* krope; u16* g1; u64* ssqkv; u64* ssqq; const float* ropec; const float* ropes;
    __device__ __forceinline__ void operator()(const Acc& acc, const Unit& u, int wr, int wc, int fr, int fq) const {
        const int row0 = u.pm * BM + wr * 64 + fr, pn = u.pn;
#pragma unroll
        for (int ai = 0; ai < 2; ++ai)
#pragma unroll
            for (int m = 0; m < 4; ++m) { const int row = row0 + ai * HALF + m * 16; const float rs = rstd_from(ssq1, row, 1.0f / 1024.0f); float ss = 0.f;
#pragma unroll
                for (int bj = 0; bj < 2; ++bj) { f32x4 v0 = acc[ai][bj][m][0] * rs, v1 = acc[ai][bj][m][1] * rs;
                    const int tc = bj * HALF + wc * 32 + 4 * fq;
                    if (pn >= 3) {
#pragma unroll
                        for (int e = 0; e < 4; ++e) { v0[e] = silu_f(v0[e]); v1[e] = silu_f(v1[e]); }
                        u16* p = g1 + (size_t)row * DM + (pn - 3) * BM + tc;
                        u32x2 w0, w1; w0.x = pkh(v0[0], v0[1]); w0.y = pkh(v0[2], v0[3]); w1.x = pkh(v1[0], v1[1]); w1.y = pkh(v1[2], v1[3]);
                        *(u32x2*)p = w0; *(u32x2*)(p + 16) = w1;
                    } else if (pn < 2 || bj == 0) {
                        u16* p = lat + (size_t)row * LATW + pn * BM + tc;
                        u32x2 w0, w1; w0.x = pkh(v0[0], v0[1]); w0.y = pkh(v0[2], v0[3]); w1.x = pkh(v1[0], v1[1]); w1.y = pkh(v1[2], v1[3]);
                        *(u32x2*)p = w0; *(u32x2*)(p + 16) = w1;
                        ss += (v0[0] * v0[0] + v0[1] * v0[1]) + (v0[2] * v0[2] + v0[3] * v0[3]) + (v1[0] * v1[0] + v1[1] * v1[1]) + (v1[2] * v1[2] + v1[3] * v1[3]);
                    } else if (wc == 0) {
                        const int pos = row & (SEQ - 1); const f32x4 cs = *(const f32x4*)(ropec + pos * 16 + 4 * fq), sn = *(const f32x4*)(ropes + pos * 16 + 4 * fq);
                        const f32x4 o0 = v0 * cs - v1 * sn, o1 = v0 * sn + v1 * cs;
                        u16* p = krope + (size_t)row * 32 + 4 * fq;
                        u32x2 w0, w1; w0.x = pkh(o0[0], o0[1]); w0.y = pkh(o0[2], o0[3]); w1.x = pkh(o1[0], o1[1]); w1.y = pkh(o1[2], o1[3]);
                        *(u32x2*)p = w0; *(u32x2*)(p + 16) = w1;
                    } }
                if (pn == 0) { if (ssqkv) ssq_add(ssqkv, row, ss, fq); } else if (pn <= 2) { if (ssqq) ssq_add(ssqq, row, ss, fq); }
                asm volatile("" ::: "memory"); }
    }
};
struct EpiQ1 {
    static constexpr bool PERM = false;
    const u64* ssqq; u16* q1; const float* ropec; const float* ropes;
    __device__ __forceinline__ void operator()(const Acc& acc, const Unit& u, int wr, int wc, int fr, int fq) const {
        const int row0 = u.pm * BM + wr * 64 + fr;
#pragma unroll
        for (int ai = 0; ai < 2; ++ai)
#pragma unroll
            for (int m = 0; m < 4; ++m) { const int row = row0 + ai * HALF + m * 16; const float rs = rstd_from(ssqq, row, 1.0f / 384.0f);
#pragma unroll
                for (int bj = 0; bj < 2; ++bj) { f32x4 v0 = acc[ai][bj][m][0] * rs, v1 = acc[ai][bj][m][1] * rs;
                    const int g0 = u.pn * BM + bj * HALF + wc * 32;
                    if ((g0 % 96) == 64) { const int pos = row & (SEQ - 1); const f32x4 cs = *(const f32x4*)(ropec + pos * 16 + 4 * fq), sn = *(const f32x4*)(ropes + pos * 16 + 4 * fq);
                        const f32x4 o0 = v0 * cs - v1 * sn, o1 = v0 * sn + v1 * cs; v0 = o0; v1 = o1; }
                    u16* p = q1 + (size_t)row * 1536 + g0 + 4 * fq;
                    u32x2 w0, w1; w0.x = pkh(v0[0], v0[1]); w0.y = pkh(v0[2], v0[3]); w1.x = pkh(v1[0], v1[1]); w1.y = pkh(v1[2], v1[3]);
                    *(u32x2*)p = w0; *(u32x2*)(p + 16) = w1; }
                asm volatile("" ::: "memory"); }
    }
};
struct EpiKV1 {
    static constexpr bool PERM = true;
    const u64* ssqkv; u16* kv1;
    __device__ __forceinline__ void operator()(const Acc& acc, const Unit& u, int wr, int wc, int fr, int fq) const {
        const int row0 = u.pm * BM + wr * 64 + fr, col0 = u.pn * BM + wc * 32 + 8 * fq;
#pragma unroll
        for (int ai = 0; ai < 2; ++ai)
#pragma unroll
            for (int m = 0; m < 4; ++m) { const int row = row0 + ai * HALF + m * 16; const float rs = rstd_from(ssqkv, row, 1.0f / 256.0f); u16* rowp = kv1 + (size_t)row * 2048 + col0;
#pragma unroll
                for (int bj = 0; bj < 2; ++bj) { const f32x4 v0 = acc[ai][bj][m][0] * rs, v1 = acc[ai][bj][m][1] * rs;
                    u32x4 w; w.x = pkh(v0[0], v0[1]); w.y = pkh(v0[2], v0[3]); w.z = pkh(v1[0], v1[1]); w.w = pkh(v1[2], v1[3]);
                    *(u32x4*)(rowp + bj * HALF) = w; }
                if (m & 1) asm volatile("" ::: "memory"); }
    }
};
}

#define XB_TMO      128
#define XB_XCNT(j)  (256  + 64 * (j))
#define XB_XSUB(j)  (1280 + 64 * (j))
#define XB_XGEN(j)  (2304 + 64 * (j))
#define XB_TOP      3328
#define XB_TOPGEN   3392
#define XCD_BAR_WORDS 3456
#define XB_SPIN_CAP (1u << 20)
__device__ __forceinline__ unsigned xb_ld(unsigned* p)              { return __hip_atomic_load(p, __ATOMIC_RELAXED, __HIP_MEMORY_SCOPE_AGENT); }
__device__ __forceinline__ unsigned xb_add(unsigned* p, unsigned v) { return __hip_atomic_fetch_add(p, v, __ATOMIC_RELAXED, __HIP_MEMORY_SCOPE_AGENT); }
__device__ __forceinline__ unsigned xb_xcc_id() { return (unsigned)__builtin_amdgcn_s_getreg((3 << 11) | 20) & 0xFu; }
#define XB_SPIN(cond, bar) do { unsigned _sp = 0; while (cond) { __builtin_amdgcn_s_sleep(1); \
    if ((++_sp & 255u) == 0u) { if (xb_ld(&(bar)[XB_TMO])) break; if (_sp > XB_SPIN_CAP) { atomicAdd(&(bar)[XB_TMO], 1u); break; } } } } while (0)
struct XcdBarrier { unsigned* bar; unsigned x; volatile LAS unsigned* st; };
__device__ __forceinline__ XcdBarrier xcd_barrier_post(unsigned* bar, volatile LAS unsigned* st) {
    XcdBarrier b; b.bar = bar; b.x = xb_xcc_id(); b.st = st;
    if (threadIdx.x == 0) (void)xb_add(&bar[XB_XCNT(b.x)], 1u);
    return b;
}
__device__ __forceinline__ void xcd_barrier_complete(unsigned* bar, unsigned x, unsigned& nloc, unsigned& nx) {
    const unsigned G = gridDim.x * gridDim.y * gridDim.z;
    unsigned sum, cnt, mine, sp = 0u;
    for (;;) {
        sum = 0u; cnt = 0u; mine = 0u;
#pragma unroll
        for (unsigned j = 0; j < 16; ++j) { const unsigned c = xb_ld(&bar[XB_XCNT(j)]); sum += c; cnt += (c > 0u) ? 1u : 0u; mine = (j == x) ? c : mine; }
        if (sum == G) break;
        __builtin_amdgcn_s_sleep(1);
        if ((++sp & 255u) == 0u) { if (xb_ld(&bar[XB_TMO])) break; if (sp > XB_SPIN_CAP) { atomicAdd(&bar[XB_TMO], 1u); break; } }
    }
    nloc = mine > 0u ? mine : 1u; nx = cnt > 0u ? cnt : 1u;
}
__device__ __forceinline__ void xcd_barrier(const XcdBarrier& b) {
    asm volatile("s_waitcnt vmcnt(0)" ::: "memory");
    __syncthreads();
    if (threadIdx.x == 0) {
        unsigned* bar = b.bar;
        __builtin_amdgcn_s_waitcnt(0);
        unsigned nloc = b.st[0], nx = b.st[1];
        if (nloc == 0u) { xcd_barrier_complete(bar, b.x, nloc, nx); b.st[0] = nloc; b.st[1] = nx; }
        const unsigned old = xb_add(&bar[XB_XSUB(b.x)], 1u);
        const unsigned gen = old / nloc;
        if (old + 1u == (gen + 1u) * nloc) {
            __builtin_amdgcn_fence(__ATOMIC_RELEASE, "agent");
            asm volatile("s_waitcnt vmcnt(0)" ::: "memory");
            const unsigned og = xb_add(&bar[XB_TOP], 1u);
            const unsigned tg = og / nx;
            if (og + 1u == (tg + 1u) * nx) xb_add(&bar[XB_TOPGEN], 1u);
            else XB_SPIN(xb_ld(&bar[XB_TOPGEN]) == tg, bar);
            __builtin_amdgcn_fence(__ATOMIC_ACQUIRE, "agent");
            xb_add(&bar[XB_XGEN(b.x)], 1u);
            asm volatile("s_waitcnt vmcnt(0)" ::: "memory");
        } else {
            XB_SPIN(xb_ld(&bar[XB_XGEN(b.x)]) == gen, bar);
            __builtin_amdgcn_fence(__ATOMIC_ACQUIRE, "agent");
            asm volatile("s_waitcnt vmcnt(0)" ::: "memory");
        }
    }
    __syncthreads();
}

struct Args { const float* in[18]; float* out; unsigned char* ws; int ph_lo, ph_hi; };
struct Frame {
    LAS unsigned char* lds;
    volatile LAS unsigned* MISC;
    unsigned* ctl;
    int tid, lane, wave, G;
    float* out;
    unsigned char* ws;
};
enum { I_X = 0, I_RELB, I_ENORM, I_EWIN, I_LQ1, I_LK1, I_LQ2, I_LK2, I_SUBLN, I_EWO, I_ONORM, I_OWIN, I_OQNORM, I_OWUQ, I_OKVNORM, I_OWUKV, I_OWO, I_FNORM };

__device__ __forceinline__ int t5_bucket(int rel) {
    const int n = rel < 0 ? -rel : rel;
    const int v = n < 8 ? n : n < 12 ? 8 : n < 16 ? 9 : n < 23 ? 10 : n < 32 ? 11 : n < 46 ? 12 : n < 64 ? 13 : n < 91 ? 14 : 15;
    return (rel > 0 ? 16 : 0) + v;
}

__device__ __forceinline__ int wsrc_col(int mat, int n) {
    switch (mat) {
        case 0: return n < 2760 ? n : (n < C_G0 ? -1 : n - 56);
        case 2: return n < 256 ? 384 + n : (n < 640 ? n - 256 : (n < 672 ? n : (n < 768 ? -1 : n - 96)));
        default: return n;
    }
}
__device__ __forceinline__ float wcol_scale(int mat, int n) {
    if (mat == 0) return (n < 512 || (n >= C_QB && n < C_QB + 512)) ? QS_AB : 1.0f;
    if (mat == 3) return QS_C;
    return 1.0f;
}
__device__ __forceinline__ void p0_transpose_item(const float* W, int K, int Nsrc, int Npad, const float* gain, int mat, u16* WT, LAS float* scr, int item, int lane) {
    const int nblk = Npad / 32, kb = item / nblk, nb = item % nblk, k0 = 64 * kb, n0 = 32 * nb;
    const int n = n0 + (lane & 31); const int sc = wsrc_col(mat, n); const float cs = wcol_scale(mat, n);
#pragma unroll 8
    for (int i = 0; i < 32; ++i) { const int kk = 2 * i + (lane >> 5); float v = 0.f;
        if (sc >= 0) { v = W[(size_t)(k0 + kk) * Nsrc + sc] * cs; if (gain) v *= gain[k0 + kk]; }
        scr[kk * 33 + (lane & 31)] = v; }
    LDS_WAIT(); asm volatile("" ::: "memory");
    const int c = lane & 7;
#pragma unroll
    for (int j = 0; j < 4; ++j) { const int nn = (lane >> 3) + 8 * j; const LAS float* s = scr + (8 * c) * 33 + nn;
        u32x4 o; o.x = pkh(s[0 * 33], s[1 * 33]); o.y = pkh(s[2 * 33], s[3 * 33]); o.z = pkh(s[4 * 33], s[5 * 33]); o.w = pkh(s[6 * 33], s[7 * 33]);
        *(u32x4*)(WT + (size_t)(n0 + nn) * K + k0 + 8 * c) = o; }
    LDS_WAIT(); asm volatile("" ::: "memory");
}
__device__ __forceinline__ void p0_prologue(Frame& F, const Args& AR) {
    LAS float* scr = (LAS float*)(F.lds + F.wave * 16384);
    const int gw = blockIdx.x * NWAVES + F.wave, NGW = F.G * NWAVES;
    unsigned char* ws = F.ws;
    constexpr int I0 = (1024 / 64) * (P0W / 32), I1 = (1024 / 64) * (1024 / 32), I2 = (1024 / 64) * (P1W / 32), I3 = (384 / 64) * (1536 / 32), I4 = (256 / 64) * (2048 / 32), I5 = I1;
    constexpr int NITEMS = I0 + I1 + I2 + I3 + I4 + I5;
    for (int it = gw; it < NITEMS; it += NGW) {
        int r = it;
        if (r < I0) { p0_transpose_item(AR.in[I_EWIN], 1024, L0_SRC, P0W, nullptr, 0, (u16*)(ws + WS_W0T), scr, r, F.lane); continue; } r -= I0;
        if (r < I1) { p0_transpose_item(AR.in[I_EWO], 1024, 1024, 1024, nullptr, 1, (u16*)(ws + WS_WO0T), scr, r, F.lane); continue; } r -= I1;
        if (r < I2) { p0_transpose_item(AR.in[I_OWIN], 1024, L1_SRC, P1W, AR.in[I_ONORM], 2, (u16*)(ws + WS_W1T), scr, r, F.lane); continue; } r -= I2;
        if (r < I3) { p0_transpose_item(AR.in[I_OWUQ], 384, 1536, 1536, AR.in[I_OQNORM], 3, (u16*)(ws + WS_WUQT), scr, r, F.lane); continue; } r -= I3;
        if (r < I4) { p0_transpose_item(AR.in[I_OWUKV], 256, 2048, 2048, AR.in[I_OKVNORM], 4, (u16*)(ws + WS_WUKVT), scr, r, F.lane); continue; } r -= I4;
        p0_transpose_item(AR.in[I_OWO], 1024, 1024, 1024, nullptr, 5, (u16*)(ws + WS_WO1T), scr, r, F.lane);
    }
    {
        const float* gn = AR.in[I_ENORM]; f32x4 gv[4];
#pragma unroll
        for (int j = 0; j < 4; ++j) gv[j] = *(const f32x4*)(gn + 4 * F.lane + 256 * j);
        u16* XN = (u16*)(ws + WS_XN0);
        for (int mrow = gw; mrow < T; mrow += NGW) {
            const f32x4* xr = (const f32x4*)(AR.in[I_X] + (size_t)mrow * DM) + F.lane;
            f32x4 v[4]; float s = 0.f;
#pragma unroll
            for (int j = 0; j < 4; ++j) { v[j] = xr[64 * j]; s += (v[j].x * v[j].x + v[j].y * v[j].y) + (v[j].z * v[j].z + v[j].w * v[j].w); }
            const float rstd = __builtin_amdgcn_rsqf(wave_sum(s) * (1.f / DM) + RMS_EPS);
            u32x2* o8 = (u32x2*)(XN + (size_t)mrow * DM) + F.lane;
#pragma unroll
            for (int j = 0; j < 4; ++j) { const f32x4 t = v[j] * rstd * gv[j]; u32x2 w; w.x = pkh(t.x, t.y); w.y = pkh(t.z, t.w); o8[64 * j] = w; }
        }
    }
    {
        float* rc = (float*)(ws + WS_ROPEC); float* rs = (float*)(ws + WS_ROPES);
        const int gt = blockIdx.x * 512 + F.tid, NGT = F.G * 512;
        for (int e = gt; e < SEQ * 16; e += NGT) { const int pos = e >> 4, i = e & 15;
            const float inv = (float)pow(10000.0, -(double)i / 16.0); const float ang = (float)pos * inv;
            rc[e] = (float)cos((double)ang); rs[e] = (float)sin((double)ang); }
        float* bt = (float*)(ws + WS_BTG);
        for (int e = gt; e < 12 * 192; e += NGT) { const int hd = e / 192, idx = e % 192; const int rel = idx - 128;
            bt[e] = AR.in[I_RELB][t5_bucket(rel) * 12 + hd] * LOG2E; }
        if (blockIdx.x == 0 && F.wave == 0) {
            const float a = wave_sum(AR.in[I_LQ1][F.lane] * AR.in[I_LK1][F.lane]), b = wave_sum(AR.in[I_LQ2][F.lane] * AR.in[I_LK2][F.lane]);
            if (F.lane == 0) *(float*)(ws + WS_LAM) = expf(a) - expf(b) + 0.2f;
        }
    }
}

__device__ __forceinline__ h8 tr2(LAS const unsigned char* p0, LAS const unsigned char* p1) {
    const s16x4 lo = __builtin_amdgcn_ds_read_tr16_b64_v4i16((LAS s16x4*)p0), hi = __builtin_amdgcn_ds_read_tr16_b64_v4i16((LAS s16x4*)p1);
    const s16x8 v = __builtin_shufflevector(lo, hi, 0, 1, 2, 3, 4, 5, 6, 7); return __builtin_bit_cast(h8, v);
}
constexpr float SM_THR = 8.0f;
__device__ __forceinline__ float max3f(float a, float b, float c) { float r; asm("v_max3_f32 %0, %1, %2, %3" : "=v"(r) : "v"(a), "v"(b), "v"(c)); return r; }
template <int ND, bool MASKED>
__device__ __forceinline__ void softmax_step(f32x16& p0, f32x16& p1, float& mref, float& lrun, bool& have, f32x16 (&o)[ND], h8 (&pf)[4]) {
    float mx = fmaxf(fmaxf(p0[0], p1[0]), fmaxf(p0[1], p1[1]));
#pragma unroll
    for (int r = 2; r < 16; r += 2) mx = fmaxf(mx, fmaxf(fmaxf(p0[r], p1[r]), fmaxf(p0[r + 1], p1[r + 1])));
    mx = swap_max(mx);
    const bool valid = MASKED ? (mx > -1e29f) : true;
    const bool trig = valid && (!have || mx > SM_THR);
    if (__any(trig)) {
        const float dl = valid ? (have ? fmaxf(mx, 0.f) : mx) : 0.f;
        have = have || valid;
        mref += dl;
        const float alpha = __builtin_amdgcn_exp2f(-dl);
        lrun *= alpha;
#pragma unroll
        for (int r = 0; r < 16; ++r) { p0[r] -= dl; p1[r] -= dl; }
#pragma unroll
        for (int d = 0; d < ND; ++d)
#pragma unroll
            for (int r = 0; r < 16; ++r) o[d][r] *= alpha;
    }
    float s0 = 0.f, s1 = 0.f;
#pragma unroll
    for (int r = 0; r < 16; ++r) { p0[r] = __builtin_amdgcn_exp2f(p0[r]); p1[r] = __builtin_amdgcn_exp2f(p1[r]); s0 += p0[r]; s1 += p1[r]; }
    lrun += s0 + s1;
#pragma unroll
    for (int ks = 0; ks < 4; ++ks) {
        u32x4 w;
        if (ks < 2) { w.x = pkh(p0[8 * ks + 0], p0[8 * ks + 1]); w.y = pkh(p0[8 * ks + 2], p0[8 * ks + 3]); w.z = pkh(p0[8 * ks + 4], p0[8 * ks + 5]); w.w = pkh(p0[8 * ks + 6], p0[8 * ks + 7]); }
        else { const int k2 = ks - 2; w.x = pkh(p1[8 * k2 + 0], p1[8 * k2 + 1]); w.y = pkh(p1[8 * k2 + 2], p1[8 * k2 + 3]); w.z = pkh(p1[8 * k2 + 4], p1[8 * k2 + 5]); w.w = pkh(p1[8 * k2 + 6], p1[8 * k2 + 7]); }
        pf[ks] = __builtin_bit_cast(h8, w);
    }
}
__device__ __forceinline__ void add_bias(f32x16& p0, f32x16& p1, const LAS float* bt, int idx0) {
#pragma unroll
    for (int r = 0; r < 16; ++r) { const int c = (r & 3) + 8 * (r >> 2);
        const int i0 = idx0 + c, i1 = idx0 + 32 + c;
        p0[r] += bt[i0 < 0 ? 0 : i0]; p1[r] += bt[i1 < 0 ? 0 : i1]; }
}
__device__ __forceinline__ int next_unit(Frame& F, int cw) {
    volatile LAS unsigned* slot = F.MISC + 16;
    __syncthreads();
    if (F.tid == 0) slot[0] = __hip_atomic_fetch_add(F.ctl + cw, 1u, __ATOMIC_RELAXED, __HIP_MEMORY_SCOPE_AGENT);
    __syncthreads();
    return (int)slot[0];
}

__device__ __forceinline__ void attnA_unit(Frame& F, const Args& AR, int b, int h, int qb) {
    LAS unsigned char* lds = F.lds;
    int tid = F.tid; asm volatile("" : "+v"(tid)); int wid = F.wave; asm volatile("" : "+s"(wid));
    const int lane = tid & 63, r32 = lane & 31, hi = lane >> 5;
    const int m = wid & 1, qsub = wid >> 1, q0 = 128 * qb + 32 * qsub, cw = q0 >> 6, nt = 2 * qb + 2;
    const size_t rowb = (size_t)b * SEQ;
    const u16* P0 = (const u16*)(F.ws + WS_PROJ0);
    LAS float* bt = (LAS float*)(lds + 65536);
    if (tid < 192) bt[tid] = ((const float*)(F.ws + WS_BTG))[h * 192 + tid];
    h8 qf[4];
    { const u16* qp = P0 + (rowb + q0 + r32) * P0W + C_QA + h * 128 + m * 64 + hi * 8;
#pragma unroll
      for (int d0 = 0; d0 < 4; ++d0) qf[d0] = *(const h8*)(qp + d0 * 16); }
    f32x16 o[4];
#pragma unroll
    for (int d = 0; d < 4; ++d)
#pragma unroll
        for (int r = 0; r < 16; ++r) o[d][r] = 0.f;
    float mrun = 0.f, lrun = 0.f; bool have = false;
    const int krow = tid >> 3, kch = tid & 7, vrow = tid >> 4, vch = tid & 15;
    const u16* ksrc = P0 + (rowb + krow) * P0W + C_KA + h * 128 + kch * 8;
    const u16* vsrc = P0 + (rowb + vrow) * P0W + C_VA + h * 128 + vch * 8;
    const int kdst = krow * 128 + ((kch ^ ((krow >> 1) & 7)) << 4);
    const int vdst = 16384 + vrow * 256 + ((vch ^ ((vrow & 3) << 2)) << 4);
    u32x4 st0, st1, st2, st3;
#define A_LOAD(t) do { const size_t to = (size_t)(t) * 64 * P0W; st0 = *(const u32x4*)(ksrc + to); st1 = *(const u32x4*)(ksrc + to + 64); st2 = *(const u32x4*)(vsrc + to); st3 = *(const u32x4*)(vsrc + to + (size_t)32 * P0W); } while (0)
#define A_WRITE(s) do { LAS unsigned char* sb = lds + (s) * 32768; *(LAS u32x4*)(sb + kdst) = st0; *(LAS u32x4*)(sb + 8192 + kdst) = st1; *(LAS u32x4*)(sb + vdst) = st2; *(LAS u32x4*)(sb + vdst + 32 * 256) = st3; } while (0)
    const int kfo = r32 * 128, ksw = (r32 >> 1) & 7;
    const int i16 = lane & 15, qrow = i16 >> 2, pp = i16 & 3, g16 = (lane >> 4) & 1;
    const int vlane = (4 * hi + qrow) * 256 + ((2 * g16 + (pp >> 1)) << 4) + 8 * (pp & 1);
    const int qglob = q0 + r32;
    A_LOAD(0); A_WRITE(0); __syncthreads();
    for (int t = 0; t < nt; ++t) {
        if (t + 1 < nt) A_LOAD(t + 1);
        if (t <= cw) {
            LAS const unsigned char* sb = lds + (t & 1) * 32768; LAS const unsigned char* kb = sb + m * 8192 + kfo; LAS const unsigned char* vb = sb + 16384 + vlane;
            const bool nearb = (64 * t + 63 - q0) > -128;
            const float c0 = (nearb ? 0.f : bt[0]) - mrun;
            f32x16 p0, p1;
#pragma unroll
            for (int r = 0; r < 16; ++r) { p0[r] = c0; p1[r] = c0; }
#pragma unroll
            for (int d0 = 0; d0 < 4; ++d0) { const int co = ((2 * d0 + hi) ^ ksw) << 4;
                const h8 ka = *(LAS const h8*)(kb + co), kc = *(LAS const h8*)(kb + 4096 + co);
                p0 = __builtin_amdgcn_mfma_f32_32x32x16_f16(ka, qf[d0], p0, 0, 0, 0); p1 = __builtin_amdgcn_mfma_f32_32x32x16_f16(kc, qf[d0], p1, 0, 0, 0); }
            if (nearb) add_bias(p0, p1, bt, 64 * t + 4 * hi - qglob + 128);
            h8 pf[4];
            softmax_step<4, false>(p0, p1, mrun, lrun, have, o, pf);
#pragma unroll
            for (int d0 = 0; d0 < 4; ++d0) { const int dx = (d0 ^ qrow) << 6;
#pragma unroll
                for (int ks = 0; ks < 4; ++ks) { const h8 vf = tr2(vb + ks * 4096 + dx, vb + ks * 4096 + 2048 + dx);
                    o[d0] = __builtin_amdgcn_mfma_f32_32x32x16_f16(vf, pf[ks], o[d0], 0, 0, 0); } }
        }
        if (t + 1 < nt) A_WRITE((t + 1) & 1);
        __syncthreads();
    }
#undef A_LOAD
#undef A_WRITE
    const float linv = 1.0f / swap_sum(lrun);
    LAS f32x4* xb = (LAS f32x4*)(lds + qsub * 16384);
    if (m == 1) {
#pragma unroll
        for (int d0 = 0; d0 < 4; ++d0)
#pragma unroll
            for (int g = 0; g < 4; ++g) { f32x4 v = {o[d0][4 * g] * linv, o[d0][4 * g + 1] * linv, o[d0][4 * g + 2] * linv, o[d0][4 * g + 3] * linv};
                xb[(8 * d0 + 2 * g + hi) * 32 + r32] = v; }
    }
    __syncthreads();
    if (m == 0) {
        const float lam = *(const float*)(F.ws + WS_LAM);
        float ss = 0.f;
#pragma unroll
        for (int d0 = 0; d0 < 4; ++d0)
#pragma unroll
            for (int g = 0; g < 4; ++g) { const f32x4 v1 = xb[(8 * d0 + 2 * g + hi) * 32 + r32];
#pragma unroll
                for (int e = 0; e < 4; ++e) { const float v = o[d0][4 * g + e] * linv - lam * v1[e]; o[d0][4 * g + e] = v; ss += v * v; } }
        ss = swap_sum(ss);
        const float rs = __builtin_amdgcn_rsqf(ss * (1.0f / 128.0f) + RMS_EPS) * 0.8f;
        const size_t row = rowb + qglob;
        const u16* gp = P0 + row * P0W + C_G0 + h * 128;
        u16* op = (u16*)(F.ws + WS_MG0) + row * DM + h * 128;
        const float* sg = AR.in[I_SUBLN];
#pragma unroll
        for (int d0 = 0; d0 < 4; ++d0)
#pragma unroll
            for (int g = 0; g < 4; ++g) { const int d = 32 * d0 + 8 * g + 4 * hi;
                const h4 gv = *(const h4*)(gp + d); const f32x4 sv = *(const f32x4*)(sg + d);
                u32x2 w; w.x = pkh(o[d0][4 * g] * rs * sv[0] * (float)gv[0], o[d0][4 * g + 1] * rs * sv[1] * (float)gv[1]);
                w.y = pkh(o[d0][4 * g + 2] * rs * sv[2] * (float)gv[2], o[d0][4 * g + 3] * rs * sv[3] * (float)gv[3]);
                *(u32x2*)(op + d) = w; }
    }
}

constexpr int B_XROW = 1028, B_MASK = 66560, B_QF = 82944, B_BT = 99328;
__device__ __forceinline__ float next_up(float x) { if (x == 0.f) return __uint_as_float(1u); const unsigned u = __float_as_uint(x); return __uint_as_float(x > 0.f ? u + 1u : u - 1u); }
template <int OP> __device__ __forceinline__ float hw_red_f(float v) {
#define HWR_STEP(ctrl) { const float o_ = __uint_as_float((unsigned)__builtin_amdgcn_update_dpp(0, (int)__float_as_uint(v), ctrl, 0xf, 0xf, false)); v = OP ? fmaxf(v, o_) : fminf(v, o_); }
    HWR_STEP(0xB1) HWR_STEP(0x4E) HWR_STEP(0x141) HWR_STEP(0x140)
#undef HWR_STEP
    const float o2 = __shfl_xor(v, 16); return OP ? fmaxf(v, o2) : fminf(v, o2);
}
__device__ __forceinline__ unsigned hw_sum_u(unsigned v) {
#define HWS_STEP(ctrl) v += (unsigned)__builtin_amdgcn_update_dpp(0, (int)v, ctrl, 0xf, 0xf, false);
    HWS_STEP(0xB1) HWS_STEP(0x4E) HWS_STEP(0x141) HWS_STEP(0x140)
#undef HWS_STEP
    return v + (unsigned)__shfl_xor((int)v, 16);
}
__device__ __forceinline__ void selB_16(Frame& F, int b, int c, int q0, int mrow0, int abl = 0) {
    LAS unsigned char* lds = F.lds;
    int tid = F.tid; asm volatile("" : "+v"(tid)); int wid = F.wave; asm volatile("" : "+s"(wid));
    const int lane = tid & 63, ql = lane & 15, g = lane >> 4, l31 = lane & 31, hq = lane >> 5;
    const size_t rowb = (size_t)b * SEQ;
    const u16* P0 = (const u16*)(F.ws + WS_PROJ0);
    const int NT16 = 4 * (c + 1), N = 64 * (c + 1);
    if (c < 4) {
        for (int e = tid; e < 16 * (c + 1); e += 512) { const int q = e / (c + 1), t = e % (c + 1); *(LAS u64*)(lds + B_MASK + ((mrow0 + q) * 64 + t) * 8) = ~0ull; }
        return;
    }
    LAS h8* qfl = (LAS h8*)(lds + B_QF);
#pragma unroll
    for (int i = 0; i < 2; ++i) { const int idx = tid + 512 * i, fg = idx >> 6, ln = idx & 63, hh = fg >> 1, ks = fg & 1;
        qfl[idx] = *(const h8*)(P0 + (rowb + q0 + (ln & 15)) * P0W + C_QI + hh * 64 + 32 * ks + 8 * (ln >> 4)); }
    float wq[8];
    { const h8 wv = *(const h8*)(P0 + (rowb + q0 + ql) * P0W + C_WI);
#pragma unroll
      for (int i = 0; i < 8; ++i) wq[i] = (float)wv[i]; }
    __syncthreads();
    float sc[128]; float mn = INFINITY, mxv = -INFINITY;
    LAS float* X = (LAS float*)lds;
    const u16* kp = P0 + (rowb + ql) * P0W + C_KI + 8 * g;
    const int nq = (N + 1023) >> 10;
#pragma unroll
    for (int qr = 0; qr < 4; ++qr) {
        if (qr < nq) {
            h8 ka[2][2], kn[2][2];
#pragma unroll
            for (int u = 0; u < 2; ++u) { const int j = 64 * qr + wid + 8 * u; const int jc = j < NT16 ? j : 0;
                ka[u][0] = *(const h8*)(kp + (size_t)(16 * jc) * P0W); ka[u][1] = *(const h8*)(kp + (size_t)(16 * jc) * P0W + 32); }
#pragma unroll
            for (int gq = 0; gq < 4; ++gq) {
                if (64 * qr + wid + 16 * gq < NT16) {
                    if (gq < 3) {
#pragma unroll
                        for (int u = 0; u < 2; ++u) { const int j = 64 * qr + wid + 8 * (2 * gq + 2 + u); const int jc = j < NT16 ? j : 0;
                            kn[u][0] = *(const h8*)(kp + (size_t)(16 * jc) * P0W); kn[u][1] = *(const h8*)(kp + (size_t)(16 * jc) * P0W + 32); } }
                    f32x4 s4[2] = {{0.f, 0.f, 0.f, 0.f}, {0.f, 0.f, 0.f, 0.f}};
                    h8 qc0 = qfl[lane], qc1 = qfl[64 + lane];
#pragma unroll
                    for (int hh = 0; hh < 8; ++hh) {
                        h8 qn0 = qc0, qn1 = qc1;
                        if (hh < 7) { qn0 = qfl[((hh + 1) * 2 + 0) * 64 + lane]; qn1 = qfl[((hh + 1) * 2 + 1) * 64 + lane]; }
                        f32x4 ac0 = {0.f, 0.f, 0.f, 0.f}, ac1 = {0.f, 0.f, 0.f, 0.f};
                        ac0 = __builtin_amdgcn_mfma_f32_16x16x32_f16(ka[0][0], qc0, ac0, 0, 0, 0);
                        ac1 = __builtin_amdgcn_mfma_f32_16x16x32_f16(ka[1][0], qc0, ac1, 0, 0, 0);
                        ac0 = __builtin_amdgcn_mfma_f32_16x16x32_f16(ka[0][1], qc1, ac0, 0, 0, 0);
                        ac1 = __builtin_amdgcn_mfma_f32_16x16x32_f16(ka[1][1], qc1, ac1, 0, 0, 0);
#pragma unroll
                        for (int r = 0; r < 4; ++r) { s4[0][r] += wq[hh] * __int_as_float(max(__float_as_int(ac0[r]), 0)); s4[1][r] += wq[hh] * __int_as_float(max(__float_as_int(ac1[r]), 0)); }
                        qc0 = qn0; qc1 = qn1;
                    }
#pragma unroll
                    for (int u = 0; u < 2; ++u) { const int m = 2 * gq + u; if (64 * qr + wid + 8 * m < NT16) *(LAS f32x4*)(X + ql * B_XROW + 16 * (wid + 8 * m) + 4 * g) = s4[u]; }
#pragma unroll
                    for (int u = 0; u < 2; ++u) { ka[u][0] = kn[u][0]; ka[u][1] = kn[u][1]; }
                }
            }
            {
            __syncthreads();
            { LAS const float* xr = X + (2 * wid + hq) * B_XROW + l31;
#pragma unroll
              for (int i = 0; i < 32; ++i) { if (1024 * qr + 32 * i < N) { const float v = xr[32 * i]; sc[32 * qr + i] = v; mn = fminf(mn, v); mxv = fmaxf(mxv, v); } else sc[32 * qr + i] = -INFINITY; } }
            __syncthreads(); }
        } else {
#pragma unroll
            for (int i = 0; i < 32; ++i) sc[32 * qr + i] = -INFINITY;
        }
    }
    float lo = hw_red_f<0>(mn), hi = next_up(hw_red_f<1>(mxv));
    unsigned clo = (unsigned)N, chi = 0u;
    if (abl != 6) {
        const float smn = lo, smx = hw_red_f<1>(mxv);
        LAS unsigned* H = (LAS unsigned*)lds + (2 * wid + hq) * 1024;
        LAS unsigned* CS = (LAS unsigned*)(lds + B_QF) + (2 * wid + hq) * 32;
#pragma unroll
        for (int i = 0; i < 32; ++i) H[l31 + 32 * i] = 0u;
        const float scale = 1023.5f / fmaxf(smx - smn, 1e-30f), nsm = -smn * scale;
#pragma unroll
        for (int e = 0; e < 128; ++e) { if (32 * e < N) { int bin = (int)__builtin_fmaf(sc[e], scale, nsm); bin = bin > 1023 ? 1023 : (bin < 0 ? 0 : bin);
            __hip_atomic_fetch_add(H + bin, 1u, __ATOMIC_RELAXED, __HIP_MEMORY_SCOPE_WORKGROUP); } }
        asm volatile("s_waitcnt lgkmcnt(0)" ::: "memory");
        unsigned hw[32]; unsigned cl = 0u;
#pragma unroll
        for (int i = 0; i < 8; ++i) { const u32x4 v = *(LAS const u32x4*)(H + 32 * l31 + 4 * i); hw[4 * i] = v.x; hw[4 * i + 1] = v.y; hw[4 * i + 2] = v.z; hw[4 * i + 3] = v.w; cl += (v.x + v.y) + (v.z + v.w); }
        CS[l31] = cl;
        asm volatile("s_waitcnt lgkmcnt(0)" ::: "memory");
        unsigned ssuf = 0u;
#pragma unroll
        for (int i = 0; i < 8; ++i) { const u32x4 v = *(LAS const u32x4*)(CS + 4 * i);
            ssuf += (4 * i >= l31 ? v.x : 0u) + (4 * i + 1 >= l31 ? v.y : 0u) + (4 * i + 2 >= l31 ? v.z : 0u) + (4 * i + 3 >= l31 ? v.w : 0u); }
        const bool flag = ssuf >= (unsigned)TOPK && (ssuf - cl) < (unsigned)TOPK;
        unsigned run = ssuf - cl, bstar = 0u, above = 0u, cntb = 0u; bool found = false;
#pragma unroll
        for (int w = 31; w >= 0; --w) { run += hw[w]; if (!found && run >= (unsigned)TOPK) { found = true; bstar = 32u * l31 + (unsigned)w; above = run - hw[w]; cntb = hw[w]; } }
        const unsigned long long fb = __ballot(flag);
        const int src = hq ? 32 + __builtin_ctz((unsigned)(fb >> 32) | 0x80000000u) : __builtin_ctz((unsigned)fb | 0x80000000u);
        bstar = (unsigned)__shfl((int)bstar, src); above = (unsigned)__shfl((int)above, src); cntb = (unsigned)__shfl((int)cntb, src);
        if (smx > smn) {
            const float inv = (smx - smn) * (1.0f / 1023.5f);
            const float l2 = smn + ((float)bstar - 0.01f) * inv, h2 = smn + ((float)bstar + 1.01f) * inv;
            if (l2 > lo) { lo = l2; clo = above + cntb; }
            if (h2 < hi) { hi = h2; chi = above; }
        }
    }
#define SEL_LTBITS(W, P) do { _Pragma("unroll") for (int w_ = 0; w_ < 4; ++w_) { unsigned a_ = 0u; _Pragma("unroll") for (int k_ = 0; k_ < 32; ++k_) \
        a_ = __builtin_amdgcn_alignbit(a_, __float_as_uint(sc[32 * w_ + k_] - (P)), 31); W[w_] = a_; } } while (0)
    bool done = false, tie = false; float Tv = 0.f;
#define SEL_STEP(it_) do { \
        float mid = lo + (hi - lo) * 0.5f; \
        if ((it_) < 2 && clo > chi + 16u) { const float xi = lo + (hi - lo) * ((float)clo - 255.5f) / (float)(clo - chi); if (xi > lo && xi < hi) mid = xi; } \
        if (!done && !(mid > lo && mid < hi)) { done = true; tie = true; Tv = lo; } \
        const float pv = done ? Tv : mid; \
        unsigned ltw[4]; SEL_LTBITS(ltw, pv); \
        const unsigned tot = hw_sum_u(128u - (unsigned)(__builtin_popcount(ltw[0]) + __builtin_popcount(ltw[1]) + __builtin_popcount(ltw[2]) + __builtin_popcount(ltw[3]))); \
        if (!done) { if (tot == (unsigned)TOPK) { done = true; Tv = mid; } else if (tot > (unsigned)TOPK) { lo = mid; clo = tot; } else { hi = mid; chi = tot; } } } while (0)
    const int it_cap = (abl == 6 ? 1 : abl == 10 ? 6 : abl == 11 ? 12 : 200);
    int it = 0;
    for (; it < 8 && it < it_cap; ++it) { SEL_STEP(it); if (__all(done)) break; }
    if (!__all(done) && it_cap > 8) {
        float p0 = INFINITY, p1 = -INFINITY;
#pragma unroll
        for (int e = 0; e < 128; ++e) { const float sv = sc[e]; p0 = fminf(p0, sv >= lo ? sv : INFINITY); p1 = fmaxf(p1, sv < hi ? sv : -INFINITY); }
        p0 = hw_red_f<0>(p0); p1 = hw_red_f<1>(p1);
        if (!done && p0 == p1) { done = true; tie = true; Tv = p0; }
        for (; it < it_cap; ++it) { if (__all(done)) break; SEL_STEP(8); }
    }
#undef SEL_STEP
    if (abl == 6 || abl == 10 || abl == 11) tie = false;
    unsigned selw[4];
    { unsigned ltw[4]; SEL_LTBITS(ltw, Tv);
#pragma unroll
      for (int w = 0; w < 4; ++w) selw[w] = __builtin_bitreverse32(~ltw[w]); }
    if (__any(tie)) {
        unsigned eqw[4];
        { unsigned lew[4]; const float tn = next_up(Tv); SEL_LTBITS(lew, tn);
#pragma unroll
          for (int w = 0; w < 4; ++w) eqw[w] = __builtin_bitreverse32(lew[w]) & selw[w]; }
        const unsigned rneed = (unsigned)TOPK - chi;
        int ilo = -1, ihi = N - 1, icut = N; bool tdone = !tie;
        for (int it = 0; it < 40; ++it) {
            const int imid = (ilo + ihi) >> 1;
            if (!tdone && (ihi - ilo) <= 1) { tdone = true; icut = ihi; }
            const int iv = (tdone ? icut : imid) - l31;
            const int nle = iv < 0 ? 0 : min(128, (iv >> 5) + 1);
            unsigned cnt = 0u;
#pragma unroll
            for (int w = 0; w < 4; ++w) { const int nw = min(max(nle - 32 * w, 0), 32); const unsigned mk = nw >= 32 ? 0xffffffffu : ((1u << nw) - 1u); cnt += (unsigned)__builtin_popcount(eqw[w] & mk); }
            const unsigned tot = hw_sum_u(cnt);
            if (!tdone) { if (tot == rneed) { tdone = true; icut = imid; } else if (tot < rneed) ilo = imid; else ihi = imid; }
            if (__all(tdone)) break;
        }
        if (tie) {
            const int iv = icut - l31; const int nle = iv < 0 ? 0 : min(128, (iv >> 5) + 1);
#pragma unroll
            for (int w = 0; w < 4; ++w) { const int nw = min(max(nle - 32 * w, 0), 32); const unsigned mk = nw >= 32 ? 0xffffffffu : ((1u << nw) - 1u); selw[w] = (selw[w] & ~eqw[w]) | (eqw[w] & mk); }
        }
    }
#undef SEL_LTBITS
    LAS unsigned* mrow = (LAS unsigned*)(lds + B_MASK) + (mrow0 + 2 * wid + hq) * 128;
#pragma unroll
    for (int w = 0; w < 4; ++w) {
        unsigned x = selw[w];
#define TR_STEP(S, MK) { const unsigned y_ = (unsigned)__shfl_xor((int)x, S); x = (l31 & S) ? ((x & ~(MK)) | ((y_ >> S) & (MK))) : ((x & (MK)) | ((y_ << S) & ~(MK))); }
        TR_STEP(16, 0x0000ffffu) TR_STEP(8, 0x00ff00ffu) TR_STEP(4, 0x0f0f0f0fu) TR_STEP(2, 0x33333333u) TR_STEP(1, 0x55555555u)
#undef TR_STEP
        if (32 * (32 * w + l31) < N) mrow[32 * w + l31] = x;
    }
}
__device__ __forceinline__ void attnB_unit(Frame& F, int b, int qb32, int mode = 0) {
    LAS unsigned char* lds = F.lds;
    int tid = F.tid; asm volatile("" : "+v"(tid)); int wid = F.wave; asm volatile("" : "+s"(wid));
    const int lane = tid & 63, r32 = lane & 31, hi = lane >> 5;
    const int q0 = 32 * qb32, c = q0 >> 6, nt = c + 1;
    const size_t rowb = (size_t)b * SEQ;
    const u16* P0 = (const u16*)(F.ws + WS_PROJ0);
    if (mode != 3) {
#pragma unroll 1
        for (int s2 = 0; s2 < 2; ++s2) { selB_16(F, b, c, q0 + 16 * s2, 16 * s2, mode); __syncthreads(); }
    }
    if (mode >= 4) return;
    LAS float* bt = (LAS float*)(lds + B_BT) + wid * 192;
    for (int e = tid; e < 8 * 192; e += 512) ((LAS float*)(lds + B_BT))[e] = ((const float*)(F.ws + WS_BTG))[4 * 192 + e];
    h8 qf[4];
    { const u16* qp = P0 + (rowb + q0 + r32) * P0W + C_QB + wid * 64 + hi * 8;
#pragma unroll
      for (int d0 = 0; d0 < 4; ++d0) qf[d0] = *(const h8*)(qp + d0 * 16); }
    f32x16 o[2];
#pragma unroll
    for (int d = 0; d < 2; ++d)
#pragma unroll
        for (int r = 0; r < 16; ++r) o[d][r] = 0.f;
    float mrun = 0.f, lrun = 0.f; bool have = false;
    const int krow = tid >> 3, kch = tid & 7;
    const u16* ksrc = P0 + (rowb + krow) * P0W + C_KB + kch * 8;
    const int kdst = krow * 128 + ((kch ^ ((krow >> 1) & 7)) << 4);
    const int vdst = 8192 + krow * 128 + ((kch ^ (((krow >> 1) & 1) << 2)) << 4);
    u32x4 st0, st1;
#define B_LOAD(t) do { const size_t to = (size_t)(t) * 64 * P0W; st0 = *(const u32x4*)(ksrc + to); st1 = *(const u32x4*)(ksrc + to + 64); } while (0)
#define B_WRITE(s) do { LAS unsigned char* sb = lds + (s) * 16384; *(LAS u32x4*)(sb + kdst) = st0; *(LAS u32x4*)(sb + vdst) = st1; } while (0)
    const int kfo = r32 * 128, ksw = (r32 >> 1) & 7;
    const int i16 = lane & 15, qrow = i16 >> 2, pp = i16 & 3, g16 = (lane >> 4) & 1;
    const int vlane = (4 * hi + qrow) * 128 + ((2 * g16 + (pp >> 1)) << 4) + 8 * (pp & 1);
    const int qglob = q0 + r32;
    B_LOAD(0); B_WRITE(0); __syncthreads();
    for (int t = 0; t < nt; ++t) {
        if (t + 1 < nt) B_LOAD(t + 1);
        {
            LAS const unsigned char* sb = lds + (t & 1) * 16384; LAS const unsigned char* kb = sb + kfo; LAS const unsigned char* vb = sb + 8192 + vlane;
            const bool nearb = (64 * t + 63 - q0) > -128;
            const float c0 = (nearb ? 0.f : bt[0]) - mrun;
            f32x16 p0, p1;
#pragma unroll
            for (int r = 0; r < 16; ++r) { p0[r] = c0; p1[r] = c0; }
#pragma unroll
            for (int d0 = 0; d0 < 4; ++d0) { const int co = ((2 * d0 + hi) ^ ksw) << 4;
                const h8 ka = *(LAS const h8*)(kb + co), kc = *(LAS const h8*)(kb + 4096 + co);
                p0 = __builtin_amdgcn_mfma_f32_32x32x16_f16(ka, qf[d0], p0, 0, 0, 0); p1 = __builtin_amdgcn_mfma_f32_32x32x16_f16(kc, qf[d0], p1, 0, 0, 0); }
            if (nearb) add_bias(p0, p1, bt, 64 * t + 4 * hi - qglob + 128);
            const u64 mw = *(LAS const u64*)(lds + B_MASK + (r32 * 64 + t) * 8);
            const unsigned mlo = (unsigned)mw >> (4 * hi), mhi = (unsigned)(mw >> 32) >> (4 * hi);
#pragma unroll
            for (int r = 0; r < 16; ++r) { const int cb = (r & 3) + 8 * (r >> 2);
                if (!((mlo >> cb) & 1u)) p0[r] = -1e30f; if (!((mhi >> cb) & 1u)) p1[r] = -1e30f; }
            h8 pf[4];
            softmax_step<2, true>(p0, p1, mrun, lrun, have, o, pf);
#pragma unroll
            for (int d0 = 0; d0 < 2; ++d0) { const int dx = (d0 ^ (qrow >> 1)) << 6;
#pragma unroll
                for (int ks = 0; ks < 4; ++ks) { const h8 vf = tr2(vb + ks * 2048 + dx, vb + ks * 2048 + 1024 + dx);
                    o[d0] = __builtin_amdgcn_mfma_f32_32x32x16_f16(vf, pf[ks], o[d0], 0, 0, 0); } }
        }
        if (t + 1 < nt) B_WRITE((t + 1) & 1);
        __syncthreads();
    }
#undef B_LOAD
#undef B_WRITE
    const float linv = 1.0f / swap_sum(lrun);
    const size_t row = rowb + qglob;
    const u16* gp = P0 + row * P0W + C_G0 + 512 + wid * 64;
    u16* op = (u16*)(F.ws + WS_MG0) + row * DM + 512 + wid * 64;
#pragma unroll
    for (int d0 = 0; d0 < 2; ++d0)
#pragma unroll
        for (int g = 0; g < 4; ++g) { const int d = 32 * d0 + 8 * g + 4 * hi;
            const h4 gv = *(const h4*)(gp + d);
            u32x2 w; w.x = pkh(o[d0][4 * g] * linv * (float)gv[0], o[d0][4 * g + 1] * linv * (float)gv[1]);
            w.y = pkh(o[d0][4 * g + 2] * linv * (float)gv[2], o[d0][4 * g + 3] * linv * (float)gv[3]);
            *(u32x2*)(op + d) = w; }
}

__device__ __forceinline__ void pv_tile64_asm(f32x16 (&o)[2], unsigned va0, unsigned va1, const h8 (&pf)[4]) {
#pragma unroll
    for (int d0 = 0; d0 < 2; ++d0) { const unsigned va = d0 ? va1 : va0; s16x4 lo[4], hi[4];
        asm volatile("ds_read_b64_tr_b16 %0, %1 offset:0" : "=&v"(lo[0]) : "v"(va) : "memory");    asm volatile("ds_read_b64_tr_b16 %0, %1 offset:1024" : "=&v"(hi[0]) : "v"(va) : "memory");
        asm volatile("ds_read_b64_tr_b16 %0, %1 offset:2048" : "=&v"(lo[1]) : "v"(va) : "memory"); asm volatile("ds_read_b64_tr_b16 %0, %1 offset:3072" : "=&v"(hi[1]) : "v"(va) : "memory");
        asm volatile("ds_read_b64_tr_b16 %0, %1 offset:4096" : "=&v"(lo[2]) : "v"(va) : "memory"); asm volatile("ds_read_b64_tr_b16 %0, %1 offset:5120" : "=&v"(hi[2]) : "v"(va) : "memory");
        asm volatile("ds_read_b64_tr_b16 %0, %1 offset:6144" : "=&v"(lo[3]) : "v"(va) : "memory"); asm volatile("ds_read_b64_tr_b16 %0, %1 offset:7168" : "=&v"(hi[3]) : "v"(va) : "memory");
        asm volatile("s_waitcnt lgkmcnt(0)" ::: "memory"); __builtin_amdgcn_sched_barrier(0);
#pragma unroll
        for (int ks = 0; ks < 4; ++ks) { const s16x8 v = __builtin_shufflevector(lo[ks], hi[ks], 0, 1, 2, 3, 4, 5, 6, 7);
            o[d0] = __builtin_amdgcn_mfma_f32_32x32x16_f16(__builtin_bit_cast(h8, v), pf[ks], o[d0], 0, 0, 0); } }
}
__device__ __forceinline__ void qk64C(f32x16& p0, f32x16& p1, LAS const unsigned char* sb, const h8 (&qf)[6], int kfo, int ksw, int rfo, int rsw, int hi, const f32x16& negm) {
    LAS const unsigned char* kb = sb + kfo; LAS const unsigned char* rb = sb + rfo;
#pragma unroll
    for (int d0 = 0; d0 < 4; ++d0) { const int co = ((2 * d0 + hi) ^ ksw) << 4;
        const h8 ka = *(LAS const h8*)(kb + co), kc = *(LAS const h8*)(kb + 4096 + co);
        if (d0 == 0) { p0 = __builtin_amdgcn_mfma_f32_32x32x16_f16(ka, qf[0], negm, 0, 0, 0); p1 = __builtin_amdgcn_mfma_f32_32x32x16_f16(kc, qf[0], negm, 0, 0, 0); }
        else { p0 = __builtin_amdgcn_mfma_f32_32x32x16_f16(ka, qf[d0], p0, 0, 0, 0); p1 = __builtin_amdgcn_mfma_f32_32x32x16_f16(kc, qf[d0], p1, 0, 0, 0); } }
#pragma unroll
    for (int d0 = 0; d0 < 2; ++d0) { const int co = ((2 * d0 + hi) ^ rsw) << 4;
        const h8 ka = *(LAS const h8*)(rb + co), kc = *(LAS const h8*)(rb + 2048 + co);
        p0 = __builtin_amdgcn_mfma_f32_32x32x16_f16(ka, qf[4 + d0], p0, 0, 0, 0); p1 = __builtin_amdgcn_mfma_f32_32x32x16_f16(kc, qf[4 + d0], p1, 0, 0, 0); }
}
__device__ __forceinline__ void pack4(h8 (&pf)[4], const f32x16& p0, const f32x16& p1) {
#pragma unroll
    for (int ks = 0; ks < 4; ++ks) { const f32x16& pp = ks < 2 ? p0 : p1; const int k2 = ks & 1; u32x4 w;
        w.x = pkh(pp[8 * k2 + 0], pp[8 * k2 + 1]); w.y = pkh(pp[8 * k2 + 2], pp[8 * k2 + 3]); w.z = pkh(pp[8 * k2 + 4], pp[8 * k2 + 5]); w.w = pkh(pp[8 * k2 + 6], pp[8 * k2 + 7]);
        pf[ks] = __builtin_bit_cast(h8, w); }
}
__device__ __forceinline__ void attnC_unit(Frame& F, int b, int h, int qb) {
    LAS unsigned char* lds = F.lds;
    int tid = F.tid; asm volatile("" : "+v"(tid)); int wid = F.wave; asm volatile("" : "+s"(wid));
    const int lane = tid & 63, r32 = lane & 31, hi = lane >> 5;
    const int q0 = 256 * qb + 32 * wid, cw = q0 >> 6, nt = 4 * qb + 4;
    const size_t rowb = (size_t)b * SEQ;
    const u16* Q1 = (const u16*)(F.ws + WS_Q1); const u16* KV = (const u16*)(F.ws + WS_KV1); const u16* KR = (const u16*)(F.ws + WS_KROPE);
    h8 qf[6];
    { const u16* qp = Q1 + (rowb + q0 + r32) * 1536 + h * 96 + hi * 8;
#pragma unroll
      for (int d0 = 0; d0 < 6; ++d0) qf[d0] = *(const h8*)(qp + d0 * 16); }
    f32x16 o[2];
#pragma unroll
    for (int d = 0; d < 2; ++d)
#pragma unroll
        for (int r = 0; r < 16; ++r) o[d][r] = 0.f;
    float mrun = 0.f, lrun = 0.f; bool have = false;
    f32x16 negm;
#pragma unroll
    for (int r = 0; r < 16; ++r) negm[r] = 0.f;
    const int krow = 8 * wid + (lane >> 3), kcp = lane & 7;
    const u16* ksrc = KV + (rowb + krow) * 2048 + h * 128 + ((kcp ^ ((krow >> 1) & 7)) << 3);
    const u16* vsrc = KV + (rowb + krow) * 2048 + h * 128 + 64 + ((kcp ^ (((krow >> 1) & 1) << 2)) << 3);
    const int rrow = 16 * (wid & 3) + (lane >> 2), rcp = lane & 3;
    const u16* rsrc = KR + (rowb + rrow) * 32 + ((rcp ^ ((rrow >> 2) & 3)) << 3);
    const int kofs = wid * 1024, rofs = 8192 + (wid & 3) * 1024, vofs = 12288 + wid * 1024;
#define C_DMA(t, slot) do { LAS unsigned char* sb_ = lds + (slot) * 20480; \
        __builtin_amdgcn_global_load_lds((const unsigned*)(ksrc + (size_t)(t) * 64 * 2048), (LAS unsigned*)(sb_ + kofs), 16, 0, 0); \
        __builtin_amdgcn_global_load_lds((const unsigned*)(rsrc + (size_t)(t) * 64 * 32), (LAS unsigned*)(sb_ + rofs), 16, 0, 0); \
        __builtin_amdgcn_global_load_lds((const unsigned*)(vsrc + (size_t)(t) * 64 * 2048), (LAS unsigned*)(sb_ + vofs), 16, 0, 0); } while (0)
    const int kfo = r32 * 128, ksw = (r32 >> 1) & 7;
    const int rfo = 8192 + r32 * 64, rsw = (r32 >> 2) & 3;
    const int i16 = lane & 15, qrow = i16 >> 2, pp = i16 & 3, g16 = (lane >> 4) & 1;
    const int vlane = (4 * hi + qrow) * 128 + ((2 * g16 + (pp >> 1)) << 4) + 8 * (pp & 1);
    const unsigned dx0 = (unsigned)((0 ^ (qrow >> 1)) << 6), dx1 = (unsigned)((1 ^ (qrow >> 1)) << 6);
    asm volatile("s_waitcnt vmcnt(0)" ::: "memory");
    C_DMA(0, 0); C_DMA(1, 1);
    const int np = nt >> 1;
    for (int T = 0; T < np; ++T) {
        asm volatile("s_waitcnt vmcnt(0)" ::: "memory");
        __builtin_amdgcn_s_barrier(); asm volatile("" ::: "memory");
        const int sA = (T & 1) * 2;
        if (T + 1 < np) { C_DMA(2 * T + 2, sA ^ 2); C_DMA(2 * T + 3, (sA ^ 2) + 1); }
        if (2 * T <= cw) {
            LAS const unsigned char* sb0 = lds + sA * 20480; LAS const unsigned char* sb1 = sb0 + 20480;
            f32x16 p0, p1, p2, p3;
            qk64C(p0, p1, sb0, qf, kfo, ksw, rfo, rsw, hi, negm);
            int two = __builtin_amdgcn_readfirstlane((2 * T + 1 <= cw) ? 1 : 0); asm volatile("" : "+s"(two));
            if (two) qk64C(p2, p3, sb1, qf, kfo, ksw, rfo, rsw, hi, negm);
            else {
#pragma unroll
                for (int r = 0; r < 16; ++r) { p2[r] = -1e30f; p3[r] = -1e30f; } }
            float ma[4];
#pragma unroll
            for (int i = 0; i < 4; ++i) { float t = max3f(p0[i], p0[i + 4], p0[i + 8]); t = max3f(t, p0[i + 12], p1[i]); t = max3f(t, p1[i + 4], p1[i + 8]); t = max3f(t, p1[i + 12], p2[i]);
                t = max3f(t, p2[i + 4], p2[i + 8]); t = max3f(t, p2[i + 12], p3[i]); t = max3f(t, p3[i + 4], p3[i + 8]); ma[i] = max3f(t, p3[i + 12], t); }
            const float mx = swap_max(max3f(max3f(ma[0], ma[1], ma[2]), ma[3], ma[3]));
            if (__any(!have || mx > SM_THR)) {
                const float dl = have ? fmaxf(mx, 0.f) : mx; have = true; mrun += dl;
                const float alpha = __builtin_amdgcn_exp2f(-dl); lrun *= alpha;
#pragma unroll
                for (int r = 0; r < 16; ++r) { p0[r] -= dl; p1[r] -= dl; p2[r] -= dl; p3[r] -= dl; negm[r] -= dl; o[0][r] *= alpha; o[1][r] *= alpha; }
            }
            float s0 = 0.f, s1 = 0.f, s2 = 0.f, s3 = 0.f;
#pragma unroll
            for (int r = 0; r < 16; ++r) { p0[r] = __builtin_amdgcn_exp2f(p0[r]); p1[r] = __builtin_amdgcn_exp2f(p1[r]); p2[r] = __builtin_amdgcn_exp2f(p2[r]); p3[r] = __builtin_amdgcn_exp2f(p3[r]);
                s0 += p0[r]; s1 += p1[r]; s2 += p2[r]; s3 += p3[r]; }
            lrun += (s0 + s1) + (s2 + s3);
            h8 pfa[4], pfb[4]; pack4(pfa, p0, p1); pack4(pfb, p2, p3);
            const unsigned vb0 = (unsigned)(size_t)(sb0 + 12288 + vlane), vb1 = (unsigned)(size_t)(sb1 + 12288 + vlane);
            pv_tile64_asm(o, vb0 + dx0, vb0 + dx1, pfa);
            pv_tile64_asm(o, vb1 + dx0, vb1 + dx1, pfb);
        }
    }
#undef C_DMA
    const float linv = 1.0f / swap_sum(lrun);
    const size_t row = rowb + q0 + r32;
    const u16* gp = (const u16*)(F.ws + WS_G1) + row * DM + h * 64;
    u16* op = (u16*)(F.ws + WS_MG1) + row * DM + h * 64;
#pragma unroll
    for (int d0 = 0; d0 < 2; ++d0)
#pragma unroll
        for (int g = 0; g < 4; ++g) { const int d = 32 * d0 + 8 * g + 4 * hi;
            const h4 gv = *(const h4*)(gp + d);
            u32x2 w; w.x = pkh(o[d0][4 * g] * linv * (float)gv[0], o[d0][4 * g + 1] * linv * (float)gv[1]);
            w.y = pkh(o[d0][4 * g + 2] * linv * (float)gv[2], o[d0][4 * g + 3] * linv * (float)gv[3]);
            *(u32x2*)(op + d) = w; }
}

__device__ __forceinline__ void p8_final(Frame& F, const Args& AR) {
    const int gw = blockIdx.x * NWAVES + F.wave, NGW = F.G * NWAVES;
    const float* gn = AR.in[I_FNORM]; f32x4 gv[4];
#pragma unroll
    for (int j = 0; j < 4; ++j) gv[j] = *(const f32x4*)(gn + 4 * F.lane + 256 * j);
    const u16* X2 = (const u16*)(F.ws + WS_X2H);
    for (int mrow = gw; mrow < T; mrow += NGW) {
        const h4* xr = (const h4*)(X2 + (size_t)mrow * DM) + F.lane;
        f32x4 v[4]; float s = 0.f;
#pragma unroll
        for (int j = 0; j < 4; ++j) { const h4 hv = xr[64 * j]; v[j] = (f32x4){(float)hv[0], (float)hv[1], (float)hv[2], (float)hv[3]}; s += (v[j].x * v[j].x + v[j].y * v[j].y) + (v[j].z * v[j].z + v[j].w * v[j].w); }
        const float rstd = __builtin_amdgcn_rsqf(wave_sum(s) * (1.f / DM) + RMS_EPS);
        f32x4* orow = (f32x4*)(F.out + (size_t)mrow * DM) + F.lane;
#pragma unroll
        for (int j = 0; j < 4; ++j) orow[64 * j] = v[j] * rstd * gv[j];
    }
}

#ifndef NAIVE_ATTN
#define NAIVE_ATTN 0
#endif
struct NaiveSh { float sh[4096]; float red[256]; unsigned char sel[4096]; };
__device__ __forceinline__ float blk_max(NaiveSh& S, float v, int tid) { S.red[tid] = v; __syncthreads(); for (int o2 = 128; o2 > 0; o2 >>= 1) { if (tid < o2) S.red[tid] = fmaxf(S.red[tid], S.red[tid + o2]); __syncthreads(); } const float r = S.red[0]; __syncthreads(); return r; }
__device__ __forceinline__ float blk_sum(NaiveSh& S, float v, int tid) { S.red[tid] = v; __syncthreads(); for (int o2 = 128; o2 > 0; o2 >>= 1) { if (tid < o2) S.red[tid] += S.red[tid + o2]; __syncthreads(); } const float r = S.red[0]; __syncthreads(); return r; }
__device__ __forceinline__ float blk_softmax(NaiveSh& S, int nk, int tid) {
    float mx = -1e30f; for (int k = tid; k < nk; k += 256) mx = fmaxf(mx, S.sh[k]); mx = blk_max(S, mx, tid);
    float ls = 0.f; for (int k = tid; k < nk; k += 256) { const float p = S.sh[k] > -1e29f ? exp2f(S.sh[k] - mx) : 0.f; S.sh[k] = p; ls += p; }
    return blk_sum(S, ls, tid);
}
__device__ __forceinline__ float naiveA(NaiveSh& S, const Args& args, int b, int q, int hd, int tid) {
    unsigned char* ws = args.ws; const u16* P0 = (const u16*)(ws + WS_PROJ0); const float* BT = (const float*)(ws + WS_BTG);
    const size_t row = (size_t)b * SEQ + q; const int nk = 64 * (q / 64 + 1); float outv[2] = {0.f, 0.f};
    for (int m = 0; m < 2; ++m) {
        for (int k = tid; k < nk; k += 256) { float sacc = 0.f; const u16* qp = P0 + row * P0W + C_QA + hd * 128 + m * 64; const u16* kp = P0 + ((size_t)b * SEQ + k) * P0W + C_KA + hd * 128 + m * 64;
            for (int d = 0; d < 64; ++d) sacc += h2f(qp[d]) * h2f(kp[d]);
            int rel = k - q; rel = rel < -128 ? -128 : rel; S.sh[k] = sacc + BT[hd * 192 + rel + 128]; }
        __syncthreads();
        const float ls = blk_softmax(S, nk, tid);
        if (tid < 128) { float a = 0.f; for (int k = 0; k < nk; ++k) a += S.sh[k] * h2f(P0[((size_t)b * SEQ + k) * P0W + C_VA + hd * 128 + tid]); outv[m] = a / ls; }
        __syncthreads();
    }
    const float lam = *(const float*)(ws + WS_LAM); const float v = tid < 128 ? outv[0] - lam * outv[1] : 0.f;
    const float ss = blk_sum(S, v * v, tid);
    const float rs = rsqrtf(ss / 128.f + RMS_EPS) * 0.8f;
    return tid < 128 ? v * rs * args.in[I_SUBLN][tid] * h2f(P0[row * P0W + C_G0 + hd * 128 + tid]) : 0.f;
}
__device__ __forceinline__ void naiveB_select(NaiveSh& S, const Args& args, int b, int q, int tid) {
    const u16* P0 = (const u16*)(args.ws + WS_PROJ0); const size_t row = (size_t)b * SEQ + q; const int nk = 64 * (q / 64 + 1);
    for (int k = tid; k < nk; k += 256) { float sc = 0.f;
        for (int hh = 0; hh < 8; ++hh) { float l = 0.f; const u16* qp = P0 + row * P0W + C_QI + hh * 64; const u16* kp = P0 + ((size_t)b * SEQ + k) * P0W + C_KI;
            for (int d = 0; d < 64; ++d) l += h2f(qp[d]) * h2f(kp[d]);
            sc += h2f(P0[row * P0W + C_WI + hh]) * fmaxf(l, 0.f); }
        S.sh[k] = sc; }
    __syncthreads();
    for (int k = tid; k < nk; k += 256) { const float sk = S.sh[k]; int rank = 0; for (int k2 = 0; k2 < nk; ++k2) { const float s2 = S.sh[k2]; rank += (s2 > sk || (s2 == sk && k2 < k)) ? 1 : 0; } S.sel[k] = rank < TOPK ? 1 : 0; }
    __syncthreads();
}
__device__ __forceinline__ float naiveB_head(NaiveSh& S, const Args& args, int b, int q, int hd, int tid) {
    const u16* P0 = (const u16*)(args.ws + WS_PROJ0); const float* BT = (const float*)(args.ws + WS_BTG); const size_t row = (size_t)b * SEQ + q; const int nk = 64 * (q / 64 + 1);
    for (int k = tid; k < nk; k += 256) { float sacc = -1e30f;
        if (S.sel[k]) { sacc = 0.f; const u16* qp = P0 + row * P0W + C_QB + hd * 64; const u16* kp = P0 + ((size_t)b * SEQ + k) * P0W + C_KB;
            for (int d = 0; d < 64; ++d) sacc += h2f(qp[d]) * h2f(kp[d]);
            int rel = k - q; rel = rel < -128 ? -128 : rel; sacc += BT[(4 + hd) * 192 + rel + 128]; }
        S.sh[k] = sacc; }
    __syncthreads();
    const float ls = blk_softmax(S, nk, tid);
    float r = 0.f;
    if (tid < 64) { float a = 0.f; for (int k = 0; k < nk; ++k) a += S.sh[k] * h2f(P0[((size_t)b * SEQ + k) * P0W + C_VB + tid]); r = a / ls * h2f(P0[row * P0W + C_G0 + 512 + hd * 64 + tid]); }
    __syncthreads();
    return r;
}
__device__ __forceinline__ float naiveC(NaiveSh& S, const Args& args, int b, int q, int hd, int tid) {
    unsigned char* ws = args.ws; const size_t row = (size_t)b * SEQ + q; const int nk = 64 * (q / 64 + 1);
    const u16* Q1 = (const u16*)(ws + WS_Q1); const u16* KV = (const u16*)(ws + WS_KV1); const u16* KR = (const u16*)(ws + WS_KROPE);
    for (int k = tid; k < nk; k += 256) { float sacc = 0.f; const u16* qp = Q1 + row * 1536 + hd * 96; const size_t kr = (size_t)b * SEQ + k;
        for (int d = 0; d < 64; ++d) sacc += h2f(qp[d]) * h2f(KV[kr * 2048 + hd * 128 + d]);
        for (int d = 0; d < 32; ++d) sacc += h2f(qp[64 + d]) * h2f(KR[kr * 32 + d]);
        S.sh[k] = sacc; }
    __syncthreads();
    const float ls = blk_softmax(S, nk, tid);
    float r = 0.f;
    if (tid < 64) { float a = 0.f; for (int k = 0; k < nk; ++k) a += S.sh[k] * h2f(KV[((size_t)b * SEQ + k) * 2048 + hd * 128 + 64 + tid]); r = a / ls * h2f(((const u16*)(ws + WS_G1))[row * DM + hd * 64 + tid]); }
    __syncthreads();
    return r;
}
#if NAIVE_ATTN
__global__ void __launch_bounds__(256) naive_attn(Args args, int which) {
    __shared__ NaiveSh S; const int tid = threadIdx.x; unsigned char* ws = args.ws;
    if (which == 0) {
        for (int it = blockIdx.x; it < T * 5; it += gridDim.x) {
            const int row = it / 5, sub = it % 5, b = row / SEQ, q = row % SEQ;
            if (sub < 4) { const float v = naiveA(S, args, b, q, sub, tid); if (tid < 128) ((u16*)(ws + WS_MG0))[(size_t)row * DM + sub * 128 + tid] = (u16)(pkh(v, 0.f) & 0xffffu); }
            else { naiveB_select(S, args, b, q, tid);
                for (int hd = 0; hd < 8; ++hd) { const float v = naiveB_head(S, args, b, q, hd, tid); if (tid < 64) ((u16*)(ws + WS_MG0))[(size_t)row * DM + 512 + hd * 64 + tid] = (u16)(pkh(v, 0.f) & 0xffffu); } }
        }
    } else {
        for (int it = blockIdx.x; it < T * 16; it += gridDim.x) {
            const int row = it >> 4, hd = it & 15, b = row / SEQ, q = row % SEQ;
            const float v = naiveC(S, args, b, q, hd, tid); if (tid < 64) ((u16*)(ws + WS_MG1))[(size_t)row * DM + hd * 64 + tid] = (u16)(pkh(v, 0.f) & 0xffffu);
        }
    }
}
#endif

#if DEBUG_CHECK
constexpr size_t WS_DBG = 3 * MiB;
#ifndef DBG_BITS_MODE
#define DBG_BITS_MODE 1
#define DBG_BITS_IDS 14, 4, 5, 21, 22, 23
#endif
#ifndef DBG_SKIP_MASK
#define DBG_SKIP_MASK 0x10
#endif
#ifndef DBG_REPORT_ID
#define DBG_REPORT_ID 0
#endif
__device__ __forceinline__ unsigned dhash(unsigned x) { x ^= x >> 16; x *= 0x7feb352du; x ^= x >> 15; x *= 0x846ca68bu; x ^= x >> 16; return x; }
__device__ __forceinline__ void dbg_rec(unsigned char* ws, int id, float got, float ref, float scale) {
    float e = fabsf(got - ref) / (fabsf(ref) + scale); if (!(e == e)) e = 1e6f;
    atomicMax((unsigned*)(ws + WS_DBG) + id, __float_as_uint(e));
}
__device__ __forceinline__ float dh(const u16* p, size_t i) { return h2f(p[i]); }
__global__ void __launch_bounds__(256) dbg_check(Args args, int stage) {
    unsigned char* ws = args.ws; const int tid = threadIdx.x, bid = blockIdx.x, gid = bid * 256 + tid;
    if (stage == 0) { if (gid < 64) ((unsigned*)(ws + WS_DBG))[gid] = (gid == 44) ? 0xffffu : 0u; return; }
    if (stage == 1) {
        const unsigned h = dhash(gid * 7919u + 13u);
        { const int n = h % P0W, k = (h >> 12) % 1024; const int sc = wsrc_col(0, n); const float ref = sc < 0 ? 0.f : args.in[I_EWIN][(size_t)k * L0_SRC + sc] * wcol_scale(0, n);
          dbg_rec(ws, 1, dh((const u16*)(ws + WS_W0T), (size_t)n * 1024 + k), ref, 1e-3f); }
        { const int n = h % P1W, k = (h >> 12) % 1024; const int sc = wsrc_col(2, n); const float ref = sc < 0 ? 0.f : args.in[I_OWIN][(size_t)k * L1_SRC + sc] * args.in[I_ONORM][k];
          dbg_rec(ws, 1, dh((const u16*)(ws + WS_W1T), (size_t)n * 1024 + k), ref, 1e-3f); }
        { const int n = h % 1536, k = (h >> 12) % 384; const float ref = args.in[I_OWUQ][(size_t)k * 1536 + n] * args.in[I_OQNORM][k] * QS_C;
          dbg_rec(ws, 1, dh((const u16*)(ws + WS_WUQT), (size_t)n * 384 + k), ref, 1e-3f); }
        { const int n = h % 2048, k = (h >> 12) % 256; const float ref = args.in[I_OWUKV][(size_t)k * 2048 + n] * args.in[I_OKVNORM][k];
          dbg_rec(ws, 1, dh((const u16*)(ws + WS_WUKVT), (size_t)n * 256 + k), ref, 1e-3f); }
        { const int n = h % 1024, k = (h >> 12) % 1024; dbg_rec(ws, 1, dh((const u16*)(ws + WS_WO0T), (size_t)n * 1024 + k), args.in[I_EWO][(size_t)k * 1024 + n], 1e-3f);
          dbg_rec(ws, 1, dh((const u16*)(ws + WS_WO1T), (size_t)n * 1024 + k), args.in[I_OWO][(size_t)k * 1024 + n], 1e-3f); }
        { const int row = h % T, col = (h >> 15) % 1024; const float* xr = args.in[I_X] + (size_t)row * DM; float ss = 0.f; for (int k = 0; k < DM; ++k) ss += xr[k] * xr[k];
          const float ref = xr[col] * rsqrtf(ss / DM + RMS_EPS) * args.in[I_ENORM][col]; dbg_rec(ws, 2, dh((const u16*)(ws + WS_XN0), (size_t)row * DM + col), ref, 1e-2f); }
        return;
    }
    if (stage == 2) {
        const unsigned h = dhash(gid * 104729u + 7u); const int row = h % T; int col = (h >> 15) % P0W; if (gid & 1) col = C_G0 + (col & 1023); if ((gid & 7) == 2) col = C_KI + (col & 63);
        const u16* a = (const u16*)(ws + WS_XN0) + (size_t)row * DM; const u16* b = (const u16*)(ws + WS_W0T) + (size_t)col * 1024; float acc = 0.f;
        for (int k = 0; k < 1024; ++k) acc += h2f(a[k]) * h2f(b[k]);
        if (col >= C_G0) acc = acc / (1.f + expf(-acc));
        dbg_rec(ws, 3, dh((const u16*)(ws + WS_PROJ0), (size_t)row * P0W + col), acc, 2e-2f);
        return;
    }
    if (stage == 3) {
        __shared__ NaiveSh NS;
        const unsigned h = dhash(bid * 2654435761u + 99u);
        int q = h % SEQ; const int b = (h >> 12) % NB; if (bid % 5 == 0) q = q % 320;
        const size_t row = (size_t)b * SEQ + q;
        if (bid < 48) { const int hd = (h >> 20) % 4; const float ref = naiveA(NS, args, b, q, hd, tid);
            if (tid < 128) dbg_rec(ws, 4, dh((const u16*)(ws + WS_MG0), row * DM + hd * 128 + tid), ref, 2e-2f); }
        else { const int hd = (h >> 20) % 8; naiveB_select(NS, args, b, q, tid); const float ref = naiveB_head(NS, args, b, q, hd, tid);
            if (tid < 64) dbg_rec(ws, 5, dh((const u16*)(ws + WS_MG0), row * DM + 512 + hd * 64 + tid), ref, 2e-2f); }
        return;
    }
    if (stage == 4) {
        const unsigned h = dhash(gid * 15485863u + 3u); const int row = h % T, col = (h >> 15) % 1024;
        const u16* a = (const u16*)(ws + WS_MG0) + (size_t)row * DM; const u16* b = (const u16*)(ws + WS_WO0T) + (size_t)col * 1024; float acc = 0.f;
        for (int k = 0; k < 1024; ++k) acc += h2f(a[k]) * h2f(b[k]);
        const float ref = args.in[I_X][(size_t)row * DM + col] + acc;
        dbg_rec(ws, 6, args.out[(size_t)row * DM + col], ref, 1e-2f); dbg_rec(ws, 6, dh((const u16*)(ws + WS_XN0), (size_t)row * DM + col), ref, 1e-2f);
        if (gid < 2048) { float ss = 0.f; for (int k = 0; k < DM; ++k) { const float v = args.out[(size_t)row * DM + k]; ss += v * v; }
            dbg_rec(ws, 7, (float)((const u64*)(ws + WS_SSQ1))[row] / FXS, ss, 1e-3f); }
        return;
    }
    if (stage == 5) {
        const unsigned h = dhash(gid * 32452843u + 5u); const int row = h % T; int col = (h >> 15) % P1W; if ((gid & 3) == 1) col = 640 + (col & 31);
        if (col >= 672 && col < 768) col -= 200;
        const u16* a = (const u16*)(ws + WS_XN0) + (size_t)row * DM; float ss = 0.f; for (int k = 0; k < DM; ++k) { const float v = args.out[(size_t)row * DM + k]; ss += v * v; }
        const float rs = rsqrtf(ss / DM + RMS_EPS);
        auto dotc = [&](int c) { const u16* b = (const u16*)(ws + WS_W1T) + (size_t)c * 1024; float acc = 0.f; for (int k = 0; k < 1024; ++k) acc += h2f(a[k]) * h2f(b[k]); return acc * rs; };
        const float v = dotc(col);
        if (col < 640) dbg_rec(ws, 8, dh((const u16*)(ws + WS_LAT), (size_t)row * LATW + col), v, 2e-2f);
        else if (col < 672) { const int j = col - 640, pos = row & (SEQ - 1), i = j & 15; const float inv = (float)pow(10000.0, -(double)i / 16.0), ang = (float)pos * inv; const float cs = cosf(ang), sn = sinf(ang);
            const float other = dotc(j < 16 ? col + 16 : col - 16); const float ref = j < 16 ? v * cs - other * sn : other * sn + v * cs;
            dbg_rec(ws, 9, dh((const u16*)(ws + WS_KROPE), (size_t)row * 32 + j), ref, 2e-2f); }
        else dbg_rec(ws, 10, dh((const u16*)(ws + WS_G1), (size_t)row * DM + col - 768), v / (1.f + expf(-v)), 2e-2f);
        if (gid < 1024) { const u16* lat = (const u16*)(ws + WS_LAT) + (size_t)row * LATW; float s1 = 0.f, s2 = 0.f; for (int k = 0; k < 256; ++k) s1 += h2f(lat[k]) * h2f(lat[k]); for (int k = 256; k < 640; ++k) s2 += h2f(lat[k]) * h2f(lat[k]);
            dbg_rec(ws, 11, (float)((const u64*)(ws + WS_SSQKV))[row] / FXS, s1, 1e-2f); dbg_rec(ws, 11, (float)((const u64*)(ws + WS_SSQQ))[row] / FXS, s2, 1e-2f); }
        return;
    }
    if (stage == 6) {
        const unsigned h = dhash(gid * 49979687u + 11u); const int row = h % T; const u16* lat = (const u16*)(ws + WS_LAT) + (size_t)row * LATW;
        { const int col = (h >> 15) % 2048; float s1 = 0.f; for (int k = 0; k < 256; ++k) s1 += h2f(lat[k]) * h2f(lat[k]); const float rs = rsqrtf(s1 / 256.f + RMS_EPS);
          const u16* b = (const u16*)(ws + WS_WUKVT) + (size_t)col * 256; float acc = 0.f; for (int k = 0; k < 256; ++k) acc += h2f(lat[k]) * h2f(b[k]);
          dbg_rec(ws, 13, dh((const u16*)(ws + WS_KV1), (size_t)row * 2048 + col), acc * rs, 2e-2f); }
        { int col = (h >> 15) % 1536; if (gid & 1) col = (col / 96) * 96 + 64 + (col & 31);
          float s2 = 0.f; for (int k = 256; k < 640; ++k) s2 += h2f(lat[k]) * h2f(lat[k]); const float rs = rsqrtf(s2 / 384.f + RMS_EPS);
          auto dotc = [&](int c) { const u16* b = (const u16*)(ws + WS_WUQT) + (size_t)c * 384; float acc = 0.f; for (int k = 0; k < 384; ++k) acc += h2f(lat[256 + k]) * h2f(b[k]); return acc * rs; };
          float v = dotc(col); const int jj = col % 96;
          if (jj >= 64) { const int j = jj - 64, pos = row & (SEQ - 1), i = j & 15; const float inv = (float)pow(10000.0, -(double)i / 16.0), ang = (float)pos * inv; const float cs = cosf(ang), sn = sinf(ang);
              const float other = dotc(j < 16 ? col + 16 : col - 16); v = j < 16 ? v * cs - other * sn : other * sn + v * cs; }
          dbg_rec(ws, 12, dh((const u16*)(ws + WS_Q1), (size_t)row * 1536 + col), v, 2e-2f); }
        return;
    }
    if (stage == 7) {
        __shared__ NaiveSh NS;
        const unsigned h = dhash(bid * 2654435761u + 777u); int q = h % SEQ; const int b = (h >> 12) % NB, hd = (h >> 20) % 16; if (bid % 5 == 0) q = q % 320;
        const size_t row = (size_t)b * SEQ + q; const float ref = naiveC(NS, args, b, q, hd, tid);
        if (tid < 64) dbg_rec(ws, 14, dh((const u16*)(ws + WS_MG1), row * DM + hd * 64 + tid), ref, 2e-2f);
        { const float got = tid < 64 ? dh((const u16*)(ws + WS_MG1), row * DM + hd * 64 + tid) : 0.f; const bool bad = tid < 64 && fabsf(got - ref) / (fabsf(ref) + 2e-2f) > 0.05f;
          if (__syncthreads_or(bad ? 1 : 0) && tid == 0) { atomicAdd((unsigned*)(ws + WS_DBG) + 43, 1u); atomicMin((unsigned*)(ws + WS_DBG) + 44, (unsigned)(q / 64)); atomicMax((unsigned*)(ws + WS_DBG) + 45, (unsigned)(q / 64)); } }
        {
            const u16* Q1 = (const u16*)(ws + WS_Q1); const u16* KV = (const u16*)(ws + WS_KV1); const u16* KR = (const u16*)(ws + WS_KROPE); const float* db = (const float*)(ws + WS_DBGBUF) + 4096;
            for (int e = gid; e < 256 * 64; e += gridDim.x * 256) { const int qq = e >> 6, d = e & 63, qpos = 256 * TAPQB + qq, nkk = 64 * (qpos / 64 + 1); float mx = -1e30f, ls = 0.f, a = 0.f;
                const size_t rb = (size_t)TAPB * SEQ; const u16* qp = Q1 + (rb + qpos) * 1536 + TAPH * 96;
                for (int pass = 0; pass < 2; ++pass)
                for (int k = 0; k < nkk; ++k) { float sacc = 0.f; for (int dd = 0; dd < 64; ++dd) sacc += h2f(qp[dd]) * h2f(KV[(rb + k) * 2048 + TAPH * 128 + dd]);
                    for (int dd = 0; dd < 32; ++dd) sacc += h2f(qp[64 + dd]) * h2f(KR[(rb + k) * 32 + dd]);
                    if (pass == 0) mx = fmaxf(mx, sacc); else { const float p = exp2f(sacc - mx); ls += p; a += p * h2f(KV[(rb + k) * 2048 + TAPH * 128 + 64 + d]); } }
                dbg_rec(ws, 21 + (qq >> 6), db[e], a / ls, 2e-2f); }
        }
        if (bid == 0) {
            const u16* Q1 = (const u16*)(ws + WS_Q1); const u16* KV = (const u16*)(ws + WS_KV1); const u16* KR = (const u16*)(ws + WS_KROPE); const float* db = (const float*)(ws + WS_DBGBUF);
            for (int e = tid; e < 32 * 64; e += 256) { const int qq = e >> 6, k = e & 63; float sacc = 0.f;
                for (int d = 0; d < 64; ++d) sacc += h2f(Q1[(size_t)qq * 1536 + d]) * h2f(KV[(size_t)k * 2048 + d]);
                for (int d = 0; d < 32; ++d) sacc += h2f(Q1[(size_t)qq * 1536 + 64 + d]) * h2f(KR[(size_t)k * 32 + d]);
                dbg_rec(ws, 20, db[e], sacc, 2e-2f); dbg_rec(ws, 41, db[e], 0.f, 1.0f); dbg_rec(ws, 42, sacc, 0.f, 1.0f); }
            (void)0;
        }
        return;
    }
    if (stage == 9) {
        if (gid == 0) { const unsigned* e = (const unsigned*)(ws + WS_DBG);
            if (DBG_REPORT_ID >= 43 && DBG_REPORT_ID <= 45) { args.out[0] = 100.0f * (float)e[DBG_REPORT_ID] + 50.f; }
            else if (DBG_REPORT_ID == 40) { args.out[0] = 100.0f * (float)(e[40] / 32u) + 50.f; }
            else if (DBG_REPORT_ID > 0) { args.out[0] = 1000.0f * __uint_as_float(e[DBG_REPORT_ID]); }
            else if (DBG_BITS_MODE) { const int ids[6] = {DBG_BITS_IDS}; int v = 0; for (int i = 0; i < 6; ++i) if (ids[i] > 0 && __uint_as_float(e[ids[i]]) > 0.05f) v |= 1 << i; if (v) args.out[0] = 100.0f * v; }
            else { int first = 0; for (int id = 1; id < 32 && !first; ++id) if (!((DBG_SKIP_MASK >> id) & 1) && __uint_as_float(e[id]) > 0.05f) first = id; if (first) args.out[0] = 100.0f * first; } }
        return;
    }
}
#endif

constexpr int N_PHASES = 9;
__global__ void __launch_bounds__(NWAVES * 64) hybrid_fwd(Args args) {
    extern __shared__ __attribute__((aligned(16))) unsigned char lds_raw[];
    Frame F;
    F.lds = (LAS unsigned char*)lds_raw;
    F.MISC = (volatile LAS unsigned*)(F.lds + MISC_OFF);
    F.tid = threadIdx.x; F.lane = F.tid & 63; F.wave = __builtin_amdgcn_readfirstlane(F.tid >> 6);
    F.G = gridDim.x;
    F.out = args.out; F.ws = args.ws; F.ctl = (unsigned*)(args.ws + WS_CTL);
    for (int u = F.tid; u < (LDS_BYTES - RING_BYTES) / 4; u += NWAVES * 64) ((LAS unsigned*)(F.lds + RING_BYTES))[u] = 0u;
    __syncthreads();
    const int lo = args.ph_lo, hi = args.ph_hi;
    const bool multi = (hi - lo) > 1;
    XcdBarrier bar; bar.bar = F.ctl + CW_BAR; bar.x = 0; bar.st = nullptr;
    if (multi) bar = xcd_barrier_post(F.ctl + CW_BAR, F.MISC + 8);
#ifndef PH_MASK
#define PH_MASK 0x1FF
#endif
#define IN(k) (((PH_MASK >> (k)) & 1) && lo <= (k) && (k) < hi)
#define SEAM(k) do { if (IN(k) && IN((k) + 1)) xcd_barrier(bar); } while (0)
    unsigned char* ws = args.ws;
    LAS unsigned char* ring = F.lds;

#define PHASE1(rep) do { \
        pg8::Gemm g{(const u16*)(ws + WS_XN0), (const u16*)(ws + WS_W0T), T, P0W, 1024, 1024}; pg8::StaticOrder S; S.init(T, P0W, F.G, (int)blockIdx.x); \
        pg8::EpiProj0 E{(u16*)(ws + WS_PROJ0)}; \
        pg8::gemm_phase<pg8::EpiProj0>(ring, g, S, E); } while (0)
#define PHASE2(rep) do { if (!NAIVE_ATTN) { \
        for (;;) { \
            const int u = next_unit(F, (rep) ? CW_Q0 + 16 : CW_Q0); \
            if (u >= 2048) break; \
            const int lvl = 31 - (u >> 6), r = u & 63; \
            if (r < 32) { if (!((rep) && REPEAT_SUB == 1)) { const int c = 2 * lvl + 1 - (r >> 4), rr = r & 15; attnB_unit(F, rr >> 1, 2 * c + (rr & 1), (rep) ? REPEAT_SUB : 0); } } \
            else { if (!((rep) && REPEAT_SUB >= 2)) { const int idx = r - 32; attnA_unit(F, args, idx >> 2, idx & 3, lvl); } } \
        } \
        __syncthreads(); } } while (0)
#define PHASE3(rep) do { \
        pg8::Gemm g{(const u16*)(ws + WS_MG0), (const u16*)(ws + WS_WO0T), T, 1024, 1024, 1024}; pg8::StaticOrder S; S.init(T, 1024, F.G, (int)blockIdx.x); \
        pg8::EpiRes0 E{args.in[I_X], (u16*)(ws + WS_XN0), (rep) ? nullptr : (u64*)(ws + WS_SSQ1)}; \
        pg8::gemm_phase<pg8::EpiRes0>(ring, g, S, E); } while (0)
#define PHASE4(rep) do { \
        pg8::Gemm g{(const u16*)(ws + WS_XN0), (const u16*)(ws + WS_W1T), T, P1W, 1024, 1024}; pg8::StaticOrder S; S.init(T, P1W, F.G, (int)blockIdx.x); \
        pg8::EpiProj1 E{(const u64*)(ws + WS_SSQ1), (u16*)(ws + WS_LAT), (u16*)(ws + WS_KROPE), (u16*)(ws + WS_G1), (rep) ? nullptr : (u64*)(ws + WS_SSQKV), (rep) ? nullptr : (u64*)(ws + WS_SSQQ), (const float*)(ws + WS_ROPEC), (const float*)(ws + WS_ROPES)}; \
        pg8::gemm_phase<pg8::EpiProj1>(ring, g, S, E); } while (0)
#define PHASE5(rep) do { \
        { pg8::Gemm g{(const u16*)(ws + WS_LAT) + 256, (const u16*)(ws + WS_WUQT), T, 1536, 384, LATW}; pg8::StaticOrder S; S.init(T, 1536, F.G, (int)blockIdx.x); \
          pg8::EpiQ1 E{(const u64*)(ws + WS_SSQQ), (u16*)(ws + WS_Q1), (const float*)(ws + WS_ROPEC), (const float*)(ws + WS_ROPES)}; \
          pg8::gemm_phase<pg8::EpiQ1>(ring, g, S, E); } \
        { pg8::Gemm g{(const u16*)(ws + WS_LAT), (const u16*)(ws + WS_WUKVT), T, 2048, 256, LATW}; pg8::StaticOrder S; S.init(T, 2048, F.G, (int)blockIdx.x); \
          pg8::EpiKV1 E{(const u64*)(ws + WS_SSQKV), (u16*)(ws + WS_KV1)}; \
          pg8::gemm_phase<pg8::EpiKV1>(ring, g, S, E); } } while (0)
#define PHASE6(rep) do { if (!NAIVE_ATTN) { \
        for (;;) { \
            const int u = next_unit(F, (rep) ? CW_Q1 + 16 : CW_Q1); \
            if (u >= 2048) break; \
            const int qb = 15 - (u >> 7), r = u & 127; \
            attnC_unit(F, r >> 4, r & 15, qb); \
        } \
        __syncthreads(); } } while (0)
#define PHASE7(rep) do { \
        pg8::Gemm g{(const u16*)(ws + WS_MG1), (const u16*)(ws + WS_WO1T), T, 1024, 1024, 1024}; pg8::StaticOrder S; S.init(T, 1024, F.G, (int)blockIdx.x); \
        pg8::EpiRes1 E{(const u16*)(ws + WS_XN0), (u16*)(ws + WS_X2H)}; \
        pg8::gemm_phase<pg8::EpiRes1>(ring, g, S, E); } while (0)
#define REPEAT(k, CALL) do { if (REPEAT_PHASE == (k) && multi) { xcd_barrier(bar); CALL; } } while (0)
    if (IN(0)) { p0_prologue(F, args); REPEAT(0, p0_prologue(F, args)); } SEAM(0);
    if (IN(1)) { PHASE1(0); REPEAT(1, PHASE1(1)); } SEAM(1);
    if (IN(2)) { PHASE2(0); REPEAT(2, PHASE2(1)); } SEAM(2);
    if (IN(3)) { PHASE3(0); REPEAT(3, PHASE3(1)); } SEAM(3);
    if (IN(4)) { PHASE4(0); REPEAT(4, PHASE4(1)); } SEAM(4);
    if (IN(5)) { PHASE5(0); REPEAT(5, PHASE5(1)); } SEAM(5);
    if (IN(6)) { PHASE6(0); REPEAT(6, PHASE6(1)); } SEAM(6);
    if (IN(7)) { PHASE7(0); } SEAM(7);
    if (IN(8)) { p8_final(F, args); }
#undef IN
#undef SEAM
}

extern "C" void kernel_launch(void* const* d_in, const int* in_sizes, int n_in, void* d_out, int out_size, void* d_ws, size_t ws_size, hipStream_t stream) {
    static int grid = 0;
    if (grid == 0) {
        if (n_in != 18 || in_sizes[0] != T * DM || out_size != T * DM || ws_size < WS_END) {
            fprintf(stderr, "kernel_launch: unexpected shapes (n_in %d, in0 %d, out %d, ws %zu, need %zu); nothing launched\n", n_in, n_in > 0 ? in_sizes[0] : -1, out_size, ws_size, (size_t)WS_END); grid = -1; return; }
        int dev = 0, cus = 0, per_cu = 0;
        if (hipGetDevice(&dev) != hipSuccess || hipDeviceGetAttribute(&cus, hipDeviceAttributeMultiprocessorCount, dev) != hipSuccess) { fprintf(stderr, "kernel_launch: device query failed\n"); grid = -1; return; }
        if (hipFuncSetAttribute((const void*)hybrid_fwd, hipFuncAttributeMaxDynamicSharedMemorySize, LDS_BYTES) != hipSuccess) { fprintf(stderr, "kernel_launch: hipFuncSetAttribute failed\n"); grid = -1; return; }
        if (hipOccupancyMaxActiveBlocksPerMultiprocessor(&per_cu, (const void*)hybrid_fwd, NWAVES * 64, LDS_BYTES) != hipSuccess || per_cu < 1)
            fprintf(stderr, "kernel_launch: note: occupancy query reports %d workgroups per CU\n", per_cu);
        (void)hipGetLastError();
        grid = cus;
        if (grid % 8 != 0) grid -= grid % 8;
    }
    if (grid <= 0) return;
    (void)hipMemsetAsync((char*)d_ws + WS_CTL, 0, CTL_ZERO_BYTES, stream);
    Args a{};
    for (int i = 0; i < 18; ++i) a.in[i] = (const float*)d_in[i];
    a.out = (float*)d_out; a.ws = (unsigned char*)d_ws;
#if MK_N_LAUNCHES == 1
    a.ph_lo = 0; a.ph_hi = N_PHASES;
    hipLaunchKernelGGL(hybrid_fwd, dim3(grid), dim3(NWAVES * 64), LDS_BYTES, stream, a);
#else
#if DEBUG_CHECK
    hipLaunchKernelGGL(dbg_check, dim3(1), dim3(256), 0, stream, a, 0);
#endif
    for (int p = 0; p < N_PHASES; ++p) { a.ph_lo = p; a.ph_hi = p + 1;
#if NAIVE_ATTN
        if (p == 2) { hipLaunchKernelGGL(naive_attn, dim3(8192), dim3(256), 0, stream, a, 0); continue; }
        if (p == 6) { hipLaunchKernelGGL(naive_attn, dim3(8192), dim3(256), 0, stream, a, 1); continue; }
#endif
        hipLaunchKernelGGL(hybrid_fwd, dim3(grid), dim3(NWAVES * 64), LDS_BYTES, stream, a);
#if DEBUG_CHECK
        if (p <= 6) hipLaunchKernelGGL(dbg_check, dim3((p == 2 || p == 6) ? 96 : 64), dim3(256), 0, stream, a, p + 1);
#endif
    }
#if DEBUG_CHECK
    hipLaunchKernelGGL(dbg_check, dim3(1), dim3(256), 0, stream, a, 9);
#endif
#endif
    const hipError_t le = hipPeekAtLastError();
    if (le != hipSuccess) fprintf(stderr, "kernel_launch: launch failed: %s\n", hipGetErrorName(le));
}
```

```cpp
#include <hip/hip_runtime.h>
#include <cstdio>
#include <cstdint>

#ifndef DEBUG_CHECK
#define DEBUG_CHECK 0
#endif
#define TAPB 3
#define TAPH 5
#define TAPQB 7
#ifndef REPEAT_PHASE
#define REPEAT_PHASE -1
#define REPEAT_SUB 0
#endif
#ifndef MK_N_LAUNCHES
#define MK_N_LAUNCHES 1
#endif

#define LAS __attribute__((address_space(3)))
#define GAS __attribute__((address_space(1)))
typedef unsigned short u16;
typedef unsigned long long u64;
typedef _Float16 h8 __attribute__((ext_vector_type(8)));
typedef _Float16 h2 __attribute__((ext_vector_type(2)));
typedef _Float16 h4 __attribute__((ext_vector_type(4)));
typedef short s16x4 __attribute__((ext_vector_type(4)));
typedef short s16x8 __attribute__((ext_vector_type(8)));
typedef float f32x2 __attribute__((ext_vector_type(2)));
typedef float f32x4 __attribute__((ext_vector_type(4)));
typedef float f32x16 __attribute__((ext_vector_type(16)));
typedef unsigned u32x2 __attribute__((ext_vector_type(2)));
typedef unsigned u32x4 __attribute__((ext_vector_type(4)));

constexpr int SEQ = 4096, NB = 8, T = NB * SEQ, DM = 1024;
constexpr int P0W = 3840;
constexpr int C_QA = 0, C_KA = 512, C_VA = 1024, C_QB = 1536, C_KB = 2048, C_VB = 2112, C_QI = 2176, C_KI = 2688, C_WI = 2752, C_G0 = 2816;
constexpr int L0_SRC = 3784;
constexpr int P1W = 1792;
constexpr int L1_SRC = 1696;
constexpr int LATW = 640;
constexpr int TOPK = 256;
constexpr float LOG2E = 1.4426950408889634f;
constexpr float QS_AB = 0.125f * LOG2E;
constexpr float QS_C = 0.10206207261596575f * LOG2E;
constexpr float RMS_EPS = 1e-6f;
constexpr float FXS = 1048576.0f;

constexpr size_t MiB = 1u << 20;
constexpr size_t WS_CTL = 0, CTL_ZERO_BYTES = 2 * MiB;
constexpr size_t WS_SSQ1 = 1 * MiB, WS_SSQKV = WS_SSQ1 + 256 * 1024, WS_SSQQ = WS_SSQKV + 256 * 1024;
constexpr size_t WS_ROPEC = 2 * MiB, WS_ROPES = WS_ROPEC + 256 * 1024, WS_BTG = WS_ROPES + 256 * 1024, WS_LAM = WS_BTG + 16 * 1024;
constexpr size_t WS_W0T = 4 * MiB;
constexpr size_t WS_WO0T = 12 * MiB;
constexpr size_t WS_W1T = 14 * MiB;
constexpr size_t WS_WUQT = 18 * MiB;
constexpr size_t WS_WUKVT = 20 * MiB;
constexpr size_t WS_WO1T = 22 * MiB;
constexpr size_t WS_XN0 = 32 * MiB;
constexpr size_t WS_PROJ0 = 96 * MiB;
constexpr size_t WS_MG0 = 336 * MiB;
constexpr size_t WS_LAT = 96 * MiB;
constexpr size_t WS_KROPE = 136 * MiB;
constexpr size_t WS_G1 = 140 * MiB;
constexpr size_t WS_Q1 = 204 * MiB;
constexpr size_t WS_KV1 = 300 * MiB;
constexpr size_t WS_MG1 = 428 * MiB;
constexpr size_t WS_X2H = 96 * MiB;
constexpr size_t WS_END = 492 * MiB;
constexpr size_t WS_DBGBUF = 3 * MiB + 4096;
constexpr int CW_TMO = 0, CW_CODE = 1, CW_Q0 = 64, CW_Q1 = 128, CW_BAR = 4096;

constexpr int RING_BYTES = 131072;
constexpr int MISC_OFF = RING_BYTES + 320;
constexpr int LDS_BYTES = 147456;
constexpr int NWAVES = 8;

__device__ __forceinline__ unsigned pkh(float lo, float hi) { f32x2 v = {lo, hi}; h2 h = __builtin_convertvector(v, h2); return __builtin_bit_cast(unsigned, h); }
__device__ __forceinline__ float h2f(u16 b) { return (float)__builtin_bit_cast(_Float16, b); }
__device__ __forceinline__ float silu_f(float x) { return x * __builtin_amdgcn_rcpf(1.0f + __builtin_amdgcn_exp2f(-x * LOG2E)); }
__device__ __forceinline__ float swap_max(float m) { auto rr = __builtin_amdgcn_permlane32_swap(__float_as_uint(m), __float_as_uint(m), false, false); return fmaxf(__uint_as_float(rr[0]), __uint_as_float(rr[1])); }
__device__ __forceinline__ float swap_sum(float m) { auto rr = __builtin_amdgcn_permlane32_swap(__float_as_uint(m), __float_as_uint(m), false, false); return __uint_as_float(rr[0]) + __uint_as_float(rr[1]); }
__device__ __forceinline__ float wave_sum(float v) {
#pragma unroll
    for (int o = 1; o < 64; o <<= 1) v += __shfl_xor(v, o);
    return v;
}
#define LDS_WAIT() asm volatile("s_waitcnt lgkmcnt(0)" ::: "memory")
#define VM_WAIT() asm volatile("s_waitcnt vmcnt(0)" ::: "memory")

namespace pg8 {
constexpr int BM = 256, BK = 64, HALF = 128, HTB = HALF * BK * 2, STAGE_BYTES = 8 * HTB, NXCD = 8, WGM = 8;
__host__ __device__ __forceinline__ int lds_byte(int r, int c) { const int st = (r >> 4) * 2 + (c >> 5), rr = r & 15, cc = c & 31, ob = rr * 64 + cc * 2; return st * 1024 + (ob ^ (((ob >> 9) & 1) << 5)); }
__host__ __device__ __forceinline__ void stage_rc(int b, int& R, int& C) { const int st = b / 1024, sb = b % 1024, swz = sb ^ (((sb >> 9) & 1) << 5); R = (st >> 1) * 16 + swz / 64; C = (st & 1) * 32 + (swz % 64) / 2; }
__host__ __device__ __forceinline__ int perm32(int rho) { const int n = rho >> 4, i = rho & 15; return 8 * (i >> 2) + 4 * n + (i & 3); }
struct Unit { int pm, pn; };
struct Gemm { const u16* A; const u16* Bt; int M, N, K, lda; };
struct StaticOrder {
    int nM, nN, nwg, G, c;
    __device__ void init(int M, int N, int G_, int c_) { nM = M / BM; nN = N / BM; nwg = nM * nN; G = G_; c = c_; }
    __device__ bool next(int i, Unit& u) const {
        const long L = (long)i * G + c; if (L >= nwg) return false;
        int wgid = (int)L; { const int q = nwg / NXCD, r = nwg % NXCD, xcd = wgid % NXCD, off = wgid / NXCD; wgid = (xcd < r ? xcd * (q + 1) : r * (q + 1) + (xcd - r) * q) + off; }
        const int nig = WGM * nN, gid = wgid / nig, fm = gid * WGM, gsz = (nM - fm) < WGM ? (nM - fm) : WGM;
        u.pm = fm + ((wgid % nig) % gsz); u.pn = (wgid % nig) / gsz; return true;
    }
};
template <class Epi>
__device__ __forceinline__ void gemm_phase(LAS unsigned char* lds, const Gemm g, const StaticOrder& S, const Epi& E) {
    const int tid = threadIdx.x, wid = __builtin_amdgcn_readfirstlane(tid >> 6), lane = tid & 63, wr = wid >> 2, wc = wid & 3, fr = lane & 15, fq = lane >> 4;
    const int K = g.K, nt = K / BK, lda = g.lda;
    unsigned voffA[2], voffB[2];
#pragma unroll
    for (int i = 0; i < 2; ++i) { int R, C; stage_rc(tid * 16 + i * 8192, R, C); const int Rb = Epi::PERM ? ((R & ~31) + perm32(R & 31)) : R;
        voffA[i] = (unsigned)(R * lda + C) * 2u; voffB[i] = (unsigned)(Rb * K + C) * 2u; }
    const size_t kstep = (size_t)(BK * 2);
    const size_t hstepA = (size_t)HALF * lda * 2, tstepA = 2 * hstepA;
    const size_t hstepB = (size_t)HALF * K * 2, tstepB = 2 * hstepB;
    const unsigned ldsw = (unsigned)wid * 1024u;
    const int aoff = lds_byte(wr * 64 + fr, fq * 8), boff = lds_byte(wc * 32 + fr, fq * 8);
#define PG8_SA(b, h) (((b) * 2 + (h)) * HTB)
#define PG8_SB(b, h) ((4 + (b) * 2 + (h)) * HTB)
#define PG8_STAGE(bufoff, gbase, voff) do { _Pragma("unroll") for (int _i = 0; _i < 2; ++_i) \
        __builtin_amdgcn_global_load_lds((const unsigned*)((const char*)(gbase) + (voff)[_i]), (LAS unsigned*)(lds + (bufoff) + ldsw + _i * 8192), 16, 0, 0); } while (0)
#define PG8_LDA(dst, b, h) do { _Pragma("unroll") for (int m = 0; m < 4; ++m) _Pragma("unroll") for (int k = 0; k < 2; ++k) dst[m][k] = *(const LAS h8*)(lds + PG8_SA(b, h) + aoff + m * 2048 + k * 1024); } while (0)
#define PG8_LDB(dst, b, h) do { _Pragma("unroll") for (int n = 0; n < 2; ++n) _Pragma("unroll") for (int k = 0; k < 2; ++k) dst[n][k] = *(const LAS h8*)(lds + PG8_SB(b, h) + boff + n * 2048 + k * 1024); } while (0)
#define PG8_MMA(ai, bj, At, Bt) do { __builtin_amdgcn_s_setprio(1); _Pragma("unroll") for (int m = 0; m < 4; ++m) _Pragma("unroll") for (int n = 0; n < 2; ++n) _Pragma("unroll") for (int k = 0; k < 2; ++k) \
        acc[ai][bj][m][n] = __builtin_amdgcn_mfma_f32_16x16x32_f16(Bt[n][k], At[m][k], acc[ai][bj][m][n], 0, 0, 0); __builtin_amdgcn_s_setprio(0); } while (0)
#define PG8_WAIT_V(n) asm volatile("s_waitcnt vmcnt(" #n ")" ::: "memory")
#define PG8_WAIT_L(n) asm volatile("s_waitcnt lgkmcnt(" #n ")" ::: "memory")
#define PG8_BAR __builtin_amdgcn_s_barrier()
#define PG8_SCHED __builtin_amdgcn_sched_barrier(0)
    Unit cur, nxt; int ui = 0;
    if (!S.next(0, cur)) return;
    f32x4 acc[2][2][4][2];
#pragma unroll
    for (int a = 0; a < 2; ++a)
#pragma unroll
        for (int b = 0; b < 2; ++b)
#pragma unroll
            for (int m = 0; m < 4; ++m)
#pragma unroll
                for (int n = 0; n < 2; ++n) acc[a][b][m][n] = (f32x4){0.f, 0.f, 0.f, 0.f};
    h8 At[4][2], B0[2][2], B1[2][2];
    const char* cA = (const char*)g.A + (size_t)cur.pm * tstepA; const char* cB = (const char*)g.Bt + (size_t)cur.pn * tstepB;
    PG8_STAGE(PG8_SB(0, 0), cB, voffB); PG8_STAGE(PG8_SB(0, 1), cB + hstepB, voffB); PG8_STAGE(PG8_SA(0, 0), cA, voffA); PG8_STAGE(PG8_SA(0, 1), cA + hstepA, voffA);
    if (wr == 1) PG8_BAR;
    PG8_WAIT_V(2); PG8_BAR;
    PG8_STAGE(PG8_SB(1, 0), cB + kstep, voffB); PG8_STAGE(PG8_SA(1, 0), cA + kstep, voffA); PG8_STAGE(PG8_SB(1, 1), cB + hstepB + kstep, voffB);
    PG8_WAIT_V(6); PG8_BAR;
    for (;;) {
        const bool has_next = S.next(ui + 1, nxt);
        const char* nA = has_next ? (const char*)g.A + (size_t)nxt.pm * tstepA : cA; const char* nB = has_next ? (const char*)g.Bt + (size_t)nxt.pn * tstepB : cB;
#pragma unroll 1
        for (int t = 0; t < nt; t += 2) {
            const bool last = (t == nt - 2);
            const char* a1 = cA + (size_t)(t + 1) * kstep;
            const char* a2 = last ? nA : cA + (size_t)(t + 2) * kstep; const char* b2 = last ? nB : cB + (size_t)(t + 2) * kstep;
            const char* a3 = a2 + kstep; const char* b3 = b2 + kstep;
            PG8_LDB(B0, 0, 0); PG8_LDB(B1, 0, 1); PG8_SCHED; PG8_LDA(At, 0, 0); PG8_STAGE(PG8_SA(1, 1), a1 + hstepA, voffA);
            PG8_WAIT_V(8); PG8_WAIT_L(0); PG8_BAR; PG8_MMA(0, 0, At, B0); PG8_MMA(0, 1, At, B1); PG8_BAR; PG8_SCHED;
            PG8_LDA(At, 0, 1); PG8_STAGE(PG8_SB(0, 0), b2, voffB); PG8_STAGE(PG8_SB(0, 1), b2 + hstepB, voffB); PG8_STAGE(PG8_SA(0, 0), a2, voffA);
            PG8_WAIT_V(8); PG8_WAIT_L(0); PG8_BAR; PG8_MMA(1, 0, At, B0); PG8_MMA(1, 1, At, B1); PG8_BAR; PG8_SCHED;
            PG8_LDB(B0, 1, 0); PG8_LDB(B1, 1, 1); PG8_SCHED; PG8_LDA(At, 1, 0); PG8_STAGE(PG8_SA(0, 1), a2 + hstepA, voffA);
            PG8_WAIT_V(8); PG8_WAIT_L(0); PG8_BAR; PG8_MMA(0, 0, At, B0); PG8_MMA(0, 1, At, B1); PG8_BAR; PG8_SCHED;
            PG8_LDA(At, 1, 1); PG8_STAGE(PG8_SB(1, 0), b3, voffB); PG8_STAGE(PG8_SB(1, 1), b3 + hstepB, voffB); PG8_STAGE(PG8_SA(1, 0), a3, voffA);
            PG8_WAIT_V(8); PG8_WAIT_L(0); PG8_BAR; PG8_MMA(1, 0, At, B0); PG8_MMA(1, 1, At, B1); PG8_BAR; PG8_SCHED;
        }
        if (wr == 0) PG8_BAR;
        E(acc, cur, wr, wc, fr, fq);
        if (!has_next) break;
#pragma unroll
        for (int a = 0; a < 2; ++a)
#pragma unroll
            for (int b = 0; b < 2; ++b)
#pragma unroll
                for (int m = 0; m < 4; ++m)
#pragma unroll
                    for (int n = 0; n < 2; ++n) acc[a][b][m][n] = (f32x4){0.f, 0.f, 0.f, 0.f};
        cur = nxt; cA = nA; cB = nB; ++ui;
        if (wr == 1) PG8_BAR;
    }
    PG8_WAIT_V(0);
    PG8_BAR;
#undef PG8_SA
#undef PG8_SB
#undef PG8_STAGE
#undef PG8_LDA
#undef PG8_LDB
#undef PG8_MMA
#undef PG8_WAIT_V
#undef PG8_WAIT_L
#undef PG8_BAR
#undef PG8_SCHED
}

typedef f32x4 Acc[2][2][4][2];
__device__ __forceinline__ float rstd_from(const u64* ssq, int row, float inv_n) { return __builtin_amdgcn_rsqf((float)ssq[row] * (1.0f / FXS) * inv_n + RMS_EPS); }
__device__ __forceinline__ void ssq_add(u64* ssq, int row, float ss, int fq) {
    ss += __shfl_xor(ss, 16); ss += __shfl_xor(ss, 32);
    if (fq == 0) atomicAdd((unsigned long long*)(ssq + row), (unsigned long long)(ss * FXS + 0.5f));
}
struct EpiProj0 {
    static constexpr bool PERM = true;
    u16* O;
    __device__ __forceinline__ void operator()(const Acc& acc, const Unit& u, int wr, int wc, int fr, int fq) const {
        const int row0 = u.pm * BM + wr * 64 + fr, col0 = u.pn * BM + wc * 32 + 8 * fq; const bool gate = u.pn >= 11;
#pragma unroll
        for (int ai = 0; ai < 2; ++ai)
#pragma unroll
            for (int m = 0; m < 4; ++m) { u16* rowp = O + (size_t)(row0 + ai * HALF + m * 16) * P0W + col0;
#pragma unroll
                for (int bj = 0; bj < 2; ++bj) { f32x4 v0 = acc[ai][bj][m][0], v1 = acc[ai][bj][m][1];
                    if (gate) {
#pragma unroll
                        for (int e = 0; e < 4; ++e) { v0[e] = silu_f(v0[e]); v1[e] = silu_f(v1[e]); } }
                    u32x4 w; w.x = pkh(v0[0], v0[1]); w.y = pkh(v0[2], v0[3]); w.z = pkh(v1[0], v1[1]); w.w = pkh(v1[2], v1[3]);
                    *(u32x4*)(rowp + bj * HALF) = w; } }
    }
};
struct EpiRes0 {
    static constexpr bool PERM = false;
    const float* base; u16* outh; u64* ssq;
    __device__ __forceinline__ void operator()(const Acc& acc, const Unit& u, int wr, int wc, int fr, int fq) const {
        const int row0 = u.pm * BM + wr * 64 + fr, col0 = u.pn * BM + wc * 32 + 4 * fq;
#pragma unroll
        for (int ai = 0; ai < 2; ++ai)
#pragma unroll
            for (int m = 0; m < 4; ++m) { const int row = row0 + ai * HALF + m * 16; const size_t off = (size_t)row * DM + col0; float ss = 0.f;
#pragma unroll
                for (int bj = 0; bj < 2; ++bj)
#pragma unroll
                    for (int n = 0; n < 2; ++n) { const f32x4 bs = *(const f32x4*)(base + off + bj * HALF + n * 16); const f32x4 o = bs + acc[ai][bj][m][n];
                        u32x2 w; w.x = pkh(o[0], o[1]); w.y = pkh(o[2], o[3]); *(u32x2*)(outh + off + bj * HALF + n * 16) = w;
                        ss += (o[0] * o[0] + o[1] * o[1]) + (o[2] * o[2] + o[3] * o[3]); }
                if (ssq) ssq_add(ssq, row, ss, fq); }
    }
};
struct EpiRes1 {
    static constexpr bool PERM = false;
    const u16* baseh; u16* outh;
    __device__ __forceinline__ void operator()(const Acc& acc, const Unit& u, int wr, int wc, int fr, int fq) const {
        const int row0 = u.pm * BM + wr * 64 + fr, col0 = u.pn * BM + wc * 32 + 4 * fq;
#pragma unroll
        for (int ai = 0; ai < 2; ++ai)
#pragma unroll
            for (int m = 0; m < 4; ++m) { const int row = row0 + ai * HALF + m * 16; const size_t off = (size_t)row * DM + col0;
#pragma unroll
                for (int bj = 0; bj < 2; ++bj)
#pragma unroll
                    for (int n = 0; n < 2; ++n) { const h4 bh = *(const h4*)(baseh + off + bj * HALF + n * 16);
                        const f32x4 a = acc[ai][bj][m][n];
                        u32x2 w; w.x = pkh(a[0] + (float)bh[0], a[1] + (float)bh[1]); w.y = pkh(a[2] + (float)bh[2], a[3] + (float)bh[3]);
                        *(u32x2*)(outh + off + bj * HALF + n * 16) = w; } }
    }
};
struct EpiProj1 {
    static constexpr bool PERM = false;
    const u64* ssq1; u16* lat; u16* krope; u16* g1; u64* ssqkv; u64* ssqq; const float* ropec; const float* ropes;
    __device__ __forceinline__ void operator()(const Acc& acc, const Unit& u, int wr, int wc, int fr, int fq) const {
        const int row0 = u.pm * BM + wr * 64 + fr, pn = u.pn;
#pragma unroll
        for (int ai = 0; ai < 2; ++ai)
#pragma unroll
            for (int m = 0; m < 4; ++m) { const int row = row0 + ai * HALF + m * 16; const float rs = rstd_from(ssq1, row, 1.0f / 1024.0f); float ss = 0.f;
#pragma unroll
                for (int bj = 0; bj < 2; ++bj) { f32x4 v0 = acc[ai][bj][m][0] * rs, v1 = acc[ai][bj][m][1] * rs;
                    const int tc = bj * HALF + wc * 32 + 4 * fq;
                    if (pn >= 3) {
#pragma unroll
                        for (int e = 0; e < 4; ++e) { v0[e] = silu_f(v0[e]); v1[e] = silu_f(v1[e]); }
                        u16* p = g1 + (size_t)row * DM + (pn - 3) * BM + tc;
                        u32x2 w0, w1; w0.x = pkh(v0[0], v0[1]); w0.y = pkh(v0[2], v0[3]); w1.x = pkh(v1[0], v1[1]); w1.y = pkh(v1[2], v1[3]);
                        *(u32x2*)p = w0; *(u32x2*)(p + 16) = w1;
                    } else if (pn < 2 || bj == 0) {
                        u16* p = lat + (size_t)row * LATW + pn * BM + tc;
                        u32x2 w0, w1; w0.x = pkh(v0[0], v0[1]); w0.y = pkh(v0[2], v0[3]); w1.x = pkh(v1[0], v1[1]); w1.y = pkh(v1[2], v1[3]);
                        *(u32x2*)p = w0; *(u32x2*)(p + 16) = w1;
                        ss += (v0[0] * v0[0] + v0[1] * v0[1]) + (v0[2] * v0[2] + v0[3] * v0[3]) + (v1[0] * v1[0] + v1[1] * v1[1]) + (v1[2] * v1[2] + v1[3] * v1[3]);
                    } else if (wc == 0) {
                        const int pos = row & (SEQ - 1); const f32x4 cs = *(const f32x4*)(ropec + pos * 16 + 4 * fq), sn = *(const f32x4*)(ropes + pos * 16 + 4 * fq);
                        const f32x4 o0 = v0 * cs - v1 * sn, o1 = v0 * sn + v1 * cs;
                        u16* p = krope + (size_t)row * 32 + 4 * fq;
                        u32x2 w0, w1; w0.x = pkh(o0[0], o0[1]); w0.y = pkh(o0[2], o0[3]); w1.x = pkh(o1[0], o1[1]); w1.y = pkh(o1[2], o1[3]);
                        *(u32x2*)p = w0; *(u32x2*)(p + 16) = w1;
                    } }
                if (pn == 0) { if (ssqkv) ssq_add(ssqkv, row, ss, fq); } else if (pn <= 2) { if (ssqq) ssq_add(ssqq, row, ss, fq); }
                asm volatile("" ::: "memory"); }
    }
};
struct EpiQ1 {
    static constexpr bool PERM = false;
    const u64* ssqq; u16* q1; const float* ropec; const float* ropes;
    __device__ __forceinline__ void operator()(const Acc& acc, const Unit& u, int wr, int wc, int fr, int fq) const {
        const int row0 = u.pm * BM + wr * 64 + fr;
#pragma unroll
        for (int ai = 0; ai < 2; ++ai)
#pragma unroll
            for (int m = 0; m < 4; ++m) { const int row = row0 + ai * HALF + m * 16; const float rs = rstd_from(ssqq, row, 1.0f / 384.0f);
#pragma unroll
                for (int bj = 0; bj < 2; ++bj) { f32x4 v0 = acc[ai][bj][m][0] * rs, v1 = acc[ai][bj][m][1] * rs;
                    const int g0 = u.pn * BM + bj * HALF + wc * 32;
                    if ((g0 % 96) == 64) { const int pos = row & (SEQ - 1); const f32x4 cs = *(const f32x4*)(ropec + pos * 16 + 4 * fq), sn = *(const f32x4*)(ropes + pos * 16 + 4 * fq);
                        const f32x4 o0 = v0 * cs - v1 * sn, o1 = v0 * sn + v1 * cs; v0 = o0; v1 = o1; }
                    u16* p = q1 + (size_t)row * 1536 + g0 + 4 * fq;
                    u32x2 w0, w1; w0.x = pkh(v0[0], v0[1]); w0.y = pkh(v0[2], v0[3]); w1.x = pkh(v1[0], v1[1]); w1.y = pkh(v1[2], v1[3]);
                    *(u32x2*)p = w0; *(u32x2*)(p + 16) = w1; }
                asm volatile("" ::: "memory"); }
    }
};
struct EpiKV1 {
    static constexpr bool PERM = true;
    const u64* ssqkv; u16* kv1;
    __device__ __forceinline__ void operator()(const Acc& acc, const Unit& u, int wr, int wc, int fr, int fq) const {
        const int row0 = u.pm * BM + wr * 64 + fr, col0 = u.pn * BM + wc * 32 + 8 * fq;
#pragma unroll
        for (int ai = 0; ai < 2; ++ai)
#pragma unroll
            for (int m = 0; m < 4; ++m) { const int row = row0 + ai * HALF + m * 16; const float rs = rstd_from(ssqkv, row, 1.0f / 256.0f); u16* rowp = kv1 + (size_t)row * 2048 + col0;
#pragma unroll
                for (int bj = 0; bj < 2; ++bj) { const f32x4 v0 = acc[ai][bj][m][0] * rs, v1 = acc[ai][bj][m][1] * rs;
                    u32x4 w; w.x = pkh(v0[0], v0[1]); w.y = pkh(v0[2], v0[3]); w.z = pkh(v1[0], v1[1]); w.w = pkh(v1[2], v1[3]);
                    *(u32x4*)(rowp + bj * HALF) = w; }
                if (m & 1) asm volatile("" ::: "memory"); }
    }
};
}

#define XB_TMO      128
#define XB_XCNT(j)  (256  + 64 * (j))
#define XB_XSUB(j)  (1280 + 64 * (j))
#define XB_XGEN(j)  (2304 + 64 * (j))
#define XB_TOP      3328
#define XB_TOPGEN   3392
#define XCD_BAR_WORDS 3456
#define XB_SPIN_CAP (1u << 20)
__device__ __forceinline__ unsigned xb_ld(unsigned* p)              { return __hip_atomic_load(p, __ATOMIC_RELAXED, __HIP_MEMORY_SCOPE_AGENT); }
__device__ __forceinline__ unsigned xb_add(unsigned* p, unsigned v) { return __hip_atomic_fetch_add(p, v, __ATOMIC_RELAXED, __HIP_MEMORY_SCOPE_AGENT); }
__device__ __forceinline__ unsigned xb_xcc_id() { return (unsigned)__builtin_amdgcn_s_getreg((3 << 11) | 20) & 0xFu; }
#define XB_SPIN(cond, bar) do { unsigned _sp = 0; while (cond) { __builtin_amdgcn_s_sleep(1); \
    if ((++_sp & 255u) == 0u) { if (xb_ld(&(bar)[XB_TMO])) break; if (_sp > XB_SPIN_CAP) { atomicAdd(&(bar)[XB_TMO], 1u); break; } } } } while (0)
struct XcdBarrier { unsigned* bar; unsigned x; volatile LAS unsigned* st; };
__device__ __forceinline__ XcdBarrier xcd_barrier_post(unsigned* bar, volatile LAS unsigned* st) {
    XcdBarrier b; b.bar = bar; b.x = xb_xcc_id(); b.st = st;
    if (threadIdx.x == 0) (void)xb_add(&bar[XB_XCNT(b.x)], 1u);
    return b;
}
__device__ __forceinline__ void xcd_barrier_complete(unsigned* bar, unsigned x, unsigned& nloc, unsigned& nx) {
    const unsigned G = gridDim.x * gridDim.y * gridDim.z;
    unsigned sum, cnt, mine, sp = 0u;
    for (;;) {
        sum = 0u; cnt = 0u; mine = 0u;
#pragma unroll
        for (unsigned j = 0; j < 16; ++j) { const unsigned c = xb_ld(&bar[XB_XCNT(j)]); sum += c; cnt += (c > 0u) ? 1u : 0u; mine = (j == x) ? c : mine; }
        if (sum == G) break;
        __builtin_amdgcn_s_sleep(1);
        if ((++sp & 255u) == 0u) { if (xb_ld(&bar[XB_TMO])) break; if (sp > XB_SPIN_CAP) { atomicAdd(&bar[XB_TMO], 1u); break; } }
    }
    nloc = mine > 0u ? mine : 1u; nx = cnt > 0u ? cnt : 1u;
}
__device__ __forceinline__ void xcd_barrier(const XcdBarrier& b) {
    asm volatile("s_waitcnt vmcnt(0)" ::: "memory");
    __syncthreads();
    if (threadIdx.x == 0) {
        unsigned* bar = b.bar;
        __builtin_amdgcn_s_waitcnt(0);
        unsigned nloc = b.st[0], nx = b.st[1];
        if (nloc == 0u) { xcd_barrier_complete(bar, b.x, nloc, nx); b.st[0] = nloc; b.st[1] = nx; }
        const unsigned old = xb_add(&bar[XB_XSUB(b.x)], 1u);
        const unsigned gen = old / nloc;
        if (old + 1u == (gen + 1u) * nloc) {
            __builtin_amdgcn_fence(__ATOMIC_RELEASE, "agent");
            asm volatile("s_waitcnt vmcnt(0)" ::: "memory");
            const unsigned og = xb_add(&bar[XB_TOP], 1u);
            const unsigned tg = og / nx;
            if (og + 1u == (tg + 1u) * nx) xb_add(&bar[XB_TOPGEN], 1u);
            else XB_SPIN(xb_ld(&bar[XB_TOPGEN]) == tg, bar);
            __builtin_amdgcn_fence(__ATOMIC_ACQUIRE, "agent");
            xb_add(&bar[XB_XGEN(b.x)], 1u);
            asm volatile("s_waitcnt vmcnt(0)" ::: "memory");
        } else {
            XB_SPIN(xb_ld(&bar[XB_XGEN(b.x)]) == gen, bar);
            __builtin_amdgcn_fence(__ATOMIC_ACQUIRE, "agent");
            asm volatile("s_waitcnt vmcnt(0)" ::: "memory");
        }
    }
    __syncthreads();
}

struct Args { const float* in[18]; float* out; unsigned char* ws; int ph_lo, ph_hi; };
struct Frame {
    LAS unsigned char* lds;
    volatile LAS unsigned* MISC;
    unsigned* ctl;
    int tid, lane, wave, G;
    float* out;
    unsigned char* ws;
};
enum { I_X = 0, I_RELB, I_ENORM, I_EWIN, I_LQ1, I_LK1, I_LQ2, I_LK2, I_SUBLN, I_EWO, I_ONORM, I_OWIN, I_OQNORM, I_OWUQ, I_OKVNORM, I_OWUKV, I_OWO, I_FNORM };

__device__ __forceinline__ int t5_bucket(int rel) {
    const int n = rel < 0 ? -rel : rel;
    const int v = n < 8 ? n : n < 12 ? 8 : n < 16 ? 9 : n < 23 ? 10 : n < 32 ? 11 : n < 46 ? 12 : n < 64 ? 13 : n < 91 ? 14 : 15;
    return (rel > 0 ? 16 : 0) + v;
}

__device__ __forceinline__ int wsrc_col(int mat, int n) {
    switch (mat) {
        case 0: return n < 2760 ? n : (n < C_G0 ? -1 : n - 56);
        case 2: return n < 256 ? 384 + n : (n < 640 ? n - 256 : (n < 672 ? n : (n < 768 ? -1 : n - 96)));
        default: return n;
    }
}
__device__ __forceinline__ float wcol_scale(int mat, int n) {
    if (mat == 0) return (n < 512 || (n >= C_QB && n < C_QB + 512)) ? QS_AB : 1.0f;
    if (mat == 3) return QS_C;
    return 1.0f;
}
__device__ __forceinline__ void p0_transpose_item(const float* W, int K, int Nsrc, int Npad, const float* gain, int mat, u16* WT, LAS float* scr, int item, int lane) {
    const int nblk = Npad / 32, kb = item / nblk, nb = item % nblk, k0 = 64 * kb, n0 = 32 * nb;
    const int n = n0 + (lane & 31); const int sc = wsrc_col(mat, n); const float cs = wcol_scale(mat, n);
#pragma unroll 8
    for (int i = 0; i < 32; ++i) { const int kk = 2 * i + (lane >> 5); float v = 0.f;
        if (sc >= 0) { v = W[(size_t)(k0 + kk) * Nsrc + sc] * cs; if (gain) v *= gain[k0 + kk]; }
        scr[kk * 33 + (lane & 31)] = v; }
    LDS_WAIT(); asm volatile("" ::: "memory");
    const int c = lane & 7;
#pragma unroll
    for (int j = 0; j < 4; ++j) { const int nn = (lane >> 3) + 8 * j; const LAS float* s = scr + (8 * c) * 33 + nn;
        u32x4 o; o.x = pkh(s[0 * 33], s[1 * 33]); o.y = pkh(s[2 * 33], s[3 * 33]); o.z = pkh(s[4 * 33], s[5 * 33]); o.w = pkh(s[6 * 33], s[7 * 33]);
        *(u32x4*)(WT + (size_t)(n0 + nn) * K + k0 + 8 * c) = o; }
    LDS_WAIT(); asm volatile("" ::: "memory");
}
__device__ __forceinline__ void p0_prologue(Frame& F, const Args& AR) {
    LAS float* scr = (LAS float*)(F.lds + F.wave * 16384);
    const int gw = blockIdx.x * NWAVES + F.wave, NGW = F.G * NWAVES;
    unsigned char* ws = F.ws;
    constexpr int I0 = (1024 / 64) * (P0W / 32), I1 = (1024 / 64) * (1024 / 32), I2 = (1024 / 64) * (P1W / 32), I3 = (384 / 64) * (1536 / 32), I4 = (256 / 64) * (2048 / 32), I5 = I1;
    constexpr int NITEMS = I0 + I1 + I2 + I3 + I4 + I5;
    for (int it = gw; it < NITEMS; it += NGW) {
        int r = it;
        if (r < I0) { p0_transpose_item(AR.in[I_EWIN], 1024, L0_SRC, P0W, nullptr, 0, (u16*)(ws + WS_W0T), scr, r, F.lane); continue; } r -= I0;
        if (r < I1) { p0_transpose_item(AR.in[I_EWO], 1024, 1024, 1024, nullptr, 1, (u16*)(ws + WS_WO0T), scr, r, F.lane); continue; } r -= I1;
        if (r < I2) { p0_transpose_item(AR.in[I_OWIN], 1024, L1_SRC, P1W, AR.in[I_ONORM], 2, (u16*)(ws + WS_W1T), scr, r, F.lane); continue; } r -= I2;
        if (r < I3) { p0_transpose_item(AR.in[I_OWUQ], 384, 1536, 1536, AR.in[I_OQNORM], 3, (u16*)(ws + WS_WUQT), scr, r, F.lane); continue; } r -= I3;
        if (r < I4) { p0_transpose_item(AR.in[I_OWUKV], 256, 2048, 2048, AR.in[I_OKVNORM], 4, (u16*)(ws + WS_WUKVT), scr, r, F.lane); continue; } r -= I4;
        p0_transpose_item(AR.in[I_OWO], 1024, 1024, 1024, nullptr, 5, (u16*)(ws + WS_WO1T), scr, r, F.lane);
    }
    {
        const float* gn = AR.in[I_ENORM]; f32x4 gv[4];
#pragma unroll
        for (int j = 0; j < 4; ++j) gv[j] = *(const f32x4*)(gn + 4 * F.lane + 256 * j);
        u16* XN = (u16*)(ws + WS_XN0);
        for (int mrow = gw; mrow < T; mrow += NGW) {
            const f32x4* xr = (const f32x4*)(AR.in[I_X] + (size_t)mrow * DM) + F.lane;
            f32x4 v[4]; float s = 0.f;
#pragma unroll
            for (int j = 0; j < 4; ++j) { v[j] = xr[64 * j]; s += (v[j].x * v[j].x + v[j].y * v[j].y) + (v[j].z * v[j].z + v[j].w * v[j].w); }
            const float rstd = __builtin_amdgcn_rsqf(wave_sum(s) * (1.f / DM) + RMS_EPS);
            u32x2* o8 = (u32x2*)(XN + (size_t)mrow * DM) + F.lane;
#pragma unroll
            for (int j = 0; j < 4; ++j) { const f32x4 t = v[j] * rstd * gv[j]; u32x2 w; w.x = pkh(t.x, t.y); w.y = pkh(t.z, t.w); o8[64 * j] = w; }
        }
    }
    {
        float* rc = (float*)(ws + WS_ROPEC); float* rs = (float*)(ws + WS_ROPES);
        const int gt = blockIdx.x * 512 + F.tid, NGT = F.G * 512;
        for (int e = gt; e < SEQ * 16; e += NGT) { const int pos = e >> 4, i = e & 15;
            const float inv = (float)pow(10000.0, -(double)i / 16.0); const float ang = (float)pos * inv;
            rc[e] = (float)cos((double)ang); rs[e] = (float)sin((double)ang); }
        float* bt = (float*)(ws + WS_BTG);
        for (int e = gt; e < 12 * 192; e += NGT) { const int hd = e / 192, idx = e % 192; const int rel = idx - 128;
            bt[e] = AR.in[I_RELB][t5_bucket(rel) * 12 + hd] * LOG2E; }
        if (blockIdx.x == 0 && F.wave == 0) {
            const float a = wave_sum(AR.in[I_LQ1][F.lane] * AR.in[I_LK1][F.lane]), b = wave_sum(AR.in[I_LQ2][F.lane] * AR.in[I_LK2][F.lane]);
            if (F.lane == 0) *(float*)(ws + WS_LAM) = expf(a) - expf(b) + 0.2f;
        }
    }
}

__device__ __forceinline__ h8 tr2(LAS const unsigned char* p0, LAS const unsigned char* p1) {
    const s16x4 lo = __builtin_amdgcn_ds_read_tr16_b64_v4i16((LAS s16x4*)p0), hi = __builtin_amdgcn_ds_read_tr16_b64_v4i16((LAS s16x4*)p1);
    const s16x8 v = __builtin_shufflevector(lo, hi, 0, 1, 2, 3, 4, 5, 6, 7); return __builtin_bit_cast(h8, v);
}
constexpr float SM_THR = 8.0f;
__device__ __forceinline__ float max3f(float a, float b, float c) { float r; asm("v_max3_f32 %0, %1, %2, %3" : "=v"(r) : "v"(a), "v"(b), "v"(c)); return r; }
template <int ND, bool MASKED>
__device__ __forceinline__ void softmax_step(f32x16& p0, f32x16& p1, float& mref, float& lrun, bool& have, f32x16 (&o)[ND], h8 (&pf)[4]) {
    float mx = fmaxf(fmaxf(p0[0], p1[0]), fmaxf(p0[1], p1[1]));
#pragma unroll
    for (int r = 2; r < 16; r += 2) mx = fmaxf(mx, fmaxf(fmaxf(p0[r], p1[r]), fmaxf(p0[r + 1], p1[r + 1])));
    mx = swap_max(mx);
    const bool valid = MASKED ? (mx > -1e29f) : true;
    const bool trig = valid && (!have || mx > SM_THR);
    if (__any(trig)) {
        const float dl = valid ? (have ? fmaxf(mx, 0.f) : mx) : 0.f;
        have = have || valid;
        mref += dl;
        const float alpha = __builtin_amdgcn_exp2f(-dl);
        lrun *= alpha;
#pragma unroll
        for (int r = 0; r < 16; ++r) { p0[r] -= dl; p1[r] -= dl; }
#pragma unroll
        for (int d = 0; d < ND; ++d)
#pragma unroll
            for (int r = 0; r < 16; ++r) o[d][r] *= alpha;
    }
    float s0 = 0.f, s1 = 0.f;
#pragma unroll
    for (int r = 0; r < 16; ++r) { p0[r] = __builtin_amdgcn_exp2f(p0[r]); p1[r] = __builtin_amdgcn_exp2f(p1[r]); s0 += p0[r]; s1 += p1[r]; }
    lrun += s0 + s1;
#pragma unroll
    for (int ks = 0; ks < 4; ++ks) {
        u32x4 w;
        if (ks < 2) { w.x = pkh(p0[8 * ks + 0], p0[8 * ks + 1]); w.y = pkh(p0[8 * ks + 2], p0[8 * ks + 3]); w.z = pkh(p0[8 * ks + 4], p0[8 * ks + 5]); w.w = pkh(p0[8 * ks + 6], p0[8 * ks + 7]); }
        else { const int k2 = ks - 2; w.x = pkh(p1[8 * k2 + 0], p1[8 * k2 + 1]); w.y = pkh(p1[8 * k2 + 2], p1[8 * k2 + 3]); w.z = pkh(p1[8 * k2 + 4], p1[8 * k2 + 5]); w.w = pkh(p1[8 * k2 + 6], p1[8 * k2 + 7]); }
        pf[ks] = __builtin_bit_cast(h8, w);
    }
}
__device__ __forceinline__ void add_bias(f32x16& p0, f32x16& p1, const LAS float* bt, int idx0) {
#pragma unroll
    for (int r = 0; r < 16; ++r) { const int c = (r & 3) + 8 * (r >> 2);
        const int i0 = idx0 + c, i1 = idx0 + 32 + c;
        p0[r] += bt[i0 < 0 ? 0 : i0]; p1[r] += bt[i1 < 0 ? 0 : i1]; }
}
__device__ __forceinline__ int next_unit(Frame& F, int cw) {
    volatile LAS unsigned* slot = F.MISC + 16;
    __syncthreads();
    if (F.tid == 0) slot[0] = __hip_atomic_fetch_add(F.ctl + cw, 1u, __ATOMIC_RELAXED, __HIP_MEMORY_SCOPE_AGENT);
    __syncthreads();
    return (int)slot[0];
}

__device__ __forceinline__ void attnA_unit(Frame& F, const Args& AR, int b, int h, int qb) {
    LAS unsigned char* lds = F.lds;
    int tid = F.tid; asm volatile("" : "+v"(tid)); int wid = F.wave; asm volatile("" : "+s"(wid));
    const int lane = tid & 63, r32 = lane & 31, hi = lane >> 5;
    const int m = wid & 1, qsub = wid >> 1, q0 = 128 * qb + 32 * qsub, cw = q0 >> 6, nt = 2 * qb + 2;
    const size_t rowb = (size_t)b * SEQ;
    const u16* P0 = (const u16*)(F.ws + WS_PROJ0);
    LAS float* bt = (LAS float*)(lds + 65536);
    if (tid < 192) bt[tid] = ((const float*)(F.ws + WS_BTG))[h * 192 + tid];
    h8 qf[4];
    { const u16* qp = P0 + (rowb + q0 + r32) * P0W + C_QA + h * 128 + m * 64 + hi * 8;
#pragma unroll
      for (int d0 = 0; d0 < 4; ++d0) qf[d0] = *(const h8*)(qp + d0 * 16); }
    f32x16 o[4];
#pragma unroll
    for (int d = 0; d < 4; ++d)
#pragma unroll
        for (int r = 0; r < 16; ++r) o[d][r] = 0.f;
    float mrun = 0.f, lrun = 0.f; bool have = false;
    const int krow = tid >> 3, kch = tid & 7, vrow = tid >> 4, vch = tid & 15;
    const u16* ksrc = P0 + (rowb + krow) * P0W + C_KA + h * 128 + kch * 8;
    const u16* vsrc = P0 + (rowb + vrow) * P0W + C_VA + h * 128 + vch * 8;
    const int kdst = krow * 128 + ((kch ^ ((krow >> 1) & 7)) << 4);
    const int vdst = 16384 + vrow * 256 + ((vch ^ ((vrow & 3) << 2)) << 4);
    u32x4 st0, st1, st2, st3;
#define A_LOAD(t) do { const size_t to = (size_t)(t) * 64 * P0W; st0 = *(const u32x4*)(ksrc + to); st1 = *(const u32x4*)(ksrc + to + 64); st2 = *(const u32x4*)(vsrc + to); st3 = *(const u32x4*)(vsrc + to + (size_t)32 * P0W); } while (0)
#define A_WRITE(s) do { LAS unsigned char* sb = lds + (s) * 32768; *(LAS u32x4*)(sb + kdst) = st0; *(LAS u32x4*)(sb + 8192 + kdst) = st1; *(LAS u32x4*)(sb + vdst) = st2; *(LAS u32x4*)(sb + vdst + 32 * 256) = st3; } while (0)
    const int kfo = r32 * 128, ksw = (r32 >> 1) & 7;
    const int i16 = lane & 15, qrow = i16 >> 2, pp = i16 & 3, g16 = (lane >> 4) & 1;
    const int vlane = (4 * hi + qrow) * 256 + ((2 * g16 + (pp >> 1)) << 4) + 8 * (pp & 1);
    const int qglob = q0 + r32;
    A_LOAD(0); A_WRITE(0); __syncthreads();
    for (int t = 0; t < nt; ++t) {
        if (t + 1 < nt) A_LOAD(t + 1);
        if (t <= cw) {
            LAS const unsigned char* sb = lds + (t & 1) * 32768; LAS const unsigned char* kb = sb + m * 8192 + kfo; LAS const unsigned char* vb = sb + 16384 + vlane;
            const bool nearb = (64 * t + 63 - q0) > -128;
            const float c0 = (nearb ? 0.f : bt[0]) - mrun;
            f32x16 p0, p1;
#pragma unroll
            for (int r = 0; r < 16; ++r) { p0[r] = c0; p1[r] = c0; }
#pragma unroll
            for (int d0 = 0; d0 < 4; ++d0) { const int co = ((2 * d0 + hi) ^ ksw) << 4;
                const h8 ka = *(LAS const h8*)(kb + co), kc = *(LAS const h8*)(kb + 4096 + co);
                p0 = __builtin_amdgcn_mfma_f32_32x32x16_f16(ka, qf[d0], p0, 0, 0, 0); p1 = __builtin_amdgcn_mfma_f32_32x32x16_f16(kc, qf[d0], p1, 0, 0, 0); }
            if (nearb) add_bias(p0, p1, bt, 64 * t + 4 * hi - qglob + 128);
            h8 pf[4];
            softmax_step<4, false>(p0, p1, mrun, lrun, have, o, pf);
#pragma unroll
            for (int d0 = 0; d0 < 4; ++d0) { const int dx = (d0 ^ qrow) << 6;
#pragma unroll
                for (int ks = 0; ks < 4; ++ks) { const h8 vf = tr2(vb + ks * 4096 + dx, vb + ks * 4096 + 2048 + dx);
                    o[d0] = __builtin_amdgcn_mfma_f32_32x32x16_f16(vf, pf[ks], o[d0], 0, 0, 0); } }
        }
        if (t + 1 < nt) A_WRITE((t + 1) & 1);
        __syncthreads();
    }
#undef A_LOAD
#undef A_WRITE
    const float linv = 1.0f / swap_sum(lrun);
    LAS f32x4* xb = (LAS f32x4*)(lds + qsub * 16384);
    if (m == 1) {
#pragma unroll
        for (int d0 = 0; d0 < 4; ++d0)
#pragma unroll
            for (int g = 0; g < 4; ++g) { f32x4 v = {o[d0][4 * g] * linv, o[d0][4 * g + 1] * linv, o[d0][4 * g + 2] * linv, o[d0][4 * g + 3] * linv};
                xb[(8 * d0 + 2 * g + hi) * 32 + r32] = v; }
    }
    __syncthreads();
    if (m == 0) {
        const float lam = *(const float*)(F.ws + WS_LAM);
        float ss = 0.f;
#pragma unroll
        for (int d0 = 0; d0 < 4; ++d0)
#pragma unroll
            for (int g = 0; g < 4; ++g) { const f32x4 v1 = xb[(8 * d0 + 2 * g + hi) * 32 + r32];
#pragma unroll
                for (int e = 0; e < 4; ++e) { const float v = o[d0][4 * g + e] * linv - lam * v1[e]; o[d0][4 * g + e] = v; ss += v * v; } }
        ss = swap_sum(ss);
        const float rs = __builtin_amdgcn_rsqf(ss * (1.0f / 128.0f) + RMS_EPS) * 0.8f;
        const size_t row = rowb + qglob;
        const u16* gp = P0 + row * P0W + C_G0 + h * 128;
        u16* op = (u16*)(F.ws + WS_MG0) + row * DM + h * 128;
        const float* sg = AR.in[I_SUBLN];
#pragma unroll
        for (int d0 = 0; d0 < 4; ++d0)
#pragma unroll
            for (int g = 0; g < 4; ++g) { const int d = 32 * d0 + 8 * g + 4 * hi;
                const h4 gv = *(const h4*)(gp + d); const f32x4 sv = *(const f32x4*)(sg + d);
                u32x2 w; w.x = pkh(o[d0][4 * g] * rs * sv[0] * (float)gv[0], o[d0][4 * g + 1] * rs * sv[1] * (float)gv[1]);
                w.y = pkh(o[d0][4 * g + 2] * rs * sv[2] * (float)gv[2], o[d0][4 * g + 3] * rs * sv[3] * (float)gv[3]);
                *(u32x2*)(op + d) = w; }
    }
}

constexpr int B_XROW = 1028, B_MASK = 66560, B_QF = 82944, B_BT = 99328;
__device__ __forceinline__ float next_up(float x) { if (x == 0.f) return __uint_as_float(1u); const unsigned u = __float_as_uint(x); return __uint_as_float(x > 0.f ? u + 1u : u - 1u); }
template <int OP> __device__ __forceinline__ float hw_red_f(float v) {
#define HWR_STEP(ctrl) { const float o_ = __uint_as_float((unsigned)__builtin_amdgcn_update_dpp(0, (int)__float_as_uint(v), ctrl, 0xf, 0xf, false)); v = OP ? fmaxf(v, o_) : fminf(v, o_); }
    HWR_STEP(0xB1) HWR_STEP(0x4E) HWR_STEP(0x141) HWR_STEP(0x140)
#undef HWR_STEP
    const float o2 = __shfl_xor(v, 16); return OP ? fmaxf(v, o2) : fminf(v, o2);
}
__device__ __forceinline__ unsigned hw_sum_u(unsigned v) {
#define HWS_STEP(ctrl) v += (unsigned)__builtin_amdgcn_update_dpp(0, (int)v, ctrl, 0xf, 0xf, false);
    HWS_STEP(0xB1) HWS_STEP(0x4E) HWS_STEP(0x141) HWS_STEP(0x140)
#undef HWS_STEP
    return v + (unsigned)__shfl_xor((int)v, 16);
}
__device__ __forceinline__ void selB_16(Frame& F, int b, int c, int q0, int mrow0, int abl = 0) {
    LAS unsigned char* lds = F.lds;
    int tid = F.tid; asm volatile("" : "+v"(tid)); int wid = F.wave; asm volatile("" : "+s"(wid));
    const int lane = tid & 63, ql = lane & 15, g = lane >> 4, l31 = lane & 31, hq = lane >> 5;
    const size_t rowb = (size_t)b * SEQ;
    const u16* P0 = (const u16*)(F.ws + WS_PROJ0);
    const int NT16 = 4 * (c + 1), N = 64 * (c + 1);
    if (c < 4) {
        for (int e = tid; e < 16 * (c + 1); e += 512) { const int q = e / (c + 1), t = e % (c + 1); *(LAS u64*)(lds + B_MASK + ((mrow0 + q) * 64 + t) * 8) = ~0ull; }
        return;
    }
    LAS h8* qfl = (LAS h8*)(lds + B_QF);
#pragma unroll
    for (int i = 0; i < 2; ++i) { const int idx = tid + 512 * i, fg = idx >> 6, ln = idx & 63, hh = fg >> 1, ks = fg & 1;
        qfl[idx] = *(const h8*)(P0 + (rowb + q0 + (ln & 15)) * P0W + C_QI + hh * 64 + 32 * ks + 8 * (ln >> 4)); }
    float wq[8];
    { const h8 wv = *(const h8*)(P0 + (rowb + q0 + ql) * P0W + C_WI);
#pragma unroll
      for (int i = 0; i < 8; ++i) wq[i] = (float)wv[i]; }
    __syncthreads();
    float sc[128]; float mn = INFINITY, mxv = -INFINITY;
    LAS float* X = (LAS float*)lds;
    const u16* kp = P0 + (rowb + ql) * P0W + C_KI + 8 * g;
    const int nq = (N + 1023) >> 10;
#pragma unroll
    for (int qr = 0; qr < 4; ++qr) {
        if (qr < nq) {
            h8 ka[2][2], kn[2][2];
#pragma unroll
            for (int u = 0; u < 2; ++u) { const int j = 64 * qr + wid + 8 * u; const int jc = j < NT16 ? j : 0;
                ka[u][0] = *(const h8*)(kp + (size_t)(16 * jc) * P0W); ka[u][1] = *(const h8*)(kp + (size_t)(16 * jc) * P0W + 32); }
#pragma unroll
            for (int gq = 0; gq < 4; ++gq) {
                if (64 * qr + wid + 16 * gq < NT16) {
                    if (gq < 3) {
#pragma unroll
                        for (int u = 0; u < 2; ++u) { const int j = 64 * qr + wid + 8 * (2 * gq + 2 + u); const int jc = j < NT16 ? j : 0;
                            kn[u][0] = *(const h8*)(kp + (size_t)(16 * jc) * P0W); kn[u][1] = *(const h8*)(kp + (size_t)(16 * jc) * P0W + 32); } }
                    f32x4 s4[2] = {{0.f, 0.f, 0.f, 0.f}, {0.f, 0.f, 0.f, 0.f}};
                    h8 qc0 = qfl[lane], qc1 = qfl[64 + lane];
#pragma unroll
                    for (int hh = 0; hh < 8; ++hh) {
                        h8 qn0 = qc0, qn1 = qc1;
                        if (hh < 7) { qn0 = qfl[((hh + 1) * 2 + 0) * 64 + lane]; qn1 = qfl[((hh + 1) * 2 + 1) * 64 + lane]; }
                        f32x4 ac0 = {0.f, 0.f, 0.f, 0.f}, ac1 = {0.f, 0.f, 0.f, 0.f};
                        ac0 = __builtin_amdgcn_mfma_f32_16x16x32_f16(ka[0][0], qc0, ac0, 0, 0, 0);
                        ac1 = __builtin_amdgcn_mfma_f32_16x16x32_f16(ka[1][0], qc0, ac1, 0, 0, 0);
                        ac0 = __builtin_amdgcn_mfma_f32_16x16x32_f16(ka[0][1], qc1, ac0, 0, 0, 0);
                        ac1 = __builtin_amdgcn_mfma_f32_16x16x32_f16(ka[1][1], qc1, ac1, 0, 0, 0);
#pragma unroll
                        for (int r = 0; r < 4; ++r) { s4[0][r] += wq[hh] * __int_as_float(max(__float_as_int(ac0[r]), 0)); s4[1][r] += wq[hh] * __int_as_float(max(__float_as_int(ac1[r]), 0)); }
                        qc0 = qn0; qc1 = qn1;
                    }
#pragma unroll
                    for (int u = 0; u < 2; ++u) { const int m = 2 * gq + u; if (64 * qr + wid + 8 * m < NT16) *(LAS f32x4*)(X + ql * B_XROW + 16 * (wid + 8 * m) + 4 * g) = s4[u]; }
#pragma unroll
                    for (int u = 0; u < 2; ++u) { ka[u][0] = kn[u][0]; ka[u][1] = kn[u][1]; }
                }
            }
            {
            __syncthreads();
            { LAS const float* xr = X + (2 * wid + hq) * B_XROW + l31;
#pragma unroll
              for (int i = 0; i < 32; ++i) { if (1024 * qr + 32 * i < N) { const float v = xr[32 * i]; sc[32 * qr + i] = v; mn = fminf(mn, v); mxv = fmaxf(mxv, v); } else sc[32 * qr + i] = -INFINITY; } }
            __syncthreads(); }
        } else {
#pragma unroll
            for (int i = 0; i < 32; ++i) sc[32 * qr + i] = -INFINITY;
        }
    }
    float lo = hw_red_f<0>(mn), hi = next_up(hw_red_f<1>(mxv));
    unsigned clo = (unsigned)N, chi = 0u;
    if (abl != 6) {
        const float smn = lo, smx = hw_red_f<1>(mxv);
        LAS unsigned* H = (LAS unsigned*)lds + (2 * wid + hq) * 1024;
        LAS unsigned* CS = (LAS unsigned*)(lds + B_QF) + (2 * wid + hq) * 32;
#pragma unroll
        for (int i = 0; i < 32; ++i) H[l31 + 32 * i] = 0u;
        const float scale = 1023.5f / fmaxf(smx - smn, 1e-30f), nsm = -smn * scale;
#pragma unroll
        for (int e = 0; e < 128; ++e) { if (32 * e < N) { int bin = (int)__builtin_fmaf(sc[e], scale, nsm); bin = bin > 1023 ? 1023 : (bin < 0 ? 0 : bin);
            __hip_atomic_fetch_add(H + bin, 1u, __ATOMIC_RELAXED, __HIP_MEMORY_SCOPE_WORKGROUP); } }
        asm volatile("s_waitcnt lgkmcnt(0)" ::: "memory");
        unsigned hw[32]; unsigned cl = 0u;
#pragma unroll
        for (int i = 0; i < 8; ++i) { const u32x4 v = *(LAS const u32x4*)(H + 32 * l31 + 4 * i); hw[4 * i] = v.x; hw[4 * i + 1] = v.y; hw[4 * i + 2] = v.z; hw[4 * i + 3] = v.w; cl += (v.x + v.y) + (v.z + v.w); }
        CS[l31] = cl;
        asm volatile("s_waitcnt lgkmcnt(0)" ::: "memory");
        unsigned ssuf = 0u;
#pragma unroll
        for (int i = 0; i < 8; ++i) { const u32x4 v = *(LAS const u32x4*)(CS + 4 * i);
            ssuf += (4 * i >= l31 ? v.x : 0u) + (4 * i + 1 >= l31 ? v.y : 0u) + (4 * i + 2 >= l31 ? v.z : 0u) + (4 * i + 3 >= l31 ? v.w : 0u); }
        const bool flag = ssuf >= (unsigned)TOPK && (ssuf - cl) < (unsigned)TOPK;
        unsigned run = ssuf - cl, bstar = 0u, above = 0u, cntb = 0u; bool found = false;
#pragma unroll
        for (int w = 31; w >= 0; --w) { run += hw[w]; if (!found && run >= (unsigned)TOPK) { found = true; bstar = 32u * l31 + (unsigned)w; above = run - hw[w]; cntb = hw[w]; } }
        const unsigned long long fb = __ballot(flag);
        const int src = hq ? 32 + __builtin_ctz((unsigned)(fb >> 32) | 0x80000000u) : __builtin_ctz((unsigned)fb | 0x80000000u);
        bstar = (unsigned)__shfl((int)bstar, src); above = (unsigned)__shfl((int)above, src); cntb = (unsigned)__shfl((int)cntb, src);
        if (smx > smn) {
            const float inv = (smx - smn) * (1.0f / 1023.5f);
            const float l2 = smn + ((float)bstar - 0.01f) * inv, h2 = smn + ((float)bstar + 1.01f) * inv;
            if (l2 > lo) { lo = l2; clo = above + cntb; }
            if (h2 < hi) { hi = h2; chi = above; }
        }
    }
#define SEL_LTBITS(W, P) do { _Pragma("unroll") for (int w_ = 0; w_ < 4; ++w_) { unsigned a_ = 0u; _Pragma("unroll") for (int k_ = 0; k_ < 32; ++k_) \
        a_ = __builtin_amdgcn_alignbit(a_, __float_as_uint(sc[32 * w_ + k_] - (P)), 31); W[w_] = a_; } } while (0)
    bool done = false, tie = false; float Tv = 0.f;
#define SEL_STEP(it_) do { \
        float mid = lo + (hi - lo) * 0.5f; \
        if ((it_) < 2 && clo > chi + 16u) { const float xi = lo + (hi - lo) * ((float)clo - 255.5f) / (float)(clo - chi); if (xi > lo && xi < hi) mid = xi; } \
        if (!done && !(mid > lo && mid < hi)) { done = true; tie = true; Tv = lo; } \
        const float pv = done ? Tv : mid; \
        unsigned ltw[4]; SEL_LTBITS(ltw, pv); \
        const unsigned tot = hw_sum_u(128u - (unsigned)(__builtin_popcount(ltw[0]) + __builtin_popcount(ltw[1]) + __builtin_popcount(ltw[2]) + __builtin_popcount(ltw[3]))); \
        if (!done) { if (tot == (unsigned)TOPK) { done = true; Tv = mid; } else if (tot > (unsigned)TOPK) { lo = mid; clo = tot; } else { hi = mid; chi = tot; } } } while (0)
    const int it_cap = (abl == 6 ? 1 : abl == 10 ? 6 : abl == 11 ? 12 : 200);
    int it = 0;
    for (; it < 8 && it < it_cap; ++it) { SEL_STEP(it); if (__all(done)) break; }
    if (!__all(done) && it_cap > 8) {
        float p0 = INFINITY, p1 = -INFINITY;
#pragma unroll
        for (int e = 0; e < 128; ++e) { const float sv = sc[e]; p0 = fminf(p0, sv >= lo ? sv : INFINITY); p1 = fmaxf(p1, sv < hi ? sv : -INFINITY); }
        p0 = hw_red_f<0>(p0); p1 = hw_red_f<1>(p1);
        if (!done && p0 == p1) { done = true; tie = true; Tv = p0; }
        for (; it < it_cap; ++it) { if (__all(done)) break; SEL_STEP(8); }
    }
#undef SEL_STEP
    if (abl == 6 || abl == 10 || abl == 11) tie = false;
    unsigned selw[4];
    { unsigned ltw[4]; SEL_LTBITS(ltw, Tv);
#pragma unroll
      for (int w = 0; w < 4; ++w) selw[w] = __builtin_bitreverse32(~ltw[w]); }
    if (__any(tie)) {
        unsigned eqw[4];
        { unsigned lew[4]; const float tn = next_up(Tv); SEL_LTBITS(lew, tn);
#pragma unroll
          for (int w = 0; w < 4; ++w) eqw[w] = __builtin_bitreverse32(lew[w]) & selw[w]; }
        const unsigned rneed = (unsigned)TOPK - chi;
        int ilo = -1, ihi = N - 1, icut = N; bool tdone = !tie;
        for (int it = 0; it < 40; ++it) {
            const int imid = (ilo + ihi) >> 1;
            if (!tdone && (ihi - ilo) <= 1) { tdone = true; icut = ihi; }
            const int iv = (tdone ? icut : imid) - l31;
            const int nle = iv < 0 ? 0 : min(128, (iv >> 5) + 1);
            unsigned cnt = 0u;
#pragma unroll
            for (int w = 0; w < 4; ++w) { const int nw = min(max(nle - 32 * w, 0), 32); const unsigned mk = nw >= 32 ? 0xffffffffu : ((1u << nw) - 1u); cnt += (unsigned)__builtin_popcount(eqw[w] & mk); }
            const unsigned tot = hw_sum_u(cnt);
            if (!tdone) { if (tot == rneed) { tdone = true; icut = imid; } else if (tot < rneed) ilo = imid; else ihi = imid; }
            if (__all(tdone)) break;
        }
        if (tie) {
            const int iv = icut - l31; const int nle = iv < 0 ? 0 : min(128, (iv >> 5) + 1);
#pragma unroll
            for (int w = 0; w < 4; ++w) { const int nw = min(max(nle - 32 * w, 0), 32); const unsigned mk = nw >= 32 ? 0xffffffffu : ((1u << nw) - 1u); selw[w] = (selw[w] & ~eqw[w]) | (eqw[w] & mk); }
        }
    }
#undef SEL_LTBITS
    LAS unsigned* mrow = (LAS unsigned*)(lds + B_MASK) + (mrow0 + 2 * wid + hq) * 128;
#pragma unroll
    for (int w = 0; w < 4; ++w) {
        unsigned x = selw[w];
#define TR_STEP(S, MK) { const unsigned y_ = (unsigned)__shfl_xor((int)x, S); x = (l31 & S) ? ((x & ~(MK)) | ((y_ >> S) & (MK))) : ((x & (MK)) | ((y_ << S) & ~(MK))); }
        TR_STEP(16, 0x0000ffffu) TR_STEP(8, 0x00ff00ffu) TR_STEP(4, 0x0f0f0f0fu) TR_STEP(2, 0x33333333u) TR_STEP(1, 0x55555555u)
#undef TR_STEP
        if (32 * (32 * w + l31) < N) mrow[32 * w + l31] = x;
    }
}
__device__ __forceinline__ void attnB_unit(Frame& F, int b, int qb32, int mode = 0) {
    LAS unsigned char* lds = F.lds;
    int tid = F.tid; asm volatile("" : "+v"(tid)); int wid = F.wave; asm volatile("" : "+s"(wid));
    const int lane = tid & 63, r32 = lane & 31, hi = lane >> 5;
    const int q0 = 32 * qb32, c = q0 >> 6, nt = c + 1;
    const size_t rowb = (size_t)b * SEQ;
    const u16* P0 = (const u16*)(F.ws + WS_PROJ0);
    if (mode != 3) {
#pragma unroll 1
        for (int s2 = 0; s2 < 2; ++s2) { selB_16(F, b, c, q0 + 16 * s2, 16 * s2, mode); __syncthreads(); }
    }
    if (mode >= 4) return;
    LAS float* bt = (LAS float*)(lds + B_BT) + wid * 192;
    for (int e = tid; e < 8 * 192; e += 512) ((LAS float*)(lds + B_BT))[e] = ((const float*)(F.ws + WS_BTG))[4 * 192 + e];
    h8 qf[4];
    { const u16* qp = P0 + (rowb + q0 + r32) * P0W + C_QB + wid * 64 + hi * 8;
#pragma unroll
      for (int d0 = 0; d0 < 4; ++d0) qf[d0] = *(const h8*)(qp + d0 * 16); }
    f32x16 o[2];
#pragma unroll
    for (int d = 0; d < 2; ++d)
#pragma unroll
        for (int r = 0; r < 16; ++r) o[d][r] = 0.f;
    float mrun = 0.f, lrun = 0.f; bool have = false;
    const int krow = tid >> 3, kch = tid & 7;
    const u16* ksrc = P0 + (rowb + krow) * P0W + C_KB + kch * 8;
    const int kdst = krow * 128 + ((kch ^ ((krow >> 1) & 7)) << 4);
    const int vdst = 8192 + krow * 128 + ((kch ^ (((krow >> 1) & 1) << 2)) << 4);
    u32x4 st0, st1;
#define B_LOAD(t) do { const size_t to = (size_t)(t) * 64 * P0W; st0 = *(const u32x4*)(ksrc + to); st1 = *(const u32x4*)(ksrc + to + 64); } while (0)
#define B_WRITE(s) do { LAS unsigned char* sb = lds + (s) * 16384; *(LAS u32x4*)(sb + kdst) = st0; *(LAS u32x4*)(sb + vdst) = st1; } while (0)
    const int kfo = r32 * 128, ksw = (r32 >> 1) & 7;
    const int i16 = lane & 15, qrow = i16 >> 2, pp = i16 & 3, g16 = (lane >> 4) & 1;
    const int vlane = (4 * hi + qrow) * 128 + ((2 * g16 + (pp >> 1)) << 4) + 8 * (pp & 1);
    const int qglob = q0 + r32;
    B_LOAD(0); B_WRITE(0); __syncthreads();
    for (int t = 0; t < nt; ++t) {
        if (t + 1 < nt) B_LOAD(t + 1);
        {
            LAS const unsigned char* sb = lds + (t & 1) * 16384; LAS const unsigned char* kb = sb + kfo; LAS const unsigned char* vb = sb + 8192 + vlane;
            const bool nearb = (64 * t + 63 - q0) > -128;
            const float c0 = (nearb ? 0.f : bt[0]) - mrun;
            f32x16 p0, p1;
#pragma unroll
            for (int r = 0; r < 16; ++r) { p0[r] = c0; p1[r] = c0; }
#pragma unroll
            for (int d0 = 0; d0 < 4; ++d0) { const int co = ((2 * d0 + hi) ^ ksw) << 4;
                const h8 ka = *(LAS const h8*)(kb + co), kc = *(LAS const h8*)(kb + 4096 + co);
                p0 = __builtin_amdgcn_mfma_f32_32x32x16_f16(ka, qf[d0], p0, 0, 0, 0); p1 = __builtin_amdgcn_mfma_f32_32x32x16_f16(kc, qf[d0], p1, 0, 0, 0); }
            if (nearb) add_bias(p0, p1, bt, 64 * t + 4 * hi - qglob + 128);
            const u64 mw = *(LAS const u64*)(lds + B_MASK + (r32 * 64 + t) * 8);
            const unsigned mlo = (unsigned)mw >> (4 * hi), mhi = (unsigned)(mw >> 32) >> (4 * hi);
#pragma unroll
            for (int r = 0; r < 16; ++r) { const int cb = (r & 3) + 8 * (r >> 2);
                if (!((mlo >> cb) & 1u)) p0[r] = -1e30f; if (!((mhi >> cb) & 1u)) p1[r] = -1e30f; }
            h8 pf[4];
            softmax_step<2, true>(p0, p1, mrun, lrun, have, o, pf);
#pragma unroll
            for (int d0 = 0; d0 < 2; ++d0) { const int dx = (d0 ^ (qrow >> 1)) << 6;
#pragma unroll
                for (int ks = 0; ks < 4; ++ks) { const h8 vf = tr2(vb + ks * 2048 + dx, vb + ks * 2048 + 1024 + dx);
                    o[d0] = __builtin_amdgcn_mfma_f32_32x32x16_f16(vf, pf[ks], o[d0], 0, 0, 0); } }
        }
        if (t + 1 < nt) B_WRITE((t + 1) & 1);
        __syncthreads();
    }
#undef B_LOAD
#undef B_WRITE
    const float linv = 1.0f / swap_sum(lrun);
    const size_t row = rowb + qglob;
    const u16* gp = P0 + row * P0W + C_G0 + 512 + wid * 64;
    u16* op = (u16*)(F.ws + WS_MG0) + row * DM + 512 + wid * 64;
#pragma unroll
    for (int d0 = 0; d0 < 2; ++d0)
#pragma unroll
        for (int g = 0; g < 4; ++g) { const int d = 32 * d0 + 8 * g + 4 * hi;
            const h4 gv = *(const h4*)(gp + d);
            u32x2 w; w.x = pkh(o[d0][4 * g] * linv * (float)gv[0], o[d0][4 * g + 1] * linv * (float)gv[1]);
            w.y = pkh(o[d0][4 * g + 2] * linv * (float)gv[2], o[d0][4 * g + 3] * linv * (float)gv[3]);
            *(u32x2*)(op + d) = w; }
}

__device__ __forceinline__ void pv_tile64_asm(f32x16 (&o)[2], unsigned va0, unsigned va1, const h8 (&pf)[4]) {
#pragma unroll
    for (int d0 = 0; d0 < 2; ++d0) { const unsigned va = d0 ? va1 : va0; s16x4 lo[4], hi[4];
        asm volatile("ds_read_b64_tr_b16 %0, %1 offset:0" : "=&v"(lo[0]) : "v"(va) : "memory");    asm volatile("ds_read_b64_tr_b16 %0, %1 offset:1024" : "=&v"(hi[0]) : "v"(va) : "memory");
        asm volatile("ds_read_b64_tr_b16 %0, %1 offset:2048" : "=&v"(lo[1]) : "v"(va) : "memory"); asm volatile("ds_read_b64_tr_b16 %0, %1 offset:3072" : "=&v"(hi[1]) : "v"(va) : "memory");
        asm volatile("ds_read_b64_tr_b16 %0, %1 offset:4096" : "=&v"(lo[2]) : "v"(va) : "memory"); asm volatile("ds_read_b64_tr_b16 %0, %1 offset:5120" : "=&v"(hi[2]) : "v"(va) : "memory");
        asm volatile("ds_read_b64_tr_b16 %0, %1 offset:6144" : "=&v"(lo[3]) : "v"(va) : "memory"); asm volatile("ds_read_b64_tr_b16 %0, %1 offset:7168" : "=&v"(hi[3]) : "v"(va) : "memory");
        asm volatile("s_waitcnt lgkmcnt(0)" ::: "memory"); __builtin_amdgcn_sched_barrier(0);
#pragma unroll
        for (int ks = 0; ks < 4; ++ks) { const s16x8 v = __builtin_shufflevector(lo[ks], hi[ks], 0, 1, 2, 3, 4, 5, 6, 7);
            o[d0] = __builtin_amdgcn_mfma_f32_32x32x16_f16(__builtin_bit_cast(h8, v), pf[ks], o[d0], 0, 0, 0); } }
}
__device__ __forceinline__ void qk64C(f32x16& p0, f32x16& p1, LAS const unsigned char* sb, const h8 (&qf)[6], int kfo, int ksw, int rfo, int rsw, int hi, const f32x16& negm) {
    LAS const unsigned char* kb = sb + kfo; LAS const unsigned char* rb = sb + rfo;
#pragma unroll
    for (int d0 = 0; d0 < 4; ++d0) { const int co = ((2 * d0 + hi) ^ ksw) << 4;
        const h8 ka = *(LAS const h8*)(kb + co), kc = *(LAS const h8*)(kb + 4096 + co);
        if (d0 == 0) { p0 = __builtin_amdgcn_mfma_f32_32x32x16_f16(ka, qf[0], negm, 0, 0, 0); p1 = __builtin_amdgcn_mfma_f32_32x32x16_f16(kc, qf[0], negm, 0, 0, 0); }
        else { p0 = __builtin_amdgcn_mfma_f32_32x32x16_f16(ka, qf[d0], p0, 0, 0, 0); p1 = __builtin_amdgcn_mfma_f32_32x32x16_f16(kc, qf[d0], p1, 0, 0, 0); } }
#pragma unroll
    for (int d0 = 0; d0 < 2; ++d0) { const int co = ((2 * d0 + hi) ^ rsw) << 4;
        const h8 ka = *(LAS const h8*)(rb + co), kc = *(LAS const h8*)(rb + 2048 + co);
        p0 = __builtin_amdgcn_mfma_f32_32x32x16_f16(ka, qf[4 + d0], p0, 0, 0, 0); p1 = __builtin_amdgcn_mfma_f32_32x32x16_f16(kc, qf[4 + d0], p1, 0, 0, 0); }
}
template <int OFF> __device__ __forceinline__ void dsr128(h8& dst, unsigned addr) { asm volatile("ds_read_b128 %0, %1 offset:%2" : "=&v"(dst) : "v"(addr), "i"(OFF) : "memory"); }
template <int N> __device__ __forceinline__ void qkC_read(h8& dst, const unsigned (&va)[4], const unsigned (&vr)[2]) {
    constexpr int t = N / 12, j = N % 12, d = j >> 1, c = j & 1;
    if constexpr (d < 4) dsr128<t * 20480 + c * 4096>(dst, va[d]); else dsr128<t * 20480 + c * 2048>(dst, vr[d - 4]);
}
template <int N> __device__ __forceinline__ void qkC_mma(f32x16& pa, f32x16& pb, const h8& kf, const h8 (&qf)[6], const f32x16& negm) {
    constexpr int j = N % 12, d = j >> 1, c = j & 1;
    f32x16& acc = c ? pb : pa;
    if constexpr (d == 0) acc = __builtin_amdgcn_mfma_f32_32x32x16_f16(kf, qf[0], negm, 0, 0, 0); else acc = __builtin_amdgcn_mfma_f32_32x32x16_f16(kf, qf[d], acc, 0, 0, 0);
}
#define QKC_RP(G, F) do { qkC_read<2 * (G)>(F[0], va, vr); qkC_read<2 * (G) + 1>(F[1], va, vr); } while (0)
#define QKC_MP(G, F, PA, PB) do { qkC_mma<2 * (G)>(PA, PB, F[0], qf, negm); qkC_mma<2 * (G) + 1>(PA, PB, F[1], qf, negm); __builtin_amdgcn_sched_barrier(0); } while (0)
#define QKC_WAIT(n) do { asm volatile("s_waitcnt lgkmcnt(" #n ")" ::: "memory"); __builtin_amdgcn_sched_barrier(0); } while (0)
__device__ __forceinline__ void qk128C(f32x16& p0, f32x16& p1, f32x16& p2, f32x16& p3, const unsigned (&va)[4], const unsigned (&vr)[2], const h8 (&qf)[6], const f32x16& negm, int two) {
    h8 f0[2], f1[2], f2[2];
    QKC_RP(0, f0); QKC_RP(1, f1); QKC_RP(2, f2);
    QKC_WAIT(4); QKC_MP(0, f0, p0, p1); QKC_RP(3, f0);
    QKC_WAIT(4); QKC_MP(1, f1, p0, p1); QKC_RP(4, f1);
    QKC_WAIT(4); QKC_MP(2, f2, p0, p1); QKC_RP(5, f2);
    if (two) {
        QKC_WAIT(4); QKC_MP(3, f0, p0, p1); QKC_RP(6, f0);
        QKC_WAIT(4); QKC_MP(4, f1, p0, p1); QKC_RP(7, f1);
        QKC_WAIT(4); QKC_MP(5, f2, p0, p1); QKC_RP(8, f2);
        QKC_WAIT(4); QKC_MP(6, f0, p2, p3); QKC_RP(9, f0);
        QKC_WAIT(4); QKC_MP(7, f1, p2, p3); QKC_RP(10, f1);
        QKC_WAIT(4); QKC_MP(8, f2, p2, p3); QKC_RP(11, f2);
        QKC_WAIT(4); QKC_MP(9, f0, p2, p3);
        QKC_WAIT(2); QKC_MP(10, f1, p2, p3);
        QKC_WAIT(0); QKC_MP(11, f2, p2, p3);
    } else {
        QKC_WAIT(4); QKC_MP(3, f0, p0, p1);
        QKC_WAIT(2); QKC_MP(4, f1, p0, p1);
        QKC_WAIT(0); QKC_MP(5, f2, p0, p1);
#pragma unroll
        for (int r = 0; r < 16; ++r) { p2[r] = -1e30f; p3[r] = -1e30f; }
    }
}
__device__ __forceinline__ void pack4(h8 (&pf)[4], const f32x16& p0, const f32x16& p1) {
#pragma unroll
    for (int ks = 0; ks < 4; ++ks) { const f32x16& pp = ks < 2 ? p0 : p1; const int k2 = ks & 1; u32x4 w;
        w.x = pkh(pp[8 * k2 + 0], pp[8 * k2 + 1]); w.y = pkh(pp[8 * k2 + 2], pp[8 * k2 + 3]); w.z = pkh(pp[8 * k2 + 4], pp[8 * k2 + 5]); w.w = pkh(pp[8 * k2 + 6], pp[8 * k2 + 7]);
        pf[ks] = __builtin_bit_cast(h8, w); }
}
template <int MODE> __device__ __forceinline__ void attnC_unit(Frame& F, int b, int h, int qb) {
    LAS unsigned char* lds = F.lds;
    int tid = F.tid; asm volatile("" : "+v"(tid)); int wid = F.wave; asm volatile("" : "+s"(wid));
    const int lane = tid & 63, r32 = lane & 31, hi = lane >> 5;
    const int q0 = 256 * qb + 32 * wid, cw = q0 >> 6, nt = 4 * qb + 4;
    const size_t rowb = (size_t)b * SEQ;
    const u16* Q1 = (const u16*)(F.ws + WS_Q1); const u16* KV = (const u16*)(F.ws + WS_KV1); const u16* KR = (const u16*)(F.ws + WS_KROPE);
    h8 qf[6];
    { const u16* qp = Q1 + (rowb + q0 + r32) * 1536 + h * 96 + hi * 8;
#pragma unroll
      for (int d0 = 0; d0 < 6; ++d0) qf[d0] = *(const h8*)(qp + d0 * 16); }
    f32x16 o[2];
#pragma unroll
    for (int d = 0; d < 2; ++d)
#pragma unroll
        for (int r = 0; r < 16; ++r) o[d][r] = 0.f;
    float mrun = 0.f, lrun = 0.f; bool have = false;
    f32x16 negm;
#pragma unroll
    for (int r = 0; r < 16; ++r) negm[r] = 0.f;
    const int krow = 8 * wid + (lane >> 3), kcp = lane & 7;
    const u16* ksrc = KV + (rowb + krow) * 2048 + h * 128 + ((kcp ^ ((krow >> 1) & 7)) << 3);
    const u16* vsrc = KV + (rowb + krow) * 2048 + h * 128 + 64 + ((kcp ^ (((krow >> 1) & 1) << 2)) << 3);
    const int rrow = 16 * (wid & 3) + (lane >> 2), rcp = lane & 3;
    const u16* rsrc = KR + (rowb + rrow) * 32 + ((rcp ^ ((rrow >> 2) & 3)) << 3);
    const int kofs = wid * 1024, rofs = 8192 + (wid & 3) * 1024, vofs = 12288 + wid * 1024;
#define C_DMA(t, slot) do { LAS unsigned char* sb_ = lds + (slot) * 20480; \
        __builtin_amdgcn_global_load_lds((const unsigned*)(ksrc + (size_t)(t) * 64 * 2048), (LAS unsigned*)(sb_ + kofs), 16, 0, 0); \
        __builtin_amdgcn_global_load_lds((const unsigned*)(rsrc + (size_t)(t) * 64 * 32), (LAS unsigned*)(sb_ + rofs), 16, 0, 0); \
        __builtin_amdgcn_global_load_lds((const unsigned*)(vsrc + (size_t)(t) * 64 * 2048), (LAS unsigned*)(sb_ + vofs), 16, 0, 0); } while (0)
    const int kfo = r32 * 128, ksw = (r32 >> 1) & 7;
    const int rfo = 8192 + r32 * 64, rsw = (r32 >> 2) & 3;
    const int i16 = lane & 15, qrow = i16 >> 2, pp = i16 & 3, g16 = (lane >> 4) & 1;
    const int vlane = (4 * hi + qrow) * 128 + ((2 * g16 + (pp >> 1)) << 4) + 8 * (pp & 1);
    const unsigned dx0 = (unsigned)((0 ^ (qrow >> 1)) << 6), dx1 = (unsigned)((1 ^ (qrow >> 1)) << 6);
    asm volatile("s_waitcnt vmcnt(0)" ::: "memory");
    C_DMA(0, 0); C_DMA(1, 1);
    const int np = nt >> 1;
    for (int T = 0; T < np; ++T) {
        asm volatile("s_waitcnt vmcnt(0)" ::: "memory");
        if (MODE != 3) { __builtin_amdgcn_s_barrier(); } asm volatile("" ::: "memory");
        const int sA = (T & 1) * 2;
        if (MODE != 2 && MODE != 3) { if (T + 1 < np) { C_DMA(2 * T + 2, sA ^ 2); C_DMA(2 * T + 3, (sA ^ 2) + 1); } }
        if (2 * T <= cw) {
            LAS const unsigned char* sb0 = lds + sA * 20480; LAS const unsigned char* sb1 = sb0 + 20480;
            f32x16 p0, p1, p2, p3;
            int two = __builtin_amdgcn_readfirstlane((2 * T + 1 <= cw) ? 1 : 0); asm volatile("" : "+s"(two));
            unsigned va[4], vr[2];
#pragma unroll
            for (int d0 = 0; d0 < 4; ++d0) va[d0] = (unsigned)(size_t)(sb0 + kfo + (((2 * d0 + hi) ^ ksw) << 4));
#pragma unroll
            for (int d0 = 0; d0 < 2; ++d0) vr[d0] = (unsigned)(size_t)(sb0 + rfo + (((2 * d0 + hi) ^ rsw) << 4));
            if (MODE != 4) qk128C(p0, p1, p2, p3, va, vr, qf, negm, two); else { p0 = negm; p1 = negm; p2 = negm; p3 = negm; asm volatile("" : "+v"(p0), "+v"(p1), "+v"(p2), "+v"(p3)); }
            float ma[4];
            if (MODE != 1) {
#pragma unroll
            for (int i = 0; i < 4; ++i) { float t = max3f(p0[i], p0[i + 4], p0[i + 8]); t = max3f(t, p0[i + 12], p1[i]); t = max3f(t, p1[i + 4], p1[i + 8]); t = max3f(t, p1[i + 12], p2[i]);
                t = max3f(t, p2[i + 4], p2[i + 8]); t = max3f(t, p2[i + 12], p3[i]); t = max3f(t, p3[i + 4], p3[i + 8]); ma[i] = max3f(t, p3[i + 12], t); }
            const float mx = swap_max(max3f(max3f(ma[0], ma[1], ma[2]), ma[3], ma[3]));
            if (__any(!have || mx > SM_THR)) {
                const float dl = have ? fmaxf(mx, 0.f) : mx; have = true; mrun += dl;
                const float alpha = __builtin_amdgcn_exp2f(-dl); lrun *= alpha;
#pragma unroll
                for (int r = 0; r < 16; ++r) { p0[r] -= dl; p1[r] -= dl; p2[r] -= dl; p3[r] -= dl; negm[r] -= dl; o[0][r] *= alpha; o[1][r] *= alpha; }
            }
            float s0 = 0.f, s1 = 0.f, s2 = 0.f, s3 = 0.f;
#pragma unroll
            for (int r = 0; r < 16; ++r) { p0[r] = __builtin_amdgcn_exp2f(p0[r]); p1[r] = __builtin_amdgcn_exp2f(p1[r]); p2[r] = __builtin_amdgcn_exp2f(p2[r]); p3[r] = __builtin_amdgcn_exp2f(p3[r]);
                s0 += p0[r]; s1 += p1[r]; s2 += p2[r]; s3 += p3[r]; }
            lrun += (s0 + s1) + (s2 + s3);
            } else lrun = 1.f;
            h8 pfa[4], pfb[4]; pack4(pfa, p0, p1); pack4(pfb, p2, p3);
            const unsigned vb0 = (unsigned)(size_t)(sb0 + 12288 + vlane), vb1 = (unsigned)(size_t)(sb1 + 12288 + vlane);
            if (MODE != 5) { pv_tile64_asm(o, vb0 + dx0, vb0 + dx1, pfa);
            pv_tile64_asm(o, vb1 + dx0, vb1 + dx1, pfb); } else { asm volatile("" :: "v"(pfa[0]), "v"(pfa[1]), "v"(pfa[2]), "v"(pfa[3]), "v"(pfb[0]), "v"(pfb[1]), "v"(pfb[2]), "v"(pfb[3])); }
        }
    }
#undef C_DMA
    const float linv = 1.0f / swap_sum(lrun);
    if (MODE != 0 && __all(linv != 123.456f)) return;
    const size_t row = rowb + q0 + r32;
    const u16* gp = (const u16*)(F.ws + WS_G1) + row * DM + h * 64;
    u16* op = (u16*)(F.ws + WS_MG1) + row * DM + h * 64;
#pragma unroll
    for (int d0 = 0; d0 < 2; ++d0)
#pragma unroll
        for (int g = 0; g < 4; ++g) { const int d = 32 * d0 + 8 * g + 4 * hi;
            const h4 gv = *(const h4*)(gp + d);
            u32x2 w; w.x = pkh(o[d0][4 * g] * linv * (float)gv[0], o[d0][4 * g + 1] * linv * (float)gv[1]);
            w.y = pkh(o[d0][4 * g + 2] * linv * (float)gv[2], o[d0][4 * g + 3] * linv * (float)gv[3]);
            *(u32x2*)(op + d) = w; }
}

__device__ __forceinline__ void p8_final(Frame& F, const Args& AR) {
    const int gw = blockIdx.x * NWAVES + F.wave, NGW = F.G * NWAVES;
    const float* gn = AR.in[I_FNORM]; f32x4 gv[4];
#pragma unroll
    for (int j = 0; j < 4; ++j) gv[j] = *(const f32x4*)(gn + 4 * F.lane + 256 * j);
    const u16* X2 = (const u16*)(F.ws + WS_X2H);
    for (int mrow = gw; mrow < T; mrow += NGW) {
        const h4* xr = (const h4*)(X2 + (size_t)mrow * DM) + F.lane;
        f32x4 v[4]; float s = 0.f;
#pragma unroll
        for (int j = 0; j < 4; ++j) { const h4 hv = xr[64 * j]; v[j] = (f32x4){(float)hv[0], (float)hv[1], (float)hv[2], (float)hv[3]}; s += (v[j].x * v[j].x + v[j].y * v[j].y) + (v[j].z * v[j].z + v[j].w * v[j].w); }
        const float rstd = __builtin_amdgcn_rsqf(wave_sum(s) * (1.f / DM) + RMS_EPS);
        f32x4* orow = (f32x4*)(F.out + (size_t)mrow * DM) + F.lane;
#pragma unroll
        for (int j = 0; j < 4; ++j) orow[64 * j] = v[j] * rstd * gv[j];
    }
}

#ifndef NAIVE_ATTN
#define NAIVE_ATTN 0
#endif
struct NaiveSh { float sh[4096]; float red[256]; unsigned char sel[4096]; };
__device__ __forceinline__ float blk_max(NaiveSh& S, float v, int tid) { S.red[tid] = v; __syncthreads(); for (int o2 = 128; o2 > 0; o2 >>= 1) { if (tid < o2) S.red[tid] = fmaxf(S.red[tid], S.red[tid + o2]); __syncthreads(); } const float r = S.red[0]; __syncthreads(); return r; }
__device__ __forceinline__ float blk_sum(NaiveSh& S, float v, int tid) { S.red[tid] = v; __syncthreads(); for (int o2 = 128; o2 > 0; o2 >>= 1) { if (tid < o2) S.red[tid] += S.red[tid + o2]; __syncthreads(); } const float r = S.red[0]; __syncthreads(); return r; }
__device__ __forceinline__ float blk_softmax(NaiveSh& S, int nk, int tid) {
    float mx = -1e30f; for (int k = tid; k < nk; k += 256) mx = fmaxf(mx, S.sh[k]); mx = blk_max(S, mx, tid);
    float ls = 0.f; for (int k = tid; k < nk; k += 256) { const float p = S.sh[k] > -1e29f ? exp2f(S.sh[k] - mx) : 0.f; S.sh[k] = p; ls += p; }
    return blk_sum(S, ls, tid);
}
__device__ __forceinline__ float naiveA(NaiveSh& S, const Args& args, int b, int q, int hd, int tid) {
    unsigned char* ws = args.ws; const u16* P0 = (const u16*)(ws + WS_PROJ0); const float* BT = (const float*)(ws + WS_BTG);
    const size_t row = (size_t)b * SEQ + q; const int nk = 64 * (q / 64 + 1); float outv[2] = {0.f, 0.f};
    for (int m = 0; m < 2; ++m) {
        for (int k = tid; k < nk; k += 256) { float sacc = 0.f; const u16* qp = P0 + row * P0W + C_QA + hd * 128 + m * 64; const u16* kp = P0 + ((size_t)b * SEQ + k) * P0W + C_KA + hd * 128 + m * 64;
            for (int d = 0; d < 64; ++d) sacc += h2f(qp[d]) * h2f(kp[d]);
            int rel = k - q; rel = rel < -128 ? -128 : rel; S.sh[k] = sacc + BT[hd * 192 + rel + 128]; }
        __syncthreads();
        const float ls = blk_softmax(S, nk, tid);
        if (tid < 128) { float a = 0.f; for (int k = 0; k < nk; ++k) a += S.sh[k] * h2f(P0[((size_t)b * SEQ + k) * P0W + C_VA + hd * 128 + tid]); outv[m] = a / ls; }
        __syncthreads();
    }
    const float lam = *(const float*)(ws + WS_LAM); const float v = tid < 128 ? outv[0] - lam * outv[1] : 0.f;
    const float ss = blk_sum(S, v * v, tid);
    const float rs = rsqrtf(ss / 128.f + RMS_EPS) * 0.8f;
    return tid < 128 ? v * rs * args.in[I_SUBLN][tid] * h2f(P0[row * P0W + C_G0 + hd * 128 + tid]) : 0.f;
}
__device__ __forceinline__ void naiveB_select(NaiveSh& S, const Args& args, int b, int q, int tid) {
    const u16* P0 = (const u16*)(args.ws + WS_PROJ0); const size_t row = (size_t)b * SEQ + q; const int nk = 64 * (q / 64 + 1);
    for (int k = tid; k < nk; k += 256) { float sc = 0.f;
        for (int hh = 0; hh < 8; ++hh) { float l = 0.f; const u16* qp = P0 + row * P0W + C_QI + hh * 64; const u16* kp = P0 + ((size_t)b * SEQ + k) * P0W + C_KI;
            for (int d = 0; d < 64; ++d) l += h2f(qp[d]) * h2f(kp[d]);
            sc += h2f(P0[row * P0W + C_WI + hh]) * fmaxf(l, 0.f); }
        S.sh[k] = sc; }
    __syncthreads();
    for (int k = tid; k < nk; k += 256) { const float sk = S.sh[k]; int rank = 0; for (int k2 = 0; k2 < nk; ++k2) { const float s2 = S.sh[k2]; rank += (s2 > sk || (s2 == sk && k2 < k)) ? 1 : 0; } S.sel[k] = rank < TOPK ? 1 : 0; }
    __syncthreads();
}
__device__ __forceinline__ float naiveB_head(NaiveSh& S, const Args& args, int b, int q, int hd, int tid) {
    const u16* P0 = (const u16*)(args.ws + WS_PROJ0); const float* BT = (const float*)(args.ws + WS_BTG); const size_t row = (size_t)b * SEQ + q; const int nk = 64 * (q / 64 + 1);
    for (int k = tid; k < nk; k += 256) { float sacc = -1e30f;
        if (S.sel[k]) { sacc = 0.f; const u16* qp = P0 + row * P0W + C_QB + hd * 64; const u16* kp = P0 + ((size_t)b * SEQ + k) * P0W + C_KB;
            for (int d = 0; d < 64; ++d) sacc += h2f(qp[d]) * h2f(kp[d]);
            int rel = k - q; rel = rel < -128 ? -128 : rel; sacc += BT[(4 + hd) * 192 + rel + 128]; }
        S.sh[k] = sacc; }
    __syncthreads();
    const float ls = blk_softmax(S, nk, tid);
    float r = 0.f;
    if (tid < 64) { float a = 0.f; for (int k = 0; k < nk; ++k) a += S.sh[k] * h2f(P0[((size_t)b * SEQ + k) * P0W + C_VB + tid]); r = a / ls * h2f(P0[row * P0W + C_G0 + 512 + hd * 64 + tid]); }
    __syncthreads();
    return r;
}
__device__ __forceinline__ float naiveC(NaiveSh& S, const Args& args, int b, int q, int hd, int tid) {
    unsigned char* ws = args.ws; const size_t row = (size_t)b * SEQ + q; const int nk = 64 * (q / 64 + 1);
    const u16* Q1 = (const u16*)(ws + WS_Q1); const u16* KV = (const u16*)(ws + WS_KV1); const u16* KR = (const u16*)(ws + WS_KROPE);
    for (int k = tid; k < nk; k += 256) { float sacc = 0.f; const u16* qp = Q1 + row * 1536 + hd * 96; const size_t kr = (size_t)b * SEQ + k;
        for (int d = 0; d < 64; ++d) sacc += h2f(qp[d]) * h2f(KV[kr * 2048 + hd * 128 + d]);
        for (int d = 0; d < 32; ++d) sacc += h2f(qp[64 + d]) * h2f(KR[kr * 32 + d]);
        S.sh[k] = sacc; }
    __syncthreads();
    const float ls = blk_softmax(S, nk, tid);
    float r = 0.f;
    if (tid < 64) { float a = 0.f; for (int k = 0; k < nk; ++k) a += S.sh[k] * h2f(KV[((size_t)b * SEQ + k) * 2048 + hd * 128 + 64 + tid]); r = a / ls * h2f(((const u16*)(ws + WS_G1))[row * DM + hd * 64 + tid]); }
    __syncthreads();
    return r;
}
#if NAIVE_ATTN
__global__ void __launch_bounds__(256) naive_attn(Args args, int which) {
    __shared__ NaiveSh S; const int tid = threadIdx.x; unsigned char* ws = args.ws;
    if (which == 0) {
        for (int it = blockIdx.x; it < T * 5; it += gridDim.x) {
            const int row = it / 5, sub = it % 5, b = row / SEQ, q = row % SEQ;
            if (sub < 4) { const float v = naiveA(S, args, b, q, sub, tid); if (tid < 128) ((u16*)(ws + WS_MG0))[(size_t)row * DM + sub * 128 + tid] = (u16)(pkh(v, 0.f) & 0xffffu); }
            else { naiveB_select(S, args, b, q, tid);
                for (int hd = 0; hd < 8; ++hd) { const float v = naiveB_head(S, args, b, q, hd, tid); if (tid < 64) ((u16*)(ws + WS_MG0))[(size_t)row * DM + 512 + hd * 64 + tid] = (u16)(pkh(v, 0.f) & 0xffffu); } }
        }
    } else {
        for (int it = blockIdx.x; it < T * 16; it += gridDim.x) {
            const int row = it >> 4, hd = it & 15, b = row / SEQ, q = row % SEQ;
            const float v = naiveC(S, args, b, q, hd, tid); if (tid < 64) ((u16*)(ws + WS_MG1))[(size_t)row * DM + hd * 64 + tid] = (u16)(pkh(v, 0.f) & 0xffffu);
        }
    }
}
#endif

#if DEBUG_CHECK
constexpr size_t WS_DBG = 3 * MiB;
#ifndef DBG_BITS_MODE
#define DBG_BITS_MODE 1
#define DBG_BITS_IDS 14, 4, 5, 21, 22, 23
#endif
#ifndef DBG_SKIP_MASK
#define DBG_SKIP_MASK 0x10
#endif
#ifndef DBG_REPORT_ID
#define DBG_REPORT_ID 0
#endif
__device__ __forceinline__ unsigned dhash(unsigned x) { x ^= x >> 16; x *= 0x7feb352du; x ^= x >> 15; x *= 0x846ca68bu; x ^= x >> 16; return x; }
__device__ __forceinline__ void dbg_rec(unsigned char* ws, int id, float got, float ref, float scale) {
    float e = fabsf(got - ref) / (fabsf(ref) + scale); if (!(e == e)) e = 1e6f;
    atomicMax((unsigned*)(ws + WS_DBG) + id, __float_as_uint(e));
}
__device__ __forceinline__ float dh(const u16* p, size_t i) { return h2f(p[i]); }
__global__ void __launch_bounds__(256) dbg_check(Args args, int stage) {
    unsigned char* ws = args.ws; const int tid = threadIdx.x, bid = blockIdx.x, gid = bid * 256 + tid;
    if (stage == 0) { if (gid < 64) ((unsigned*)(ws + WS_DBG))[gid] = (gid == 44) ? 0xffffu : 0u; return; }
    if (stage == 1) {
        const unsigned h = dhash(gid * 7919u + 13u);
        { const int n = h % P0W, k = (h >> 12) % 1024; const int sc = wsrc_col(0, n); const float ref = sc < 0 ? 0.f : args.in[I_EWIN][(size_t)k * L0_SRC + sc] * wcol_scale(0, n);
          dbg_rec(ws, 1, dh((const u16*)(ws + WS_W0T), (size_t)n * 1024 + k), ref, 1e-3f); }
        { const int n = h % P1W, k = (h >> 12) % 1024; const int sc = wsrc_col(2, n); const float ref = sc < 0 ? 0.f : args.in[I_OWIN][(size_t)k * L1_SRC + sc] * args.in[I_ONORM][k];
          dbg_rec(ws, 1, dh((const u16*)(ws + WS_W1T), (size_t)n * 1024 + k), ref, 1e-3f); }
        { const int n = h % 1536, k = (h >> 12) % 384; const float ref = args.in[I_OWUQ][(size_t)k * 1536 + n] * args.in[I_OQNORM][k] * QS_C;
          dbg_rec(ws, 1, dh((const u16*)(ws + WS_WUQT), (size_t)n * 384 + k), ref, 1e-3f); }
        { const int n = h % 2048, k = (h >> 12) % 256; const float ref = args.in[I_OWUKV][(size_t)k * 2048 + n] * args.in[I_OKVNORM][k];
          dbg_rec(ws, 1, dh((const u16*)(ws + WS_WUKVT), (size_t)n * 256 + k), ref, 1e-3f); }
        { const int n = h % 1024, k = (h >> 12) % 1024; dbg_rec(ws, 1, dh((const u16*)(ws + WS_WO0T), (size_t)n * 1024 + k), args.in[I_EWO][(size_t)k * 1024 + n], 1e-3f);
          dbg_rec(ws, 1, dh((const u16*)(ws + WS_WO1T), (size_t)n * 1024 + k), args.in[I_OWO][(size_t)k * 1024 + n], 1e-3f); }
        { const int row = h % T, col = (h >> 15) % 1024; const float* xr = args.in[I_X] + (size_t)row * DM; float ss = 0.f; for (int k = 0; k < DM; ++k) ss += xr[k] * xr[k];
          const float ref = xr[col] * rsqrtf(ss / DM + RMS_EPS) * args.in[I_ENORM][col]; dbg_rec(ws, 2, dh((const u16*)(ws + WS_XN0), (size_t)row * DM + col), ref, 1e-2f); }
        return;
    }
    if (stage == 2) {
        const unsigned h = dhash(gid * 104729u + 7u); const int row = h % T; int col = (h >> 15) % P0W; if (gid & 1) col = C_G0 + (col & 1023); if ((gid & 7) == 2) col = C_KI + (col & 63);
        const u16* a = (const u16*)(ws + WS_XN0) + (size_t)row * DM; const u16* b = (const u16*)(ws + WS_W0T) + (size_t)col * 1024; float acc = 0.f;
        for (int k = 0; k < 1024; ++k) acc += h2f(a[k]) * h2f(b[k]);
        if (col >= C_G0) acc = acc / (1.f + expf(-acc));
        dbg_rec(ws, 3, dh((const u16*)(ws + WS_PROJ0), (size_t)row * P0W + col), acc, 2e-2f);
        return;
    }
    if (stage == 3) {
        __shared__ NaiveSh NS;
        const unsigned h = dhash(bid * 2654435761u + 99u);
        int q = h % SEQ; const int b = (h >> 12) % NB; if (bid % 5 == 0) q = q % 320;
        const size_t row = (size_t)b * SEQ + q;
        if (bid < 48) { const int hd = (h >> 20) % 4; const float ref = naiveA(NS, args, b, q, hd, tid);
            if (tid < 128) dbg_rec(ws, 4, dh((const u16*)(ws + WS_MG0), row * DM + hd * 128 + tid), ref, 2e-2f); }
        else { const int hd = (h >> 20) % 8; naiveB_select(NS, args, b, q, tid); const float ref = naiveB_head(NS, args, b, q, hd, tid);
            if (tid < 64) dbg_rec(ws, 5, dh((const u16*)(ws + WS_MG0), row * DM + 512 + hd * 64 + tid), ref, 2e-2f); }
        return;
    }
    if (stage == 4) {
        const unsigned h = dhash(gid * 15485863u + 3u); const int row = h % T, col = (h >> 15) % 1024;
        const u16* a = (const u16*)(ws + WS_MG0) + (size_t)row * DM; const u16* b = (const u16*)(ws + WS_WO0T) + (size_t)col * 1024; float acc = 0.f;
        for (int k = 0; k < 1024; ++k) acc += h2f(a[k]) * h2f(b[k]);
        const float ref = args.in[I_X][(size_t)row * DM + col] + acc;
        dbg_rec(ws, 6, args.out[(size_t)row * DM + col], ref, 1e-2f); dbg_rec(ws, 6, dh((const u16*)(ws + WS_XN0), (size_t)row * DM + col), ref, 1e-2f);
        if (gid < 2048) { float ss = 0.f; for (int k = 0; k < DM; ++k) { const float v = args.out[(size_t)row * DM + k]; ss += v * v; }
            dbg_rec(ws, 7, (float)((const u64*)(ws + WS_SSQ1))[row] / FXS, ss, 1e-3f); }
        return;
    }
    if (stage == 5) {
        const unsigned h = dhash(gid * 32452843u + 5u); const int row = h % T; int col = (h >> 15) % P1W; if ((gid & 3) == 1) col = 640 + (col & 31);
        if (col >= 672 && col < 768) col -= 200;
        const u16* a = (const u16*)(ws + WS_XN0) + (size_t)row * DM; float ss = 0.f; for (int k = 0; k < DM; ++k) { const float v = args.out[(size_t)row * DM + k]; ss += v * v; }
        const float rs = rsqrtf(ss / DM + RMS_EPS);
        auto dotc = [&](int c) { const u16* b = (const u16*)(ws + WS_W1T) + (size_t)c * 1024; float acc = 0.f; for (int k = 0; k < 1024; ++k) acc += h2f(a[k]) * h2f(b[k]); return acc * rs; };
        const float v = dotc(col);
        if (col < 640) dbg_rec(ws, 8, dh((const u16*)(ws + WS_LAT), (size_t)row * LATW + col), v, 2e-2f);
        else if (col < 672) { const int j = col - 640, pos = row & (SEQ - 1), i = j & 15; const float inv = (float)pow(10000.0, -(double)i / 16.0), ang = (float)pos * inv; const float cs = cosf(ang), sn = sinf(ang);
            const float other = dotc(j < 16 ? col + 16 : col - 16); const float ref = j < 16 ? v * cs - other * sn : other * sn + v * cs;
            dbg_rec(ws, 9, dh((const u16*)(ws + WS_KROPE), (size_t)row * 32 + j), ref, 2e-2f); }
        else dbg_rec(ws, 10, dh((const u16*)(ws + WS_G1), (size_t)row * DM + col - 768), v / (1.f + expf(-v)), 2e-2f);
        if (gid < 1024) { const u16* lat = (const u16*)(ws + WS_LAT) + (size_t)row * LATW; float s1 = 0.f, s2 = 0.f; for (int k = 0; k < 256; ++k) s1 += h2f(lat[k]) * h2f(lat[k]); for (int k = 256; k < 640; ++k) s2 += h2f(lat[k]) * h2f(lat[k]);
            dbg_rec(ws, 11, (float)((const u64*)(ws + WS_SSQKV))[row] / FXS, s1, 1e-2f); dbg_rec(ws, 11, (float)((const u64*)(ws + WS_SSQQ))[row] / FXS, s2, 1e-2f); }
        return;
    }
    if (stage == 6) {
        const unsigned h = dhash(gid * 49979687u + 11u); const int row = h % T; const u16* lat = (const u16*)(ws + WS_LAT) + (size_t)row * LATW;
        { const int col = (h >> 15) % 2048; float s1 = 0.f; for (int k = 0; k < 256; ++k) s1 += h2f(lat[k]) * h2f(lat[k]); const float rs = rsqrtf(s1 / 256.f + RMS_EPS);
          const u16* b = (const u16*)(ws + WS_WUKVT) + (size_t)col * 256; float acc = 0.f; for (int k = 0; k < 256; ++k) acc += h2f(lat[k]) * h2f(b[k]);
          dbg_rec(ws, 13, dh((const u16*)(ws + WS_KV1), (size_t)row * 2048 + col), acc * rs, 2e-2f); }
        { int col = (h >> 15) % 1536; if (gid & 1) col = (col / 96) * 96 + 64 + (col & 31);
          float s2 = 0.f; for (int k = 256; k < 640; ++k) s2 += h2f(lat[k]) * h2f(lat[k]); const float rs = rsqrtf(s2 / 384.f + RMS_EPS);
          auto dotc = [&](int c) { const u16* b = (const u16*)(ws + WS_WUQT) + (size_t)c * 384; float acc = 0.f; for (int k = 0; k < 384; ++k) acc += h2f(lat[256 + k]) * h2f(b[k]); return acc * rs; };
          float v = dotc(col); const int jj = col % 96;
          if (jj >= 64) { const int j = jj - 64, pos = row & (SEQ - 1), i = j & 15; const float inv = (float)pow(10000.0, -(double)i / 16.0), ang = (float)pos * inv; const float cs = cosf(ang), sn = sinf(ang);
              const float other = dotc(j < 16 ? col + 16 : col - 16); v = j < 16 ? v * cs - other * sn : other * sn + v * cs; }
          dbg_rec(ws, 12, dh((const u16*)(ws + WS_Q1), (size_t)row * 1536 + col), v, 2e-2f); }
        return;
    }
    if (stage == 7) {
        __shared__ NaiveSh NS;
        const unsigned h = dhash(bid * 2654435761u + 777u); int q = h % SEQ; const int b = (h >> 12) % NB, hd = (h >> 20) % 16; if (bid % 5 == 0) q = q % 320;
        const size_t row = (size_t)b * SEQ + q; const float ref = naiveC(NS, args, b, q, hd, tid);
        if (tid < 64) dbg_rec(ws, 14, dh((const u16*)(ws + WS_MG1), row * DM + hd * 64 + tid), ref, 2e-2f);
        { const float got = tid < 64 ? dh((const u16*)(ws + WS_MG1), row * DM + hd * 64 + tid) : 0.f; const bool bad = tid < 64 && fabsf(got - ref) / (fabsf(ref) + 2e-2f) > 0.05f;
          if (__syncthreads_or(bad ? 1 : 0) && tid == 0) { atomicAdd((unsigned*)(ws + WS_DBG) + 43, 1u); atomicMin((unsigned*)(ws + WS_DBG) + 44, (unsigned)(q / 64)); atomicMax((unsigned*)(ws + WS_DBG) + 45, (unsigned)(q / 64)); } }
        {
            const u16* Q1 = (const u16*)(ws + WS_Q1); const u16* KV = (const u16*)(ws + WS_KV1); const u16* KR = (const u16*)(ws + WS_KROPE); const float* db = (const float*)(ws + WS_DBGBUF) + 4096;
            for (int e = gid; e < 256 * 64; e += gridDim.x * 256) { const int qq = e >> 6, d = e & 63, qpos = 256 * TAPQB + qq, nkk = 64 * (qpos / 64 + 1); float mx = -1e30f, ls = 0.f, a = 0.f;
                const size_t rb = (size_t)TAPB * SEQ; const u16* qp = Q1 + (rb + qpos) * 1536 + TAPH * 96;
                for (int pass = 0; pass < 2; ++pass)
                for (int k = 0; k < nkk; ++k) { float sacc = 0.f; for (int dd = 0; dd < 64; ++dd) sacc += h2f(qp[dd]) * h2f(KV[(rb + k) * 2048 + TAPH * 128 + dd]);
                    for (int dd = 0; dd < 32; ++dd) sacc += h2f(qp[64 + dd]) * h2f(KR[(rb + k) * 32 + dd]);
                    if (pass == 0) mx = fmaxf(mx, sacc); else { const float p = exp2f(sacc - mx); ls += p; a += p * h2f(KV[(rb + k) * 2048 + TAPH * 128 + 64 + d]); } }
                dbg_rec(ws, 21 + (qq >> 6), db[e], a / ls, 2e-2f); }
        }
        if (bid == 0) {
            const u16* Q1 = (const u16*)(ws + WS_Q1); const u16* KV = (const u16*)(ws + WS_KV1); const u16* KR = (const u16*)(ws + WS_KROPE); const float* db = (const float*)(ws + WS_DBGBUF);
            for (int e = tid; e < 32 * 64; e += 256) { const int qq = e >> 6, k = e & 63; float sacc = 0.f;
                for (int d = 0; d < 64; ++d) sacc += h2f(Q1[(size_t)qq * 1536 + d]) * h2f(KV[(size_t)k * 2048 + d]);
                for (int d = 0; d < 32; ++d) sacc += h2f(Q1[(size_t)qq * 1536 + 64 + d]) * h2f(KR[(size_t)k * 32 + d]);
                dbg_rec(ws, 20, db[e], sacc, 2e-2f); dbg_rec(ws, 41, db[e], 0.f, 1.0f); dbg_rec(ws, 42, sacc, 0.f, 1.0f); }
            (void)0;
        }
        return;
    }
    if (stage == 9) {
        if (gid == 0) { const unsigned* e = (const unsigned*)(ws + WS_DBG);
            if (DBG_REPORT_ID >= 43 && DBG_REPORT_ID <= 45) { args.out[0] = 100.0f * (float)e[DBG_REPORT_ID] + 50.f; }
            else if (DBG_REPORT_ID == 40) { args.out[0] = 100.0f * (float)(e[40] / 32u) + 50.f; }
            else if (DBG_REPORT_ID > 0) { args.out[0] = 1000.0f * __uint_as_float(e[DBG_REPORT_ID]); }
            else if (DBG_BITS_MODE) { const int ids[6] = {DBG_BITS_IDS}; int v = 0; for (int i = 0; i < 6; ++i) if (ids[i] > 0 && __uint_as_float(e[ids[i]]) > 0.05f) v |= 1 << i; if (v) args.out[0] = 100.0f * v; }
            else { int first = 0; for (int id = 1; id < 32 && !first; ++id) if (!((DBG_SKIP_MASK >> id) & 1) && __uint_as_float(e[id]) > 0.05f) first = id; if (first) args.out[0] = 100.0f * first; } }
        return;
    }
}
#endif

constexpr int N_PHASES = 9;
__global__ void __launch_bounds__(NWAVES * 64) hybrid_fwd(Args args) {
    extern __shared__ __attribute__((aligned(16))) unsigned char lds_raw[];
    Frame F;
    F.lds = (LAS unsigned char*)lds_raw;
    F.MISC = (volatile LAS unsigned*)(F.lds + MISC_OFF);
    F.tid = threadIdx.x; F.lane = F.tid & 63; F.wave = __builtin_amdgcn_readfirstlane(F.tid >> 6);
    F.G = gridDim.x;
    F.out = args.out; F.ws = args.ws; F.ctl = (unsigned*)(args.ws + WS_CTL);
    for (int u = F.tid; u < (LDS_BYTES - RING_BYTES) / 4; u += NWAVES * 64) ((LAS unsigned*)(F.lds + RING_BYTES))[u] = 0u;
    __syncthreads();
    const int lo = args.ph_lo, hi = args.ph_hi;
    const bool multi = (hi - lo) > 1;
    XcdBarrier bar; bar.bar = F.ctl + CW_BAR; bar.x = 0; bar.st = nullptr;
    if (multi) bar = xcd_barrier_post(F.ctl + CW_BAR, F.MISC + 8);
#ifndef PH_MASK
#define PH_MASK 0x1FF
#endif
#define IN(k) (((PH_MASK >> (k)) & 1) && lo <= (k) && (k) < hi)
#define SEAM(k) do { if (IN(k) && IN((k) + 1)) xcd_barrier(bar); } while (0)
    unsigned char* ws = args.ws;
    LAS unsigned char* ring = F.lds;

#define PHASE1(rep) do { \
        pg8::Gemm g{(const u16*)(ws + WS_XN0), (const u16*)(ws + WS_W0T), T, P0W, 1024, 1024}; pg8::StaticOrder S; S.init(T, P0W, F.G, (int)blockIdx.x); \
        pg8::EpiProj0 E{(u16*)(ws + WS_PROJ0)}; \
        pg8::gemm_phase<pg8::EpiProj0>(ring, g, S, E); } while (0)
#define PHASE2(rep) do { if (!NAIVE_ATTN) { \
        for (;;) { \
            const int u = next_unit(F, (rep) ? CW_Q0 + 16 : CW_Q0); \
            if (u >= 2048) break; \
            const int lvl = 31 - (u >> 6), r = u & 63; \
            if (r < 32) { if (!((rep) && REPEAT_SUB == 1)) { const int c = 2 * lvl + 1 - (r >> 4), rr = r & 15; attnB_unit(F, rr >> 1, 2 * c + (rr & 1), (rep) ? REPEAT_SUB : 0); } } \
            else { if (!((rep) && REPEAT_SUB >= 2)) { const int idx = r - 32; attnA_unit(F, args, idx >> 2, idx & 3, lvl); } } \
        } \
        __syncthreads(); } } while (0)
#define PHASE3(rep) do { \
        pg8::Gemm g{(const u16*)(ws + WS_MG0), (const u16*)(ws + WS_WO0T), T, 1024, 1024, 1024}; pg8::StaticOrder S; S.init(T, 1024, F.G, (int)blockIdx.x); \
        pg8::EpiRes0 E{args.in[I_X], (u16*)(ws + WS_XN0), (rep) ? nullptr : (u64*)(ws + WS_SSQ1)}; \
        pg8::gemm_phase<pg8::EpiRes0>(ring, g, S, E); } while (0)
#define PHASE4(rep) do { \
        pg8::Gemm g{(const u16*)(ws + WS_XN0), (const u16*)(ws + WS_W1T), T, P1W, 1024, 1024}; pg8::StaticOrder S; S.init(T, P1W, F.G, (int)blockIdx.x); \
        pg8::EpiProj1 E{(const u64*)(ws + WS_SSQ1), (u16*)(ws + WS_LAT), (u16*)(ws + WS_KROPE), (u16*)(ws + WS_G1), (rep) ? nullptr : (u64*)(ws + WS_SSQKV), (rep) ? nullptr : (u64*)(ws + WS_SSQQ), (const float*)(ws + WS_ROPEC), (const float*)(ws + WS_ROPES)}; \
        pg8::gemm_phase<pg8::EpiProj1>(ring, g, S, E); } while (0)
#define PHASE5(rep) do { \
        { pg8::Gemm g{(const u16*)(ws + WS_LAT) + 256, (const u16*)(ws + WS_WUQT), T, 1536, 384, LATW}; pg8::StaticOrder S; S.init(T, 1536, F.G, (int)blockIdx.x); \
          pg8::EpiQ1 E{(const u64*)(ws + WS_SSQQ), (u16*)(ws + WS_Q1), (const float*)(ws + WS_ROPEC), (const float*)(ws + WS_ROPES)}; \
          pg8::gemm_phase<pg8::EpiQ1>(ring, g, S, E); } \
        { pg8::Gemm g{(const u16*)(ws + WS_LAT), (const u16*)(ws + WS_WUKVT), T, 2048, 256, LATW}; pg8::StaticOrder S; S.init(T, 2048, F.G, (int)blockIdx.x); \
          pg8::EpiKV1 E{(const u64*)(ws + WS_SSQKV), (u16*)(ws + WS_KV1)}; \
          pg8::gemm_phase<pg8::EpiKV1>(ring, g, S, E); } } while (0)
#define PHASE6(rep) do { if (!NAIVE_ATTN) { \
          \
          \
        const int xq = (int)(blockIdx.x & 7); \
        for (;;) { \
            const int u = next_unit(F, CW_Q1 + 32 * xq + ((rep) ? 16 : 0)); \
            if (u >= 256) break; \
            const int qb = 15 - ((u & 31) >> 1), hh = 2 * (u >> 5) + (u & 1); \
            if (rep) attnC_unit<REPEAT_SUB>(F, xq, hh, qb); else attnC_unit<0>(F, xq, hh, qb); \
        } \
        __syncthreads(); } } while (0)
#define PHASE7(rep) do { \
        pg8::Gemm g{(const u16*)(ws + WS_MG1), (const u16*)(ws + WS_WO1T), T, 1024, 1024, 1024}; pg8::StaticOrder S; S.init(T, 1024, F.G, (int)blockIdx.x); \
        pg8::EpiRes1 E{(const u16*)(ws + WS_XN0), (u16*)(ws + WS_X2H)}; \
        pg8::gemm_phase<pg8::EpiRes1>(ring, g, S, E); } while (0)
#define REPEAT(k, CALL) do { if (REPEAT_PHASE == (k) && multi) { xcd_barrier(bar); CALL; } } while (0)
    if (IN(0)) { p0_prologue(F, args); REPEAT(0, p0_prologue(F, args)); } SEAM(0);
    if (IN(1)) { PHASE1(0); REPEAT(1, PHASE1(1)); } SEAM(1);
    if (IN(2)) { PHASE2(0); REPEAT(2, PHASE2(1)); } SEAM(2);
    if (IN(3)) { PHASE3(0); REPEAT(3, PHASE3(1)); } SEAM(3);
    if (IN(4)) { PHASE4(0); REPEAT(4, PHASE4(1)); } SEAM(4);
    if (IN(5)) { PHASE5(0); REPEAT(5, PHASE5(1)); } SEAM(5);
    if (IN(6)) { PHASE6(0); REPEAT(6, PHASE6(1)); } SEAM(6);
    if (IN(7)) { PHASE7(0); } SEAM(7);
    if (IN(8)) { p8_final(F, args); }
#undef IN
#undef SEAM
}

extern "C" void kernel_launch(void* const* d_in, const int* in_sizes, int n_in, void* d_out, int out_size, void* d_ws, size_t ws_size, hipStream_t stream) {
    static int grid = 0;
    if (grid == 0) {
        if (n_in != 18 || in_sizes[0] != T * DM || out_size != T * DM || ws_size < WS_END) {
            fprintf(stderr, "kernel_launch: unexpected shapes (n_in %d, in0 %d, out %d, ws %zu, need %zu); nothing launched\n", n_in, n_in > 0 ? in_sizes[0] : -1, out_size, ws_size, (size_t)WS_END); grid = -1; return; }
        int dev = 0, cus = 0, per_cu = 0;
        if (hipGetDevice(&dev) != hipSuccess || hipDeviceGetAttribute(&cus, hipDeviceAttributeMultiprocessorCount, dev) != hipSuccess) { fprintf(stderr, "kernel_launch: device query failed\n"); grid = -1; return; }
        if (hipFuncSetAttribute((const void*)hybrid_fwd, hipFuncAttributeMaxDynamicSharedMemorySize, LDS_BYTES) != hipSuccess) { fprintf(stderr, "kernel_launch: hipFuncSetAttribute failed\n"); grid = -1; return; }
        if (hipOccupancyMaxActiveBlocksPerMultiprocessor(&per_cu, (const void*)hybrid_fwd, NWAVES * 64, LDS_BYTES) != hipSuccess || per_cu < 1)
            fprintf(stderr, "kernel_launch: note: occupancy query reports %d workgroups per CU\n", per_cu);
        (void)hipGetLastError();
        grid = cus;
        if (grid % 8 != 0) grid -= grid % 8;
    }
    if (grid <= 0) return;
    (void)hipMemsetAsync((char*)d_ws + WS_CTL, 0, CTL_ZERO_BYTES, stream);
    Args a{};
    for (int i = 0; i < 18; ++i) a.in[i] = (const float*)d_in[i];
    a.out = (float*)d_out; a.ws = (unsigned char*)d_ws;
#if MK_N_LAUNCHES == 1
    a.ph_lo = 0; a.ph_hi = N_PHASES;
    hipLaunchKernelGGL(hybrid_fwd, dim3(grid), dim3(NWAVES * 64), LDS_BYTES, stream, a);
#else
#if DEBUG_CHECK
    hipLaunchKernelGGL(dbg_check, dim3(1), dim3(256), 0, stream, a, 0);
#endif
    for (int p = 0; p < N_PHASES; ++p) { a.ph_lo = p; a.ph_hi = p + 1;
#if NAIVE_ATTN
        if (p == 2) { hipLaunchKernelGGL(naive_attn, dim3(8192), dim3(256), 0, stream, a, 0); continue; }
        if (p == 6) { hipLaunchKernelGGL(naive_attn, dim3(8192), dim3(256), 0, stream, a, 1); continue; }
#endif
        hipLaunchKernelGGL(hybrid_fwd, dim3(grid), dim3(NWAVES * 64), LDS_BYTES, stream, a);
#if DEBUG_CHECK
        if (p <= 6) hipLaunchKernelGGL(dbg_check, dim3((p == 2 || p == 6) ? 96 : 64), dim3(256), 0, stream, a, p + 1);
#endif
    }
#if DEBUG_CHECK
    hipLaunchKernelGGL(dbg_check, dim3(1), dim3(256), 0, stream, a, 9);
#endif
#endif
    const hipError_t le = hipPeekAtLastError();
    if (le != hipSuccess) fprintf(stderr, "kernel_launch: launch failed: %s\n", hipGetErrorName(le));
}
```

```cpp
#include <hip/hip_runtime.h>
#include <cstdio>
#include <cstdint>

#ifndef DEBUG_CHECK
#define DEBUG_CHECK 0
#endif
#define TAPB 3
#define TAPH 5
#define TAPQB 7
#ifndef UBENCH
#define UBENCH 0
#endif
#ifndef REPEAT_PHASE
#define REPEAT_PHASE -1
#define REPEAT_SUB 0
#endif
#ifndef MK_N_LAUNCHES
#define MK_N_LAUNCHES 1
#endif

#define LAS __attribute__((address_space(3)))
#define GAS __attribute__((address_space(1)))
typedef unsigned short u16;
typedef unsigned long long u64;
typedef _Float16 h8 __attribute__((ext_vector_type(8)));
typedef _Float16 h2 __attribute__((ext_vector_type(2)));
typedef _Float16 h4 __attribute__((ext_vector_type(4)));
typedef short s16x4 __attribute__((ext_vector_type(4)));
typedef short s16x8 __attribute__((ext_vector_type(8)));
typedef float f32x2 __attribute__((ext_vector_type(2)));
typedef float f32x4 __attribute__((ext_vector_type(4)));
typedef float f32x16 __attribute__((ext_vector_type(16)));
typedef unsigned u32x2 __attribute__((ext_vector_type(2)));
typedef unsigned u32x4 __attribute__((ext_vector_type(4)));

constexpr int SEQ = 4096, NB = 8, T = NB * SEQ, DM = 1024;
constexpr int P0W = 3840;
constexpr int C_QA = 0, C_KA = 512, C_VA = 1024, C_QB = 1536, C_KB = 2048, C_VB = 2112, C_QI = 2176, C_KI = 2688, C_WI = 2752, C_G0 = 2816;
constexpr int L0_SRC = 3784;
constexpr int P1W = 1792;
constexpr int L1_SRC = 1696;
constexpr int LATW = 640;
constexpr int TOPK = 256;
constexpr float LOG2E = 1.4426950408889634f;
constexpr float QS_AB = 0.125f * LOG2E;
constexpr float QS_C = 0.10206207261596575f * LOG2E;
constexpr float RMS_EPS = 1e-6f;
constexpr float FXS = 1048576.0f;

constexpr size_t MiB = 1u << 20;
constexpr size_t WS_CTL = 0, CTL_ZERO_BYTES = 2 * MiB;
constexpr size_t WS_SSQ1 = 1 * MiB, WS_SSQKV = WS_SSQ1 + 256 * 1024, WS_SSQQ = WS_SSQKV + 256 * 1024;
constexpr size_t WS_ROPEC = 2 * MiB, WS_ROPES = WS_ROPEC + 256 * 1024, WS_BTG = WS_ROPES + 256 * 1024, WS_LAM = WS_BTG + 16 * 1024;
constexpr size_t WS_W0T = 4 * MiB;
constexpr size_t WS_WO0T = 12 * MiB;
constexpr size_t WS_W1T = 14 * MiB;
constexpr size_t WS_WUQT = 18 * MiB;
constexpr size_t WS_WUKVT = 20 * MiB;
constexpr size_t WS_WO1T = 22 * MiB;
constexpr size_t WS_XN0 = 32 * MiB;
constexpr size_t WS_PROJ0 = 96 * MiB;
constexpr size_t WS_MG0 = 336 * MiB;
constexpr size_t WS_LAT = 96 * MiB;
constexpr size_t WS_KROPE = 136 * MiB;
constexpr size_t WS_G1 = 140 * MiB;
constexpr size_t WS_Q1 = 204 * MiB;
constexpr size_t WS_KV1 = 300 * MiB;
constexpr size_t WS_MG1 = 428 * MiB;
constexpr size_t WS_X2H = 96 * MiB;
constexpr size_t WS_END = 492 * MiB;
constexpr size_t WS_DBGBUF = 3 * MiB + 4096;
constexpr int CW_TMO = 0, CW_CODE = 1, CW_Q0 = 64, CW_Q1 = 128, CW_BAR = 4096;

constexpr int RING_BYTES = 131072;
constexpr int MISC_OFF = RING_BYTES + 320;
constexpr int LDS_BYTES = 147456;
constexpr int NWAVES = 8;

__device__ __forceinline__ unsigned pkh(float lo, float hi) { f32x2 v = {lo, hi}; h2 h = __builtin_convertvector(v, h2); return __builtin_bit_cast(unsigned, h); }
__device__ __forceinline__ float h2f(u16 b) { return (float)__builtin_bit_cast(_Float16, b); }
__device__ __forceinline__ float silu_f(float x) { return x * __builtin_amdgcn_rcpf(1.0f + __builtin_amdgcn_exp2f(-x * LOG2E)); }
__device__ __forceinline__ float swap_max(float m) { auto rr = __builtin_amdgcn_permlane32_swap(__float_as_uint(m), __float_as_uint(m), false, false); return fmaxf(__uint_as_float(rr[0]), __uint_as_float(rr[1])); }
__device__ __forceinline__ float swap_sum(float m) { auto rr = __builtin_amdgcn_permlane32_swap(__float_as_uint(m), __float_as_uint(m), false, false); return __uint_as_float(rr[0]) + __uint_as_float(rr[1]); }
__device__ __forceinline__ float wave_sum(float v) {
#pragma unroll
    for (int o = 1; o < 64; o <<= 1) v += __shfl_xor(v, o);
    return v;
}
#define LDS_WAIT() asm volatile("s_waitcnt lgkmcnt(0)" ::: "memory")
#define VM_WAIT() asm volatile("s_waitcnt vmcnt(0)" ::: "memory")

namespace pg8 {
constexpr int BM = 256, BK = 64, HALF = 128, HTB = HALF * BK * 2, STAGE_BYTES = 8 * HTB, NXCD = 8, WGM = 8;
__host__ __device__ __forceinline__ int lds_byte(int r, int c) { const int st = (r >> 4) * 2 + (c >> 5), rr = r & 15, cc = c & 31, ob = rr * 64 + cc * 2; return st * 1024 + (ob ^ (((ob >> 9) & 1) << 5)); }
__host__ __device__ __forceinline__ void stage_rc(int b, int& R, int& C) { const int st = b / 1024, sb = b % 1024, swz = sb ^ (((sb >> 9) & 1) << 5); R = (st >> 1) * 16 + swz / 64; C = (st & 1) * 32 + (swz % 64) / 2; }
__host__ __device__ __forceinline__ int perm32(int rho) { const int n = rho >> 4, i = rho & 15; return 8 * (i >> 2) + 4 * n + (i & 3); }
struct Unit { int pm, pn; };
struct Gemm { const u16* A; const u16* Bt; int M, N, K, lda; };
struct StaticOrder {
    int nM, nN, nwg, G, c;
    __device__ void init(int M, int N, int G_, int c_) { nM = M / BM; nN = N / BM; nwg = nM * nN; G = G_; c = c_; }
    __device__ bool next(int i, Unit& u) const {
        const long L = (long)i * G + c; if (L >= nwg) return false;
        int wgid = (int)L; { const int q = nwg / NXCD, r = nwg % NXCD, xcd = wgid % NXCD, off = wgid / NXCD; wgid = (xcd < r ? xcd * (q + 1) : r * (q + 1) + (xcd - r) * q) + off; }
        const int nig = WGM * nN, gid = wgid / nig, fm = gid * WGM, gsz = (nM - fm) < WGM ? (nM - fm) : WGM;
        u.pm = fm + ((wgid % nig) % gsz); u.pn = (wgid % nig) / gsz; return true;
    }
};
template <class Epi>
__device__ __forceinline__ void gemm_phase(LAS unsigned char* lds, const Gemm g, const StaticOrder& S, const Epi& E) {
    const int tid = threadIdx.x, wid = __builtin_amdgcn_readfirstlane(tid >> 6), lane = tid & 63, wr = wid >> 2, wc = wid & 3, fr = lane & 15, fq = lane >> 4;
    const int K = g.K, nt = K / BK, lda = g.lda;
    unsigned voffA[2], voffB[2];
#pragma unroll
    for (int i = 0; i < 2; ++i) { int R, C; stage_rc(tid * 16 + i * 8192, R, C); const int Rb = Epi::PERM ? ((R & ~31) + perm32(R & 31)) : R;
        voffA[i] = (unsigned)(R * lda + C) * 2u; voffB[i] = (unsigned)(Rb * K + C) * 2u; }
    const size_t kstep = (size_t)(BK * 2);
    const size_t hstepA = (size_t)HALF * lda * 2, tstepA = 2 * hstepA;
    const size_t hstepB = (size_t)HALF * K * 2, tstepB = 2 * hstepB;
    const unsigned ldsw = (unsigned)wid * 1024u;
    const int aoff = lds_byte(wr * 64 + fr, fq * 8), boff = lds_byte(wc * 32 + fr, fq * 8);
#define PG8_SA(b, h) (((b) * 2 + (h)) * HTB)
#define PG8_SB(b, h) ((4 + (b) * 2 + (h)) * HTB)
#define PG8_STAGE(bufoff, gbase, voff) do { _Pragma("unroll") for (int _i = 0; _i < 2; ++_i) \
        __builtin_amdgcn_global_load_lds((const unsigned*)((const char*)(gbase) + (voff)[_i]), (LAS unsigned*)(lds + (bufoff) + ldsw + _i * 8192), 16, 0, 0); } while (0)
#define PG8_LDA(dst, b, h) do { _Pragma("unroll") for (int m = 0; m < 4; ++m) _Pragma("unroll") for (int k = 0; k < 2; ++k) dst[m][k] = *(const LAS h8*)(lds + PG8_SA(b, h) + aoff + m * 2048 + k * 1024); } while (0)
#define PG8_LDB(dst, b, h) do { _Pragma("unroll") for (int n = 0; n < 2; ++n) _Pragma("unroll") for (int k = 0; k < 2; ++k) dst[n][k] = *(const LAS h8*)(lds + PG8_SB(b, h) + boff + n * 2048 + k * 1024); } while (0)
#define PG8_MMA(ai, bj, At, Bt) do { __builtin_amdgcn_s_setprio(1); _Pragma("unroll") for (int m = 0; m < 4; ++m) _Pragma("unroll") for (int n = 0; n < 2; ++n) _Pragma("unroll") for (int k = 0; k < 2; ++k) \
        acc[ai][bj][m][n] = __builtin_amdgcn_mfma_f32_16x16x32_f16(Bt[n][k], At[m][k], acc[ai][bj][m][n], 0, 0, 0); __builtin_amdgcn_s_setprio(0); } while (0)
#define PG8_WAIT_V(n) asm volatile("s_waitcnt vmcnt(" #n ")" ::: "memory")
#define PG8_WAIT_L(n) asm volatile("s_waitcnt lgkmcnt(" #n ")" ::: "memory")
#define PG8_BAR __builtin_amdgcn_s_barrier()
#define PG8_SCHED __builtin_amdgcn_sched_barrier(0)
    Unit cur, nxt; int ui = 0;
    if (!S.next(0, cur)) return;
    f32x4 acc[2][2][4][2];
#pragma unroll
    for (int a = 0; a < 2; ++a)
#pragma unroll
        for (int b = 0; b < 2; ++b)
#pragma unroll
            for (int m = 0; m < 4; ++m)
#pragma unroll
                for (int n = 0; n < 2; ++n) acc[a][b][m][n] = (f32x4){0.f, 0.f, 0.f, 0.f};
    h8 At[4][2], B0[2][2], B1[2][2];
    const char* cA = (const char*)g.A + (size_t)cur.pm * tstepA; const char* cB = (const char*)g.Bt + (size_t)cur.pn * tstepB;
    PG8_STAGE(PG8_SB(0, 0), cB, voffB); PG8_STAGE(PG8_SB(0, 1), cB + hstepB, voffB); PG8_STAGE(PG8_SA(0, 0), cA, voffA); PG8_STAGE(PG8_SA(0, 1), cA + hstepA, voffA);
    if (wr == 1) PG8_BAR;
    PG8_WAIT_V(2); PG8_BAR;
    PG8_STAGE(PG8_SB(1, 0), cB + kstep, voffB); PG8_STAGE(PG8_SA(1, 0), cA + kstep, voffA); PG8_STAGE(PG8_SB(1, 1), cB + hstepB + kstep, voffB);
    PG8_WAIT_V(6); PG8_BAR;
    for (;;) {
        const bool has_next = S.next(ui + 1, nxt);
        const char* nA = has_next ? (const char*)g.A + (size_t)nxt.pm * tstepA : cA; const char* nB = has_next ? (const char*)g.Bt + (size_t)nxt.pn * tstepB : cB;
#pragma unroll 1
        for (int t = 0; t < nt; t += 2) {
            const bool last = (t == nt - 2);
            const char* a1 = cA + (size_t)(t + 1) * kstep;
            const char* a2 = last ? nA : cA + (size_t)(t + 2) * kstep; const char* b2 = last ? nB : cB + (size_t)(t + 2) * kstep;
            const char* a3 = a2 + kstep; const char* b3 = b2 + kstep;
            PG8_LDB(B0, 0, 0); PG8_LDB(B1, 0, 1); PG8_SCHED; PG8_LDA(At, 0, 0); PG8_STAGE(PG8_SA(1, 1), a1 + hstepA, voffA);
            PG8_WAIT_V(8); PG8_WAIT_L(0); PG8_BAR; PG8_MMA(0, 0, At, B0); PG8_MMA(0, 1, At, B1); PG8_BAR; PG8_SCHED;
            PG8_LDA(At, 0, 1); PG8_STAGE(PG8_SB(0, 0), b2, voffB); PG8_STAGE(PG8_SB(0, 1), b2 + hstepB, voffB); PG8_STAGE(PG8_SA(0, 0), a2, voffA);
            PG8_WAIT_V(8); PG8_WAIT_L(0); PG8_BAR; PG8_MMA(1, 0, At, B0); PG8_MMA(1, 1, At, B1); PG8_BAR; PG8_SCHED;
            PG8_LDB(B0, 1, 0); PG8_LDB(B1, 1, 1); PG8_SCHED; PG8_LDA(At, 1, 0); PG8_STAGE(PG8_SA(0, 1), a2 + hstepA, voffA);
            PG8_WAIT_V(8); PG8_WAIT_L(0); PG8_BAR; PG8_MMA(0, 0, At, B0); PG8_MMA(0, 1, At, B1); PG8_BAR; PG8_SCHED;
            PG8_LDA(At, 1, 1); PG8_STAGE(PG8_SB(1, 0), b3, voffB); PG8_STAGE(PG8_SB(1, 1), b3 + hstepB, voffB); PG8_STAGE(PG8_SA(1, 0), a3, voffA);
            PG8_WAIT_V(8); PG8_WAIT_L(0); PG8_BAR; PG8_MMA(1, 0, At, B0); PG8_MMA(1, 1, At, B1); PG8_BAR; PG8_SCHED;
        }
        if (wr == 0) PG8_BAR;
        E(acc, cur, wr, wc, fr, fq);
        if (!has_next) break;
#pragma unroll
        for (int a = 0; a < 2; ++a)
#pragma unroll
            for (int b = 0; b < 2; ++b)
#pragma unroll
                for (int m = 0; m < 4; ++m)
#pragma unroll
                    for (int n = 0; n < 2; ++n) acc[a][b][m][n] = (f32x4){0.f, 0.f, 0.f, 0.f};
        cur = nxt; cA = nA; cB = nB; ++ui;
        if (wr == 1) PG8_BAR;
    }
    PG8_WAIT_V(0);
    PG8_BAR;
#undef PG8_SA
#undef PG8_SB
#undef PG8_STAGE
#undef PG8_LDA
#undef PG8_LDB
#undef PG8_MMA
#undef PG8_WAIT_V
#undef PG8_WAIT_L
#undef PG8_BAR
#undef PG8_SCHED
}

typedef f32x4 Acc[2][2][4][2];
__device__ __forceinline__ float rstd_from(const u64* ssq, int row, float inv_n) { return __builtin_amdgcn_rsqf((float)ssq[row] * (1.0f / FXS) * inv_n + RMS_EPS); }
__device__ __forceinline__ void ssq_add(u64* ssq, int row, float ss, int fq) {
    ss += __shfl_xor(ss, 16); ss += __shfl_xor(ss, 32);
    if (fq == 0) atomicAdd((unsigned long long*)(ssq + row), (unsigned long long)(ss * FXS + 0.5f));
}
struct EpiProj0 {
    static constexpr bool PERM = true;
    u16* O;
    __device__ __forceinline__ void operator()(const Acc& acc, const Unit& u, int wr, int wc, int fr, int fq) const {
        const int row0 = u.pm * BM + wr * 64 + fr, col0 = u.pn * BM + wc * 32 + 8 * fq; const bool gate = u.pn >= 11;
#pragma unroll
        for (int ai = 0; ai < 2; ++ai)
#pragma unroll
            for (int m = 0; m < 4; ++m) { u16* rowp = O + (size_t)(row0 + ai * HALF + m * 16) * P0W + col0;
#pragma unroll
                for (int bj = 0; bj < 2; ++bj) { f32x4 v0 = acc[ai][bj][m][0], v1 = acc[ai][bj][m][1];
                    if (gate) {
#pragma unroll
                        for (int e = 0; e < 4; ++e) { v0[e] = silu_f(v0[e]); v1[e] = silu_f(v1[e]); } }
                    u32x4 w; w.x = pkh(v0[0], v0[1]); w.y = pkh(v0[2], v0[3]); w.z = pkh(v1[0], v1[1]); w.w = pkh(v1[2], v1[3]);
                    *(u32x4*)(rowp + bj * HALF) = w; } }
    }
};
struct EpiRes0 {
    static constexpr bool PERM = false;
    const float* base; u16* outh; u64* ssq;
    __device__ __forceinline__ void operator()(const Acc& acc, const Unit& u, int wr, int wc, int fr, int fq) const {
        const int row0 = u.pm * BM + wr * 64 + fr, col0 = u.pn * BM + wc * 32 + 4 * fq;
#pragma unroll
        for (int ai = 0; ai < 2; ++ai)
#pragma unroll
            for (int m = 0; m < 4; ++m) { const int row = row0 + ai * HALF + m * 16; const size_t off = (size_t)row * DM + col0; float ss = 0.f;
#pragma unroll
                for (int bj = 0; bj < 2; ++bj)
#pragma unroll
                    for (int n = 0; n < 2; ++n) { const f32x4 bs = *(const f32x4*)(base + off + bj * HALF + n * 16); const f32x4 o = bs + acc[ai][bj][m][n];
                        u32x2 w; w.x = pkh(o[0], o[1]); w.y = pkh(o[2], o[3]); *(u32x2*)(outh + off + bj * HALF + n * 16) = w;
                        ss += (o[0] * o[0] + o[1] * o[1]) + (o[2] * o[2] + o[3] * o[3]); }
                if (ssq) ssq_add(ssq, row, ss, fq); }
    }
};
struct EpiRes1 {
    static constexpr bool PERM = false;
    const u16* baseh; u16* outh;
    __device__ __forceinline__ void operator()(const Acc& acc, const Unit& u, int wr, int wc, int fr, int fq) const {
        const int row0 = u.pm * BM + wr * 64 + fr, col0 = u.pn * BM + wc * 32 + 4 * fq;
#pragma unroll
        for (int ai = 0; ai < 2; ++ai)
#pragma unroll
            for (int m = 0; m < 4; ++m) { const int row = row0 + ai * HALF + m * 16; const size_t off = (size_t)row * DM + col0;
#pragma unroll
                for (int bj = 0; bj < 2; ++bj)
#pragma unroll
                    for (int n = 0; n < 2; ++n) { const h4 bh = *(const h4*)(baseh + off + bj * HALF + n * 16);
                        const f32x4 a = acc[ai][bj][m][n];
                        u32x2 w; w.x = pkh(a[0] + (float)bh[0], a[1] + (float)bh[1]); w.y = pkh(a[2] + (float)bh[2], a[3] + (float)bh[3]);
                        *(u32x2*)(outh + off + bj * HALF + n * 16) = w; } }
    }
};
struct EpiProj1 {
    static constexpr bool PERM = false;
    const u64* ssq1; u16* lat; u16* krope; u16* g1; u64* ssqkv; u64* ssqq; const float* ropec; const float* ropes;
    __device__ __forceinline__ void operator()(const Acc& acc, const Unit& u, int wr, int wc, int fr, int fq) const {
        const int row0 = u.pm * BM + wr * 64 + fr, pn = u.pn;
#pragma unroll
        for (int ai = 0; ai < 2; ++ai)
#pragma unroll
            for (int m = 0; m < 4; ++m) { const int row = row0 + ai * HALF + m * 16; const float rs = rstd_from(ssq1, row, 1.0f / 1024.0f); float ss = 0.f;
#pragma unroll
                for (int bj = 0; bj < 2; ++bj) { f32x4 v0 = acc[ai][bj][m][0] * rs, v1 = acc[ai][bj][m][1] * rs;
                    const int tc = bj * HALF + wc * 32 + 4 * fq;
                    if (pn >= 3) {
#pragma unroll
                        for (int e = 0; e < 4; ++e) { v0[e] = silu_f(v0[e]); v1[e] = silu_f(v1[e]); }
                        u16* p = g1 + (size_t)row * DM + (pn - 3) * BM + tc;
                        u32x2 w0, w1; w0.x = pkh(v0[0], v0[1]); w0.y = pkh(v0[2], v0[3]); w1.x = pkh(v1[0], v1[1]); w1.y = pkh(v1[2], v1[3]);
                        *(u32x2*)p = w0; *(u32x2*)(p + 16) = w1;
                    } else if (pn < 2 || bj == 0) {
                        u16* p = lat + (size_t)row * LATW + pn * BM + tc;
                        u32x2 w0, w1; w0.x = pkh(v0[0], v0[1]); w0.y = pkh(v0[2], v0[3]); w1.x = pkh(v1[0], v1[1]); w1.y = pkh(v1[2], v1[3]);
                        *(u32x2*)p = w0; *(u32x2*)(p + 16) = w1;
                        ss += (v0[0] * v0[0] + v0[1] * v0[1]) + (v0[2] * v0[2] + v0[3] * v0[3]) + (v1[0] * v1[0] + v1[1] * v1[1]) + (v1[2] * v1[2] + v1[3] * v1[3]);
                    } else if (wc == 0) {
                        const int pos = row & (SEQ - 1); const f32x4 cs = *(const f32x4*)(ropec + pos * 16 + 4 * fq), sn = *(const f32x4*)(ropes + pos * 16 + 4 * fq);
                        const f32x4 o0 = v0 * cs - v1 * sn, o1 = v0 * sn + v1 * cs;
                        u16* p = krope + (size_t)row * 32 + 4 * fq;
                        u32x2 w0, w1; w0.x = pkh(o0[0], o0[1]); w0.y = pkh(o0[2], o0[3]); w1.x = pkh(o1[0], o1[1]); w1.y = pkh(o1[2], o1[3]);
                        *(u32x2*)p = w0; *(u32x2*)(p + 16) = w1;
                    } }
                if (pn == 0) { if (ssqkv) ssq_add(ssqkv, row, ss, fq); } else if (pn <= 2) { if (ssqq) ssq_add(ssqq, row, ss, fq); }
                asm volatile("" ::: "memory"); }
    }
};
struct EpiQ1 {
    static constexpr bool PERM = false;
    const u64* ssqq; u16* q1; const float* ropec; const float* ropes;
    __device__ __forceinline__ void operator()(const Acc& acc, const Unit& u, int wr, int wc, int fr, int fq) const {
        const int row0 = u.pm * BM + wr * 64 + fr;
#pragma unroll
        for (int ai = 0; ai < 2; ++ai)
#pragma unroll
            for (int m = 0; m < 4; ++m) { const int row = row0 + ai * HALF + m * 16; const float rs = rstd_from(ssqq, row, 1.0f / 384.0f);
#pragma unroll
                for (int bj = 0; bj < 2; ++bj) { f32x4 v0 = acc[ai][bj][m][0] * rs, v1 = acc[ai][bj][m][1] * rs;
                    const int g0 = u.pn * BM + bj * HALF + wc * 32;
                    if ((g0 % 96) == 64) { const int pos = row & (SEQ - 1); const f32x4 cs = *(const f32x4*)(ropec + pos * 16 + 4 * fq), sn = *(const f32x4*)(ropes + pos * 16 + 4 * fq);
                        const f32x4 o0 = v0 * cs - v1 * sn, o1 = v0 * sn + v1 * cs; v0 = o0; v1 = o1; }
                    u16* p = q1 + (size_t)row * 1536 + g0 + 4 * fq;
                    u32x2 w0, w1; w0.x = pkh(v0[0], v0[1]); w0.y = pkh(v0[2], v0[3]); w1.x = pkh(v1[0], v1[1]); w1.y = pkh(v1[2], v1[3]);
                    *(u32x2*)p = w0; *(u32x2*)(p + 16) = w1; }
                asm volatile("" ::: "memory"); }
    }
};
struct EpiKV1 {
    static constexpr bool PERM = true;
    const u64* ssqkv; u16* kv1;
    __device__ __forceinline__ void operator()(const Acc& acc, const Unit& u, int wr, int wc, int fr, int fq) const {
        const int row0 = u.pm * BM + wr * 64 + fr, col0 = u.pn * BM + wc * 32 + 8 * fq;
#pragma unroll
        for (int ai = 0; ai < 2; ++ai)
#pragma unroll
            for (int m = 0; m < 4; ++m) { const int row = row0 + ai * HALF + m * 16; const float rs = rstd_from(ssqkv, row, 1.0f / 256.0f); u16* rowp = kv1 + (size_t)row * 2048 + col0;
#pragma unroll
                for (int bj = 0; bj < 2; ++bj) { const f32x4 v0 = acc[ai][bj][m][0] * rs, v1 = acc[ai][bj][m][1] * rs;
                    u32x4 w; w.x = pkh(v0[0], v0[1]); w.y = pkh(v0[2], v0[3]); w.z = pkh(v1[0], v1[1]); w.w = pkh(v1[2], v1[3]);
                    *(u32x4*)(rowp + bj * HALF) = w; }
                if (m & 1) asm volatile("" ::: "memory"); }
    }
};
}

#define XB_TMO      128
#define XB_XCNT(j)  (256  + 64 * (j))
#define XB_XSUB(j)  (1280 + 64 * (j))
#define XB_XGEN(j)  (2304 + 64 * (j))
#define XB_TOP      3328
#define XB_TOPGEN   3392
#define XCD_BAR_WORDS 3456
#define XB_SPIN_CAP (1u << 20)
__device__ __forceinline__ unsigned xb_ld(unsigned* p)              { return __hip_atomic_load(p, __ATOMIC_RELAXED, __HIP_MEMORY_SCOPE_AGENT); }
__device__ __forceinline__ unsigned xb_add(unsigned* p, unsigned v) { return __hip_atomic_fetch_add(p, v, __ATOMIC_RELAXED, __HIP_MEMORY_SCOPE_AGENT); }
__device__ __forceinline__ unsigned xb_xcc_id() { return (unsigned)__builtin_amdgcn_s_getreg((3 << 11) | 20) & 0xFu; }
#define XB_SPIN(cond, bar) do { unsigned _sp = 0; while (cond) { __builtin_amdgcn_s_sleep(1); \
    if ((++_sp & 255u) == 0u) { if (xb_ld(&(bar)[XB_TMO])) break; if (_sp > XB_SPIN_CAP) { atomicAdd(&(bar)[XB_TMO], 1u); break; } } } } while (0)
struct XcdBarrier { unsigned* bar; unsigned x; volatile LAS unsigned* st; };
__device__ __forceinline__ XcdBarrier xcd_barrier_post(unsigned* bar, volatile LAS unsigned* st) {
    XcdBarrier b; b.bar = bar; b.x = xb_xcc_id(); b.st = st;
    if (threadIdx.x == 0) (void)xb_add(&bar[XB_XCNT(b.x)], 1u);
    return b;
}
__device__ __forceinline__ void xcd_barrier_complete(unsigned* bar, unsigned x, unsigned& nloc, unsigned& nx) {
    const unsigned G = gridDim.x * gridDim.y * gridDim.z;
    unsigned sum, cnt, mine, sp = 0u;
    for (;;) {
        sum = 0u; cnt = 0u; mine = 0u;
#pragma unroll
        for (unsigned j = 0; j < 16; ++j) { const unsigned c = xb_ld(&bar[XB_XCNT(j)]); sum += c; cnt += (c > 0u) ? 1u : 0u; mine = (j == x) ? c : mine; }
        if (sum == G) break;
        __builtin_amdgcn_s_sleep(1);
        if ((++sp & 255u) == 0u) { if (xb_ld(&bar[XB_TMO])) break; if (sp > XB_SPIN_CAP) { atomicAdd(&bar[XB_TMO], 1u); break; } }
    }
    nloc = mine > 0u ? mine : 1u; nx = cnt > 0u ? cnt : 1u;
}
__device__ __forceinline__ void xcd_barrier(const XcdBarrier& b) {
    asm volatile("s_waitcnt vmcnt(0)" ::: "memory");
    __syncthreads();
    if (threadIdx.x == 0) {
        unsigned* bar = b.bar;
        __builtin_amdgcn_s_waitcnt(0);
        unsigned nloc = b.st[0], nx = b.st[1];
        if (nloc == 0u) { xcd_barrier_complete(bar, b.x, nloc, nx); b.st[0] = nloc; b.st[1] = nx; }
        const unsigned old = xb_add(&bar[XB_XSUB(b.x)], 1u);
        const unsigned gen = old / nloc;
        if (old + 1u == (gen + 1u) * nloc) {
            __builtin_amdgcn_fence(__ATOMIC_RELEASE, "agent");
            asm volatile("s_waitcnt vmcnt(0)" ::: "memory");
            const unsigned og = xb_add(&bar[XB_TOP], 1u);
            const unsigned tg = og / nx;
            if (og + 1u == (tg + 1u) * nx) xb_add(&bar[XB_TOPGEN], 1u);
            else XB_SPIN(xb_ld(&bar[XB_TOPGEN]) == tg, bar);
            __builtin_amdgcn_fence(__ATOMIC_ACQUIRE, "agent");
            xb_add(&bar[XB_XGEN(b.x)], 1u);
            asm volatile("s_waitcnt vmcnt(0)" ::: "memory");
        } else {
            XB_SPIN(xb_ld(&bar[XB_XGEN(b.x)]) == gen, bar);
            __builtin_amdgcn_fence(__ATOMIC_ACQUIRE, "agent");
            asm volatile("s_waitcnt vmcnt(0)" ::: "memory");
        }
    }
    __syncthreads();
}

struct Args { const float* in[18]; float* out; unsigned char* ws; int ph_lo, ph_hi; };
struct Frame {
    LAS unsigned char* lds;
    volatile LAS unsigned* MISC;
    unsigned* ctl;
    int tid, lane, wave, G;
    float* out;
    unsigned char* ws;
};
enum { I_X = 0, I_RELB, I_ENORM, I_EWIN, I_LQ1, I_LK1, I_LQ2, I_LK2, I_SUBLN, I_EWO, I_ONORM, I_OWIN, I_OQNORM, I_OWUQ, I_OKVNORM, I_OWUKV, I_OWO, I_FNORM };

__device__ __forceinline__ int t5_bucket(int rel) {
    const int n = rel < 0 ? -rel : rel;
    const int v = n < 8 ? n : n < 12 ? 8 : n < 16 ? 9 : n < 23 ? 10 : n < 32 ? 11 : n < 46 ? 12 : n < 64 ? 13 : n < 91 ? 14 : 15;
    return (rel > 0 ? 16 : 0) + v;
}

__device__ __forceinline__ int wsrc_col(int mat, int n) {
    switch (mat) {
        case 0: return n < 2760 ? n : (n < C_G0 ? -1 : n - 56);
        case 2: return n < 256 ? 384 + n : (n < 640 ? n - 256 : (n < 672 ? n : (n < 768 ? -1 : n - 96)));
        default: return n;
    }
}
__device__ __forceinline__ float wcol_scale(int mat, int n) {
    if (mat == 0) return (n < 512 || (n >= C_QB && n < C_QB + 512)) ? QS_AB : 1.0f;
    if (mat == 3) return QS_C;
    return 1.0f;
}
__device__ __forceinline__ void p0_transpose_item(const float* W, int K, int Nsrc, int Npad, const float* gain, int mat, u16* WT, LAS float* scr, int item, int lane) {
    const int nblk = Npad / 32, kb = item / nblk, nb = item % nblk, k0 = 64 * kb, n0 = 32 * nb;
    const int n = n0 + (lane & 31); const int sc = wsrc_col(mat, n); const float cs = wcol_scale(mat, n);
#pragma unroll 8
    for (int i = 0; i < 32; ++i) { const int kk = 2 * i + (lane >> 5); float v = 0.f;
        if (sc >= 0) { v = W[(size_t)(k0 + kk) * Nsrc + sc] * cs; if (gain) v *= gain[k0 + kk]; }
        scr[kk * 33 + (lane & 31)] = v; }
    LDS_WAIT(); asm volatile("" ::: "memory");
    const int c = lane & 7;
#pragma unroll
    for (int j = 0; j < 4; ++j) { const int nn = (lane >> 3) + 8 * j; const LAS float* s = scr + (8 * c) * 33 + nn;
        u32x4 o; o.x = pkh(s[0 * 33], s[1 * 33]); o.y = pkh(s[2 * 33], s[3 * 33]); o.z = pkh(s[4 * 33], s[5 * 33]); o.w = pkh(s[6 * 33], s[7 * 33]);
        *(u32x4*)(WT + (size_t)(n0 + nn) * K + k0 + 8 * c) = o; }
    LDS_WAIT(); asm volatile("" ::: "memory");
}
__device__ __forceinline__ void p0_prologue(Frame& F, const Args& AR) {
    LAS float* scr = (LAS float*)(F.lds + F.wave * 16384);
    const int gw = blockIdx.x * NWAVES + F.wave, NGW = F.G * NWAVES;
    unsigned char* ws = F.ws;
    constexpr int I0 = (1024 / 64) * (P0W / 32), I1 = (1024 / 64) * (1024 / 32), I2 = (1024 / 64) * (P1W / 32), I3 = (384 / 64) * (1536 / 32), I4 = (256 / 64) * (2048 / 32), I5 = I1;
    constexpr int NITEMS = I0 + I1 + I2 + I3 + I4 + I5;
    for (int it = gw; it < NITEMS; it += NGW) {
        int r = it;
        if (r < I0) { p0_transpose_item(AR.in[I_EWIN], 1024, L0_SRC, P0W, nullptr, 0, (u16*)(ws + WS_W0T), scr, r, F.lane); continue; } r -= I0;
        if (r < I1) { p0_transpose_item(AR.in[I_EWO], 1024, 1024, 1024, nullptr, 1, (u16*)(ws + WS_WO0T), scr, r, F.lane); continue; } r -= I1;
        if (r < I2) { p0_transpose_item(AR.in[I_OWIN], 1024, L1_SRC, P1W, AR.in[I_ONORM], 2, (u16*)(ws + WS_W1T), scr, r, F.lane); continue; } r -= I2;
        if (r < I3) { p0_transpose_item(AR.in[I_OWUQ], 384, 1536, 1536, AR.in[I_OQNORM], 3, (u16*)(ws + WS_WUQT), scr, r, F.lane); continue; } r -= I3;
        if (r < I4) { p0_transpose_item(AR.in[I_OWUKV], 256, 2048, 2048, AR.in[I_OKVNORM], 4, (u16*)(ws + WS_WUKVT), scr, r, F.lane); continue; } r -= I4;
        p0_transpose_item(AR.in[I_OWO], 1024, 1024, 1024, nullptr, 5, (u16*)(ws + WS_WO1T), scr, r, F.lane);
    }
    {
        const float* gn = AR.in[I_ENORM]; f32x4 gv[4];
#pragma unroll
        for (int j = 0; j < 4; ++j) gv[j] = *(const f32x4*)(gn + 4 * F.lane + 256 * j);
        u16* XN = (u16*)(ws + WS_XN0);
        for (int mrow = gw; mrow < T; mrow += NGW) {
            const f32x4* xr = (const f32x4*)(AR.in[I_X] + (size_t)mrow * DM) + F.lane;
            f32x4 v[4]; float s = 0.f;
#pragma unroll
            for (int j = 0; j < 4; ++j) { v[j] = xr[64 * j]; s += (v[j].x * v[j].x + v[j].y * v[j].y) + (v[j].z * v[j].z + v[j].w * v[j].w); }
            const float rstd = __builtin_amdgcn_rsqf(wave_sum(s) * (1.f / DM) + RMS_EPS);
            u32x2* o8 = (u32x2*)(XN + (size_t)mrow * DM) + F.lane;
#pragma unroll
            for (int j = 0; j < 4; ++j) { const f32x4 t = v[j] * rstd * gv[j]; u32x2 w; w.x = pkh(t.x, t.y); w.y = pkh(t.z, t.w); o8[64 * j] = w; }
        }
    }
    {
        float* rc = (float*)(ws + WS_ROPEC); float* rs = (float*)(ws + WS_ROPES);
        const int gt = blockIdx.x * 512 + F.tid, NGT = F.G * 512;
        for (int e = gt; e < SEQ * 16; e += NGT) { const int pos = e >> 4, i = e & 15;
            const float inv = (float)pow(10000.0, -(double)i / 16.0); const float ang = (float)pos * inv;
            rc[e] = (float)cos((double)ang); rs[e] = (float)sin((double)ang); }
        float* bt = (float*)(ws + WS_BTG);
        for (int e = gt; e < 12 * 192; e += NGT) { const int hd = e / 192, idx = e % 192; const int rel = idx - 128;
            bt[e] = AR.in[I_RELB][t5_bucket(rel) * 12 + hd] * LOG2E; }
        if (blockIdx.x == 0 && F.wave == 0) {
            const float a = wave_sum(AR.in[I_LQ1][F.lane] * AR.in[I_LK1][F.lane]), b = wave_sum(AR.in[I_LQ2][F.lane] * AR.in[I_LK2][F.lane]);
            if (F.lane == 0) *(float*)(ws + WS_LAM) = expf(a) - expf(b) + 0.2f;
        }
    }
}

__device__ __forceinline__ h8 tr2(LAS const unsigned char* p0, LAS const unsigned char* p1) {
    const s16x4 lo = __builtin_amdgcn_ds_read_tr16_b64_v4i16((LAS s16x4*)p0), hi = __builtin_amdgcn_ds_read_tr16_b64_v4i16((LAS s16x4*)p1);
    const s16x8 v = __builtin_shufflevector(lo, hi, 0, 1, 2, 3, 4, 5, 6, 7); return __builtin_bit_cast(h8, v);
}
constexpr float SM_THR = 8.0f;
__device__ __forceinline__ float max3f(float a, float b, float c) { float r; asm("v_max3_f32 %0, %1, %2, %3" : "=v"(r) : "v"(a), "v"(b), "v"(c)); return r; }
template <int ND, bool MASKED>
__device__ __forceinline__ void softmax_step(f32x16& p0, f32x16& p1, float& mref, float& lrun, bool& have, f32x16 (&o)[ND], h8 (&pf)[4]) {
    float mx = fmaxf(fmaxf(p0[0], p1[0]), fmaxf(p0[1], p1[1]));
#pragma unroll
    for (int r = 2; r < 16; r += 2) mx = fmaxf(mx, fmaxf(fmaxf(p0[r], p1[r]), fmaxf(p0[r + 1], p1[r + 1])));
    mx = swap_max(mx);
    const bool valid = MASKED ? (mx > -1e29f) : true;
    const bool trig = valid && (!have || mx > SM_THR);
    if (__any(trig)) {
        const float dl = valid ? (have ? fmaxf(mx, 0.f) : mx) : 0.f;
        have = have || valid;
        mref += dl;
        const float alpha = __builtin_amdgcn_exp2f(-dl);
        lrun *= alpha;
#pragma unroll
        for (int r = 0; r < 16; ++r) { p0[r] -= dl; p1[r] -= dl; }
#pragma unroll
        for (int d = 0; d < ND; ++d)
#pragma unroll
            for (int r = 0; r < 16; ++r) o[d][r] *= alpha;
    }
    float s0 = 0.f, s1 = 0.f;
#pragma unroll
    for (int r = 0; r < 16; ++r) { p0[r] = __builtin_amdgcn_exp2f(p0[r]); p1[r] = __builtin_amdgcn_exp2f(p1[r]); s0 += p0[r]; s1 += p1[r]; }
    lrun += s0 + s1;
#pragma unroll
    for (int ks = 0; ks < 4; ++ks) {
        u32x4 w;
        if (ks < 2) { w.x = pkh(p0[8 * ks + 0], p0[8 * ks + 1]); w.y = pkh(p0[8 * ks + 2], p0[8 * ks + 3]); w.z = pkh(p0[8 * ks + 4], p0[8 * ks + 5]); w.w = pkh(p0[8 * ks + 6], p0[8 * ks + 7]); }
        else { const int k2 = ks - 2; w.x = pkh(p1[8 * k2 + 0], p1[8 * k2 + 1]); w.y = pkh(p1[8 * k2 + 2], p1[8 * k2 + 3]); w.z = pkh(p1[8 * k2 + 4], p1[8 * k2 + 5]); w.w = pkh(p1[8 * k2 + 6], p1[8 * k2 + 7]); }
        pf[ks] = __builtin_bit_cast(h8, w);
    }
}
__device__ __forceinline__ void add_bias(f32x16& p0, f32x16& p1, const LAS float* bt, int idx0) {
#pragma unroll
    for (int r = 0; r < 16; ++r) { const int c = (r & 3) + 8 * (r >> 2);
        const int i0 = idx0 + c, i1 = idx0 + 32 + c;
        p0[r] += bt[i0 < 0 ? 0 : i0]; p1[r] += bt[i1 < 0 ? 0 : i1]; }
}
__device__ __forceinline__ int next_unit(Frame& F, int cw) {
    volatile LAS unsigned* slot = F.MISC + 16;
    __syncthreads();
    if (F.tid == 0) slot[0] = __hip_atomic_fetch_add(F.ctl + cw, 1u, __ATOMIC_RELAXED, __HIP_MEMORY_SCOPE_AGENT);
    __syncthreads();
    return (int)slot[0];
}

__device__ __forceinline__ void attnA_unit(Frame& F, const Args& AR, int b, int h, int qb) {
    LAS unsigned char* lds = F.lds;
    int tid = F.tid; asm volatile("" : "+v"(tid)); int wid = F.wave; asm volatile("" : "+s"(wid));
    const int lane = tid & 63, r32 = lane & 31, hi = lane >> 5;
    const int m = wid & 1, qsub = wid >> 1, q0 = 128 * qb + 32 * qsub, cw = q0 >> 6, nt = 2 * qb + 2;
    const size_t rowb = (size_t)b * SEQ;
    const u16* P0 = (const u16*)(F.ws + WS_PROJ0);
    LAS float* bt = (LAS float*)(lds + 65536);
    if (tid < 192) bt[tid] = ((const float*)(F.ws + WS_BTG))[h * 192 + tid];
    h8 qf[4];
    { const u16* qp = P0 + (rowb + q0 + r32) * P0W + C_QA + h * 128 + m * 64 + hi * 8;
#pragma unroll
      for (int d0 = 0; d0 < 4; ++d0) qf[d0] = *(const h8*)(qp + d0 * 16); }
    f32x16 o[4];
#pragma unroll
    for (int d = 0; d < 4; ++d)
#pragma unroll
        for (int r = 0; r < 16; ++r) o[d][r] = 0.f;
    float mrun = 0.f, lrun = 0.f; bool have = false;
    const int krow = tid >> 3, kch = tid & 7, vrow = tid >> 4, vch = tid & 15;
    const u16* ksrc = P0 + (rowb + krow) * P0W + C_KA + h * 128 + kch * 8;
    const u16* vsrc = P0 + (rowb + vrow) * P0W + C_VA + h * 128 + vch * 8;
    const int kdst = krow * 128 + ((kch ^ ((krow >> 1) & 7)) << 4);
    const int vdst = 16384 + vrow * 256 + ((vch ^ ((vrow & 3) << 2)) << 4);
    u32x4 st0, st1, st2, st3;
#define A_LOAD(t) do { const size_t to = (size_t)(t) * 64 * P0W; st0 = *(const u32x4*)(ksrc + to); st1 = *(const u32x4*)(ksrc + to + 64); st2 = *(const u32x4*)(vsrc + to); st3 = *(const u32x4*)(vsrc + to + (size_t)32 * P0W); } while (0)
#define A_WRITE(s) do { LAS unsigned char* sb = lds + (s) * 32768; *(LAS u32x4*)(sb + kdst) = st0; *(LAS u32x4*)(sb + 8192 + kdst) = st1; *(LAS u32x4*)(sb + vdst) = st2; *(LAS u32x4*)(sb + vdst + 32 * 256) = st3; } while (0)
    const int kfo = r32 * 128, ksw = (r32 >> 1) & 7;
    const int i16 = lane & 15, qrow = i16 >> 2, pp = i16 & 3, g16 = (lane >> 4) & 1;
    const int vlane = (4 * hi + qrow) * 256 + ((2 * g16 + (pp >> 1)) << 4) + 8 * (pp & 1);
    const int qglob = q0 + r32;
    A_LOAD(0); A_WRITE(0); __syncthreads();
    for (int t = 0; t < nt; ++t) {
        if (t + 1 < nt) A_LOAD(t + 1);
        if (t <= cw) {
            LAS const unsigned char* sb = lds + (t & 1) * 32768; LAS const unsigned char* kb = sb + m * 8192 + kfo; LAS const unsigned char* vb = sb + 16384 + vlane;
            const bool nearb = (64 * t + 63 - q0) > -128;
            const float c0 = (nearb ? 0.f : bt[0]) - mrun;
            f32x16 p0, p1;
#pragma unroll
            for (int r = 0; r < 16; ++r) { p0[r] = c0; p1[r] = c0; }
#pragma unroll
            for (int d0 = 0; d0 < 4; ++d0) { const int co = ((2 * d0 + hi) ^ ksw) << 4;
                const h8 ka = *(LAS const h8*)(kb + co), kc = *(LAS const h8*)(kb + 4096 + co);
                p0 = __builtin_amdgcn_mfma_f32_32x32x16_f16(ka, qf[d0], p0, 0, 0, 0); p1 = __builtin_amdgcn_mfma_f32_32x32x16_f16(kc, qf[d0], p1, 0, 0, 0); }
            if (nearb) add_bias(p0, p1, bt, 64 * t + 4 * hi - qglob + 128);
            h8 pf[4];
            softmax_step<4, false>(p0, p1, mrun, lrun, have, o, pf);
#pragma unroll
            for (int d0 = 0; d0 < 4; ++d0) { const int dx = (d0 ^ qrow) << 6;
#pragma unroll
                for (int ks = 0; ks < 4; ++ks) { const h8 vf = tr2(vb + ks * 4096 + dx, vb + ks * 4096 + 2048 + dx);
                    o[d0] = __builtin_amdgcn_mfma_f32_32x32x16_f16(vf, pf[ks], o[d0], 0, 0, 0); } }
        }
        if (t + 1 < nt) A_WRITE((t + 1) & 1);
        __syncthreads();
    }
#undef A_LOAD
#undef A_WRITE
    const float linv = 1.0f / swap_sum(lrun);
    LAS f32x4* xb = (LAS f32x4*)(lds + qsub * 16384);
    if (m == 1) {
#pragma unroll
        for (int d0 = 0; d0 < 4; ++d0)
#pragma unroll
            for (int g = 0; g < 4; ++g) { f32x4 v = {o[d0][4 * g] * linv, o[d0][4 * g + 1] * linv, o[d0][4 * g + 2] * linv, o[d0][4 * g + 3] * linv};
                xb[(8 * d0 + 2 * g + hi) * 32 + r32] = v; }
    }
    __syncthreads();
    if (m == 0) {
        const float lam = *(const float*)(F.ws + WS_LAM);
        float ss = 0.f;
#pragma unroll
        for (int d0 = 0; d0 < 4; ++d0)
#pragma unroll
            for (int g = 0; g < 4; ++g) { const f32x4 v1 = xb[(8 * d0 + 2 * g + hi) * 32 + r32];
#pragma unroll
                for (int e = 0; e < 4; ++e) { const float v = o[d0][4 * g + e] * linv - lam * v1[e]; o[d0][4 * g + e] = v; ss += v * v; } }
        ss = swap_sum(ss);
        const float rs = __builtin_amdgcn_rsqf(ss * (1.0f / 128.0f) + RMS_EPS) * 0.8f;
        const size_t row = rowb + qglob;
        const u16* gp = P0 + row * P0W + C_G0 + h * 128;
        u16* op = (u16*)(F.ws + WS_MG0) + row * DM + h * 128;
        const float* sg = AR.in[I_SUBLN];
#pragma unroll
        for (int d0 = 0; d0 < 4; ++d0)
#pragma unroll
            for (int g = 0; g < 4; ++g) { const int d = 32 * d0 + 8 * g + 4 * hi;
                const h4 gv = *(const h4*)(gp + d); const f32x4 sv = *(const f32x4*)(sg + d);
                u32x2 w; w.x = pkh(o[d0][4 * g] * rs * sv[0] * (float)gv[0], o[d0][4 * g + 1] * rs * sv[1] * (float)gv[1]);
                w.y = pkh(o[d0][4 * g + 2] * rs * sv[2] * (float)gv[2], o[d0][4 * g + 3] * rs * sv[3] * (float)gv[3]);
                *(u32x2*)(op + d) = w; }
    }
}

constexpr int B_XROW = 1028, B_MASK = 66560, B_QF = 82944, B_BT = 99328;
__device__ __forceinline__ float next_up(float x) { if (x == 0.f) return __uint_as_float(1u); const unsigned u = __float_as_uint(x); return __uint_as_float(x > 0.f ? u + 1u : u - 1u); }
template <int OP> __device__ __forceinline__ float hw_red_f(float v) {
#define HWR_STEP(ctrl) { const float o_ = __uint_as_float((unsigned)__builtin_amdgcn_update_dpp(0, (int)__float_as_uint(v), ctrl, 0xf, 0xf, false)); v = OP ? fmaxf(v, o_) : fminf(v, o_); }
    HWR_STEP(0xB1) HWR_STEP(0x4E) HWR_STEP(0x141) HWR_STEP(0x140)
#undef HWR_STEP
    const float o2 = __shfl_xor(v, 16); return OP ? fmaxf(v, o2) : fminf(v, o2);
}
__device__ __forceinline__ unsigned hw_sum_u(unsigned v) {
#define HWS_STEP(ctrl) v += (unsigned)__builtin_amdgcn_update_dpp(0, (int)v, ctrl, 0xf, 0xf, false);
    HWS_STEP(0xB1) HWS_STEP(0x4E) HWS_STEP(0x141) HWS_STEP(0x140)
#undef HWS_STEP
    return v + (unsigned)__shfl_xor((int)v, 16);
}
__device__ __forceinline__ void selB_16(Frame& F, int b, int c, int q0, int mrow0, int abl = 0) {
    LAS unsigned char* lds = F.lds;
    int tid = F.tid; asm volatile("" : "+v"(tid)); int wid = F.wave; asm volatile("" : "+s"(wid));
    const int lane = tid & 63, ql = lane & 15, g = lane >> 4, l31 = lane & 31, hq = lane >> 5;
    const size_t rowb = (size_t)b * SEQ;
    const u16* P0 = (const u16*)(F.ws + WS_PROJ0);
    const int NT16 = 4 * (c + 1), N = 64 * (c + 1);
    if (c < 4) {
        for (int e = tid; e < 16 * (c + 1); e += 512) { const int q = e / (c + 1), t = e % (c + 1); *(LAS u64*)(lds + B_MASK + ((mrow0 + q) * 64 + t) * 8) = ~0ull; }
        return;
    }
    LAS h8* qfl = (LAS h8*)(lds + B_QF);
#pragma unroll
    for (int i = 0; i < 2; ++i) { const int idx = tid + 512 * i, fg = idx >> 6, ln = idx & 63, hh = fg >> 1, ks = fg & 1;
        qfl[idx] = *(const h8*)(P0 + (rowb + q0 + (ln & 15)) * P0W + C_QI + hh * 64 + 32 * ks + 8 * (ln >> 4)); }
    float wq[8];
    { const h8 wv = *(const h8*)(P0 + (rowb + q0 + ql) * P0W + C_WI);
#pragma unroll
      for (int i = 0; i < 8; ++i) wq[i] = (float)wv[i]; }
    __syncthreads();
    float sc[128]; float mn = INFINITY, mxv = -INFINITY;
    LAS float* X = (LAS float*)lds;
    const u16* kp = P0 + (rowb + ql) * P0W + C_KI + 8 * g;
    const int nq = (N + 1023) >> 10;
#pragma unroll
    for (int qr = 0; qr < 4; ++qr) {
        if (qr < nq) {
            h8 ka[2][2], kn[2][2];
#pragma unroll
            for (int u = 0; u < 2; ++u) { const int j = 64 * qr + wid + 8 * u; const int jc = j < NT16 ? j : 0;
                ka[u][0] = *(const h8*)(kp + (size_t)(16 * jc) * P0W); ka[u][1] = *(const h8*)(kp + (size_t)(16 * jc) * P0W + 32); }
#pragma unroll
            for (int gq = 0; gq < 4; ++gq) {
                if (64 * qr + wid + 16 * gq < NT16) {
                    if (gq < 3) {
#pragma unroll
                        for (int u = 0; u < 2; ++u) { const int j = 64 * qr + wid + 8 * (2 * gq + 2 + u); const int jc = j < NT16 ? j : 0;
                            kn[u][0] = *(const h8*)(kp + (size_t)(16 * jc) * P0W); kn[u][1] = *(const h8*)(kp + (size_t)(16 * jc) * P0W + 32); } }
                    f32x4 s4[2] = {{0.f, 0.f, 0.f, 0.f}, {0.f, 0.f, 0.f, 0.f}};
                    h8 qc0 = qfl[lane], qc1 = qfl[64 + lane];
#pragma unroll
                    for (int hh = 0; hh < 8; ++hh) {
                        h8 qn0 = qc0, qn1 = qc1;
                        if (hh < 7) { qn0 = qfl[((hh + 1) * 2 + 0) * 64 + lane]; qn1 = qfl[((hh + 1) * 2 + 1) * 64 + lane]; }
                        f32x4 ac0 = {0.f, 0.f, 0.f, 0.f}, ac1 = {0.f, 0.f, 0.f, 0.f};
                        ac0 = __builtin_amdgcn_mfma_f32_16x16x32_f16(ka[0][0], qc0, ac0, 0, 0, 0);
                        ac1 = __builtin_amdgcn_mfma_f32_16x16x32_f16(ka[1][0], qc0, ac1, 0, 0, 0);
                        ac0 = __builtin_amdgcn_mfma_f32_16x16x32_f16(ka[0][1], qc1, ac0, 0, 0, 0);
                        ac1 = __builtin_amdgcn_mfma_f32_16x16x32_f16(ka[1][1], qc1, ac1, 0, 0, 0);
#pragma unroll
                        for (int r = 0; r < 4; ++r) { s4[0][r] += wq[hh] * __int_as_float(max(__float_as_int(ac0[r]), 0)); s4[1][r] += wq[hh] * __int_as_float(max(__float_as_int(ac1[r]), 0)); }
                        qc0 = qn0; qc1 = qn1;
                    }
#pragma unroll
                    for (int u = 0; u < 2; ++u) { const int m = 2 * gq + u; if (64 * qr + wid + 8 * m < NT16) *(LAS f32x4*)(X + ql * B_XROW + 16 * (wid + 8 * m) + 4 * g) = s4[u]; }
#pragma unroll
                    for (int u = 0; u < 2; ++u) { ka[u][0] = kn[u][0]; ka[u][1] = kn[u][1]; }
                }
            }
            {
            __syncthreads();
            { LAS const float* xr = X + (2 * wid + hq) * B_XROW + l31;
#pragma unroll
              for (int i = 0; i < 32; ++i) { if (1024 * qr + 32 * i < N) { const float v = xr[32 * i]; sc[32 * qr + i] = v; mn = fminf(mn, v); mxv = fmaxf(mxv, v); } else sc[32 * qr + i] = -INFINITY; } }
            __syncthreads(); }
        } else {
#pragma unroll
            for (int i = 0; i < 32; ++i) sc[32 * qr + i] = -INFINITY;
        }
    }
    float lo = hw_red_f<0>(mn), hi = next_up(hw_red_f<1>(mxv));
    unsigned clo = (unsigned)N, chi = 0u;
    float h_scale = 0.f, h_nsm = 0.f; unsigned h_bstar = 0u, h_above = 0u, h_cntb = ~0u; bool h_ok = false;
    if (abl != 6 && abl != 12) {
        const float smn = lo, smx = hw_red_f<1>(mxv);
        LAS unsigned* H = (LAS unsigned*)lds + (2 * wid + hq) * 1024;
        LAS unsigned* CS = (LAS unsigned*)(lds + B_QF) + (2 * wid + hq) * 32;
#pragma unroll
        for (int i = 0; i < 32; ++i) H[l31 + 32 * i] = 0u;
        const float scale = 1023.5f / fmaxf(smx - smn, 1e-30f), nsm = -smn * scale;
#pragma unroll
        for (int e = 0; e < 128; ++e) { if (32 * e < N) { int bin = (int)__builtin_fmaf(sc[e], scale, nsm); bin = bin > 1023 ? 1023 : (bin < 0 ? 0 : bin);
            __hip_atomic_fetch_add(H + bin, 1u, __ATOMIC_RELAXED, __HIP_MEMORY_SCOPE_WORKGROUP); } }
        asm volatile("s_waitcnt lgkmcnt(0)" ::: "memory");
        unsigned hw[32]; unsigned cl = 0u;
#pragma unroll
        for (int i = 0; i < 8; ++i) { const u32x4 v = *(LAS const u32x4*)(H + 32 * l31 + 4 * i); hw[4 * i] = v.x; hw[4 * i + 1] = v.y; hw[4 * i + 2] = v.z; hw[4 * i + 3] = v.w; cl += (v.x + v.y) + (v.z + v.w); }
        CS[l31] = cl;
        asm volatile("s_waitcnt lgkmcnt(0)" ::: "memory");
        unsigned ssuf = 0u;
#pragma unroll
        for (int i = 0; i < 8; ++i) { const u32x4 v = *(LAS const u32x4*)(CS + 4 * i);
            ssuf += (4 * i >= l31 ? v.x : 0u) + (4 * i + 1 >= l31 ? v.y : 0u) + (4 * i + 2 >= l31 ? v.z : 0u) + (4 * i + 3 >= l31 ? v.w : 0u); }
        const bool flag = ssuf >= (unsigned)TOPK && (ssuf - cl) < (unsigned)TOPK;
        unsigned run = ssuf - cl, bstar = 0u, above = 0u, cntb = 0u; bool found = false;
#pragma unroll
        for (int w = 31; w >= 0; --w) { run += hw[w]; if (!found && run >= (unsigned)TOPK) { found = true; bstar = 32u * l31 + (unsigned)w; above = run - hw[w]; cntb = hw[w]; } }
        const unsigned long long fb = __ballot(flag);
        const int src = hq ? 32 + __builtin_ctz((unsigned)(fb >> 32) | 0x80000000u) : __builtin_ctz((unsigned)fb | 0x80000000u);
        bstar = (unsigned)__shfl((int)bstar, src); above = (unsigned)__shfl((int)above, src); cntb = (unsigned)__shfl((int)cntb, src);
        h_scale = scale; h_nsm = nsm; h_bstar = bstar; h_above = above; h_cntb = cntb; h_ok = (smx > smn) && (fb >> (32 * hq) & 0xffffffffull) != 0ull;
        if (smx > smn) {
            const float inv = (smx - smn) * (1.0f / 1023.5f);
            const float l2 = smn + ((float)bstar - 0.01f) * inv, h2 = smn + ((float)bstar + 1.01f) * inv;
            if (l2 > lo) { lo = l2; clo = above + cntb; }
            if (h2 < hi) { hi = h2; chi = above; }
        }
    }
#define SEL_LTBITS(W, P) do { _Pragma("unroll") for (int w_ = 0; w_ < 4; ++w_) { unsigned a_ = 0u; _Pragma("unroll") for (int k_ = 0; k_ < 32; ++k_) \
        a_ = __builtin_amdgcn_alignbit(a_, __float_as_uint(sc[32 * w_ + k_] - (P)), 31); W[w_] = a_; } } while (0)
    bool done = false, tie = false; float Tv = 0.f;
    bool fastdone = false; int icutF = N;
    if (abl != 13 && __all(h_ok && h_cntb <= 32u && h_bstar >= 1u)) {
        LAS unsigned* CN = (LAS unsigned*)(lds + B_QF + 2048) + (2 * wid + hq);
        LAS float* CLV = (LAS float*)(lds + B_QF + 4096) + (2 * wid + hq) * 32; LAS unsigned* CLK = (LAS unsigned*)(lds + B_QF + 8192) + (2 * wid + hq) * 32;
        *CN = 0u;
        const float flo = (float)h_bstar;
        asm volatile("" : "+v"(h_scale), "+v"(h_nsm));
#pragma unroll
        for (int e = 0; e < 128; ++e) { if (32 * e < N) {
            const float t = __builtin_fmaf(sc[e], h_scale, h_nsm) - flo;
            if (__float_as_uint(t) < 0x3f800000u) { const unsigned slot = __hip_atomic_fetch_add(CN, 1u, __ATOMIC_RELAXED, __HIP_MEMORY_SCOPE_WORKGROUP);
                if (slot < 32u) { CLV[slot] = sc[e]; CLK[slot] = (unsigned)(32 * e + l31); } } } }
        asm volatile("s_waitcnt lgkmcnt(0)" ::: "memory");
        const unsigned n = *CN;
        const bool isc = (unsigned)l31 < n && n <= 32u;
        const float cv = isc ? CLV[l31] : -INFINITY; const unsigned ck = isc ? CLK[l31] : ~0u;
        const unsigned nmax = max((unsigned)__builtin_amdgcn_readlane((int)n, 0), (unsigned)__builtin_amdgcn_readlane((int)n, 32));
        unsigned rank = 0u;
        for (unsigned j = 0; j < nmax && j < 32u; ++j) { const float vj = CLV[j]; const unsigned kj = CLK[j];
            rank += (j < n && (vj > cv || (vj == cv && kj < ck))) ? 1u : 0u; }
        const unsigned rq = (unsigned)TOPK - h_above;
        const bool isb = isc && rank + 1u == rq;
        const unsigned long long bb = __ballot(isb);
        const unsigned bh = (unsigned)(bb >> (32 * hq));
        const int srcb = 32 * hq + __builtin_ctz(bh | 0x80000000u);
        const float Tf = __shfl(cv, srcb); const unsigned kT = (unsigned)__shfl((int)ck, srcb);
        const unsigned eqc = (unsigned)__builtin_popcount((unsigned)(__ballot(isc && cv == Tf) >> (32 * hq)));
        const bool okq = (n == h_cntb) && (__builtin_popcount(bh) == 1);
        if (__all(okq)) { fastdone = true; done = true; Tv = Tf; tie = eqc > 1u; icutF = (int)kT; }
    }
    if (!fastdone) {
#define SEL_STEP(it_) do { \
        float mid = lo + (hi - lo) * 0.5f; \
        if ((it_) < 2 && clo > chi + 16u) { const float xi = lo + (hi - lo) * ((float)clo - 255.5f) / (float)(clo - chi); if (xi > lo && xi < hi) mid = xi; } \
        if (!done && !(mid > lo && mid < hi)) { done = true; tie = true; Tv = lo; } \
        const float pv = done ? Tv : mid; \
        unsigned ltw[4]; SEL_LTBITS(ltw, pv); \
        const unsigned tot = hw_sum_u(128u - (unsigned)(__builtin_popcount(ltw[0]) + __builtin_popcount(ltw[1]) + __builtin_popcount(ltw[2]) + __builtin_popcount(ltw[3]))); \
        if (!done) { if (tot == (unsigned)TOPK) { done = true; Tv = mid; } else if (tot > (unsigned)TOPK) { lo = mid; clo = tot; } else { hi = mid; chi = tot; } } } while (0)
    const int it_cap = (abl == 6 ? 1 : abl == 10 ? 6 : abl == 11 ? 12 : 200);
    int it = 0;
    for (; it < 8 && it < it_cap; ++it) { SEL_STEP(it); if (__all(done)) break; }
    if (!__all(done) && it_cap > 8) {
        float p0 = INFINITY, p1 = -INFINITY;
#pragma unroll
        for (int e = 0; e < 128; ++e) { const float sv = sc[e]; p0 = fminf(p0, sv >= lo ? sv : INFINITY); p1 = fmaxf(p1, sv < hi ? sv : -INFINITY); }
        p0 = hw_red_f<0>(p0); p1 = hw_red_f<1>(p1);
        if (!done && p0 == p1) { done = true; tie = true; Tv = p0; }
        for (; it < it_cap; ++it) { if (__all(done)) break; SEL_STEP(8); }
    }
#undef SEL_STEP
    }
    if (abl == 6 || abl == 10 || abl == 11) tie = false;
    unsigned selw[4];
    { unsigned ltw[4]; SEL_LTBITS(ltw, Tv);
#pragma unroll
      for (int w = 0; w < 4; ++w) selw[w] = __builtin_bitreverse32(~ltw[w]); }
    if (__any(tie)) {
        unsigned eqw[4];
        { unsigned lew[4]; const float tn = next_up(Tv); SEL_LTBITS(lew, tn);
#pragma unroll
          for (int w = 0; w < 4; ++w) eqw[w] = __builtin_bitreverse32(lew[w]) & selw[w]; }
        const unsigned rneed = (unsigned)TOPK - chi;
        int ilo = -1, ihi = N - 1, icut = fastdone ? icutF : N; bool tdone = !tie || fastdone;
        for (int it = 0; it < 40 && !fastdone; ++it) {
            const int imid = (ilo + ihi) >> 1;
            if (!tdone && (ihi - ilo) <= 1) { tdone = true; icut = ihi; }
            const int iv = (tdone ? icut : imid) - l31;
            const int nle = iv < 0 ? 0 : min(128, (iv >> 5) + 1);
            unsigned cnt = 0u;
#pragma unroll
            for (int w = 0; w < 4; ++w) { const int nw = min(max(nle - 32 * w, 0), 32); const unsigned mk = nw >= 32 ? 0xffffffffu : ((1u << nw) - 1u); cnt += (unsigned)__builtin_popcount(eqw[w] & mk); }
            const unsigned tot = hw_sum_u(cnt);
            if (!tdone) { if (tot == rneed) { tdone = true; icut = imid; } else if (tot < rneed) ilo = imid; else ihi = imid; }
            if (__all(tdone)) break;
        }
        if (tie) {
            const int iv = icut - l31; const int nle = iv < 0 ? 0 : min(128, (iv >> 5) + 1);
#pragma unroll
            for (int w = 0; w < 4; ++w) { const int nw = min(max(nle - 32 * w, 0), 32); const unsigned mk = nw >= 32 ? 0xffffffffu : ((1u << nw) - 1u); selw[w] = (selw[w] & ~eqw[w]) | (eqw[w] & mk); }
        }
    }
#undef SEL_LTBITS
    LAS unsigned* mrow = (LAS unsigned*)(lds + B_MASK) + (mrow0 + 2 * wid + hq) * 128;
#pragma unroll
    for (int w = 0; w < 4; ++w) {
        unsigned x = selw[w];
#define TR_STEP(S, MK) { const unsigned y_ = (unsigned)__shfl_xor((int)x, S); x = (l31 & S) ? ((x & ~(MK)) | ((y_ >> S) & (MK))) : ((x & (MK)) | ((y_ << S) & ~(MK))); }
        TR_STEP(16, 0x0000ffffu) TR_STEP(8, 0x00ff00ffu) TR_STEP(4, 0x0f0f0f0fu) TR_STEP(2, 0x33333333u) TR_STEP(1, 0x55555555u)
#undef TR_STEP
        if (32 * (32 * w + l31) < N) mrow[32 * w + l31] = x;
    }
}
__device__ __forceinline__ void attnB_unit(Frame& F, int b, int qb32, int mode = 0) {
    LAS unsigned char* lds = F.lds;
    int tid = F.tid; asm volatile("" : "+v"(tid)); int wid = F.wave; asm volatile("" : "+s"(wid));
    const int lane = tid & 63, r32 = lane & 31, hi = lane >> 5;
    const int q0 = 32 * qb32, c = q0 >> 6, nt = c + 1;
    const size_t rowb = (size_t)b * SEQ;
    const u16* P0 = (const u16*)(F.ws + WS_PROJ0);
    if (mode != 3) {
#pragma unroll 1
        for (int s2 = 0; s2 < 2; ++s2) { selB_16(F, b, c, q0 + 16 * s2, 16 * s2, mode); __syncthreads(); }
    }
    if (mode >= 4) return;
    LAS float* bt = (LAS float*)(lds + B_BT) + wid * 192;
    for (int e = tid; e < 8 * 192; e += 512) ((LAS float*)(lds + B_BT))[e] = ((const float*)(F.ws + WS_BTG))[4 * 192 + e];
    h8 qf[4];
    { const u16* qp = P0 + (rowb + q0 + r32) * P0W + C_QB + wid * 64 + hi * 8;
#pragma unroll
      for (int d0 = 0; d0 < 4; ++d0) qf[d0] = *(const h8*)(qp + d0 * 16); }
    f32x16 o[2];
#pragma unroll
    for (int d = 0; d < 2; ++d)
#pragma unroll
        for (int r = 0; r < 16; ++r) o[d][r] = 0.f;
    float mrun = 0.f, lrun = 0.f; bool have = false;
    const int krow = tid >> 3, kch = tid & 7;
    const u16* ksrc = P0 + (rowb + krow) * P0W + C_KB + kch * 8;
    const int kdst = krow * 128 + ((kch ^ ((krow >> 1) & 7)) << 4);
    const int vdst = 8192 + krow * 128 + ((kch ^ (((krow >> 1) & 1) << 2)) << 4);
    u32x4 st0, st1;
#define B_LOAD(t) do { const size_t to = (size_t)(t) * 64 * P0W; st0 = *(const u32x4*)(ksrc + to); st1 = *(const u32x4*)(ksrc + to + 64); } while (0)
#define B_WRITE(s) do { LAS unsigned char* sb = lds + (s) * 16384; *(LAS u32x4*)(sb + kdst) = st0; *(LAS u32x4*)(sb + vdst) = st1; } while (0)
    const int kfo = r32 * 128, ksw = (r32 >> 1) & 7;
    const int i16 = lane & 15, qrow = i16 >> 2, pp = i16 & 3, g16 = (lane >> 4) & 1;
    const int vlane = (4 * hi + qrow) * 128 + ((2 * g16 + (pp >> 1)) << 4) + 8 * (pp & 1);
    const int qglob = q0 + r32;
    B_LOAD(0); B_WRITE(0); __syncthreads();
    for (int t = 0; t < nt; ++t) {
        if (t + 1 < nt) B_LOAD(t + 1);
        {
            LAS const unsigned char* sb = lds + (t & 1) * 16384; LAS const unsigned char* kb = sb + kfo; LAS const unsigned char* vb = sb + 8192 + vlane;
            const bool nearb = (64 * t + 63 - q0) > -128;
            const float c0 = (nearb ? 0.f : bt[0]) - mrun;
            f32x16 p0, p1;
#pragma unroll
            for (int r = 0; r < 16; ++r) { p0[r] = c0; p1[r] = c0; }
#pragma unroll
            for (int d0 = 0; d0 < 4; ++d0) { const int co = ((2 * d0 + hi) ^ ksw) << 4;
                const h8 ka = *(LAS const h8*)(kb + co), kc = *(LAS const h8*)(kb + 4096 + co);
                p0 = __builtin_amdgcn_mfma_f32_32x32x16_f16(ka, qf[d0], p0, 0, 0, 0); p1 = __builtin_amdgcn_mfma_f32_32x32x16_f16(kc, qf[d0], p1, 0, 0, 0); }
            if (nearb) add_bias(p0, p1, bt, 64 * t + 4 * hi - qglob + 128);
            const u64 mw = *(LAS const u64*)(lds + B_MASK + (r32 * 64 + t) * 8);
            const unsigned mlo = (unsigned)mw >> (4 * hi), mhi = (unsigned)(mw >> 32) >> (4 * hi);
#pragma unroll
            for (int r = 0; r < 16; ++r) { const int cb = (r & 3) + 8 * (r >> 2);
                if (!((mlo >> cb) & 1u)) p0[r] = -1e30f; if (!((mhi >> cb) & 1u)) p1[r] = -1e30f; }
            h8 pf[4];
            softmax_step<2, true>(p0, p1, mrun, lrun, have, o, pf);
#pragma unroll
            for (int d0 = 0; d0 < 2; ++d0) { const int dx = (d0 ^ (qrow >> 1)) << 6;
#pragma unroll
                for (int ks = 0; ks < 4; ++ks) { const h8 vf = tr2(vb + ks * 2048 + dx, vb + ks * 2048 + 1024 + dx);
                    o[d0] = __builtin_amdgcn_mfma_f32_32x32x16_f16(vf, pf[ks], o[d0], 0, 0, 0); } }
        }
        if (t + 1 < nt) B_WRITE((t + 1) & 1);
        __syncthreads();
    }
#undef B_LOAD
#undef B_WRITE
    const float linv = 1.0f / swap_sum(lrun);
    const size_t row = rowb + qglob;
    const u16* gp = P0 + row * P0W + C_G0 + 512 + wid * 64;
    u16* op = (u16*)(F.ws + WS_MG0) + row * DM + 512 + wid * 64;
#pragma unroll
    for (int d0 = 0; d0 < 2; ++d0)
#pragma unroll
        for (int g = 0; g < 4; ++g) { const int d = 32 * d0 + 8 * g + 4 * hi;
            const h4 gv = *(const h4*)(gp + d);
            u32x2 w; w.x = pkh(o[d0][4 * g] * linv * (float)gv[0], o[d0][4 * g + 1] * linv * (float)gv[1]);
            w.y = pkh(o[d0][4 * g + 2] * linv * (float)gv[2], o[d0][4 * g + 3] * linv * (float)gv[3]);
            *(u32x2*)(op + d) = w; }
}

__device__ __forceinline__ void pv_tile64_asm(f32x16 (&o)[2], unsigned va0, unsigned va1, const h8 (&pf)[4]) {
#pragma unroll
    for (int d0 = 0; d0 < 2; ++d0) { const unsigned va = d0 ? va1 : va0; s16x4 lo[4], hi[4];
        asm volatile("ds_read_b64_tr_b16 %0, %1 offset:0" : "=&v"(lo[0]) : "v"(va) : "memory");    asm volatile("ds_read_b64_tr_b16 %0, %1 offset:1024" : "=&v"(hi[0]) : "v"(va) : "memory");
        asm volatile("ds_read_b64_tr_b16 %0, %1 offset:2048" : "=&v"(lo[1]) : "v"(va) : "memory"); asm volatile("ds_read_b64_tr_b16 %0, %1 offset:3072" : "=&v"(hi[1]) : "v"(va) : "memory");
        asm volatile("ds_read_b64_tr_b16 %0, %1 offset:4096" : "=&v"(lo[2]) : "v"(va) : "memory"); asm volatile("ds_read_b64_tr_b16 %0, %1 offset:5120" : "=&v"(hi[2]) : "v"(va) : "memory");
        asm volatile("ds_read_b64_tr_b16 %0, %1 offset:6144" : "=&v"(lo[3]) : "v"(va) : "memory"); asm volatile("ds_read_b64_tr_b16 %0, %1 offset:7168" : "=&v"(hi[3]) : "v"(va) : "memory");
        asm volatile("s_waitcnt lgkmcnt(0)" ::: "memory"); __builtin_amdgcn_sched_barrier(0);
#pragma unroll
        for (int ks = 0; ks < 4; ++ks) { const s16x8 v = __builtin_shufflevector(lo[ks], hi[ks], 0, 1, 2, 3, 4, 5, 6, 7);
            o[d0] = __builtin_amdgcn_mfma_f32_32x32x16_f16(__builtin_bit_cast(h8, v), pf[ks], o[d0], 0, 0, 0); } }
}
__device__ __forceinline__ void qk64C(f32x16& p0, f32x16& p1, LAS const unsigned char* sb, const h8 (&qf)[6], int kfo, int ksw, int rfo, int rsw, int hi, const f32x16& negm) {
    LAS const unsigned char* kb = sb + kfo; LAS const unsigned char* rb = sb + rfo;
#pragma unroll
    for (int d0 = 0; d0 < 4; ++d0) { const int co = ((2 * d0 + hi) ^ ksw) << 4;
        const h8 ka = *(LAS const h8*)(kb + co), kc = *(LAS const h8*)(kb + 4096 + co);
        if (d0 == 0) { p0 = __builtin_amdgcn_mfma_f32_32x32x16_f16(ka, qf[0], negm, 0, 0, 0); p1 = __builtin_amdgcn_mfma_f32_32x32x16_f16(kc, qf[0], negm, 0, 0, 0); }
        else { p0 = __builtin_amdgcn_mfma_f32_32x32x16_f16(ka, qf[d0], p0, 0, 0, 0); p1 = __builtin_amdgcn_mfma_f32_32x32x16_f16(kc, qf[d0], p1, 0, 0, 0); } }
#pragma unroll
    for (int d0 = 0; d0 < 2; ++d0) { const int co = ((2 * d0 + hi) ^ rsw) << 4;
        const h8 ka = *(LAS const h8*)(rb + co), kc = *(LAS const h8*)(rb + 2048 + co);
        p0 = __builtin_amdgcn_mfma_f32_32x32x16_f16(ka, qf[4 + d0], p0, 0, 0, 0); p1 = __builtin_amdgcn_mfma_f32_32x32x16_f16(kc, qf[4 + d0], p1, 0, 0, 0); }
}
template <int OFF> __device__ __forceinline__ void dsr128(h8& dst, unsigned addr) { asm volatile("ds_read_b128 %0, %1 offset:%2" : "=&v"(dst) : "v"(addr), "i"(OFF) : "memory"); }
template <int N> __device__ __forceinline__ void qkC_read(h8& dst, const unsigned (&va)[4], const unsigned (&vr)[2]) {
    constexpr int t = N / 12, j = N % 12, d = j >> 1, c = j & 1;
    if constexpr (d < 4) dsr128<t * 20480 + c * 4096>(dst, va[d]); else dsr128<t * 20480 + c * 2048>(dst, vr[d - 4]);
}
template <int N> __device__ __forceinline__ void qkC_mma(f32x16& pa, f32x16& pb, const h8& kf, const h8 (&qf)[6], const f32x16& negm) {
    constexpr int j = N % 12, d = j >> 1, c = j & 1;
    f32x16& acc = c ? pb : pa;
    if constexpr (d == 0) acc = __builtin_amdgcn_mfma_f32_32x32x16_f16(kf, qf[0], negm, 0, 0, 0); else acc = __builtin_amdgcn_mfma_f32_32x32x16_f16(kf, qf[d], acc, 0, 0, 0);
}
#define QKC_RP(G, F) do { qkC_read<2 * (G)>(F[0], va, vr); qkC_read<2 * (G) + 1>(F[1], va, vr); } while (0)
#define QKC_MP(G, F, PA, PB) do { qkC_mma<2 * (G)>(PA, PB, F[0], qf, negm); qkC_mma<2 * (G) + 1>(PA, PB, F[1], qf, negm); __builtin_amdgcn_sched_barrier(0); } while (0)
#define QKC_WAIT(n) do { asm volatile("s_waitcnt lgkmcnt(" #n ")" ::: "memory"); __builtin_amdgcn_sched_barrier(0); } while (0)
__device__ __forceinline__ void qk128C(f32x16& p0, f32x16& p1, f32x16& p2, f32x16& p3, const unsigned (&va)[4], const unsigned (&vr)[2], const h8 (&qf)[6], const f32x16& negm, int two) {
    h8 f0[2], f1[2], f2[2];
    QKC_RP(0, f0); QKC_RP(1, f1); QKC_RP(2, f2);
    QKC_WAIT(4); QKC_MP(0, f0, p0, p1); QKC_RP(3, f0);
    QKC_WAIT(4); QKC_MP(1, f1, p0, p1); QKC_RP(4, f1);
    QKC_WAIT(4); QKC_MP(2, f2, p0, p1); QKC_RP(5, f2);
    if (two) {
        QKC_WAIT(4); QKC_MP(3, f0, p0, p1); QKC_RP(6, f0);
        QKC_WAIT(4); QKC_MP(4, f1, p0, p1); QKC_RP(7, f1);
        QKC_WAIT(4); QKC_MP(5, f2, p0, p1); QKC_RP(8, f2);
        QKC_WAIT(4); QKC_MP(6, f0, p2, p3); QKC_RP(9, f0);
        QKC_WAIT(4); QKC_MP(7, f1, p2, p3); QKC_RP(10, f1);
        QKC_WAIT(4); QKC_MP(8, f2, p2, p3); QKC_RP(11, f2);
        QKC_WAIT(4); QKC_MP(9, f0, p2, p3);
        QKC_WAIT(2); QKC_MP(10, f1, p2, p3);
        QKC_WAIT(0); QKC_MP(11, f2, p2, p3);
    } else {
        QKC_WAIT(4); QKC_MP(3, f0, p0, p1);
        QKC_WAIT(2); QKC_MP(4, f1, p0, p1);
        QKC_WAIT(0); QKC_MP(5, f2, p0, p1);
#pragma unroll
        for (int r = 0; r < 16; ++r) { p2[r] = -1e30f; p3[r] = -1e30f; }
    }
}
__device__ __forceinline__ void pack4(h8 (&pf)[4], const f32x16& p0, const f32x16& p1) {
#pragma unroll
    for (int ks = 0; ks < 4; ++ks) { const f32x16& pp = ks < 2 ? p0 : p1; const int k2 = ks & 1; u32x4 w;
        w.x = pkh(pp[8 * k2 + 0], pp[8 * k2 + 1]); w.y = pkh(pp[8 * k2 + 2], pp[8 * k2 + 3]); w.z = pkh(pp[8 * k2 + 4], pp[8 * k2 + 5]); w.w = pkh(pp[8 * k2 + 6], pp[8 * k2 + 7]);
        pf[ks] = __builtin_bit_cast(h8, w); }
}
template <int MODE> __device__ __forceinline__ void attnC_unit(Frame& F, int b, int h, int qb) {
    LAS unsigned char* lds = F.lds;
    int tid = F.tid; asm volatile("" : "+v"(tid)); int wid = F.wave; asm volatile("" : "+s"(wid));
    const int lane = tid & 63, r32 = lane & 31, hi = lane >> 5;
    const int q0 = 256 * qb + 32 * wid, cw = q0 >> 6, nt = 4 * qb + 4;
    const size_t rowb = (size_t)b * SEQ;
    const u16* Q1 = (const u16*)(F.ws + WS_Q1); const u16* KV = (const u16*)(F.ws + WS_KV1); const u16* KR = (const u16*)(F.ws + WS_KROPE);
    h8 qf[6];
    { const u16* qp = Q1 + (rowb + q0 + r32) * 1536 + h * 96 + hi * 8;
#pragma unroll
      for (int d0 = 0; d0 < 6; ++d0) qf[d0] = *(const h8*)(qp + d0 * 16); }
    f32x16 o[2];
#pragma unroll
    for (int d = 0; d < 2; ++d)
#pragma unroll
        for (int r = 0; r < 16; ++r) o[d][r] = 0.f;
    float mrun = 0.f, lrun = 0.f; bool have = false;
    f32x16 negm;
#pragma unroll
    for (int r = 0; r < 16; ++r) negm[r] = 0.f;
    const int krow = 8 * wid + (lane >> 3), kcp = lane & 7;
    const u16* ksrc = KV + (rowb + krow) * 2048 + h * 128 + ((kcp ^ ((krow >> 1) & 7)) << 3);
    const u16* vsrc = KV + (rowb + krow) * 2048 + h * 128 + 64 + ((kcp ^ (((krow >> 1) & 1) << 2)) << 3);
    const int rrow = 16 * (wid & 3) + (lane >> 2), rcp = lane & 3;
    const u16* rsrc = KR + (rowb + rrow) * 32 + ((rcp ^ ((rrow >> 2) & 3)) << 3);
    const int kofs = wid * 1024, rofs = 8192 + (wid & 3) * 1024, vofs = 12288 + wid * 1024;
#define C_DMA(t, slot) do { LAS unsigned char* sb_ = lds + (slot) * 20480; \
        __builtin_amdgcn_global_load_lds((const unsigned*)(ksrc + (size_t)(t) * 64 * 2048), (LAS unsigned*)(sb_ + kofs), 16, 0, 0); \
        __builtin_amdgcn_global_load_lds((const unsigned*)(rsrc + (size_t)(t) * 64 * 32), (LAS unsigned*)(sb_ + rofs), 16, 0, 0); \
        __builtin_amdgcn_global_load_lds((const unsigned*)(vsrc + (size_t)(t) * 64 * 2048), (LAS unsigned*)(sb_ + vofs), 16, 0, 0); } while (0)
    const int kfo = r32 * 128, ksw = (r32 >> 1) & 7;
    const int rfo = 8192 + r32 * 64, rsw = (r32 >> 2) & 3;
    const int i16 = lane & 15, qrow = i16 >> 2, pp = i16 & 3, g16 = (lane >> 4) & 1;
    const int vlane = (4 * hi + qrow) * 128 + ((2 * g16 + (pp >> 1)) << 4) + 8 * (pp & 1);
    const unsigned dx0 = (unsigned)((0 ^ (qrow >> 1)) << 6), dx1 = (unsigned)((1 ^ (qrow >> 1)) << 6);
    asm volatile("s_waitcnt vmcnt(0)" ::: "memory");
    C_DMA(0, 0); C_DMA(1, 1);
    const int np = nt >> 1;
    for (int T = 0; T < np; ++T) {
        asm volatile("s_waitcnt vmcnt(0)" ::: "memory");
        if (MODE != 3) { __builtin_amdgcn_s_barrier(); } asm volatile("" ::: "memory");
        const int sA = (T & 1) * 2;
        if (MODE != 2 && MODE != 3) { if (T + 1 < np) { C_DMA(2 * T + 2, sA ^ 2); C_DMA(2 * T + 3, (sA ^ 2) + 1); } }
        if (2 * T <= cw) {
            LAS const unsigned char* sb0 = lds + sA * 20480; LAS const unsigned char* sb1 = sb0 + 20480;
            f32x16 p0, p1, p2, p3;
            int two = __builtin_amdgcn_readfirstlane((2 * T + 1 <= cw) ? 1 : 0); asm volatile("" : "+s"(two));
            unsigned va[4], vr[2];
#pragma unroll
            for (int d0 = 0; d0 < 4; ++d0) va[d0] = (unsigned)(size_t)(sb0 + kfo + (((2 * d0 + hi) ^ ksw) << 4));
#pragma unroll
            for (int d0 = 0; d0 < 2; ++d0) vr[d0] = (unsigned)(size_t)(sb0 + rfo + (((2 * d0 + hi) ^ rsw) << 4));
            if (MODE != 4) qk128C(p0, p1, p2, p3, va, vr, qf, negm, two); else { p0 = negm; p1 = negm; p2 = negm; p3 = negm; asm volatile("" : "+v"(p0), "+v"(p1), "+v"(p2), "+v"(p3)); }
            float ma[4];
            if (MODE != 1) {
#pragma unroll
            for (int i = 0; i < 4; ++i) { float t = max3f(p0[i], p0[i + 4], p0[i + 8]); t = max3f(t, p0[i + 12], p1[i]); t = max3f(t, p1[i + 4], p1[i + 8]); t = max3f(t, p1[i + 12], p2[i]);
                t = max3f(t, p2[i + 4], p2[i + 8]); t = max3f(t, p2[i + 12], p3[i]); t = max3f(t, p3[i + 4], p3[i + 8]); ma[i] = max3f(t, p3[i + 12], t); }
            const float mx = swap_max(max3f(max3f(ma[0], ma[1], ma[2]), ma[3], ma[3]));
            if (__any(!have || mx > SM_THR)) {
                const float dl = have ? fmaxf(mx, 0.f) : mx; have = true; mrun += dl;
                const float alpha = __builtin_amdgcn_exp2f(-dl); lrun *= alpha;
#pragma unroll
                for (int r = 0; r < 16; ++r) { p0[r] -= dl; p1[r] -= dl; p2[r] -= dl; p3[r] -= dl; negm[r] -= dl; o[0][r] *= alpha; o[1][r] *= alpha; }
            }
            float s0 = 0.f, s1 = 0.f, s2 = 0.f, s3 = 0.f;
#pragma unroll
            for (int r = 0; r < 16; ++r) { p0[r] = __builtin_amdgcn_exp2f(p0[r]); p1[r] = __builtin_amdgcn_exp2f(p1[r]); p2[r] = __builtin_amdgcn_exp2f(p2[r]); p3[r] = __builtin_amdgcn_exp2f(p3[r]);
                s0 += p0[r]; s1 += p1[r]; s2 += p2[r]; s3 += p3[r]; }
            lrun += (s0 + s1) + (s2 + s3);
            } else lrun = 1.f;
            h8 pfa[4], pfb[4]; pack4(pfa, p0, p1); pack4(pfb, p2, p3);
            const unsigned vb0 = (unsigned)(size_t)(sb0 + 12288 + vlane), vb1 = (unsigned)(size_t)(sb1 + 12288 + vlane);
            if (MODE != 5) { pv_tile64_asm(o, vb0 + dx0, vb0 + dx1, pfa);
            pv_tile64_asm(o, vb1 + dx0, vb1 + dx1, pfb); } else { asm volatile("" :: "v"(pfa[0]), "v"(pfa[1]), "v"(pfa[2]), "v"(pfa[3]), "v"(pfb[0]), "v"(pfb[1]), "v"(pfb[2]), "v"(pfb[3])); }
        }
    }
#undef C_DMA
    const float linv = 1.0f / swap_sum(lrun);
    if (MODE != 0 && __all(linv != 123.456f)) return;
    const size_t row = rowb + q0 + r32;
    const u16* gp = (const u16*)(F.ws + WS_G1) + row * DM + h * 64;
    u16* op = (u16*)(F.ws + WS_MG1) + row * DM + h * 64;
#pragma unroll
    for (int d0 = 0; d0 < 2; ++d0)
#pragma unroll
        for (int g = 0; g < 4; ++g) { const int d = 32 * d0 + 8 * g + 4 * hi;
            const h4 gv = *(const h4*)(gp + d);
            u32x2 w; w.x = pkh(o[d0][4 * g] * linv * (float)gv[0], o[d0][4 * g + 1] * linv * (float)gv[1]);
            w.y = pkh(o[d0][4 * g + 2] * linv * (float)gv[2], o[d0][4 * g + 3] * linv * (float)gv[3]);
            *(u32x2*)(op + d) = w; }
}

__device__ __forceinline__ void p8_final(Frame& F, const Args& AR) {
    const int gw = blockIdx.x * NWAVES + F.wave, NGW = F.G * NWAVES;
    const float* gn = AR.in[I_FNORM]; f32x4 gv[4];
#pragma unroll
    for (int j = 0; j < 4; ++j) gv[j] = *(const f32x4*)(gn + 4 * F.lane + 256 * j);
    const u16* X2 = (const u16*)(F.ws + WS_X2H);
    for (int mrow = gw; mrow < T; mrow += NGW) {
        const h4* xr = (const h4*)(X2 + (size_t)mrow * DM) + F.lane;
        f32x4 v[4]; float s = 0.f;
#pragma unroll
        for (int j = 0; j < 4; ++j) { const h4 hv = xr[64 * j]; v[j] = (f32x4){(float)hv[0], (float)hv[1], (float)hv[2], (float)hv[3]}; s += (v[j].x * v[j].x + v[j].y * v[j].y) + (v[j].z * v[j].z + v[j].w * v[j].w); }
        const float rstd = __builtin_amdgcn_rsqf(wave_sum(s) * (1.f / DM) + RMS_EPS);
        f32x4* orow = (f32x4*)(F.out + (size_t)mrow * DM) + F.lane;
#pragma unroll
        for (int j = 0; j < 4; ++j) orow[64 * j] = v[j] * rstd * gv[j];
    }
}

#ifndef NAIVE_ATTN
#define NAIVE_ATTN 0
#endif
struct NaiveSh { float sh[4096]; float red[256]; unsigned char sel[4096]; };
__device__ __forceinline__ float blk_max(NaiveSh& S, float v, int tid) { S.red[tid] = v; __syncthreads(); for (int o2 = 128; o2 > 0; o2 >>= 1) { if (tid < o2) S.red[tid] = fmaxf(S.red[tid], S.red[tid + o2]); __syncthreads(); } const float r = S.red[0]; __syncthreads(); return r; }
__device__ __forceinline__ float blk_sum(NaiveSh& S, float v, int tid) { S.red[tid] = v; __syncthreads(); for (int o2 = 128; o2 > 0; o2 >>= 1) { if (tid < o2) S.red[tid] += S.red[tid + o2]; __syncthreads(); } const float r = S.red[0]; __syncthreads(); return r; }
__device__ __forceinline__ float blk_softmax(NaiveSh& S, int nk, int tid) {
    float mx = -1e30f; for (int k = tid; k < nk; k += 256) mx = fmaxf(mx, S.sh[k]); mx = blk_max(S, mx, tid);
    float ls = 0.f; for (int k = tid; k < nk; k += 256) { const float p = S.sh[k] > -1e29f ? exp2f(S.sh[k] - mx) : 0.f; S.sh[k] = p; ls += p; }
    return blk_sum(S, ls, tid);
}
__device__ __forceinline__ float naiveA(NaiveSh& S, const Args& args, int b, int q, int hd, int tid) {
    unsigned char* ws = args.ws; const u16* P0 = (const u16*)(ws + WS_PROJ0); const float* BT = (const float*)(ws + WS_BTG);
    const size_t row = (size_t)b * SEQ + q; const int nk = 64 * (q / 64 + 1); float outv[2] = {0.f, 0.f};
    for (int m = 0; m < 2; ++m) {
        for (int k = tid; k < nk; k += 256) { float sacc = 0.f; const u16* qp = P0 + row * P0W + C_QA + hd * 128 + m * 64; const u16* kp = P0 + ((size_t)b * SEQ + k) * P0W + C_KA + hd * 128 + m * 64;
            for (int d = 0; d < 64; ++d) sacc += h2f(qp[d]) * h2f(kp[d]);
            int rel = k - q; rel = rel < -128 ? -128 : rel; S.sh[k] = sacc + BT[hd * 192 + rel + 128]; }
        __syncthreads();
        const float ls = blk_softmax(S, nk, tid);
        if (tid < 128) { float a = 0.f; for (int k = 0; k < nk; ++k) a += S.sh[k] * h2f(P0[((size_t)b * SEQ + k) * P0W + C_VA + hd * 128 + tid]); outv[m] = a / ls; }
        __syncthreads();
    }
    const float lam = *(const float*)(ws + WS_LAM); const float v = tid < 128 ? outv[0] - lam * outv[1] : 0.f;
    const float ss = blk_sum(S, v * v, tid);
    const float rs = rsqrtf(ss / 128.f + RMS_EPS) * 0.8f;
    return tid < 128 ? v * rs * args.in[I_SUBLN][tid] * h2f(P0[row * P0W + C_G0 + hd * 128 + tid]) : 0.f;
}
__device__ __forceinline__ void naiveB_select(NaiveSh& S, const Args& args, int b, int q, int tid) {
    const u16* P0 = (const u16*)(args.ws + WS_PROJ0); const size_t row = (size_t)b * SEQ + q; const int nk = 64 * (q / 64 + 1);
    for (int k = tid; k < nk; k += 256) { float sc = 0.f;
        for (int hh = 0; hh < 8; ++hh) { float l = 0.f; const u16* qp = P0 + row * P0W + C_QI + hh * 64; const u16* kp = P0 + ((size_t)b * SEQ + k) * P0W + C_KI;
            for (int d = 0; d < 64; ++d) l += h2f(qp[d]) * h2f(kp[d]);
            sc += h2f(P0[row * P0W + C_WI + hh]) * fmaxf(l, 0.f); }
        S.sh[k] = sc; }
    __syncthreads();
    for (int k = tid; k < nk; k += 256) { const float sk = S.sh[k]; int rank = 0; for (int k2 = 0; k2 < nk; ++k2) { const float s2 = S.sh[k2]; rank += (s2 > sk || (s2 == sk && k2 < k)) ? 1 : 0; } S.sel[k] = rank < TOPK ? 1 : 0; }
    __syncthreads();
}
__device__ __forceinline__ float naiveB_head(NaiveSh& S, const Args& args, int b, int q, int hd, int tid) {
    const u16* P0 = (const u16*)(args.ws + WS_PROJ0); const float* BT = (const float*)(args.ws + WS_BTG); const size_t row = (size_t)b * SEQ + q; const int nk = 64 * (q / 64 + 1);
    for (int k = tid; k < nk; k += 256) { float sacc = -1e30f;
        if (S.sel[k]) { sacc = 0.f; const u16* qp = P0 + row * P0W + C_QB + hd * 64; const u16* kp = P0 + ((size_t)b * SEQ + k) * P0W + C_KB;
            for (int d = 0; d < 64; ++d) sacc += h2f(qp[d]) * h2f(kp[d]);
            int rel = k - q; rel = rel < -128 ? -128 : rel; sacc += BT[(4 + hd) * 192 + rel + 128]; }
        S.sh[k] = sacc; }
    __syncthreads();
    const float ls = blk_softmax(S, nk, tid);
    float r = 0.f;
    if (tid < 64) { float a = 0.f; for (int k = 0; k < nk; ++k) a += S.sh[k] * h2f(P0[((size_t)b * SEQ + k) * P0W + C_VB + tid]); r = a / ls * h2f(P0[row * P0W + C_G0 + 512 + hd * 64 + tid]); }
    __syncthreads();
    return r;
}
__device__ __forceinline__ float naiveC(NaiveSh& S, const Args& args, int b, int q, int hd, int tid) {
    unsigned char* ws = args.ws; const size_t row = (size_t)b * SEQ + q; const int nk = 64 * (q / 64 + 1);
    const u16* Q1 = (const u16*)(ws + WS_Q1); const u16* KV = (const u16*)(ws + WS_KV1); const u16* KR = (const u16*)(ws + WS_KROPE);
    for (int k = tid; k < nk; k += 256) { float sacc = 0.f; const u16* qp = Q1 + row * 1536 + hd * 96; const size_t kr = (size_t)b * SEQ + k;
        for (int d = 0; d < 64; ++d) sacc += h2f(qp[d]) * h2f(KV[kr * 2048 + hd * 128 + d]);
        for (int d = 0; d < 32; ++d) sacc += h2f(qp[64 + d]) * h2f(KR[kr * 32 + d]);
        S.sh[k] = sacc; }
    __syncthreads();
    const float ls = blk_softmax(S, nk, tid);
    float r = 0.f;
    if (tid < 64) { float a = 0.f; for (int k = 0; k < nk; ++k) a += S.sh[k] * h2f(KV[((size_t)b * SEQ + k) * 2048 + hd * 128 + 64 + tid]); r = a / ls * h2f(((const u16*)(ws + WS_G1))[row * DM + hd * 64 + tid]); }
    __syncthreads();
    return r;
}
#if NAIVE_ATTN
__global__ void __launch_bounds__(256) naive_attn(Args args, int which) {
    __shared__ NaiveSh S; const int tid = threadIdx.x; unsigned char* ws = args.ws;
    if (which == 0) {
        for (int it = blockIdx.x; it < T * 5; it += gridDim.x) {
            const int row = it / 5, sub = it % 5, b = row / SEQ, q = row % SEQ;
            if (sub < 4) { const float v = naiveA(S, args, b, q, sub, tid); if (tid < 128) ((u16*)(ws + WS_MG0))[(size_t)row * DM + sub * 128 + tid] = (u16)(pkh(v, 0.f) & 0xffffu); }
            else { naiveB_select(S, args, b, q, tid);
                for (int hd = 0; hd < 8; ++hd) { const float v = naiveB_head(S, args, b, q, hd, tid); if (tid < 64) ((u16*)(ws + WS_MG0))[(size_t)row * DM + 512 + hd * 64 + tid] = (u16)(pkh(v, 0.f) & 0xffffu); } }
        }
    } else {
        for (int it = blockIdx.x; it < T * 16; it += gridDim.x) {
            const int row = it >> 4, hd = it & 15, b = row / SEQ, q = row % SEQ;
            const float v = naiveC(S, args, b, q, hd, tid); if (tid < 64) ((u16*)(ws + WS_MG1))[(size_t)row * DM + hd * 64 + tid] = (u16)(pkh(v, 0.f) & 0xffffu);
        }
    }
}
#endif

#if DEBUG_CHECK
constexpr size_t WS_DBG = 3 * MiB;
#ifndef DBG_BITS_MODE
#define DBG_BITS_MODE 1
#define DBG_BITS_IDS 14, 4, 5, 21, 22, 23
#endif
#ifndef DBG_SKIP_MASK
#define DBG_SKIP_MASK 0x10
#endif
#ifndef DBG_REPORT_ID
#define DBG_REPORT_ID 0
#endif
__device__ __forceinline__ unsigned dhash(unsigned x) { x ^= x >> 16; x *= 0x7feb352du; x ^= x >> 15; x *= 0x846ca68bu; x ^= x >> 16; return x; }
__device__ __forceinline__ void dbg_rec(unsigned char* ws, int id, float got, float ref, float scale) {
    float e = fabsf(got - ref) / (fabsf(ref) + scale); if (!(e == e)) e = 1e6f;
    atomicMax((unsigned*)(ws + WS_DBG) + id, __float_as_uint(e));
}
__device__ __forceinline__ float dh(const u16* p, size_t i) { return h2f(p[i]); }
__global__ void __launch_bounds__(256) dbg_check(Args args, int stage) {
    unsigned char* ws = args.ws; const int tid = threadIdx.x, bid = blockIdx.x, gid = bid * 256 + tid;
    if (stage == 0) { if (gid < 64) ((unsigned*)(ws + WS_DBG))[gid] = (gid == 44) ? 0xffffu : 0u; return; }
    if (stage == 1) {
        const unsigned h = dhash(gid * 7919u + 13u);
        { const int n = h % P0W, k = (h >> 12) % 1024; const int sc = wsrc_col(0, n); const float ref = sc < 0 ? 0.f : args.in[I_EWIN][(size_t)k * L0_SRC + sc] * wcol_scale(0, n);
          dbg_rec(ws, 1, dh((const u16*)(ws + WS_W0T), (size_t)n * 1024 + k), ref, 1e-3f); }
        { const int n = h % P1W, k = (h >> 12) % 1024; const int sc = wsrc_col(2, n); const float ref = sc < 0 ? 0.f : args.in[I_OWIN][(size_t)k * L1_SRC + sc] * args.in[I_ONORM][k];
          dbg_rec(ws, 1, dh((const u16*)(ws + WS_W1T), (size_t)n * 1024 + k), ref, 1e-3f); }
        { const int n = h % 1536, k = (h >> 12) % 384; const float ref = args.in[I_OWUQ][(size_t)k * 1536 + n] * args.in[I_OQNORM][k] * QS_C;
          dbg_rec(ws, 1, dh((const u16*)(ws + WS_WUQT), (size_t)n * 384 + k), ref, 1e-3f); }
        { const int n = h % 2048, k = (h >> 12) % 256; const float ref = args.in[I_OWUKV][(size_t)k * 2048 + n] * args.in[I_OKVNORM][k];
          dbg_rec(ws, 1, dh((const u16*)(ws + WS_WUKVT), (size_t)n * 256 + k), ref, 1e-3f); }
        { const int n = h % 1024, k = (h >> 12) % 1024; dbg_rec(ws, 1, dh((const u16*)(ws + WS_WO0T), (size_t)n * 1024 + k), args.in[I_EWO][(size_t)k * 1024 + n], 1e-3f);
          dbg_rec(ws, 1, dh((const u16*)(ws + WS_WO1T), (size_t)n * 1024 + k), args.in[I_OWO][(size_t)k * 1024 + n], 1e-3f); }
        { const int row = h % T, col = (h >> 15) % 1024; const float* xr = args.in[I_X] + (size_t)row * DM; float ss = 0.f; for (int k = 0; k < DM; ++k) ss += xr[k] * xr[k];
          const float ref = xr[col] * rsqrtf(ss / DM + RMS_EPS) * args.in[I_ENORM][col]; dbg_rec(ws, 2, dh((const u16*)(ws + WS_XN0), (size_t)row * DM + col), ref, 1e-2f); }
        return;
    }
    if (stage == 2) {
        const unsigned h = dhash(gid * 104729u + 7u); const int row = h % T; int col = (h >> 15) % P0W; if (gid & 1) col = C_G0 + (col & 1023); if ((gid & 7) == 2) col = C_KI + (col & 63);
        const u16* a = (const u16*)(ws + WS_XN0) + (size_t)row * DM; const u16* b = (const u16*)(ws + WS_W0T) + (size_t)col * 1024; float acc = 0.f;
        for (int k = 0; k < 1024; ++k) acc += h2f(a[k]) * h2f(b[k]);
        if (col >= C_G0) acc = acc / (1.f + expf(-acc));
        dbg_rec(ws, 3, dh((const u16*)(ws + WS_PROJ0), (size_t)row * P0W + col), acc, 2e-2f);
        return;
    }
    if (stage == 3) {
        __shared__ NaiveSh NS;
        const unsigned h = dhash(bid * 2654435761u + 99u);
        int q = h % SEQ; const int b = (h >> 12) % NB; if (bid % 5 == 0) q = q % 320;
        const size_t row = (size_t)b * SEQ + q;
        if (bid < 48) { const int hd = (h >> 20) % 4; const float ref = naiveA(NS, args, b, q, hd, tid);
            if (tid < 128) dbg_rec(ws, 4, dh((const u16*)(ws + WS_MG0), row * DM + hd * 128 + tid), ref, 2e-2f); }
        else { const int hd = (h >> 20) % 8; naiveB_select(NS, args, b, q, tid); const float ref = naiveB_head(NS, args, b, q, hd, tid);
            if (tid < 64) dbg_rec(ws, 5, dh((const u16*)(ws + WS_MG0), row * DM + 512 + hd * 64 + tid), ref, 2e-2f); }
        return;
    }
    if (stage == 4) {
        const unsigned h = dhash(gid * 15485863u + 3u); const int row = h % T, col = (h >> 15) % 1024;
        const u16* a = (const u16*)(ws + WS_MG0) + (size_t)row * DM; const u16* b = (const u16*)(ws + WS_WO0T) + (size_t)col * 1024; float acc = 0.f;
        for (int k = 0; k < 1024; ++k) acc += h2f(a[k]) * h2f(b[k]);
        const float ref = args.in[I_X][(size_t)row * DM + col] + acc;
        dbg_rec(ws, 6, args.out[(size_t)row * DM + col], ref, 1e-2f); dbg_rec(ws, 6, dh((const u16*)(ws + WS_XN0), (size_t)row * DM + col), ref, 1e-2f);
        if (gid < 2048) { float ss = 0.f; for (int k = 0; k < DM; ++k) { const float v = args.out[(size_t)row * DM + k]; ss += v * v; }
            dbg_rec(ws, 7, (float)((const u64*)(ws + WS_SSQ1))[row] / FXS, ss, 1e-3f); }
        return;
    }
    if (stage == 5) {
        const unsigned h = dhash(gid * 32452843u + 5u); const int row = h % T; int col = (h >> 15) % P1W; if ((gid & 3) == 1) col = 640 + (col & 31);
        if (col >= 672 && col < 768) col -= 200;
        const u16* a = (const u16*)(ws + WS_XN0) + (size_t)row * DM; float ss = 0.f; for (int k = 0; k < DM; ++k) { const float v = args.out[(size_t)row * DM + k]; ss += v * v; }
        const float rs = rsqrtf(ss / DM + RMS_EPS);
        auto dotc = [&](int c) { const u16* b = (const u16*)(ws + WS_W1T) + (size_t)c * 1024; float acc = 0.f; for (int k = 0; k < 1024; ++k) acc += h2f(a[k]) * h2f(b[k]); return acc * rs; };
        const float v = dotc(col);
        if (col < 640) dbg_rec(ws, 8, dh((const u16*)(ws + WS_LAT), (size_t)row * LATW + col), v, 2e-2f);
        else if (col < 672) { const int j = col - 640, pos = row & (SEQ - 1), i = j & 15; const float inv = (float)pow(10000.0, -(double)i / 16.0), ang = (float)pos * inv; const float cs = cosf(ang), sn = sinf(ang);
            const float other = dotc(j < 16 ? col + 16 : col - 16); const float ref = j < 16 ? v * cs - other * sn : other * sn + v * cs;
            dbg_rec(ws, 9, dh((const u16*)(ws + WS_KROPE), (size_t)row * 32 + j), ref, 2e-2f); }
        else dbg_rec(ws, 10, dh((const u16*)(ws + WS_G1), (size_t)row * DM + col - 768), v / (1.f + expf(-v)), 2e-2f);
        if (gid < 1024) { const u16* lat = (const u16*)(ws + WS_LAT) + (size_t)row * LATW; float s1 = 0.f, s2 = 0.f; for (int k = 0; k < 256; ++k) s1 += h2f(lat[k]) * h2f(lat[k]); for (int k = 256; k < 640; ++k) s2 += h2f(lat[k]) * h2f(lat[k]);
            dbg_rec(ws, 11, (float)((const u64*)(ws + WS_SSQKV))[row] / FXS, s1, 1e-2f); dbg_rec(ws, 11, (float)((const u64*)(ws + WS_SSQQ))[row] / FXS, s2, 1e-2f); }
        return;
    }
    if (stage == 6) {
        const unsigned h = dhash(gid * 49979687u + 11u); const int row = h % T; const u16* lat = (const u16*)(ws + WS_LAT) + (size_t)row * LATW;
        { const int col = (h >> 15) % 2048; float s1 = 0.f; for (int k = 0; k < 256; ++k) s1 += h2f(lat[k]) * h2f(lat[k]); const float rs = rsqrtf(s1 / 256.f + RMS_EPS);
          const u16* b = (const u16*)(ws + WS_WUKVT) + (size_t)col * 256; float acc = 0.f; for (int k = 0; k < 256; ++k) acc += h2f(lat[k]) * h2f(b[k]);
          dbg_rec(ws, 13, dh((const u16*)(ws + WS_KV1), (size_t)row * 2048 + col), acc * rs, 2e-2f); }
        { int col = (h >> 15) % 1536; if (gid & 1) col = (col / 96) * 96 + 64 + (col & 31);
          float s2 = 0.f; for (int k = 256; k < 640; ++k) s2 += h2f(lat[k]) * h2f(lat[k]); const float rs = rsqrtf(s2 / 384.f + RMS_EPS);
          auto dotc = [&](int c) { const u16* b = (const u16*)(ws + WS_WUQT) + (size_t)c * 384; float acc = 0.f; for (int k = 0; k < 384; ++k) acc += h2f(lat[256 + k]) * h2f(b[k]); return acc * rs; };
          float v = dotc(col); const int jj = col % 96;
          if (jj >= 64) { const int j = jj - 64, pos = row & (SEQ - 1), i = j & 15; const float inv = (float)pow(10000.0, -(double)i / 16.0), ang = (float)pos * inv; const float cs = cosf(ang), sn = sinf(ang);
              const float other = dotc(j < 16 ? col + 16 : col - 16); v = j < 16 ? v * cs - other * sn : other * sn + v * cs; }
          dbg_rec(ws, 12, dh((const u16*)(ws + WS_Q1), (size_t)row * 1536 + col), v, 2e-2f); }
        return;
    }
    if (stage == 7) {
        __shared__ NaiveSh NS;
        const unsigned h = dhash(bid * 2654435761u + 777u); int q = h % SEQ; const int b = (h >> 12) % NB, hd = (h >> 20) % 16; if (bid % 5 == 0) q = q % 320;
        const size_t row = (size_t)b * SEQ + q; const float ref = naiveC(NS, args, b, q, hd, tid);
        if (tid < 64) dbg_rec(ws, 14, dh((const u16*)(ws + WS_MG1), row * DM + hd * 64 + tid), ref, 2e-2f);
        { const float got = tid < 64 ? dh((const u16*)(ws + WS_MG1), row * DM + hd * 64 + tid) : 0.f; const bool bad = tid < 64 && fabsf(got - ref) / (fabsf(ref) + 2e-2f) > 0.05f;
          if (__syncthreads_or(bad ? 1 : 0) && tid == 0) { atomicAdd((unsigned*)(ws + WS_DBG) + 43, 1u); atomicMin((unsigned*)(ws + WS_DBG) + 44, (unsigned)(q / 64)); atomicMax((unsigned*)(ws + WS_DBG) + 45, (unsigned)(q / 64)); } }
        {
            const u16* Q1 = (const u16*)(ws + WS_Q1); const u16* KV = (const u16*)(ws + WS_KV1); const u16* KR = (const u16*)(ws + WS_KROPE); const float* db = (const float*)(ws + WS_DBGBUF) + 4096;
            for (int e = gid; e < 256 * 64; e += gridDim.x * 256) { const int qq = e >> 6, d = e & 63, qpos = 256 * TAPQB + qq, nkk = 64 * (qpos / 64 + 1); float mx = -1e30f, ls = 0.f, a = 0.f;
                const size_t rb = (size_t)TAPB * SEQ; const u16* qp = Q1 + (rb + qpos) * 1536 + TAPH * 96;
                for (int pass = 0; pass < 2; ++pass)
                for (int k = 0; k < nkk; ++k) { float sacc = 0.f; for (int dd = 0; dd < 64; ++dd) sacc += h2f(qp[dd]) * h2f(KV[(rb + k) * 2048 + TAPH * 128 + dd]);
                    for (int dd = 0; dd < 32; ++dd) sacc += h2f(qp[64 + dd]) * h2f(KR[(rb + k) * 32 + dd]);
                    if (pass == 0) mx = fmaxf(mx, sacc); else { const float p = exp2f(sacc - mx); ls += p; a += p * h2f(KV[(rb + k) * 2048 + TAPH * 128 + 64 + d]); } }
                dbg_rec(ws, 21 + (qq >> 6), db[e], a / ls, 2e-2f); }
        }
        if (bid == 0) {
            const u16* Q1 = (const u16*)(ws + WS_Q1); const u16* KV = (const u16*)(ws + WS_KV1); const u16* KR = (const u16*)(ws + WS_KROPE); const float* db = (const float*)(ws + WS_DBGBUF);
            for (int e = tid; e < 32 * 64; e += 256) { const int qq = e >> 6, k = e & 63; float sacc = 0.f;
                for (int d = 0; d < 64; ++d) sacc += h2f(Q1[(size_t)qq * 1536 + d]) * h2f(KV[(size_t)k * 2048 + d]);
                for (int d = 0; d < 32; ++d) sacc += h2f(Q1[(size_t)qq * 1536 + 64 + d]) * h2f(KR[(size_t)k * 32 + d]);
                dbg_rec(ws, 20, db[e], sacc, 2e-2f); dbg_rec(ws, 41, db[e], 0.f, 1.0f); dbg_rec(ws, 42, sacc, 0.f, 1.0f); }
            (void)0;
        }
        return;
    }
    if (stage == 9) {
        if (gid == 0) { const unsigned* e = (const unsigned*)(ws + WS_DBG);
            if (DBG_REPORT_ID >= 43 && DBG_REPORT_ID <= 45) { args.out[0] = 100.0f * (float)e[DBG_REPORT_ID] + 50.f; }
            else if (DBG_REPORT_ID == 40) { args.out[0] = 100.0f * (float)(e[40] / 32u) + 50.f; }
            else if (DBG_REPORT_ID > 0) { args.out[0] = 1000.0f * __uint_as_float(e[DBG_REPORT_ID]); }
            else if (DBG_BITS_MODE) { const int ids[6] = {DBG_BITS_IDS}; int v = 0; for (int i = 0; i < 6; ++i) if (ids[i] > 0 && __uint_as_float(e[ids[i]]) > 0.05f) v |= 1 << i; if (v) args.out[0] = 100.0f * v; }
            else { int first = 0; for (int id = 1; id < 32 && !first; ++id) if (!((DBG_SKIP_MASK >> id) & 1) && __uint_as_float(e[id]) > 0.05f) first = id; if (first) args.out[0] = 100.0f * first; } }
        return;
    }
}
#endif

constexpr int N_PHASES = 9;
__global__ void __launch_bounds__(NWAVES * 64) hybrid_fwd(Args args) {
    extern __shared__ __attribute__((aligned(16))) unsigned char lds_raw[];
    Frame F;
    F.lds = (LAS unsigned char*)lds_raw;
    F.MISC = (volatile LAS unsigned*)(F.lds + MISC_OFF);
    F.tid = threadIdx.x; F.lane = F.tid & 63; F.wave = __builtin_amdgcn_readfirstlane(F.tid >> 6);
    F.G = gridDim.x;
    F.out = args.out; F.ws = args.ws; F.ctl = (unsigned*)(args.ws + WS_CTL);
    for (int u = F.tid; u < (LDS_BYTES - RING_BYTES) / 4; u += NWAVES * 64) ((LAS unsigned*)(F.lds + RING_BYTES))[u] = 0u;
    __syncthreads();
    const int lo = args.ph_lo, hi = args.ph_hi;
    const bool multi = (hi - lo) > 1;
    XcdBarrier bar; bar.bar = F.ctl + CW_BAR; bar.x = 0; bar.st = nullptr;
    if (multi) bar = xcd_barrier_post(F.ctl + CW_BAR, F.MISC + 8);
#ifndef PH_MASK
#define PH_MASK 0x1FF
#endif
#define IN(k) (((PH_MASK >> (k)) & 1) && lo <= (k) && (k) < hi)
#define SEAM(k) do { if (IN(k) && IN((k) + 1)) xcd_barrier(bar); } while (0)
    unsigned char* ws = args.ws;
    LAS unsigned char* ring = F.lds;

#define PHASE1(rep) do { \
        pg8::Gemm g{(const u16*)(ws + WS_XN0), (const u16*)(ws + WS_W0T), T, P0W, 1024, 1024}; pg8::StaticOrder S; S.init(T, P0W, F.G, (int)blockIdx.x); \
        pg8::EpiProj0 E{(u16*)(ws + WS_PROJ0)}; \
        pg8::gemm_phase<pg8::EpiProj0>(ring, g, S, E); } while (0)
#define PHASE2(rep) do { if (!NAIVE_ATTN) { \
        for (;;) { \
            const int u = next_unit(F, (rep) ? CW_Q0 + 16 : CW_Q0); \
            if (u >= 2048) break; \
            const int lvl = 31 - (u >> 6), r = u & 63; \
            if (r < 32) { if (!((rep) && REPEAT_SUB == 1)) { const int c = 2 * lvl + 1 - (r >> 4), rr = r & 15; attnB_unit(F, rr >> 1, 2 * c + (rr & 1), (rep) ? REPEAT_SUB : 0); } } \
            else { if (!((rep) && REPEAT_SUB >= 2)) { const int idx = r - 32; attnA_unit(F, args, idx >> 2, idx & 3, lvl); } } \
        } \
        __syncthreads(); } } while (0)
#define PHASE3(rep) do { \
        pg8::Gemm g{(const u16*)(ws + WS_MG0), (const u16*)(ws + WS_WO0T), T, 1024, 1024, 1024}; pg8::StaticOrder S; S.init(T, 1024, F.G, (int)blockIdx.x); \
        pg8::EpiRes0 E{args.in[I_X], (u16*)(ws + WS_XN0), (rep) ? nullptr : (u64*)(ws + WS_SSQ1)}; \
        pg8::gemm_phase<pg8::EpiRes0>(ring, g, S, E); } while (0)
#define PHASE4(rep) do { \
        pg8::Gemm g{(const u16*)(ws + WS_XN0), (const u16*)(ws + WS_W1T), T, P1W, 1024, 1024}; pg8::StaticOrder S; S.init(T, P1W, F.G, (int)blockIdx.x); \
        pg8::EpiProj1 E{(const u64*)(ws + WS_SSQ1), (u16*)(ws + WS_LAT), (u16*)(ws + WS_KROPE), (u16*)(ws + WS_G1), (rep) ? nullptr : (u64*)(ws + WS_SSQKV), (rep) ? nullptr : (u64*)(ws + WS_SSQQ), (const float*)(ws + WS_ROPEC), (const float*)(ws + WS_ROPES)}; \
        pg8::gemm_phase<pg8::EpiProj1>(ring, g, S, E); } while (0)
#define PHASE5(rep) do { \
        { pg8::Gemm g{(const u16*)(ws + WS_LAT) + 256, (const u16*)(ws + WS_WUQT), T, 1536, 384, LATW}; pg8::StaticOrder S; S.init(T, 1536, F.G, (int)blockIdx.x); \
          pg8::EpiQ1 E{(const u64*)(ws + WS_SSQQ), (u16*)(ws + WS_Q1), (const float*)(ws + WS_ROPEC), (const float*)(ws + WS_ROPES)}; \
          pg8::gemm_phase<pg8::EpiQ1>(ring, g, S, E); } \
        { pg8::Gemm g{(const u16*)(ws + WS_LAT), (const u16*)(ws + WS_WUKVT), T, 2048, 256, LATW}; pg8::StaticOrder S; S.init(T, 2048, F.G, (int)blockIdx.x); \
          pg8::EpiKV1 E{(const u64*)(ws + WS_SSQKV), (u16*)(ws + WS_KV1)}; \
          pg8::gemm_phase<pg8::EpiKV1>(ring, g, S, E); } } while (0)
#define PHASE6(rep) do { if (!NAIVE_ATTN) { \
          \
          \
        const int xq = (int)(blockIdx.x & 7); \
        for (;;) { \
            const int u = next_unit(F, CW_Q1 + 32 * xq + ((rep) ? 16 : 0)); \
            if (u >= 256) break; \
            const int qb = 15 - ((u & 31) >> 1), hh = 2 * (u >> 5) + (u & 1); \
            if (rep) attnC_unit<REPEAT_SUB>(F, xq, hh, qb); else attnC_unit<0>(F, xq, hh, qb); \
        } \
        __syncthreads(); } } while (0)
#define PHASE7(rep) do { \
        pg8::Gemm g{(const u16*)(ws + WS_MG1), (const u16*)(ws + WS_WO1T), T, 1024, 1024, 1024}; pg8::StaticOrder S; S.init(T, 1024, F.G, (int)blockIdx.x); \
        pg8::EpiRes1 E{(const u16*)(ws + WS_XN0), (u16*)(ws + WS_X2H)}; \
        pg8::gemm_phase<pg8::EpiRes1>(ring, g, S, E); } while (0)
#define REPEAT(k, CALL) do { if (REPEAT_PHASE == (k) && multi) { xcd_barrier(bar); CALL; } } while (0)
    if (IN(0)) { p0_prologue(F, args); REPEAT(0, p0_prologue(F, args)); } SEAM(0);
    if (IN(1)) { PHASE1(0); REPEAT(1, PHASE1(1)); } SEAM(1);
    if (IN(2)) { PHASE2(0); REPEAT(2, PHASE2(1)); } SEAM(2);
    if (IN(3)) { PHASE3(0); REPEAT(3, PHASE3(1)); } SEAM(3);
    if (IN(4)) { PHASE4(0); REPEAT(4, PHASE4(1)); } SEAM(4);
    if (IN(5)) { PHASE5(0); REPEAT(5, PHASE5(1)); } SEAM(5);
    if (IN(6)) { PHASE6(0); REPEAT(6, PHASE6(1)); } SEAM(6);
    if (IN(7)) { PHASE7(0); } SEAM(7);
    if (IN(8)) { p8_final(F, args); }
#if UBENCH
    {
        f32x16 a0, a1, a2, a3; h8 ha, hb; float x[16];
#pragma unroll
        for (int r = 0; r < 16; ++r) { a0[r] = 0.f; a1[r] = 0.f; a2[r] = 0.f; a3[r] = 0.f; x[r] = (float)r; }
#pragma unroll
        for (int r = 0; r < 8; ++r) { ha[r] = (_Float16)0.5f; hb[r] = (_Float16)0.25f; }
        float ca = 0.999f, cb = 0.001f; asm volatile("" : "+v"(ca), "+v"(cb));
        const bool doM = (UBENCH == 1 || UBENCH == 3 || ((UBENCH == 4 || UBENCH == 5) && F.wave < 4));
        const bool doV = (UBENCH == 2 || UBENCH == 3 || ((UBENCH == 4 || UBENCH == 6) && F.wave >= 4));
#define UB_M(A) asm volatile("v_mfma_f32_32x32x16_f16 %0, %1, %2, %0" : "+v"(A) : "v"(ha), "v"(hb))
#define UB_V8(o_) do { _Pragma("unroll") for (int i_ = 0; i_ < 8; ++i_) asm volatile("v_fma_f32 %0, %0, %1, %2" : "+v"(x[(o_) + i_]) : "v"(ca), "v"(cb)); } while (0)
        if (doM && doV) {
#pragma unroll 1
            for (int it = 0; it < 400; ++it) {
#pragma unroll
                for (int k = 0; k < 4; ++k) { UB_M(a0); UB_V8(0); UB_M(a1); UB_V8(8); UB_M(a2); UB_V8(0); UB_M(a3); UB_V8(8); } }
        } else if (doM) {
#pragma unroll 1
            for (int it = 0; it < 400; ++it) {
#pragma unroll
                for (int k = 0; k < 4; ++k) { UB_M(a0); UB_M(a1); UB_M(a2); UB_M(a3); } }
        } else if (doV) {
#pragma unroll 1
            for (int it = 0; it < 400; ++it) {
#pragma unroll
                for (int k = 0; k < 8; ++k) { UB_V8(0); UB_V8(8); } }
        }
#undef UB_M
#undef UB_V8
        asm volatile("" :: "v"(a0), "v"(a1), "v"(a2), "v"(a3));
#pragma unroll
        for (int r = 0; r < 16; ++r) asm volatile("" :: "v"(x[r]));
    }
#endif
#undef IN
#undef SEAM
}

extern "C" void kernel_launch(void* const* d_in, const int* in_sizes, int n_in, void* d_out, int out_size, void* d_ws, size_t ws_size, hipStream_t stream) {
    static int grid = 0;
    if (grid == 0) {
        if (n_in != 18 || in_sizes[0] != T * DM || out_size != T * DM || ws_size < WS_END) {
            fprintf(stderr, "kernel_launch: unexpected shapes (n_in %d, in0 %d, out %d, ws %zu, need %zu); nothing launched\n", n_in, n_in > 0 ? in_sizes[0] : -1, out_size, ws_size, (size_t)WS_END); grid = -1; return; }
        int dev = 0, cus = 0, per_cu = 0;
        if (hipGetDevice(&dev) != hipSuccess || hipDeviceGetAttribute(&cus, hipDeviceAttributeMultiprocessorCount, dev) != hipSuccess) { fprintf(stderr, "kernel_launch: device query failed\n"); grid = -1; return; }
        if (hipFuncSetAttribute((const void*)hybrid_fwd, hipFuncAttributeMaxDynamicSharedMemorySize, LDS_BYTES) != hipSuccess) { fprintf(stderr, "kernel_launch: hipFuncSetAttribute failed\n"); grid = -1; return; }
        if (hipOccupancyMaxActiveBlocksPerMultiprocessor(&per_cu, (const void*)hybrid_fwd, NWAVES * 64, LDS_BYTES) != hipSuccess || per_cu < 1)
            fprintf(stderr, "kernel_launch: note: occupancy query reports %d workgroups per CU\n", per_cu);
        (void)hipGetLastError();
        grid = cus;
        if (grid % 8 != 0) grid -= grid % 8;
    }
    if (grid <= 0) return;
    (void)hipMemsetAsync((char*)d_ws + WS_CTL, 0, CTL_ZERO_BYTES, stream);
    Args a{};
    for (int i = 0; i < 18; ++i) a.in[i] = (const float*)d_in[i];
    a.out = (float*)d_out; a.ws = (unsigned char*)d_ws;
#if MK_N_LAUNCHES == 1
    a.ph_lo = 0; a.ph_hi = N_PHASES;
    hipLaunchKernelGGL(hybrid_fwd, dim3(grid), dim3(NWAVES * 64), LDS_BYTES, stream, a);
#else
#if DEBUG_CHECK
    hipLaunchKernelGGL(dbg_check, dim3(1), dim3(256), 0, stream, a, 0);
#endif
    for (int p = 0; p < N_PHASES; ++p) { a.ph_lo = p; a.ph_hi = p + 1;
#if NAIVE_ATTN
        if (p == 2) { hipLaunchKernelGGL(naive_attn, dim3(8192), dim3(256), 0, stream, a, 0); continue; }
        if (p == 6) { hipLaunchKernelGGL(naive_attn, dim3(8192), dim3(256), 0, stream, a, 1); continue; }
#endif
        hipLaunchKernelGGL(hybrid_fwd, dim3(grid), dim3(NWAVES * 64), LDS_BYTES, stream, a);
#if DEBUG_CHECK
        if (p <= 6) hipLaunchKernelGGL(dbg_check, dim3((p == 2 || p == 6) ? 96 : 64), dim3(256), 0, stream, a, p + 1);
#endif
    }
#if DEBUG_CHECK
    hipLaunchKernelGGL(dbg_check, dim3(1), dim3(256), 0, stream, a, 9);
#endif
#endif
    const hipError_t le = hipPeekAtLastError();
    if (le != hipSuccess) fprintf(stderr, "kernel_launch: launch failed: %s\n", hipGetErrorName(le));
}
```
